# Optimizing an MI355X kernel written in HIP

```python
import jax, jax.numpy as jnp
from jax import lax
import numpy as np

D_MODEL = 2048
BATCH = 1
SEQ = 8192
DEPTH = 1

D_MIX = D_MODEL
D_CONF = D_MIX // 2
D_SC = D_MIX - D_CONF
CONF_KERNEL = 31
SC_KERNEL = 3
D_IN_PROJ = 2 * D_CONF + 3 * D_SC
PEER_HEADS = 8
N_KEYS = 128
N_EXPERTS = N_KEYS * N_KEYS
D_KEY = 256
D_HALF = D_KEY // 2
TOPK_HALF = 16
TOPK = 16
TOKEN_BLOCK = 128
LN_EPS = 1e-5
DEEPNORM_ALPHA = (2.0 * DEPTH) ** 0.25
DEEPNORM_BETA = (8.0 * DEPTH) ** -0.25

kernel_name = 'hybrid_conformer_shortconv_peer_layer'


def layer_norm(x, g, b):
    xf = x.astype(jnp.float32)
    mu = jnp.mean(xf, axis=-1, keepdims=True)
    var = jnp.mean(jnp.square(xf - mu), axis=-1, keepdims=True)
    y = (xf - mu) * lax.rsqrt(var + LN_EPS) * g.astype(jnp.float32) + b.astype(jnp.float32)
    return y.astype(x.dtype)


def causal_depthwise_conv(x, w, b):
    k, c = w.shape
    y = lax.conv_general_dilated(
        x, w[:, None, :].astype(x.dtype), window_strides=(1,), padding=[(k - 1, 0)],
        dimension_numbers=('NWC', 'WIO', 'NWC'), feature_group_count=c)
    return y + b


def peer_block(x_tok, w_q, sub_keys, peer_u, peer_v):
    t = x_tok.shape[0]
    q = (x_tok @ w_q).reshape(t, PEER_HEADS, 2, D_HALF)
    s = jnp.einsum('thpc,hpnc->thpn', q, sub_keys).astype(jnp.float32)
    s1, i1 = lax.top_k(s[:, :, 0], TOPK_HALF)
    s2, i2 = lax.top_k(s[:, :, 1], TOPK_HALF)
    cand = (s1[..., :, None] + s2[..., None, :]).reshape(t, PEER_HEADS, TOPK_HALF * TOPK_HALF)
    top_s, ci = lax.top_k(cand, TOPK)
    e1 = jnp.take_along_axis(i1, ci // TOPK_HALF, axis=-1)
    e2 = jnp.take_along_axis(i2, ci % TOPK_HALF, axis=-1)
    experts = e1 * N_KEYS + e2
    g = jax.nn.softmax(top_s, axis=-1)
    u_sel = peer_u[experts]
    act = jax.nn.gelu(jnp.einsum('td,thkd->thk', x_tok, u_sel), approximate=False)
    coef = act * g.astype(act.dtype)
    v_sel = peer_v[experts]
    return jnp.einsum('thk,thkd->td', coef, v_sel)


def setup_inputs(seed: int = 0) -> dict:
    key = jax.random.key(seed)
    ks = jax.random.split(key, 20)
    f32 = jnp.float32
    L = DEPTH

    def nrm(k, shape, scale):
        return jax.random.normal(k, shape, f32) * scale

    return {
        'x': jax.random.normal(ks[0], (BATCH, SEQ, D_MODEL), f32),
        'w_in': nrm(ks[1], (L, D_MODEL, D_IN_PROJ), D_MODEL ** -0.5),
        'b_in': nrm(ks[2], (L, D_IN_PROJ), 0.02),
        'conf_conv_w': nrm(ks[3], (L, CONF_KERNEL, D_CONF), CONF_KERNEL ** -0.5),
        'conf_conv_b': nrm(ks[4], (L, D_CONF), 0.02),
        'conf_ln_g': 1.0 + nrm(ks[5], (L, D_CONF), 0.02),
        'conf_ln_b': nrm(ks[6], (L, D_CONF), 0.02),
        'sc_conv_w': nrm(ks[7], (L, SC_KERNEL, D_SC), SC_KERNEL ** -0.5),
        'sc_conv_b': nrm(ks[8], (L, D_SC), 0.02),
        'w_out': nrm(ks[9], (L, D_MIX, D_MODEL), D_MIX ** -0.5 * DEEPNORM_BETA),
        'b_out': nrm(ks[10], (L, D_MODEL), 0.02),
        'ln1_g': 1.0 + nrm(ks[11], (L, D_MODEL), 0.02),
        'ln1_b': nrm(ks[12], (L, D_MODEL), 0.02),
        'w_q': nrm(ks[13], (L, D_MODEL, PEER_HEADS * D_KEY), D_MODEL ** -0.5),
        'sub_keys': nrm(ks[14], (L, PEER_HEADS, 2, N_KEYS, D_HALF), D_HALF ** -0.5),
        'peer_u': nrm(ks[15], (L, N_EXPERTS, D_MODEL), D_MODEL ** -0.5),
        'peer_v': nrm(ks[16], (L, N_EXPERTS, D_MODEL), DEEPNORM_BETA),
        'ln2_g': 1.0 + nrm(ks[17], (L, D_MODEL), 0.02),
        'ln2_b': nrm(ks[18], (L, D_MODEL), 0.02),
    }


def reference(x, w_in, b_in, conf_conv_w, conf_conv_b, conf_ln_g, conf_ln_b,
              sc_conv_w, sc_conv_b, w_out, b_out, ln1_g, ln1_b,
              w_q, sub_keys, peer_u, peer_v, ln2_g, ln2_b):
    splits = [D_CONF, 2 * D_CONF, 2 * D_CONF + D_SC, 2 * D_CONF + 2 * D_SC]
    for l in range(DEPTH):
        h = x @ w_in[l] + b_in[l]
        a_val, a_gate, sc_b, sc_c, sc_h = jnp.split(h, splits, axis=-1)
        a = a_val * jax.nn.sigmoid(a_gate)
        a = causal_depthwise_conv(a, conf_conv_w[l], conf_conv_b[l])
        a = jax.nn.silu(layer_norm(a, conf_ln_g[l], conf_ln_b[l]))
        s = sc_b * causal_depthwise_conv(sc_c * sc_h, sc_conv_w[l], sc_conv_b[l])
        y = jnp.concatenate([a, s], axis=-1) @ w_out[l] + b_out[l]
        x = layer_norm(DEEPNORM_ALPHA * x + y, ln1_g[l], ln1_b[l])
        x_blocks = x.reshape(-1, TOKEN_BLOCK, D_MODEL)
        wq_l, sk_l, u_l, v_l = w_q[l], sub_keys[l], peer_u[l], peer_v[l]
        f = lax.map(lambda xb: peer_block(xb, wq_l, sk_l, u_l, v_l), x_blocks)
        f = f.reshape(x.shape)
        x = layer_norm(DEEPNORM_ALPHA * x + f, ln2_g[l], ln2_b[l])
    return x
```

```cpp
#include <hip/hip_runtime.h>
#include <cstdio>
#include <cstdint>
namespace pg8 {
#define PG8_LAS __attribute__((address_space(3)))
typedef unsigned short bf16_t;
typedef short bf16x8 __attribute__((ext_vector_type(8)));
typedef float f32x4 __attribute__((ext_vector_type(4)));
typedef unsigned u32x4 __attribute__((ext_vector_type(4)));
constexpr int BM = 256, BK = 64, HALF = 128, HTB = HALF * BK * 2  , STAGE_BYTES = 8 * HTB, NXCD = 8, WGM = 8;

__host__ __device__ __forceinline__ int lds_byte(int r, int c) { const int st = (r >> 4) * 2 + (c >> 5), rr = r & 15, cc = c & 31, ob = rr * 64 + cc * 2; return st * 1024 + (ob ^ (((ob >> 9) & 1) << 5)); }
__host__ __device__ __forceinline__ void stage_rc(int b, int& R, int& C) { const int st = b / 1024, sb = b % 1024, swz = sb ^ (((sb >> 9) & 1) << 5); R = (st >> 1) * 16 + swz / 64; C = (st & 1) * 32 + (swz % 64) / 2; }
__host__ __device__ __forceinline__ int perm32(int rho) { const int n = rho >> 4, i = rho & 15; return 8 * (i >> 2) + 4 * n + (i & 3); }

struct Unit { int pm, pn; };
struct Gemm { const bf16_t* A; const bf16_t* Bt; int M, N, K; };

struct StaticOrder {
    int nM, nN, nwg, G, c;
    __host__ __device__ void init(int M, int N, int G_, int c_) { nM = M / BM; nN = N / BM; nwg = nM * nN; G = G_; c = c_; }
    __host__ __device__ bool next(int i, Unit& u) const {
        const long L = (long)i * G + c; if (L >= nwg) return false;
        int wgid = (int)L; { const int q = nwg / NXCD, r = nwg % NXCD, xcd = wgid % NXCD, off = wgid / NXCD; wgid = (xcd < r ? xcd * (q + 1) : r * (q + 1) + (xcd - r) * q) + off; }
        const int nig = WGM * nN, gid = wgid / nig, fm = gid * WGM, gsz = (nM - fm) < WGM ? (nM - fm) : WGM;
        u.pm = fm + ((wgid % nig) % gsz); u.pn = (wgid % nig) / gsz; return true;
    }
    __device__ __forceinline__ void a_ready(const Unit&) const {}
    __device__ __forceinline__ void done(const Unit&) const {}
};

__device__ __forceinline__ unsigned cvt_pk_bf16(float lo, float hi) { unsigned r; asm volatile("v_cvt_pk_bf16_f32 %0, %1, %2" : "=v"(r) : "v"(lo), "v"(hi)); return r; }
__device__ __forceinline__ float sigmoidf_fast(float g) { return __builtin_amdgcn_rcpf(1.0f + __expf(-g)); }

struct EpiInProj {
    static constexpr bool PERM = true, AFTER_DRAIN = false;
    bf16_t* aglu; bf16_t* cv; bf16_t* scb; const float* b_in;
    __device__ __forceinline__ void operator()(const f32x4 (&acc)[2][2][4][2], const Unit& u, int wr, int wc, int fr, int fq) const {
        const int row0 = u.pm * BM + wr * 64 + fr, cc = wc * 32 + 8 * fq;
        if (u.pn < 16) {
            const bool conf = u.pn < 8; const int j = conf ? u.pn : u.pn - 8;
            const float* b0 = b_in + (conf ? 0 : 3072) + 128 * j + cc;
            const float* b1 = b_in + (conf ? 1024 : 4096) + 128 * j + cc;
            bf16_t* O = (conf ? aglu : cv) + 128 * j + cc;
            f32x4 bv0[2], bv1[2];
#pragma unroll
            for (int n = 0; n < 2; ++n) { bv0[n] = *(const f32x4*)(b0 + 4 * n); bv1[n] = *(const f32x4*)(b1 + 4 * n); }
#pragma unroll
            for (int ai = 0; ai < 2; ++ai)
#pragma unroll
                for (int m = 0; m < 4; ++m) {
                    f32x4 r[2];
#pragma unroll
                    for (int n = 0; n < 2; ++n) { const f32x4 a = acc[ai][0][m][n] + bv0[n]; f32x4 g = acc[ai][1][m][n] + bv1[n];
                        if (conf) { g[0] = sigmoidf_fast(g[0]); g[1] = sigmoidf_fast(g[1]); g[2] = sigmoidf_fast(g[2]); g[3] = sigmoidf_fast(g[3]); }
                        r[n] = a * g; }
                    u32x4 w; w.x = cvt_pk_bf16(r[0][0], r[0][1]); w.y = cvt_pk_bf16(r[0][2], r[0][3]); w.z = cvt_pk_bf16(r[1][0], r[1][1]); w.w = cvt_pk_bf16(r[1][2], r[1][3]);
                    *(u32x4*)(O + (size_t)(row0 + ai * HALF + m * 16) * 1024) = w; }
        } else {
            const int j = u.pn - 16;
#pragma unroll
            for (int bj = 0; bj < 2; ++bj) {
                const float* b0 = b_in + 2048 + 256 * j + 128 * bj + cc; bf16_t* O = scb + 256 * j + 128 * bj + cc;
                const f32x4 bva = *(const f32x4*)(b0), bvb = *(const f32x4*)(b0 + 4);
#pragma unroll
                for (int ai = 0; ai < 2; ++ai)
#pragma unroll
                    for (int m = 0; m < 4; ++m) { const f32x4 v0 = acc[ai][bj][m][0] + bva, v1 = acc[ai][bj][m][1] + bvb;
                        u32x4 w; w.x = cvt_pk_bf16(v0[0], v0[1]); w.y = cvt_pk_bf16(v0[2], v0[3]); w.z = cvt_pk_bf16(v1[0], v1[1]); w.w = cvt_pk_bf16(v1[2], v1[3]);
                        *(u32x4*)(O + (size_t)(row0 + ai * HALF + m * 16) * 1024) = w; } }
        }
    }
};
struct EpiOutProj {
    static constexpr bool PERM = false, AFTER_DRAIN = false;
    float* Y; const float* bias; const float* x; float alpha;
    __device__ __forceinline__ void operator()(const f32x4 (&acc)[2][2][4][2], const Unit& u, int wr, int wc, int fr, int fq) const {
        const int row0 = u.pm * BM + wr * 64 + fr, col0 = u.pn * BM + wc * 32 + 4 * fq;
        f32x4 bv[2][2];
#pragma unroll
        for (int bj = 0; bj < 2; ++bj)
#pragma unroll
            for (int n = 0; n < 2; ++n) bv[bj][n] = *(const f32x4*)(bias + col0 + bj * HALF + n * 16);
#pragma unroll
        for (int ai = 0; ai < 2; ++ai)
#pragma unroll
            for (int m = 0; m < 4; ++m) { const size_t off = (size_t)(row0 + ai * HALF + m * 16) * 2048 + col0;
#pragma unroll
                for (int bj = 0; bj < 2; ++bj)
#pragma unroll
                    for (int n = 0; n < 2; ++n) { const f32x4 xv = *(const f32x4*)(x + off + bj * HALF + n * 16);
                        *(f32x4*)(Y + off + bj * HALF + n * 16) = acc[ai][bj][m][n] + bv[bj][n] + xv * alpha; }
                asm volatile("" ::: "memory"); }
    }
};
struct EpiF32 {
    static constexpr bool PERM = false, AFTER_DRAIN = false;
    float* C; int ldc;
    __device__ __forceinline__ void operator()(const f32x4 (&acc)[2][2][4][2], const Unit& u, int wr, int wc, int fr, int fq) const {
        const int row0 = u.pm * BM + wr * 64 + fr, col0 = u.pn * BM + wc * 32 + 4 * fq;
#pragma unroll
        for (int ai = 0; ai < 2; ++ai)
#pragma unroll
            for (int m = 0; m < 4; ++m) { float* rowp = C + (size_t)(row0 + ai * HALF + m * 16) * ldc + col0;
#pragma unroll
                for (int bj = 0; bj < 2; ++bj)
#pragma unroll
                    for (int n = 0; n < 2; ++n) *(f32x4*)(rowp + bj * HALF + n * 16) = acc[ai][bj][m][n]; }
    }
};

template <class Epi, class Sched, bool ALIGN_EPI = false, bool SP2 = false>
__device__ __forceinline__ void gemm_phase(PG8_LAS unsigned char* lds, const Gemm g, const Sched& S, const Epi& E) {
    const int tid = threadIdx.x, wid = __builtin_amdgcn_readfirstlane(tid >> 6), lane = tid & 63, wr = wid >> 2, wc = wid & 3, fr = lane & 15, fq = lane >> 4;
    const int K = g.K, nt = K / BK;
    unsigned voffA[2], voffB[2];
#pragma unroll
    for (int i = 0; i < 2; ++i) { int R, C; stage_rc(tid * 16 + i * 8192, R, C); const int Rb = Epi::PERM ? ((R & ~31) + perm32(R & 31)) : R;
        voffA[i] = (unsigned)(R * K + C) * 2u; voffB[i] = (unsigned)(Rb * K + C) * 2u; }
    const size_t kstep = (size_t)(BK * 2);
    const size_t hstep = (size_t)HALF * K * 2;
    const size_t tstep = 2 * hstep;
    const unsigned ldsw = (unsigned)wid * 1024u;
    const int aoff = lds_byte(wr * 64 + fr, fq * 8), boff = lds_byte(wc * 32 + fr, fq * 8);
#define PG8_SA(b, h) (((b) * 2 + (h)) * HTB)
#define PG8_SB(b, h) ((4 + (b) * 2 + (h)) * HTB)
#define PG8_STAGE(bufoff, gbase, voff) do { _Pragma("unroll") for (int _i = 0; _i < 2; ++_i) \
        __builtin_amdgcn_global_load_lds((const unsigned*)((const char*)(gbase) + (voff)[_i]), (PG8_LAS unsigned*)(lds + (bufoff) + ldsw + _i * 8192), 16, 0, 0); } while (0)
#define PG8_LDA(dst, b, h) do { _Pragma("unroll") for (int m = 0; m < 4; ++m) _Pragma("unroll") for (int k = 0; k < 2; ++k) dst[m][k] = *(const PG8_LAS bf16x8*)(lds + PG8_SA(b, h) + aoff + m * 2048 + k * 1024); } while (0)
#define PG8_LDB(dst, b, h) do { _Pragma("unroll") for (int n = 0; n < 2; ++n) _Pragma("unroll") for (int k = 0; k < 2; ++k) dst[n][k] = *(const PG8_LAS bf16x8*)(lds + PG8_SB(b, h) + boff + n * 2048 + k * 1024); } while (0)
#define PG8_MMA(ai, bj, At, Bt) do { __builtin_amdgcn_s_setprio(1); _Pragma("unroll") for (int m = 0; m < 4; ++m) _Pragma("unroll") for (int n = 0; n < 2; ++n) _Pragma("unroll") for (int k = 0; k < 2; ++k) \
        acc[ai][bj][m][n] = __builtin_amdgcn_mfma_f32_16x16x32_bf16(Bt[n][k], At[m][k], acc[ai][bj][m][n], 0, 0, 0); __builtin_amdgcn_s_setprio(0); } while (0)
#define PG8_WAIT_V(n) asm volatile("s_waitcnt vmcnt(" #n ")" ::: "memory")
#define PG8_WAIT_L(n) asm volatile("s_waitcnt lgkmcnt(" #n ")" ::: "memory")
#define PG8_BAR __builtin_amdgcn_s_barrier()
#define PG8_SCHED __builtin_amdgcn_sched_barrier(0)
    Unit cur, nxt; int ui = 0;
    if (!S.next(0, cur)) return;
    f32x4 acc[2][2][4][2];
#pragma unroll
    for (int a = 0; a < 2; ++a)
#pragma unroll
        for (int b = 0; b < 2; ++b)
#pragma unroll
            for (int m = 0; m < 4; ++m)
#pragma unroll
                for (int n = 0; n < 2; ++n) acc[a][b][m][n] = (f32x4){0.f, 0.f, 0.f, 0.f};
    bf16x8 At[4][2], B0[2][2], B1[2][2];
    const char* cA = (const char*)g.A + (size_t)cur.pm * tstep; const char* cB = (const char*)g.Bt + (size_t)cur.pn * tstep;
    S.a_ready(cur);
    if constexpr (SP2) {
        PG8_STAGE(PG8_SB(0, 0), cB, voffB); PG8_STAGE(PG8_SB(0, 1), cB + hstep, voffB); PG8_STAGE(PG8_SA(0, 0), cA, voffA); PG8_STAGE(PG8_SA(0, 1), cA + hstep, voffA);
        if (wr == 1) PG8_BAR;
        PG8_WAIT_V(2); PG8_BAR;
        PG8_STAGE(PG8_SB(1, 0), cB + kstep, voffB); PG8_STAGE(PG8_SA(1, 0), cA + kstep, voffA); PG8_STAGE(PG8_SB(1, 1), cB + hstep + kstep, voffB);
        PG8_WAIT_V(6); PG8_BAR;
    } else {
        PG8_STAGE(PG8_SB(0, 0), cB, voffB); PG8_STAGE(PG8_SA(0, 0), cA, voffA); PG8_STAGE(PG8_SB(0, 1), cB + hstep, voffB); PG8_STAGE(PG8_SA(0, 1), cA + hstep, voffA);
        if (wr == 1) PG8_BAR;
        PG8_WAIT_V(4); PG8_BAR;
        PG8_STAGE(PG8_SB(1, 0), cB + kstep, voffB); PG8_STAGE(PG8_SA(1, 0), cA + kstep, voffA); PG8_STAGE(PG8_SB(1, 1), cB + hstep + kstep, voffB);
        PG8_WAIT_V(6); PG8_BAR;
    }
    for (;;) {
        const bool has_next = S.next(ui + 1, nxt);
        const char* nA = has_next ? (const char*)g.A + (size_t)nxt.pm * tstep : cA; const char* nB = has_next ? (const char*)g.Bt + (size_t)nxt.pn * tstep : cB;
        for (int t = 0; t < nt; t += 2) {
            const bool last = (t == nt - 2);
            const char* a1 = cA + (size_t)(t + 1) * kstep;
            const char* a2 = last ? nA : cA + (size_t)(t + 2) * kstep; const char* b2 = last ? nB : cB + (size_t)(t + 2) * kstep;
            const char* a3 = a2 + kstep; const char* b3 = b2 + kstep;
            if (last && has_next) S.a_ready(nxt);
            if constexpr (SP2) {
            PG8_LDB(B0, 0, 0); PG8_LDB(B1, 0, 1); PG8_SCHED; PG8_LDA(At, 0, 0); PG8_STAGE(PG8_SA(1, 1), a1 + hstep, voffA);
            PG8_WAIT_V(8); PG8_WAIT_L(0); PG8_BAR; PG8_MMA(0, 0, At, B0); PG8_MMA(0, 1, At, B1); PG8_BAR; PG8_SCHED;
            PG8_LDA(At, 0, 1); PG8_STAGE(PG8_SB(0, 0), b2, voffB); PG8_STAGE(PG8_SB(0, 1), b2 + hstep, voffB); PG8_STAGE(PG8_SA(0, 0), a2, voffA);
            PG8_WAIT_V(8); PG8_WAIT_L(0); PG8_BAR; PG8_MMA(1, 0, At, B0); PG8_MMA(1, 1, At, B1); PG8_BAR; PG8_SCHED;
            PG8_LDB(B0, 1, 0); PG8_LDB(B1, 1, 1); PG8_SCHED; PG8_LDA(At, 1, 0); PG8_STAGE(PG8_SA(0, 1), a2 + hstep, voffA);
            PG8_WAIT_V(8); PG8_WAIT_L(0); PG8_BAR; PG8_MMA(0, 0, At, B0); PG8_MMA(0, 1, At, B1); PG8_BAR; PG8_SCHED;
            PG8_LDA(At, 1, 1); PG8_STAGE(PG8_SB(1, 0), b3, voffB); PG8_STAGE(PG8_SB(1, 1), b3 + hstep, voffB); PG8_STAGE(PG8_SA(1, 0), a3, voffA);
            PG8_WAIT_V(8); PG8_WAIT_L(0); PG8_BAR; PG8_MMA(1, 0, At, B0); PG8_MMA(1, 1, At, B1); PG8_BAR; PG8_SCHED;
            } else {
            PG8_LDB(B0, 0, 0); PG8_SCHED; PG8_LDA(At, 0, 0); PG8_STAGE(PG8_SA(1, 1), a1 + hstep, voffA);
            PG8_WAIT_L(8); PG8_BAR; PG8_WAIT_L(0); PG8_MMA(0, 0, At, B0); PG8_BAR; PG8_SCHED;
            PG8_LDB(B1, 0, 1); PG8_STAGE(PG8_SB(0, 0), b2, voffB);
            PG8_BAR; PG8_WAIT_L(0); PG8_MMA(0, 1, At, B1); PG8_BAR;
            PG8_LDA(At, 0, 1); PG8_STAGE(PG8_SA(0, 0), a2, voffA);
            PG8_BAR; PG8_WAIT_L(0); PG8_MMA(1, 0, At, B0); PG8_BAR; PG8_SCHED;
            PG8_STAGE(PG8_SB(0, 1), b2 + hstep, voffB);
            PG8_WAIT_V(6); PG8_BAR; PG8_MMA(1, 1, At, B1); PG8_BAR;
            PG8_LDB(B0, 1, 0); PG8_SCHED; PG8_LDA(At, 1, 0); PG8_STAGE(PG8_SA(0, 1), a2 + hstep, voffA);
            PG8_WAIT_L(8); PG8_BAR; PG8_WAIT_L(0); PG8_MMA(0, 0, At, B0); PG8_BAR; PG8_SCHED;
            PG8_LDB(B1, 1, 1); PG8_STAGE(PG8_SB(1, 0), b3, voffB);
            PG8_BAR; PG8_WAIT_L(0); PG8_MMA(0, 1, At, B1); PG8_BAR;
            PG8_LDA(At, 1, 1); PG8_STAGE(PG8_SA(1, 0), a3, voffA);
            PG8_BAR; PG8_WAIT_L(0); PG8_MMA(1, 0, At, B0); PG8_BAR; PG8_SCHED;
            PG8_STAGE(PG8_SB(1, 1), b3 + hstep, voffB);
            PG8_WAIT_V(6); PG8_BAR; PG8_MMA(1, 1, At, B1); PG8_BAR;
            }
        }
        if constexpr (ALIGN_EPI) { if (wr == 0) PG8_BAR; }
        if constexpr (!Epi::AFTER_DRAIN) { E(acc, cur, wr, wc, fr, fq); S.done(cur); }
        if (!has_next) break;
#pragma unroll
        for (int a = 0; a < 2; ++a)
#pragma unroll
            for (int b = 0; b < 2; ++b)
#pragma unroll
                for (int m = 0; m < 4; ++m)
#pragma unroll
                    for (int n = 0; n < 2; ++n) acc[a][b][m][n] = (f32x4){0.f, 0.f, 0.f, 0.f};
        cur = nxt; cA = nA; cB = nB; ++ui;
        if constexpr (ALIGN_EPI) { if (wr == 1) PG8_BAR; }
    }
    PG8_WAIT_V(0);
    if constexpr (!ALIGN_EPI) { if (wr == 0) PG8_BAR; }
    PG8_BAR;
    if constexpr (Epi::AFTER_DRAIN) { E.fused(acc, cur, wr, wc, fr, fq, lds, wid, lane); S.done(cur); }
#undef PG8_SA
#undef PG8_SB
#undef PG8_STAGE
#undef PG8_LDA
#undef PG8_LDB
#undef PG8_MMA
#undef PG8_WAIT_V
#undef PG8_WAIT_L
#undef PG8_BAR
#undef PG8_SCHED
}
}

#ifndef PG8_SP2
#define PG8_SP2 true
#endif
#ifndef PG8_ALIGN
#define PG8_ALIGN true
#endif
constexpr int NWAVES = 8;
#ifndef MK_N_LAUNCHES
#define MK_N_LAUNCHES 1
#endif
constexpr int N_PHASES = 8;
constexpr int N_LAUNCHES = MK_N_LAUNCHES;

constexpr int S = 8192, D = 2048, NIN = 5120, DC = 1024, NE = 16384, NPAIR = 128;
constexpr float LN_EPS = 1e-5f;
constexpr float ALPHA = 1.189207115002721f;

constexpr size_t MiB = 1u << 20;
constexpr size_t WS_CTL = 0, CTL_ZERO_BYTES = 64 * 1024;
constexpr size_t WS_XB = 2 * MiB;
constexpr size_t WS_BT1 = 34 * MiB;
constexpr size_t WS_BT2 = 54 * MiB;
constexpr size_t WS_BT3 = 62 * MiB;
constexpr size_t WS_AGLU = 70 * MiB;
constexpr size_t WS_CV = 86 * MiB;
constexpr size_t WS_SCB = 102 * MiB;
constexpr size_t WS_MIX = 118 * MiB;
constexpr size_t WS_Y = 150 * MiB;
constexpr size_t WS_X1 = 214 * MiB;
constexpr size_t WS_S = 246 * MiB;
constexpr size_t WS_IDX = 310 * MiB;
constexpr size_t WS_GV = 314 * MiB;
constexpr size_t WS_SU = 318 * MiB;
constexpr size_t WS_U8 = 322 * MiB;
constexpr size_t WS_V8 = 354 * MiB;
constexpr size_t WS_USC = 386 * MiB;
constexpr size_t WS_VSC = 386 * MiB + 65536;
constexpr size_t WS_END = 387 * MiB;
constexpr int CW_BAR = 4096;

constexpr int RING_OFF = 0, RING_BYTES = 131072;
constexpr int LDSCTL_OFF = RING_BYTES, MISC_OFF = LDSCTL_OFF + 320;
constexpr int LDS_BYTES = 147456;

#define GAS __attribute__((address_space(1)))
#define LAS __attribute__((address_space(3)))
typedef unsigned short bf16;
typedef unsigned v4u __attribute__((ext_vector_type(4)));
typedef unsigned v2u __attribute__((ext_vector_type(2)));
typedef float f32x4 __attribute__((ext_vector_type(4)));
typedef float f32x2 __attribute__((ext_vector_type(2)));
typedef short bf16x8 __attribute__((ext_vector_type(8)));
typedef GAS unsigned gu32;
#define LDS_WAIT() asm volatile("s_waitcnt lgkmcnt(0)" ::: "memory")
#define VM_WAIT() asm volatile("s_waitcnt vmcnt(0)" ::: "memory")
__device__ __forceinline__ unsigned pk2(float lo, float hi) { return pg8::cvt_pk_bf16(lo, hi); }
__device__ __forceinline__ float bf_lo(unsigned w) { return __uint_as_float(w << 16); }
__device__ __forceinline__ float bf_hi(unsigned w) { return __uint_as_float(w & 0xffff0000u); }
__device__ __forceinline__ float wave_sum(float v) {
#pragma unroll
    for (int o = 1; o < 64; o <<= 1) v += __shfl_xor(v, o);
    return v;
}
__device__ __forceinline__ float wave_max(float v) {
#pragma unroll
    for (int o = 1; o < 64; o <<= 1) v = fmaxf(v, __shfl_xor(v, o));
    return v;
}

#define XB_TMO      128
#define XB_XCNT(j)  (256  + 64 * (j))
#define XB_XSUB(j)  (1280 + 64 * (j))
#define XB_XGEN(j)  (2304 + 64 * (j))
#define XB_TOP      3328
#define XB_TOPGEN   3392
#define XCD_BAR_WORDS 3456
#define XB_SPIN_CAP (1u << 18)

__device__ __forceinline__ unsigned xb_ld(unsigned* p)              { return __hip_atomic_load(p, __ATOMIC_RELAXED, __HIP_MEMORY_SCOPE_AGENT); }
__device__ __forceinline__ unsigned xb_add(unsigned* p, unsigned v) { return __hip_atomic_fetch_add(p, v, __ATOMIC_RELAXED, __HIP_MEMORY_SCOPE_AGENT); }
__device__ __forceinline__ unsigned xb_xcc_id() { return (unsigned)__builtin_amdgcn_s_getreg((3 << 11) | 20) & 0xFu; }
#define XB_SPIN(cond, bar) do { unsigned _sp = 0; while (cond) { __builtin_amdgcn_s_sleep(1); \
    if ((++_sp & 255u) == 0u) { if (xb_ld(&(bar)[XB_TMO])) break; if (_sp > XB_SPIN_CAP) { atomicAdd(&(bar)[XB_TMO], 1u); break; } } } } while (0)

struct XcdBarrier {
    unsigned* bar; unsigned x;
    volatile LAS unsigned* st;
};

__device__ __forceinline__ XcdBarrier xcd_barrier_post(unsigned* bar, volatile LAS unsigned* st) {
    XcdBarrier b; b.bar = bar; b.x = xb_xcc_id(); b.st = st;
    if (threadIdx.x == 0) (void)xb_add(&bar[XB_XCNT(b.x)], 1u);
    return b;
}
__device__ __forceinline__ void xcd_barrier_complete(unsigned* bar, unsigned x, unsigned& nloc, unsigned& nx) {
    const unsigned G = gridDim.x * gridDim.y * gridDim.z;
    unsigned sum, cnt, mine, sp = 0u;
    for (;;) {
        sum = 0u; cnt = 0u; mine = 0u;
#pragma unroll
        for (unsigned j = 0; j < 16; ++j) { const unsigned c = xb_ld(&bar[XB_XCNT(j)]); sum += c; cnt += (c > 0u) ? 1u : 0u; mine = (j == x) ? c : mine; }
        if (sum == G) break;
        __builtin_amdgcn_s_sleep(1);
        if ((++sp & 255u) == 0u) { if (xb_ld(&bar[XB_TMO])) break; if (sp > XB_SPIN_CAP) { atomicAdd(&bar[XB_TMO], 1u); break; } }
    }
    nloc = mine > 0u ? mine : 1u; nx = cnt > 0u ? cnt : 1u;
}

__device__ __forceinline__ void xcd_barrier(const XcdBarrier& b) {
    asm volatile("s_waitcnt vmcnt(0)" ::: "memory");
    __syncthreads();
    if (threadIdx.x == 0) {
        unsigned* bar = b.bar;
        __builtin_amdgcn_s_waitcnt(0);
        unsigned nloc = b.st[0], nx = b.st[1];
        if (nloc == 0u) { xcd_barrier_complete(bar, b.x, nloc, nx); b.st[0] = nloc; b.st[1] = nx; }
        const unsigned old = xb_add(&bar[XB_XSUB(b.x)], 1u);
        const unsigned gen = old / nloc;
        if (old + 1u == (gen + 1u) * nloc) {
            __builtin_amdgcn_fence(__ATOMIC_RELEASE, "agent");
            asm volatile("s_waitcnt vmcnt(0)" ::: "memory");
            const unsigned og = xb_add(&bar[XB_TOP], 1u);
            const unsigned tg = og / nx;
            if (og + 1u == (tg + 1u) * nx) xb_add(&bar[XB_TOPGEN], 1u);
            else XB_SPIN(xb_ld(&bar[XB_TOPGEN]) == tg, bar);
            __builtin_amdgcn_fence(__ATOMIC_ACQUIRE, "agent");
            xb_add(&bar[XB_XGEN(b.x)], 1u);
            asm volatile("s_waitcnt vmcnt(0)" ::: "memory");
        } else {
            XB_SPIN(xb_ld(&bar[XB_XGEN(b.x)]) == gen, bar);
            __builtin_amdgcn_fence(__ATOMIC_ACQUIRE, "agent");
            asm volatile("s_waitcnt vmcnt(0)" ::: "memory");
        }
    }
    __syncthreads();
}

struct Frame {
    LAS unsigned char* lds;
    volatile LAS unsigned* MISC;
    gu32* ctl;
    int tid, lane, wave, vcu, G;
    const float *x, *w_in, *b_in, *ccw, *ccb, *clg, *clb, *scw, *scbias, *w_out, *b_out, *ln1g, *ln1b, *w_q, *sub_keys, *peer_u, *peer_v, *ln2g, *ln2b;
    float* out;
    bf16 *XB, *BT1, *BT2, *BT3, *AGLU, *CV, *SCB, *MIX, *X1;
    float *Y, *SS; int* IDX; float *GV, *SU; unsigned char *U8, *V8; float *USC, *VSC;
};

__device__ __forceinline__ int bt1_row(int n0) {
    const int grp = n0 >> 10, c = n0 & 1023, j = c >> 7, r = c & 127;
    if (grp == 0) return 256 * j + r;
    if (grp == 1) return 256 * j + 128 + r;
    if (grp == 2) return 4096 + c;
    if (grp == 3) return 2048 + 256 * j + r;
    return 2048 + 256 * j + 128 + r;
}
template <bool PERM_IN>
__device__ __forceinline__ void p0_transpose_item(const float* W, int K, int N, bf16* WT, LAS float* scr, int item, int lane) {
    const int nblk = N / 32, kb = item / nblk, nb = item % nblk, k0 = 64 * kb, n0 = 32 * nb;
    const int drow = PERM_IN ? bt1_row(n0) : n0;
#pragma unroll 8
    for (int i = 0; i < 32; ++i) { const int kk = 2 * i + (lane >> 5); scr[kk * 33 + (lane & 31)] = W[(size_t)(k0 + kk) * N + n0 + (lane & 31)]; }
    LDS_WAIT(); asm volatile("" ::: "memory");
    const int c = lane & 7;
#pragma unroll
    for (int j = 0; j < 4; ++j) { const int n = (lane >> 3) + 8 * j; const LAS float* s = scr + (8 * c) * 33 + n;
        v4u o; o.x = pk2(s[0 * 33], s[1 * 33]); o.y = pk2(s[2 * 33], s[3 * 33]); o.z = pk2(s[4 * 33], s[5 * 33]); o.w = pk2(s[6 * 33], s[7 * 33]);
        *(GAS v4u*)(WT + (size_t)(drow + n) * K + k0 + 8 * c) = o; }
    LDS_WAIT(); asm volatile("" ::: "memory");
}
__device__ __forceinline__ bf16x8 ld8_bf16(const float* p) {
    const f32x4 a = *(const f32x4*)p, b = *(const f32x4*)(p + 4);
    v4u w; w.x = pk2(a.x, a.y); w.y = pk2(a.z, a.w); w.z = pk2(b.x, b.y); w.w = pk2(b.z, b.w);
    return __builtin_bit_cast(bf16x8, w);
}
__device__ __forceinline__ void p0_prologue(Frame& F) {
    LAS float* scr = (LAS float*)(F.lds + RING_OFF + F.wave * 16384);
    const int gw = F.vcu * NWAVES + F.wave, NGW = F.G * NWAVES, lane = F.lane;
    constexpr int I_IN = (D / 64) * (NIN / 32), I_OUT = (D / 64) * (D / 32);
    for (int it = gw; it < I_IN + I_OUT; it += NGW) {
        if (it < I_IN) p0_transpose_item<true>(F.w_in, D, NIN, F.BT1, scr, it, lane);
        else p0_transpose_item<false>(F.w_out, D, D, F.BT2, scr, it - I_IN, lane);
    }
    for (int it = gw; it < 4096; it += NGW) {
        const int hp = it >> 8, nb = (it >> 5) & 7, db = it & 31, n0 = nb * 16, d0 = db * 64;
        const float* sk = F.sub_keys + ((size_t)hp * 128 + n0 + (lane & 15)) * 128 + 8 * (lane >> 4);
        const float* wq = F.w_q + (size_t)(d0 + (lane & 15)) * 2048 + hp * 128 + 8 * (lane >> 4);
        f32x4 acc[4];
#pragma unroll
        for (int dt = 0; dt < 4; ++dt) acc[dt] = (f32x4){0.f, 0.f, 0.f, 0.f};
#pragma unroll
        for (int ks = 0; ks < 4; ++ks) {
            const bf16x8 yf = ld8_bf16(sk + 32 * ks);
#pragma unroll
            for (int dt = 0; dt < 4; ++dt) { const bf16x8 xf = ld8_bf16(wq + (size_t)dt * 16 * 2048 + 32 * ks);
                acc[dt] = __builtin_amdgcn_mfma_f32_16x16x32_bf16(xf, yf, acc[dt], 0, 0, 0); }
        }
        bf16* orow = F.BT3 + (size_t)(hp * 128 + n0 + (lane & 15)) * 2048 + d0 + 4 * (lane >> 4);
#pragma unroll
        for (int dt = 0; dt < 4; ++dt) { v2u o; o.x = pk2(acc[dt][0], acc[dt][1]); o.y = pk2(acc[dt][2], acc[dt][3]); *(GAS v2u*)(orow + 16 * dt) = o; }
    }
    for (int r = gw; r < S; r += NGW) {
        const GAS f32x4* src = (const GAS f32x4*)(F.x + (size_t)r * D) + 2 * lane;
        GAS v4u* dst = (GAS v4u*)(F.XB + (size_t)r * D) + lane;
#pragma unroll
        for (int j = 0; j < 4; ++j) { const f32x4 a = src[128 * j], b = src[128 * j + 1];
            v4u o; o.x = pk2(a.x, a.y); o.y = pk2(a.z, a.w); o.z = pk2(b.x, b.y); o.w = pk2(b.z, b.w); dst[64 * j] = o; }
    }
    for (int r = gw; r < 2 * NE; r += NGW) {
        const bool isv = r >= NE; const int e = isv ? r - NE : r;
        const float* src = (isv ? F.peer_v : F.peer_u) + (size_t)e * D + 16 * lane;
        f32x4 v[2][4]; float am = 0.f;
#pragma unroll
        for (int j = 0; j < 2; ++j)
#pragma unroll
            for (int q = 0; q < 4; ++q) { v[j][q] = *(const GAS f32x4*)(src + 1024 * j + 4 * q);
                am = fmaxf(am, fmaxf(fmaxf(fabsf(v[j][q].x), fabsf(v[j][q].y)), fmaxf(fabsf(v[j][q].z), fabsf(v[j][q].w)))); }
        am = wave_max(am);
        const float sc = am > 0.f ? 440.f / am : 1.f, inv = am > 0.f ? am / 440.f : 1.f;
        unsigned char* dst = (isv ? F.V8 : F.U8) + (size_t)e * D + 16 * lane;
#pragma unroll
        for (int j = 0; j < 2; ++j) { v4u o;
#pragma unroll
            for (int q = 0; q < 4; ++q) { int p = 0; p = __builtin_amdgcn_cvt_pk_fp8_f32(v[j][q].x * sc, v[j][q].y * sc, p, false); p = __builtin_amdgcn_cvt_pk_fp8_f32(v[j][q].z * sc, v[j][q].w * sc, p, true); o[q] = (unsigned)p; }
            *(GAS v4u*)(dst + 1024 * j) = o; }
        if (lane == 0) (isv ? F.VSC : F.USC)[e] = inv;
    }
}

__device__ __forceinline__ void p2_unit(Frame& F, int unit) {
    const int t0 = unit * 32, tid = F.tid, lane = F.lane, c0 = 2 * tid;
    LAS float* cbuf = (LAS float*)(F.lds + RING_OFF);
    {
        f32x2 w[31];
#pragma unroll
        for (int k = 0; k < 31; ++k) w[k] = *(const GAS f32x2*)(F.ccw + k * 1024 + c0);
        const f32x2 bias = *(const GAS f32x2*)(F.ccb + c0);
#pragma unroll 1
        for (int g = 0; g < 4; ++g) {
            const int tb = t0 + 8 * g - 30;
            f32x2 in[38];
#pragma unroll
            for (int i = 0; i < 38; ++i) { const int t = tb + i; const int tc = t < 0 ? 0 : t;
                const unsigned raw = *(const GAS unsigned*)(F.AGLU + (size_t)tc * 1024 + c0);
                in[i] = t < 0 ? (f32x2){0.f, 0.f} : (f32x2){bf_lo(raw), bf_hi(raw)}; }
#pragma unroll
            for (int tt = 0; tt < 8; ++tt) { f32x2 a = bias;
#pragma unroll
                for (int k = 0; k < 31; ++k) a += w[k] * in[tt + k];
                *(LAS f32x2*)(cbuf + (8 * g + tt) * 1024 + c0) = a; }
        }
    }
    {
        const f32x2 w0 = *(const GAS f32x2*)(F.scw + c0), w1 = *(const GAS f32x2*)(F.scw + 1024 + c0), w2 = *(const GAS f32x2*)(F.scw + 2048 + c0), bias = *(const GAS f32x2*)(F.scbias + c0);
        f32x2 p2 = (f32x2){0.f, 0.f}, p1 = (f32x2){0.f, 0.f};
        if (t0 > 0) { const unsigned r2 = *(const GAS unsigned*)(F.CV + (size_t)(t0 - 2) * 1024 + c0), r1 = *(const GAS unsigned*)(F.CV + (size_t)(t0 - 1) * 1024 + c0);
            p2 = (f32x2){bf_lo(r2), bf_hi(r2)}; p1 = (f32x2){bf_lo(r1), bf_hi(r1)}; }
#pragma unroll 8
        for (int tt = 0; tt < 32; ++tt) {
            const unsigned rc = *(const GAS unsigned*)(F.CV + (size_t)(t0 + tt) * 1024 + c0), rg = *(const GAS unsigned*)(F.SCB + (size_t)(t0 + tt) * 1024 + c0);
            const f32x2 cur = (f32x2){bf_lo(rc), bf_hi(rc)}, gate = (f32x2){bf_lo(rg), bf_hi(rg)};
            const f32x2 o = gate * (bias + w0 * p2 + w1 * p1 + w2 * cur);
            *(GAS unsigned*)(F.MIX + (size_t)(t0 + tt) * 2048 + 1024 + c0) = pk2(o.x, o.y);
            p2 = p1; p1 = cur;
        }
    }
    LDS_WAIT(); __syncthreads();
#pragma unroll 1
    for (int q = 0; q < 4; ++q) {
        const int tt = F.wave * 4 + q;
        f32x4 v[4]; float s = 0.f;
#pragma unroll
        for (int j = 0; j < 4; ++j) { v[j] = *(const LAS f32x4*)(cbuf + tt * 1024 + 4 * lane + 256 * j); s += (v[j].x + v[j].y) + (v[j].z + v[j].w); }
        const float mean = wave_sum(s) * (1.f / 1024.f); float s2 = 0.f;
#pragma unroll
        for (int j = 0; j < 4; ++j) { v[j] = v[j] - mean; s2 += (v[j].x * v[j].x + v[j].y * v[j].y) + (v[j].z * v[j].z + v[j].w * v[j].w); }
        const float rstd = 1.f / sqrtf(wave_sum(s2) * (1.f / 1024.f) + LN_EPS);
#pragma unroll
        for (int j = 0; j < 4; ++j) { const f32x4 g = *(const GAS f32x4*)(F.clg + 4 * lane + 256 * j), b = *(const GAS f32x4*)(F.clb + 4 * lane + 256 * j);
            f32x4 y = v[j] * rstd * g + b;
            y.x *= pg8::sigmoidf_fast(y.x); y.y *= pg8::sigmoidf_fast(y.y); y.z *= pg8::sigmoidf_fast(y.z); y.w *= pg8::sigmoidf_fast(y.w);
            v2u o; o.x = pk2(y.x, y.y); o.y = pk2(y.z, y.w);
            *(GAS v2u*)(F.MIX + (size_t)(t0 + tt) * 2048 + 4 * lane + 256 * j) = o; }
    }
    __syncthreads();
}

__device__ __forceinline__ void p4_ln1(Frame& F) {
    const int gw = F.vcu * NWAVES + F.wave, NGW = F.G * NWAVES, lane = F.lane;
    for (int r = gw; r < S; r += NGW) {
        const GAS f32x4* yr = (const GAS f32x4*)(F.Y + (size_t)r * D) + lane;
        f32x4 v[8]; float s = 0.f;
#pragma unroll
        for (int j = 0; j < 8; ++j) { v[j] = yr[64 * j]; s += (v[j].x + v[j].y) + (v[j].z + v[j].w); }
        const float mean = wave_sum(s) * (1.f / D); float s2 = 0.f;
#pragma unroll
        for (int j = 0; j < 8; ++j) { v[j] = v[j] - mean; s2 += (v[j].x * v[j].x + v[j].y * v[j].y) + (v[j].z * v[j].z + v[j].w * v[j].w); }
        const float rstd = 1.f / sqrtf(wave_sum(s2) * (1.f / D) + LN_EPS);
        GAS v2u* o8 = (GAS v2u*)(F.X1 + (size_t)r * D) + lane;
#pragma unroll
        for (int j = 0; j < 8; ++j) { const f32x4 g = *(const GAS f32x4*)(F.ln1g + 4 * lane + 256 * j), b = *(const GAS f32x4*)(F.ln1b + 4 * lane + 256 * j);
            const f32x4 y = v[j] * rstd * g + b; v2u o; o.x = pk2(y.x, y.y); o.y = pk2(y.z, y.w); o8[64 * j] = o; }
    }
}

__device__ __forceinline__ int imax_(int a, int b) { return a > b ? a : b; }
__device__ __forceinline__ int imin_(int a, int b) { return a < b ? a : b; }
template <bool DESC> __device__ __forceinline__ void ce_i(int& a, int& b) { const int mx = imax_(a, b), mn = imin_(a, b); a = DESC ? mx : mn; b = DESC ? mn : mx; }
template <bool DESC> __device__ __forceinline__ void sort16_i(int (&v)[16]) {
#pragma unroll
    for (int k = 2; k <= 16; k <<= 1)
#pragma unroll
        for (int j = k >> 1; j > 0; j >>= 1)
#pragma unroll
            for (int i = 0; i < 16; ++i) { const int l = i ^ j; if (l > i) { const bool up = ((i & k) == 0); if (up != DESC) ce_i<false>(v[i], v[l]); else ce_i<true>(v[i], v[l]); } }
}
template <bool DESC> __device__ __forceinline__ void merge16_i(int (&v)[16]) {
#pragma unroll
    for (int j = 8; j > 0; j >>= 1)
#pragma unroll
        for (int i = 0; i < 16; ++i) { const int l = i ^ j; if (l > i) ce_i<DESC>(v[i], v[l]); }
}
template <bool DESC> __device__ __forceinline__ void ce_p(float& a, int& pa, float& b, int& pb) {
    const bool sw = DESC ? (a < b) : (a > b); const float ta = sw ? b : a, tb = sw ? a : b; const int qa = sw ? pb : pa, qb = sw ? pa : pb; a = ta; b = tb; pa = qa; pb = qb; }
template <bool DESC> __device__ __forceinline__ void sort16_p(float (&v)[16], int (&p)[16]) {
#pragma unroll
    for (int k = 2; k <= 16; k <<= 1)
#pragma unroll
        for (int j = k >> 1; j > 0; j >>= 1)
#pragma unroll
            for (int i = 0; i < 16; ++i) { const int l = i ^ j; if (l > i) { const bool up = ((i & k) == 0); if (up != DESC) ce_p<false>(v[i], p[i], v[l], p[l]); else ce_p<true>(v[i], p[i], v[l], p[l]); } }
}
template <bool DESC> __device__ __forceinline__ void merge16_p(float (&v)[16], int (&p)[16]) {
#pragma unroll
    for (int j = 8; j > 0; j >>= 1)
#pragma unroll
        for (int i = 0; i < 16; ++i) { const int l = i ^ j; if (l > i) ce_p<DESC>(v[i], p[i], v[l], p[l]); }
}
__device__ __forceinline__ int f2key(float f) { const int b = __float_as_int(f); return b ^ ((b >> 31) & 0x7fffffff); }
__device__ __forceinline__ float key2f(int k) { return __int_as_float(k ^ ((k >> 31) & 0x7fffffff)); }

__device__ __forceinline__ void p6_topk(Frame& F) {
    const int gw = F.vcu * NWAVES + F.wave, NGW = F.G * NWAVES, lane = F.lane;
    for (int it = gw; it < (S * 16) / 64; it += NGW) {
        const int prob = it * 64 + lane, t = prob >> 4, hp = prob & 15;
        const float* sp = F.SS + (size_t)t * 2048 + hp * 128;
        int top[16];
        {
            f32x4 r[4];
#pragma unroll
            for (int q = 0; q < 4; ++q) r[q] = *(const GAS f32x4*)(sp + 4 * q);
#pragma unroll
            for (int q = 0; q < 4; ++q)
#pragma unroll
                for (int e = 0; e < 4; ++e) top[4 * q + e] = (f2key(r[q][e]) & ~127) | (4 * q + e);
            sort16_i<true>(top);
        }
#pragma unroll 1
        for (int c = 1; c < 8; ++c) {
            f32x4 r[4]; int nw[16];
#pragma unroll
            for (int q = 0; q < 4; ++q) r[q] = *(const GAS f32x4*)(sp + 16 * c + 4 * q);
#pragma unroll
            for (int q = 0; q < 4; ++q)
#pragma unroll
                for (int e = 0; e < 4; ++e) nw[4 * q + e] = (f2key(r[q][e]) & ~127) | (16 * c + 4 * q + e);
            sort16_i<false>(nw);
#pragma unroll
            for (int i = 0; i < 16; ++i) top[i] = imax_(top[i], nw[i]);
            merge16_i<true>(top);
        }
        const bool odd = (lane & 1) != 0;
        float Av[16], Bv[16]; int Ai[16], Bi[16];
#pragma unroll
        for (int i = 0; i < 16; ++i) { const int mine = top[i]; const int other = __shfl_xor(mine, 1); const int ka = odd ? other : mine, kb = odd ? mine : other;
            Av[i] = key2f(ka & ~127); Ai[i] = ka & 127; Bv[i] = key2f(kb & ~127); Bi[i] = kb & 127; }
        float tv[16]; int tp[16];
#pragma unroll
        for (int j = 0; j < 16; ++j) { tv[j] = Av[0] + Bv[j]; tp[j] = Ai[0] * 128 + Bi[j]; }
        {
            float nv[16]; int np[16];
#pragma unroll
            for (int j = 0; j < 8; ++j) { nv[j] = Av[1] + Bv[j]; np[j] = Ai[1] * 128 + Bi[j]; }
#pragma unroll
            for (int j = 0; j < 5; ++j) { nv[8 + j] = Av[2] + Bv[j]; np[8 + j] = Ai[2] * 128 + Bi[j]; }
#pragma unroll
            for (int j = 0; j < 3; ++j) { nv[13 + j] = Av[3] + Bv[j]; np[13 + j] = Ai[3] * 128 + Bi[j]; }
            sort16_p<false>(nv, np);
#pragma unroll
            for (int i = 0; i < 16; ++i) { const bool g = nv[i] > tv[i]; tv[i] = g ? nv[i] : tv[i]; tp[i] = g ? np[i] : tp[i]; }
            merge16_p<true>(tv, tp);
        }
        {
            float nv[16]; int np[16];
            nv[0] = Av[3] + Bv[3]; np[0] = Ai[3] * 128 + Bi[3];
#pragma unroll
            for (int j = 0; j < 3; ++j) { nv[1 + j] = Av[4] + Bv[j]; np[1 + j] = Ai[4] * 128 + Bi[j]; }
#pragma unroll
            for (int i = 5; i < 8; ++i)
#pragma unroll
                for (int j = 0; j < 2; ++j) { nv[4 + 2 * (i - 5) + j] = Av[i] + Bv[j]; np[4 + 2 * (i - 5) + j] = Ai[i] * 128 + Bi[j]; }
#pragma unroll
            for (int i = 8; i < 14; ++i) { nv[10 + i - 8] = Av[i] + Bv[0]; np[10 + i - 8] = Ai[i] * 128 + Bi[0]; }
            sort16_p<false>(nv, np);
#pragma unroll
            for (int i = 0; i < 16; ++i) { const bool g = nv[i] > tv[i]; tv[i] = g ? nv[i] : tv[i]; tp[i] = g ? np[i] : tp[i]; }
            merge16_p<true>(tv, tp);
        }
        {
            const float hi = Av[14] + Bv[0], lo = Av[15] + Bv[0]; const int phi = Ai[14] * 128 + Bi[0], plo = Ai[15] * 128 + Bi[0];
            const float t14 = tv[14], t15 = tv[15]; const int q14 = tp[14], q15 = tp[15];
            const bool g14 = lo > t14, g15 = hi > t15;
            tv[14] = g14 ? lo : t14; tp[14] = g14 ? plo : q14; tv[15] = g15 ? hi : t15; tp[15] = g15 ? phi : q15;
        }
        float mx = tv[0];
#pragma unroll
        for (int i = 1; i < 16; ++i) mx = fmaxf(mx, tv[i]);
        float sum = 0.f;
#pragma unroll
        for (int i = 0; i < 16; ++i) { tv[i] = __expf(tv[i] - mx); sum += tv[i]; }
        const float rs = 1.f / sum;
        const size_t ob = (size_t)t * NPAIR + hp * 8;
        int oe[8]; float og[8], ou[8];
#pragma unroll
        for (int k = 0; k < 8; ++k) { const int pa = tp[k], pb = tp[8 + k]; const float va = tv[k], vb = tv[8 + k];
            oe[k] = odd ? pb : pa; const float g = (odd ? vb : va) * rs; og[k] = g * F.VSC[oe[k]]; ou[k] = F.USC[oe[k]]; }
        *(GAS v4u*)(F.IDX + ob) = (v4u){(unsigned)oe[0], (unsigned)oe[1], (unsigned)oe[2], (unsigned)oe[3]};
        *(GAS v4u*)(F.IDX + ob + 4) = (v4u){(unsigned)oe[4], (unsigned)oe[5], (unsigned)oe[6], (unsigned)oe[7]};
        *(GAS f32x4*)(F.GV + ob) = (f32x4){og[0], og[1], og[2], og[3]};
        *(GAS f32x4*)(F.GV + ob + 4) = (f32x4){og[4], og[5], og[6], og[7]};
        *(GAS f32x4*)(F.SU + ob) = (f32x4){ou[0], ou[1], ou[2], ou[3]};
        *(GAS f32x4*)(F.SU + ob + 4) = (f32x4){ou[4], ou[5], ou[6], ou[7]};
    }
}

constexpr int P7K = 2;
struct RowsK { v4u u[P7K][2]; v4u v[P7K][2]; };
__device__ __forceinline__ void p7_issue(Frame& F, RowsK& R, int ev, int c, int lane) {
#pragma unroll
    for (int k = 0; k < P7K; ++k) {
        const int e = __builtin_amdgcn_readlane(ev, ((P7K * c) & 63) + k);
        const unsigned char* up = F.U8 + (size_t)e * D + 16 * lane; const unsigned char* vp = F.V8 + (size_t)e * D + 16 * lane;
        R.u[k][0] = *(const GAS v4u*)(up); R.u[k][1] = *(const GAS v4u*)(up + 1024);
        R.v[k][0] = *(const GAS v4u*)(vp); R.v[k][1] = *(const GAS v4u*)(vp + 1024);
    }
}
__device__ __forceinline__ float gelu_erf(float z) { return 0.5f * z * (1.0f + erff(z * 0.70710678118654752f)); }
__device__ __forceinline__ void p7_compute(const RowsK& R, const float (&xf)[32], float (&acc)[32], float suv, float gvv, int c, int lane) {
    static_assert(P7K == 2, "reduction below is written for 2 experts per chunk");
    float d[P7K];
#pragma unroll
    for (int k = 0; k < P7K; ++k) {
        float s0 = 0.f, s1 = 0.f;
#pragma unroll
        for (int j = 0; j < 2; ++j)
#pragma unroll
            for (int q = 0; q < 4; ++q) { const int w = (int)R.u[k][j][q];
                const f32x2 lo = __builtin_amdgcn_cvt_pk_f32_fp8(w, false), hi = __builtin_amdgcn_cvt_pk_f32_fp8(w, true);
                s0 = fmaf(xf[16 * j + 4 * q + 0], lo.x, s0); s1 = fmaf(xf[16 * j + 4 * q + 1], lo.y, s1);
                s0 = fmaf(xf[16 * j + 4 * q + 2], hi.x, s0); s1 = fmaf(xf[16 * j + 4 * q + 3], hi.y, s1); }
        d[k] = s0 + s1;
    }
    const bool b5 = (lane & 32) != 0;
    const float keep = b5 ? d[1] : d[0], send = b5 ? d[0] : d[1];
    float tot = keep + __shfl_xor(send, 32);
    tot += __shfl_xor(tot, 16); tot += __shfl_xor(tot, 8); tot += __shfl_xor(tot, 4); tot += __shfl_xor(tot, 2); tot += __shfl_xor(tot, 1);
    const int pl = ((P7K * c) & 63) + (lane >> 5);
    const float my_su = __shfl(suv, pl), my_g = __shfl(gvv, pl);
    const float coef = gelu_erf(tot * my_su) * my_g;
#pragma unroll
    for (int k = 0; k < P7K; ++k) {
        const float ck = __int_as_float(__builtin_amdgcn_readlane(__float_as_int(coef), 32 * k));
#pragma unroll
        for (int j = 0; j < 2; ++j)
#pragma unroll
            for (int q = 0; q < 4; ++q) { const int w = (int)R.v[k][j][q];
                const f32x2 lo = __builtin_amdgcn_cvt_pk_f32_fp8(w, false), hi = __builtin_amdgcn_cvt_pk_f32_fp8(w, true);
                acc[16 * j + 4 * q + 0] = fmaf(ck, lo.x, acc[16 * j + 4 * q + 0]); acc[16 * j + 4 * q + 1] = fmaf(ck, lo.y, acc[16 * j + 4 * q + 1]);
                acc[16 * j + 4 * q + 2] = fmaf(ck, hi.x, acc[16 * j + 4 * q + 2]); acc[16 * j + 4 * q + 3] = fmaf(ck, hi.y, acc[16 * j + 4 * q + 3]); }
    }
}
__device__ __forceinline__ void p7_peer(Frame& F) {
    const int gw = F.vcu * NWAVES + F.wave, NGW = F.G * NWAVES, lane = F.lane;
    constexpr int NCH = NPAIR / P7K, HCH = NCH / 2;
#pragma unroll 1
    for (int t = gw; t < S; t += NGW) {
        const int e0 = F.IDX[(size_t)t * NPAIR + lane], e1 = F.IDX[(size_t)t * NPAIR + 64 + lane];
        const float g0 = F.GV[(size_t)t * NPAIR + lane], g1 = F.GV[(size_t)t * NPAIR + 64 + lane];
        const float u0 = F.SU[(size_t)t * NPAIR + lane], u1 = F.SU[(size_t)t * NPAIR + 64 + lane];
        float xf[32], acc[32];
        {
            const GAS v4u* xr = (const GAS v4u*)(F.X1 + (size_t)t * D + 16 * lane);
#pragma unroll
            for (int j = 0; j < 2; ++j)
#pragma unroll
                for (int h = 0; h < 2; ++h) { const v4u w = xr[64 * 2 * j + h];
#pragma unroll
                    for (int q = 0; q < 4; ++q) { xf[16 * j + 8 * h + 2 * q] = bf_lo(w[q]); xf[16 * j + 8 * h + 2 * q + 1] = bf_hi(w[q]); } }
        }
#pragma unroll
        for (int i = 0; i < 32; ++i) acc[i] = 0.f;
        RowsK RA, RB;
        p7_issue(F, RA, e0, 0, lane);
#pragma unroll 1
        for (int c = 0; c < NCH; c += 2) {
            const int ev = c < HCH ? e0 : e1; const float gvv = c < HCH ? g0 : g1, suv = c < HCH ? u0 : u1;
            p7_issue(F, RB, ev, c + 1, lane);
            p7_compute(RA, xf, acc, suv, gvv, c, lane);
            const int c2 = c + 2 < NCH ? c + 2 : 0;
            p7_issue(F, RA, c2 < HCH ? e0 : e1, c2, lane);
            p7_compute(RB, xf, acc, suv, gvv, c + 1, lane);
        }
        float s = 0.f;
#pragma unroll
        for (int i = 0; i < 32; ++i) { acc[i] = fmaf(ALPHA, xf[i], acc[i]); s += acc[i]; }
        const float mean = wave_sum(s) * (1.f / D); float s2 = 0.f;
#pragma unroll
        for (int i = 0; i < 32; ++i) { acc[i] -= mean; s2 = fmaf(acc[i], acc[i], s2); }
        const float rstd = 1.f / sqrtf(wave_sum(s2) * (1.f / D) + LN_EPS);
        float* orow = F.out + (size_t)t * D + 16 * lane;
#pragma unroll
        for (int j = 0; j < 2; ++j)
#pragma unroll
            for (int q = 0; q < 4; ++q) { const int col = 16 * lane + 1024 * j + 4 * q;
                const f32x4 g = *(const GAS f32x4*)(F.ln2g + col), b = *(const GAS f32x4*)(F.ln2b + col);
                f32x4 o; o.x = acc[16 * j + 4 * q + 0] * rstd * g.x + b.x; o.y = acc[16 * j + 4 * q + 1] * rstd * g.y + b.y; o.z = acc[16 * j + 4 * q + 2] * rstd * g.z + b.z; o.w = acc[16 * j + 4 * q + 3] * rstd * g.w + b.w;
                *(GAS f32x4*)(orow + 1024 * j + 4 * q) = o; }
    }
}

struct Args { const float* in[19]; float* out; unsigned char* ws; int ph_lo, ph_hi, li, pad; };
__global__ void __launch_bounds__(NWAVES * 64, 2) peer_layer_fwd(Args args) {
    extern __shared__ __attribute__((aligned(16))) unsigned char lds[];
    Frame F;
    F.lds = (LAS unsigned char*)lds;
    F.MISC = (volatile LAS unsigned*)(F.lds + MISC_OFF);
    F.tid = threadIdx.x; F.lane = F.tid & 63; F.wave = __builtin_amdgcn_readfirstlane(F.tid >> 6);
    F.G = gridDim.x; { const int bx = blockIdx.x; F.vcu = (F.G % 8 == 0) ? (bx % 8) * (F.G / 8) + bx / 8 : bx; }
    unsigned char* ws = args.ws;
    F.ctl = (gu32*)(ws + WS_CTL);
    F.x = args.in[0]; F.w_in = args.in[1]; F.b_in = args.in[2]; F.ccw = args.in[3]; F.ccb = args.in[4]; F.clg = args.in[5]; F.clb = args.in[6];
    F.scw = args.in[7]; F.scbias = args.in[8]; F.w_out = args.in[9]; F.b_out = args.in[10]; F.ln1g = args.in[11]; F.ln1b = args.in[12];
    F.w_q = args.in[13]; F.sub_keys = args.in[14]; F.peer_u = args.in[15]; F.peer_v = args.in[16]; F.ln2g = args.in[17]; F.ln2b = args.in[18];
    F.out = args.out;
    F.XB = (bf16*)(ws + WS_XB); F.BT1 = (bf16*)(ws + WS_BT1); F.BT2 = (bf16*)(ws + WS_BT2); F.BT3 = (bf16*)(ws + WS_BT3);
    F.AGLU = (bf16*)(ws + WS_AGLU); F.CV = (bf16*)(ws + WS_CV); F.SCB = (bf16*)(ws + WS_SCB); F.MIX = (bf16*)(ws + WS_MIX); F.X1 = (bf16*)(ws + WS_X1);
    F.Y = (float*)(ws + WS_Y); F.SS = (float*)(ws + WS_S); F.IDX = (int*)(ws + WS_IDX); F.GV = (float*)(ws + WS_GV); F.SU = (float*)(ws + WS_SU);
    F.U8 = ws + WS_U8; F.V8 = ws + WS_V8; F.USC = (float*)(ws + WS_USC); F.VSC = (float*)(ws + WS_VSC);
    for (int u = F.tid; u < (LDS_BYTES - LDSCTL_OFF) / 4; u += NWAVES * 64) ((LAS unsigned*)(F.lds + LDSCTL_OFF))[u] = 0u;
    __syncthreads();
    XcdBarrier bar; bar.bar = (unsigned*)(F.ctl + CW_BAR); bar.x = 0; bar.st = nullptr;
    if (N_LAUNCHES == 1) bar = xcd_barrier_post((unsigned*)(F.ctl + CW_BAR), F.MISC + 8);
    const int lo = args.ph_lo, hi = args.ph_hi;
#ifndef ONLY_PHASE
#define ONLY_PHASE -1
#endif
#define IN(k) ((ONLY_PHASE < 0 || ONLY_PHASE == (k)) && lo <= (k) && (k) < hi)
#define SEAM(k) do { if (IN(k) && IN((k) + 1)) xcd_barrier(bar); } while (0)

    if (IN(0)) { p0_prologue(F); SEAM(0); }
    if (IN(1)) {
        pg8::Gemm g{F.XB, F.BT1, S, NIN, D}; pg8::StaticOrder So; So.init(S, NIN, F.G, (int)blockIdx.x);
        pg8::EpiInProj E{F.AGLU, F.CV, F.SCB, F.b_in};
        pg8::gemm_phase<pg8::EpiInProj, pg8::StaticOrder, PG8_ALIGN, PG8_SP2>(F.lds + RING_OFF, g, So, E);
        SEAM(1);
    }
    if (IN(2)) { for (int u = F.vcu; u < S / 32; u += F.G) p2_unit(F, u); SEAM(2); }
    if (IN(3)) {
        pg8::Gemm g{F.MIX, F.BT2, S, D, D}; pg8::StaticOrder So; So.init(S, D, F.G, (int)blockIdx.x);
        pg8::EpiOutProj E{F.Y, F.b_out, F.x, ALPHA};
        pg8::gemm_phase<pg8::EpiOutProj, pg8::StaticOrder, PG8_ALIGN, PG8_SP2>(F.lds + RING_OFF, g, So, E);
        SEAM(3);
    }
    if (IN(4)) { p4_ln1(F); SEAM(4); }
    if (IN(5)) {
        pg8::Gemm g{F.X1, F.BT3, S, D, D}; pg8::StaticOrder So; So.init(S, D, F.G, (int)blockIdx.x);
        pg8::EpiF32 E{F.SS, D};
        pg8::gemm_phase<pg8::EpiF32, pg8::StaticOrder, PG8_ALIGN, PG8_SP2>(F.lds + RING_OFF, g, So, E);
        SEAM(5);
    }
    if (IN(6)) { p6_topk(F); SEAM(6); }
    if (IN(7)) { p7_peer(F); }
#undef IN
#undef SEAM
}

extern "C" void kernel_launch(void* const* d_in, const int* in_sizes, int n_in, void* d_out, int out_size, void* d_ws, size_t ws_size, hipStream_t stream) {
    static int grid = 0;
    if (grid == 0) {
        if (n_in != 19 || in_sizes[0] != S * D || out_size != S * D || ws_size < WS_END) {
            fprintf(stderr, "kernel_launch: built for 19 inputs, x/out of %d floats, >= %zu bytes of workspace; got n_in %d, in0 %d, out %d, ws %zu; nothing launched\n", S * D, (size_t)WS_END, n_in, n_in > 0 ? in_sizes[0] : -1, out_size, ws_size);
            grid = -1; return; }
        int dev = 0, cus = 0, per_cu = 0;
        if (hipGetDevice(&dev) != hipSuccess || hipDeviceGetAttribute(&cus, hipDeviceAttributeMultiprocessorCount, dev) != hipSuccess) { fprintf(stderr, "kernel_launch: device query failed\n"); grid = -1; return; }
        if (hipFuncSetAttribute((const void*)peer_layer_fwd, hipFuncAttributeMaxDynamicSharedMemorySize, LDS_BYTES) != hipSuccess) { fprintf(stderr, "kernel_launch: hipFuncSetAttribute failed\n"); grid = -1; return; }
        if (hipOccupancyMaxActiveBlocksPerMultiprocessor(&per_cu, (const void*)peer_layer_fwd, NWAVES * 64, LDS_BYTES) != hipSuccess || per_cu < 1) {
            fprintf(stderr, "kernel_launch: occupancy query reports %d workgroups per CU; nothing launched\n", per_cu); (void)hipGetLastError(); grid = -1; return; }
        (void)hipGetLastError();
        grid = cus;
    }
    if (grid < 0) return;
    if (hipMemsetAsync((char*)d_ws + WS_CTL, 0, CTL_ZERO_BYTES, stream) != hipSuccess) { fprintf(stderr, "kernel_launch: hipMemsetAsync failed\n"); return; }
    Args a{};
    for (int i = 0; i < 19; ++i) a.in[i] = (const float*)d_in[i];
    a.out = (float*)d_out; a.ws = (unsigned char*)d_ws;
    for (int li = 0; li < N_LAUNCHES; ++li) {
        a.ph_lo = (N_LAUNCHES == 1) ? 0 : li; a.ph_hi = (N_LAUNCHES == 1) ? N_PHASES : li + 1; a.li = li;
        hipError_t le;
        if (N_LAUNCHES == 1) { void* kargs[] = {&a}; le = hipLaunchCooperativeKernel((const void*)peer_layer_fwd, dim3(grid), dim3(NWAVES * 64), kargs, LDS_BYTES, stream); }
        else { hipLaunchKernelGGL(peer_layer_fwd, dim3(grid), dim3(NWAVES * 64), LDS_BYTES, stream, a); le = hipPeekAtLastError(); }
        if (le != hipSuccess) { fprintf(stderr, "kernel_launch: launch %d failed: %s (grid %d x %d threads, %d B LDS)\n", li, hipGetErrorName(le), grid, NWAVES * 64, LDS_BYTES); break; }
    }
}
```

```cpp
#include <hip/hip_runtime.h>
#include <cstdio>
#include <cstdint>
namespace pg8 {
#define PG8_LAS __attribute__((address_space(3)))
typedef unsigned short bf16_t;
typedef short bf16x8 __attribute__((ext_vector_type(8)));
typedef float f32x4 __attribute__((ext_vector_type(4)));
typedef unsigned u32x4 __attribute__((ext_vector_type(4)));
constexpr int BM = 256, BK = 64, HALF = 128, HTB = HALF * BK * 2  , STAGE_BYTES = 8 * HTB, NXCD = 8, WGM = 8;

__host__ __device__ __forceinline__ int lds_byte(int r, int c) { const int st = (r >> 4) * 2 + (c >> 5), rr = r & 15, cc = c & 31, ob = rr * 64 + cc * 2; return st * 1024 + (ob ^ (((ob >> 9) & 1) << 5)); }
__host__ __device__ __forceinline__ void stage_rc(int b, int& R, int& C) { const int st = b / 1024, sb = b % 1024, swz = sb ^ (((sb >> 9) & 1) << 5); R = (st >> 1) * 16 + swz / 64; C = (st & 1) * 32 + (swz % 64) / 2; }
__host__ __device__ __forceinline__ int perm32(int rho) { const int n = rho >> 4, i = rho & 15; return 8 * (i >> 2) + 4 * n + (i & 3); }

struct Unit { int pm, pn; };
struct Gemm { const bf16_t* A; const bf16_t* Bt; int M, N, K; };

struct StaticOrder {
    int nM, nN, nwg, G, c;
    __host__ __device__ void init(int M, int N, int G_, int c_) { nM = M / BM; nN = N / BM; nwg = nM * nN; G = G_; c = c_; }
    __host__ __device__ bool next(int i, Unit& u) const {
        const long L = (long)i * G + c; if (L >= nwg) return false;
        int wgid = (int)L; { const int q = nwg / NXCD, r = nwg % NXCD, xcd = wgid % NXCD, off = wgid / NXCD; wgid = (xcd < r ? xcd * (q + 1) : r * (q + 1) + (xcd - r) * q) + off; }
        const int nig = WGM * nN, gid = wgid / nig, fm = gid * WGM, gsz = (nM - fm) < WGM ? (nM - fm) : WGM;
        u.pm = fm + ((wgid % nig) % gsz); u.pn = (wgid % nig) / gsz; return true;
    }
    __device__ __forceinline__ void a_ready(const Unit&) const {}
    __device__ __forceinline__ void done(const Unit&) const {}
};

__device__ __forceinline__ unsigned cvt_pk_bf16(float lo, float hi) { unsigned r; asm volatile("v_cvt_pk_bf16_f32 %0, %1, %2" : "=v"(r) : "v"(lo), "v"(hi)); return r; }
__device__ __forceinline__ float sigmoidf_fast(float g) { return __builtin_amdgcn_rcpf(1.0f + __expf(-g)); }

struct EpiInProj {
    static constexpr bool PERM = true, AFTER_DRAIN = false;
    bf16_t* aglu; bf16_t* cv; bf16_t* scb; const float* b_in;
    __device__ __forceinline__ void operator()(const f32x4 (&acc)[2][2][4][2], const Unit& u, int wr, int wc, int fr, int fq) const {
        const int row0 = u.pm * BM + wr * 64 + fr, cc = wc * 32 + 8 * fq;
        if (u.pn < 16) {
            const bool conf = u.pn < 8; const int j = conf ? u.pn : u.pn - 8;
            const float* b0 = b_in + (conf ? 0 : 3072) + 128 * j + cc;
            const float* b1 = b_in + (conf ? 1024 : 4096) + 128 * j + cc;
            bf16_t* O = (conf ? aglu : cv) + 128 * j + cc;
            f32x4 bv0[2], bv1[2];
#pragma unroll
            for (int n = 0; n < 2; ++n) { bv0[n] = *(const f32x4*)(b0 + 4 * n); bv1[n] = *(const f32x4*)(b1 + 4 * n); }
#pragma unroll
            for (int ai = 0; ai < 2; ++ai)
#pragma unroll
                for (int m = 0; m < 4; ++m) {
                    f32x4 r[2];
#pragma unroll
                    for (int n = 0; n < 2; ++n) { const f32x4 a = acc[ai][0][m][n] + bv0[n]; f32x4 g = acc[ai][1][m][n] + bv1[n];
                        if (conf) { g[0] = sigmoidf_fast(g[0]); g[1] = sigmoidf_fast(g[1]); g[2] = sigmoidf_fast(g[2]); g[3] = sigmoidf_fast(g[3]); }
                        r[n] = a * g; }
                    u32x4 w; w.x = cvt_pk_bf16(r[0][0], r[0][1]); w.y = cvt_pk_bf16(r[0][2], r[0][3]); w.z = cvt_pk_bf16(r[1][0], r[1][1]); w.w = cvt_pk_bf16(r[1][2], r[1][3]);
                    *(u32x4*)(O + (size_t)(row0 + ai * HALF + m * 16) * 1024) = w; }
        } else {
            const int j = u.pn - 16;
#pragma unroll
            for (int bj = 0; bj < 2; ++bj) {
                const float* b0 = b_in + 2048 + 256 * j + 128 * bj + cc; bf16_t* O = scb + 256 * j + 128 * bj + cc;
                const f32x4 bva = *(const f32x4*)(b0), bvb = *(const f32x4*)(b0 + 4);
#pragma unroll
                for (int ai = 0; ai < 2; ++ai)
#pragma unroll
                    for (int m = 0; m < 4; ++m) { const f32x4 v0 = acc[ai][bj][m][0] + bva, v1 = acc[ai][bj][m][1] + bvb;
                        u32x4 w; w.x = cvt_pk_bf16(v0[0], v0[1]); w.y = cvt_pk_bf16(v0[2], v0[3]); w.z = cvt_pk_bf16(v1[0], v1[1]); w.w = cvt_pk_bf16(v1[2], v1[3]);
                        *(u32x4*)(O + (size_t)(row0 + ai * HALF + m * 16) * 1024) = w; } }
        }
    }
};
struct EpiOutProj {
    static constexpr bool PERM = false, AFTER_DRAIN = false;
    float* Y; const float* bias; const float* x; float alpha;
    __device__ __forceinline__ void operator()(const f32x4 (&acc)[2][2][4][2], const Unit& u, int wr, int wc, int fr, int fq) const {
        const int row0 = u.pm * BM + wr * 64 + fr, col0 = u.pn * BM + wc * 32 + 4 * fq;
        f32x4 bv[2][2];
#pragma unroll
        for (int bj = 0; bj < 2; ++bj)
#pragma unroll
            for (int n = 0; n < 2; ++n) bv[bj][n] = *(const f32x4*)(bias + col0 + bj * HALF + n * 16);
#pragma unroll
        for (int ai = 0; ai < 2; ++ai)
#pragma unroll
            for (int m = 0; m < 4; ++m) { const size_t off = (size_t)(row0 + ai * HALF + m * 16) * 2048 + col0;
#pragma unroll
                for (int bj = 0; bj < 2; ++bj)
#pragma unroll
                    for (int n = 0; n < 2; ++n) { const f32x4 xv = *(const f32x4*)(x + off + bj * HALF + n * 16);
                        *(f32x4*)(Y + off + bj * HALF + n * 16) = acc[ai][bj][m][n] + bv[bj][n] + xv * alpha; }
                asm volatile("" ::: "memory"); }
    }
};
struct EpiF32 {
    static constexpr bool PERM = false, AFTER_DRAIN = false;
    float* C; int ldc;
    __device__ __forceinline__ void operator()(const f32x4 (&acc)[2][2][4][2], const Unit& u, int wr, int wc, int fr, int fq) const {
        const int row0 = u.pm * BM + wr * 64 + fr, col0 = u.pn * BM + wc * 32 + 4 * fq;
#pragma unroll
        for (int ai = 0; ai < 2; ++ai)
#pragma unroll
            for (int m = 0; m < 4; ++m) { float* rowp = C + (size_t)(row0 + ai * HALF + m * 16) * ldc + col0;
#pragma unroll
                for (int bj = 0; bj < 2; ++bj)
#pragma unroll
                    for (int n = 0; n < 2; ++n) *(f32x4*)(rowp + bj * HALF + n * 16) = acc[ai][bj][m][n]; }
    }
};

template <class Epi, class Sched, bool ALIGN_EPI = false, bool SP2 = false>
__device__ __forceinline__ void gemm_phase(PG8_LAS unsigned char* lds, const Gemm g, const Sched& S, const Epi& E) {
    const int tid = threadIdx.x, wid = __builtin_amdgcn_readfirstlane(tid >> 6), lane = tid & 63, wr = wid >> 2, wc = wid & 3, fr = lane & 15, fq = lane >> 4;
    const int K = g.K, nt = K / BK;
    unsigned voffA[2], voffB[2];
#pragma unroll
    for (int i = 0; i < 2; ++i) { int R, C; stage_rc(tid * 16 + i * 8192, R, C); const int Rb = Epi::PERM ? ((R & ~31) + perm32(R & 31)) : R;
        voffA[i] = (unsigned)(R * K + C) * 2u; voffB[i] = (unsigned)(Rb * K + C) * 2u; }
    const size_t kstep = (size_t)(BK * 2);
    const size_t hstep = (size_t)HALF * K * 2;
    const size_t tstep = 2 * hstep;
    const unsigned ldsw = (unsigned)wid * 1024u;
    const int aoff = lds_byte(wr * 64 + fr, fq * 8), boff = lds_byte(wc * 32 + fr, fq * 8);
#define PG8_SA(b, h) (((b) * 2 + (h)) * HTB)
#define PG8_SB(b, h) ((4 + (b) * 2 + (h)) * HTB)
#define PG8_STAGE(bufoff, gbase, voff) do { _Pragma("unroll") for (int _i = 0; _i < 2; ++_i) \
        __builtin_amdgcn_global_load_lds((const unsigned*)((const char*)(gbase) + (voff)[_i]), (PG8_LAS unsigned*)(lds + (bufoff) + ldsw + _i * 8192), 16, 0, 0); } while (0)
#define PG8_LDA(dst, b, h) do { _Pragma("unroll") for (int m = 0; m < 4; ++m) _Pragma("unroll") for (int k = 0; k < 2; ++k) dst[m][k] = *(const PG8_LAS bf16x8*)(lds + PG8_SA(b, h) + aoff + m * 2048 + k * 1024); } while (0)
#define PG8_LDB(dst, b, h) do { _Pragma("unroll") for (int n = 0; n < 2; ++n) _Pragma("unroll") for (int k = 0; k < 2; ++k) dst[n][k] = *(const PG8_LAS bf16x8*)(lds + PG8_SB(b, h) + boff + n * 2048 + k * 1024); } while (0)
#define PG8_MMA(ai, bj, At, Bt) do { __builtin_amdgcn_s_setprio(1); _Pragma("unroll") for (int m = 0; m < 4; ++m) _Pragma("unroll") for (int n = 0; n < 2; ++n) _Pragma("unroll") for (int k = 0; k < 2; ++k) \
        acc[ai][bj][m][n] = __builtin_amdgcn_mfma_f32_16x16x32_bf16(Bt[n][k], At[m][k], acc[ai][bj][m][n], 0, 0, 0); __builtin_amdgcn_s_setprio(0); } while (0)
#define PG8_WAIT_V(n) asm volatile("s_waitcnt vmcnt(" #n ")" ::: "memory")
#define PG8_WAIT_L(n) asm volatile("s_waitcnt lgkmcnt(" #n ")" ::: "memory")
#define PG8_BAR __builtin_amdgcn_s_barrier()
#define PG8_SCHED __builtin_amdgcn_sched_barrier(0)
    Unit cur, nxt; int ui = 0;
    if (!S.next(0, cur)) return;
    f32x4 acc[2][2][4][2];
#pragma unroll
    for (int a = 0; a < 2; ++a)
#pragma unroll
        for (int b = 0; b < 2; ++b)
#pragma unroll
            for (int m = 0; m < 4; ++m)
#pragma unroll
                for (int n = 0; n < 2; ++n) acc[a][b][m][n] = (f32x4){0.f, 0.f, 0.f, 0.f};
    bf16x8 At[4][2], B0[2][2], B1[2][2];
    const char* cA = (const char*)g.A + (size_t)cur.pm * tstep; const char* cB = (const char*)g.Bt + (size_t)cur.pn * tstep;
    S.a_ready(cur);
    if constexpr (SP2) {
        PG8_STAGE(PG8_SB(0, 0), cB, voffB); PG8_STAGE(PG8_SB(0, 1), cB + hstep, voffB); PG8_STAGE(PG8_SA(0, 0), cA, voffA); PG8_STAGE(PG8_SA(0, 1), cA + hstep, voffA);
        if (wr == 1) PG8_BAR;
        PG8_WAIT_V(2); PG8_BAR;
        PG8_STAGE(PG8_SB(1, 0), cB + kstep, voffB); PG8_STAGE(PG8_SA(1, 0), cA + kstep, voffA); PG8_STAGE(PG8_SB(1, 1), cB + hstep + kstep, voffB);
        PG8_WAIT_V(6); PG8_BAR;
    } else {
        PG8_STAGE(PG8_SB(0, 0), cB, voffB); PG8_STAGE(PG8_SA(0, 0), cA, voffA); PG8_STAGE(PG8_SB(0, 1), cB + hstep, voffB); PG8_STAGE(PG8_SA(0, 1), cA + hstep, voffA);
        if (wr == 1) PG8_BAR;
        PG8_WAIT_V(4); PG8_BAR;
        PG8_STAGE(PG8_SB(1, 0), cB + kstep, voffB); PG8_STAGE(PG8_SA(1, 0), cA + kstep, voffA); PG8_STAGE(PG8_SB(1, 1), cB + hstep + kstep, voffB);
        PG8_WAIT_V(6); PG8_BAR;
    }
    for (;;) {
        const bool has_next = S.next(ui + 1, nxt);
        const char* nA = has_next ? (const char*)g.A + (size_t)nxt.pm * tstep : cA; const char* nB = has_next ? (const char*)g.Bt + (size_t)nxt.pn * tstep : cB;
        for (int t = 0; t < nt; t += 2) {
            const bool last = (t == nt - 2);
            const char* a1 = cA + (size_t)(t + 1) * kstep;
            const char* a2 = last ? nA : cA + (size_t)(t + 2) * kstep; const char* b2 = last ? nB : cB + (size_t)(t + 2) * kstep;
            const char* a3 = a2 + kstep; const char* b3 = b2 + kstep;
            if (last && has_next) S.a_ready(nxt);
            if constexpr (SP2) {
            PG8_LDB(B0, 0, 0); PG8_LDB(B1, 0, 1); PG8_SCHED; PG8_LDA(At, 0, 0); PG8_STAGE(PG8_SA(1, 1), a1 + hstep, voffA);
            PG8_WAIT_V(8); PG8_WAIT_L(0); PG8_BAR; PG8_MMA(0, 0, At, B0); PG8_MMA(0, 1, At, B1); PG8_BAR; PG8_SCHED;
            PG8_LDA(At, 0, 1); PG8_STAGE(PG8_SB(0, 0), b2, voffB); PG8_STAGE(PG8_SB(0, 1), b2 + hstep, voffB); PG8_STAGE(PG8_SA(0, 0), a2, voffA);
            PG8_WAIT_V(8); PG8_WAIT_L(0); PG8_BAR; PG8_MMA(1, 0, At, B0); PG8_MMA(1, 1, At, B1); PG8_BAR; PG8_SCHED;
            PG8_LDB(B0, 1, 0); PG8_LDB(B1, 1, 1); PG8_SCHED; PG8_LDA(At, 1, 0); PG8_STAGE(PG8_SA(0, 1), a2 + hstep, voffA);
            PG8_WAIT_V(8); PG8_WAIT_L(0); PG8_BAR; PG8_MMA(0, 0, At, B0); PG8_MMA(0, 1, At, B1); PG8_BAR; PG8_SCHED;
            PG8_LDA(At, 1, 1); PG8_STAGE(PG8_SB(1, 0), b3, voffB); PG8_STAGE(PG8_SB(1, 1), b3 + hstep, voffB); PG8_STAGE(PG8_SA(1, 0), a3, voffA);
            PG8_WAIT_V(8); PG8_WAIT_L(0); PG8_BAR; PG8_MMA(1, 0, At, B0); PG8_MMA(1, 1, At, B1); PG8_BAR; PG8_SCHED;
            } else {
            PG8_LDB(B0, 0, 0); PG8_SCHED; PG8_LDA(At, 0, 0); PG8_STAGE(PG8_SA(1, 1), a1 + hstep, voffA);
            PG8_WAIT_L(8); PG8_BAR; PG8_WAIT_L(0); PG8_MMA(0, 0, At, B0); PG8_BAR; PG8_SCHED;
            PG8_LDB(B1, 0, 1); PG8_STAGE(PG8_SB(0, 0), b2, voffB);
            PG8_BAR; PG8_WAIT_L(0); PG8_MMA(0, 1, At, B1); PG8_BAR;
            PG8_LDA(At, 0, 1); PG8_STAGE(PG8_SA(0, 0), a2, voffA);
            PG8_BAR; PG8_WAIT_L(0); PG8_MMA(1, 0, At, B0); PG8_BAR; PG8_SCHED;
            PG8_STAGE(PG8_SB(0, 1), b2 + hstep, voffB);
            PG8_WAIT_V(6); PG8_BAR; PG8_MMA(1, 1, At, B1); PG8_BAR;
            PG8_LDB(B0, 1, 0); PG8_SCHED; PG8_LDA(At, 1, 0); PG8_STAGE(PG8_SA(0, 1), a2 + hstep, voffA);
            PG8_WAIT_L(8); PG8_BAR; PG8_WAIT_L(0); PG8_MMA(0, 0, At, B0); PG8_BAR; PG8_SCHED;
            PG8_LDB(B1, 1, 1); PG8_STAGE(PG8_SB(1, 0), b3, voffB);
            PG8_BAR; PG8_WAIT_L(0); PG8_MMA(0, 1, At, B1); PG8_BAR;
            PG8_LDA(At, 1, 1); PG8_STAGE(PG8_SA(1, 0), a3, voffA);
            PG8_BAR; PG8_WAIT_L(0); PG8_MMA(1, 0, At, B0); PG8_BAR; PG8_SCHED;
            PG8_STAGE(PG8_SB(1, 1), b3 + hstep, voffB);
            PG8_WAIT_V(6); PG8_BAR; PG8_MMA(1, 1, At, B1); PG8_BAR;
            }
        }
        if constexpr (ALIGN_EPI) { if (wr == 0) PG8_BAR; }
        if constexpr (!Epi::AFTER_DRAIN) { E(acc, cur, wr, wc, fr, fq); S.done(cur); }
        if (!has_next) break;
#pragma unroll
        for (int a = 0; a < 2; ++a)
#pragma unroll
            for (int b = 0; b < 2; ++b)
#pragma unroll
                for (int m = 0; m < 4; ++m)
#pragma unroll
                    for (int n = 0; n < 2; ++n) acc[a][b][m][n] = (f32x4){0.f, 0.f, 0.f, 0.f};
        cur = nxt; cA = nA; cB = nB; ++ui;
        if constexpr (ALIGN_EPI) { if (wr == 1) PG8_BAR; }
    }
    PG8_WAIT_V(0);
    if constexpr (!ALIGN_EPI) { if (wr == 0) PG8_BAR; }
    PG8_BAR;
    if constexpr (Epi::AFTER_DRAIN) { E.fused(acc, cur, wr, wc, fr, fq, lds, wid, lane); S.done(cur); }
#undef PG8_SA
#undef PG8_SB
#undef PG8_STAGE
#undef PG8_LDA
#undef PG8_LDB
#undef PG8_MMA
#undef PG8_WAIT_V
#undef PG8_WAIT_L
#undef PG8_BAR
#undef PG8_SCHED
}
}

#ifndef PG8_SP2
#define PG8_SP2 true
#endif
#ifndef PG8_ALIGN
#define PG8_ALIGN true
#endif
constexpr int NWAVES = 8;
#ifndef MK_N_LAUNCHES
#define MK_N_LAUNCHES 1
#endif
constexpr int N_PHASES = 8;
constexpr int N_LAUNCHES = MK_N_LAUNCHES;

constexpr int ROWB = 1536;
constexpr int S = 8192, D = 2048, NIN = 5120, DC = 1024, NE = 16384, NPAIR = 128;
constexpr float LN_EPS = 1e-5f;
constexpr float ALPHA = 1.189207115002721f;

constexpr size_t MiB = 1u << 20;
constexpr size_t WS_CTL = 0, CTL_ZERO_BYTES = 64 * 1024;
constexpr size_t WS_XB = 2 * MiB;
constexpr size_t WS_BT1 = 34 * MiB;
constexpr size_t WS_BT2 = 54 * MiB;
constexpr size_t WS_BT3 = 62 * MiB;
constexpr size_t WS_AGLU = 70 * MiB;
constexpr size_t WS_CV = 86 * MiB;
constexpr size_t WS_SCB = 102 * MiB;
constexpr size_t WS_MIX = 118 * MiB;
constexpr size_t WS_Y = 150 * MiB;
constexpr size_t WS_X1 = 214 * MiB;
constexpr size_t WS_S = 246 * MiB;
constexpr size_t WS_IDX = 310 * MiB;
constexpr size_t WS_GV = 314 * MiB;
constexpr size_t WS_SU = 318 * MiB;
constexpr size_t WS_U8 = 322 * MiB;
constexpr size_t WS_V8 = 354 * MiB;
constexpr size_t WS_USC = 386 * MiB;
constexpr size_t WS_VSC = 386 * MiB + 65536;
constexpr size_t WS_END = 387 * MiB;
constexpr int CW_BAR = 4096;

constexpr int RING_OFF = 0, RING_BYTES = 131072;
constexpr int LDSCTL_OFF = RING_BYTES, MISC_OFF = LDSCTL_OFF + 320;
constexpr int LDS_BYTES = 147456;

#define GAS __attribute__((address_space(1)))
#define LAS __attribute__((address_space(3)))
typedef unsigned short bf16;
typedef unsigned v4u __attribute__((ext_vector_type(4)));
typedef unsigned v2u __attribute__((ext_vector_type(2)));
typedef float f32x4 __attribute__((ext_vector_type(4)));
typedef float f32x2 __attribute__((ext_vector_type(2)));
typedef short bf16x8 __attribute__((ext_vector_type(8)));
typedef GAS unsigned gu32;
#define LDS_WAIT() asm volatile("s_waitcnt lgkmcnt(0)" ::: "memory")
#define VM_WAIT() asm volatile("s_waitcnt vmcnt(0)" ::: "memory")
__device__ __forceinline__ unsigned pk2(float lo, float hi) { return pg8::cvt_pk_bf16(lo, hi); }
__device__ __forceinline__ float bf_lo(unsigned w) { return __uint_as_float(w << 16); }
__device__ __forceinline__ float bf_hi(unsigned w) { return __uint_as_float(w & 0xffff0000u); }
__device__ __forceinline__ float wave_sum(float v) {
#pragma unroll
    for (int o = 1; o < 64; o <<= 1) v += __shfl_xor(v, o);
    return v;
}
__device__ __forceinline__ float wave_max(float v) {
#pragma unroll
    for (int o = 1; o < 64; o <<= 1) v = fmaxf(v, __shfl_xor(v, o));
    return v;
}

#define XB_TMO      128
#define XB_XCNT(j)  (256  + 64 * (j))
#define XB_XSUB(j)  (1280 + 64 * (j))
#define XB_XGEN(j)  (2304 + 64 * (j))
#define XB_TOP      3328
#define XB_TOPGEN   3392
#define XCD_BAR_WORDS 3456
#define XB_SPIN_CAP (1u << 18)

__device__ __forceinline__ unsigned xb_ld(unsigned* p)              { return __hip_atomic_load(p, __ATOMIC_RELAXED, __HIP_MEMORY_SCOPE_AGENT); }
__device__ __forceinline__ unsigned xb_add(unsigned* p, unsigned v) { return __hip_atomic_fetch_add(p, v, __ATOMIC_RELAXED, __HIP_MEMORY_SCOPE_AGENT); }
__device__ __forceinline__ unsigned xb_xcc_id() { return (unsigned)__builtin_amdgcn_s_getreg((3 << 11) | 20) & 0xFu; }
#define XB_SPIN(cond, bar) do { unsigned _sp = 0; while (cond) { __builtin_amdgcn_s_sleep(1); \
    if ((++_sp & 255u) == 0u) { if (xb_ld(&(bar)[XB_TMO])) break; if (_sp > XB_SPIN_CAP) { atomicAdd(&(bar)[XB_TMO], 1u); break; } } } } while (0)

struct XcdBarrier {
    unsigned* bar; unsigned x;
    volatile LAS unsigned* st;
};

__device__ __forceinline__ XcdBarrier xcd_barrier_post(unsigned* bar, volatile LAS unsigned* st) {
    XcdBarrier b; b.bar = bar; b.x = xb_xcc_id(); b.st = st;
    if (threadIdx.x == 0) (void)xb_add(&bar[XB_XCNT(b.x)], 1u);
    return b;
}
__device__ __forceinline__ void xcd_barrier_complete(unsigned* bar, unsigned x, unsigned& nloc, unsigned& nx) {
    const unsigned G = gridDim.x * gridDim.y * gridDim.z;
    unsigned sum, cnt, mine, sp = 0u;
    for (;;) {
        sum = 0u; cnt = 0u; mine = 0u;
#pragma unroll
        for (unsigned j = 0; j < 16; ++j) { const unsigned c = xb_ld(&bar[XB_XCNT(j)]); sum += c; cnt += (c > 0u) ? 1u : 0u; mine = (j == x) ? c : mine; }
        if (sum == G) break;
        __builtin_amdgcn_s_sleep(1);
        if ((++sp & 255u) == 0u) { if (xb_ld(&bar[XB_TMO])) break; if (sp > XB_SPIN_CAP) { atomicAdd(&bar[XB_TMO], 1u); break; } }
    }
    nloc = mine > 0u ? mine : 1u; nx = cnt > 0u ? cnt : 1u;
}

__device__ __forceinline__ void xcd_barrier(const XcdBarrier& b) {
    asm volatile("s_waitcnt vmcnt(0)" ::: "memory");
    __syncthreads();
    if (threadIdx.x == 0) {
        unsigned* bar = b.bar;
        __builtin_amdgcn_s_waitcnt(0);
        unsigned nloc = b.st[0], nx = b.st[1];
        if (nloc == 0u) { xcd_barrier_complete(bar, b.x, nloc, nx); b.st[0] = nloc; b.st[1] = nx; }
        const unsigned old = xb_add(&bar[XB_XSUB(b.x)], 1u);
        const unsigned gen = old / nloc;
        if (old + 1u == (gen + 1u) * nloc) {
            __builtin_amdgcn_fence(__ATOMIC_RELEASE, "agent");
            asm volatile("s_waitcnt vmcnt(0)" ::: "memory");
            const unsigned og = xb_add(&bar[XB_TOP], 1u);
            const unsigned tg = og / nx;
            if (og + 1u == (tg + 1u) * nx) xb_add(&bar[XB_TOPGEN], 1u);
            else XB_SPIN(xb_ld(&bar[XB_TOPGEN]) == tg, bar);
            __builtin_amdgcn_fence(__ATOMIC_ACQUIRE, "agent");
            xb_add(&bar[XB_XGEN(b.x)], 1u);
            asm volatile("s_waitcnt vmcnt(0)" ::: "memory");
        } else {
            XB_SPIN(xb_ld(&bar[XB_XGEN(b.x)]) == gen, bar);
            __builtin_amdgcn_fence(__ATOMIC_ACQUIRE, "agent");
            asm volatile("s_waitcnt vmcnt(0)" ::: "memory");
        }
    }
    __syncthreads();
}

struct Frame {
    LAS unsigned char* lds;
    volatile LAS unsigned* MISC;
    gu32* ctl;
    int tid, lane, wave, vcu, G;
    const float *x, *w_in, *b_in, *ccw, *ccb, *clg, *clb, *scw, *scbias, *w_out, *b_out, *ln1g, *ln1b, *w_q, *sub_keys, *peer_u, *peer_v, *ln2g, *ln2b;
    float* out;
    bf16 *XB, *BT1, *BT2, *BT3, *AGLU, *CV, *SCB, *MIX, *X1;
    float *Y, *SS; int* IDX; float *GV, *SU; unsigned char *U8, *V8; float *USC, *VSC;
};

__device__ __forceinline__ int bt1_row(int n0) {
    const int grp = n0 >> 10, c = n0 & 1023, j = c >> 7, r = c & 127;
    if (grp == 0) return 256 * j + r;
    if (grp == 1) return 256 * j + 128 + r;
    if (grp == 2) return 4096 + c;
    if (grp == 3) return 2048 + 256 * j + r;
    return 2048 + 256 * j + 128 + r;
}
template <bool PERM_IN>
__device__ __forceinline__ void p0_transpose_item(const float* W, int K, int N, bf16* WT, LAS float* scr, int item, int lane) {
    const int nblk = N / 32, kb = item / nblk, nb = item % nblk, k0 = 64 * kb, n0 = 32 * nb;
    const int drow = PERM_IN ? bt1_row(n0) : n0;
#pragma unroll 8
    for (int i = 0; i < 32; ++i) { const int kk = 2 * i + (lane >> 5); scr[kk * 33 + (lane & 31)] = W[(size_t)(k0 + kk) * N + n0 + (lane & 31)]; }
    LDS_WAIT(); asm volatile("" ::: "memory");
    const int c = lane & 7;
#pragma unroll
    for (int j = 0; j < 4; ++j) { const int n = (lane >> 3) + 8 * j; const LAS float* s = scr + (8 * c) * 33 + n;
        v4u o; o.x = pk2(s[0 * 33], s[1 * 33]); o.y = pk2(s[2 * 33], s[3 * 33]); o.z = pk2(s[4 * 33], s[5 * 33]); o.w = pk2(s[6 * 33], s[7 * 33]);
        *(GAS v4u*)(WT + (size_t)(drow + n) * K + k0 + 8 * c) = o; }
    LDS_WAIT(); asm volatile("" ::: "memory");
}
__device__ __forceinline__ bf16x8 ld8_bf16(const float* p) {
    const f32x4 a = *(const f32x4*)p, b = *(const f32x4*)(p + 4);
    v4u w; w.x = pk2(a.x, a.y); w.y = pk2(a.z, a.w); w.z = pk2(b.x, b.y); w.w = pk2(b.z, b.w);
    return __builtin_bit_cast(bf16x8, w);
}
__device__ __forceinline__ unsigned fp6_encode(float y) {
    const unsigned sb = (__float_as_uint(y) >> 31) << 5;
    const float a = fabsf(y);
    const unsigned sub = (unsigned)__builtin_rintf(a * 8.0f);
    unsigned b = __float_as_uint(a); b += 0x7FFFFu + ((b >> 20) & 1u); b >>= 20;
    unsigned nrm = b - 1008u; nrm = nrm > 31u ? 31u : nrm;
    return sb | (a < 1.0f ? sub : nrm);
}
__device__ __forceinline__ void p0_prologue(Frame& F) {
    LAS float* scr = (LAS float*)(F.lds + RING_OFF + F.wave * 16384);
    const int gw = F.vcu * NWAVES + F.wave, NGW = F.G * NWAVES, lane = F.lane;
    constexpr int I_IN = (D / 64) * (NIN / 32), I_OUT = (D / 64) * (D / 32);
    for (int it = gw; it < I_IN + I_OUT; it += NGW) {
        if (it < I_IN) p0_transpose_item<true>(F.w_in, D, NIN, F.BT1, scr, it, lane);
        else p0_transpose_item<false>(F.w_out, D, D, F.BT2, scr, it - I_IN, lane);
    }
    for (int it = gw; it < 4096; it += NGW) {
        const int hp = it >> 8, nb = (it >> 5) & 7, db = it & 31, n0 = nb * 16, d0 = db * 64;
        const float* sk = F.sub_keys + ((size_t)hp * 128 + n0 + (lane & 15)) * 128 + 8 * (lane >> 4);
        const float* wq = F.w_q + (size_t)(d0 + (lane & 15)) * 2048 + hp * 128 + 8 * (lane >> 4);
        f32x4 acc[4];
#pragma unroll
        for (int dt = 0; dt < 4; ++dt) acc[dt] = (f32x4){0.f, 0.f, 0.f, 0.f};
#pragma unroll
        for (int ks = 0; ks < 4; ++ks) {
            const bf16x8 yf = ld8_bf16(sk + 32 * ks);
#pragma unroll
            for (int dt = 0; dt < 4; ++dt) { const bf16x8 xf = ld8_bf16(wq + (size_t)dt * 16 * 2048 + 32 * ks);
                acc[dt] = __builtin_amdgcn_mfma_f32_16x16x32_bf16(xf, yf, acc[dt], 0, 0, 0); }
        }
        bf16* orow = F.BT3 + (size_t)(hp * 128 + n0 + (lane & 15)) * 2048 + d0 + 4 * (lane >> 4);
#pragma unroll
        for (int dt = 0; dt < 4; ++dt) { v2u o; o.x = pk2(acc[dt][0], acc[dt][1]); o.y = pk2(acc[dt][2], acc[dt][3]); *(GAS v2u*)(orow + 16 * dt) = o; }
    }
    for (int r = gw; r < S; r += NGW) {
        const GAS f32x4* src = (const GAS f32x4*)(F.x + (size_t)r * D) + 2 * lane;
        GAS v4u* dst = (GAS v4u*)(F.XB + (size_t)r * D) + lane;
#pragma unroll
        for (int j = 0; j < 4; ++j) { const f32x4 a = src[128 * j], b = src[128 * j + 1];
            v4u o; o.x = pk2(a.x, a.y); o.y = pk2(a.z, a.w); o.z = pk2(b.x, b.y); o.w = pk2(b.z, b.w); dst[64 * j] = o; }
    }
    for (int r = gw; r < 2 * NE; r += NGW) {
        const bool isv = r >= NE; const int e = isv ? r - NE : r;
        const GAS f32x4* src = (const GAS f32x4*)((isv ? F.peer_v : F.peer_u) + (size_t)e * D) + lane;
        f32x4 v[8]; float am = 0.f;
#pragma unroll
        for (int j = 0; j < 8; ++j) { v[j] = src[64 * j];
            am = fmaxf(am, fmaxf(fmaxf(fabsf(v[j].x), fabsf(v[j].y)), fmaxf(fabsf(v[j].z), fabsf(v[j].w)))); }
        am = wave_max(am);
        const float sc = am > 0.f ? 7.5f / am : 1.f, inv = am > 0.f ? am / 7.5f : 1.f;
        unsigned w[6];
#pragma unroll
        for (int h = 0; h < 2; ++h) {
            unsigned c[16];
#pragma unroll
            for (int i = 0; i < 16; ++i) c[i] = fp6_encode(v[4 * h + (i >> 2)][i & 3] * sc);
            w[3 * h + 0] = c[0] | (c[1] << 6) | (c[2] << 12) | (c[3] << 18) | (c[4] << 24) | (c[5] << 30);
            w[3 * h + 1] = (c[5] >> 2) | (c[6] << 4) | (c[7] << 10) | (c[8] << 16) | (c[9] << 22) | (c[10] << 28);
            w[3 * h + 2] = (c[10] >> 4) | (c[11] << 2) | (c[12] << 8) | (c[13] << 14) | (c[14] << 20) | (c[15] << 26);
        }
        unsigned char* dst = (isv ? F.V8 : F.U8) + (size_t)e * ROWB + 24 * lane;
        *(GAS v2u*)(dst) = (v2u){w[0], w[1]}; *(GAS v2u*)(dst + 8) = (v2u){w[2], w[3]}; *(GAS v2u*)(dst + 16) = (v2u){w[4], w[5]};
        if (lane == 0) (isv ? F.VSC : F.USC)[e] = inv;
    }
}

__device__ __forceinline__ void p2_unit(Frame& F, int unit) {
    const int t0 = unit * 32, tid = F.tid, lane = F.lane, c0 = 2 * tid;
    LAS float* cbuf = (LAS float*)(F.lds + RING_OFF);
    {
        f32x2 w[31];
#pragma unroll
        for (int k = 0; k < 31; ++k) w[k] = *(const GAS f32x2*)(F.ccw + k * 1024 + c0);
        const f32x2 bias = *(const GAS f32x2*)(F.ccb + c0);
#pragma unroll 1
        for (int g = 0; g < 4; ++g) {
            const int tb = t0 + 8 * g - 30;
            f32x2 in[38];
#pragma unroll
            for (int i = 0; i < 38; ++i) { const int t = tb + i; const int tc = t < 0 ? 0 : t;
                const unsigned raw = *(const GAS unsigned*)(F.AGLU + (size_t)tc * 1024 + c0);
                in[i] = t < 0 ? (f32x2){0.f, 0.f} : (f32x2){bf_lo(raw), bf_hi(raw)}; }
#pragma unroll
            for (int tt = 0; tt < 8; ++tt) { f32x2 a = bias;
#pragma unroll
                for (int k = 0; k < 31; ++k) a += w[k] * in[tt + k];
                *(LAS f32x2*)(cbuf + (8 * g + tt) * 1024 + c0) = a; }
        }
    }
    {
        const f32x2 w0 = *(const GAS f32x2*)(F.scw + c0), w1 = *(const GAS f32x2*)(F.scw + 1024 + c0), w2 = *(const GAS f32x2*)(F.scw + 2048 + c0), bias = *(const GAS f32x2*)(F.scbias + c0);
        f32x2 p2 = (f32x2){0.f, 0.f}, p1 = (f32x2){0.f, 0.f};
        if (t0 > 0) { const unsigned r2 = *(const GAS unsigned*)(F.CV + (size_t)(t0 - 2) * 1024 + c0), r1 = *(const GAS unsigned*)(F.CV + (size_t)(t0 - 1) * 1024 + c0);
            p2 = (f32x2){bf_lo(r2), bf_hi(r2)}; p1 = (f32x2){bf_lo(r1), bf_hi(r1)}; }
#pragma unroll 8
        for (int tt = 0; tt < 32; ++tt) {
            const unsigned rc = *(const GAS unsigned*)(F.CV + (size_t)(t0 + tt) * 1024 + c0), rg = *(const GAS unsigned*)(F.SCB + (size_t)(t0 + tt) * 1024 + c0);
            const f32x2 cur = (f32x2){bf_lo(rc), bf_hi(rc)}, gate = (f32x2){bf_lo(rg), bf_hi(rg)};
            const f32x2 o = gate * (bias + w0 * p2 + w1 * p1 + w2 * cur);
            *(GAS unsigned*)(F.MIX + (size_t)(t0 + tt) * 2048 + 1024 + c0) = pk2(o.x, o.y);
            p2 = p1; p1 = cur;
        }
    }
    LDS_WAIT(); __syncthreads();
#pragma unroll 1
    for (int q = 0; q < 4; ++q) {
        const int tt = F.wave * 4 + q;
        f32x4 v[4]; float s = 0.f;
#pragma unroll
        for (int j = 0; j < 4; ++j) { v[j] = *(const LAS f32x4*)(cbuf + tt * 1024 + 4 * lane + 256 * j); s += (v[j].x + v[j].y) + (v[j].z + v[j].w); }
        const float mean = wave_sum(s) * (1.f / 1024.f); float s2 = 0.f;
#pragma unroll
        for (int j = 0; j < 4; ++j) { v[j] = v[j] - mean; s2 += (v[j].x * v[j].x + v[j].y * v[j].y) + (v[j].z * v[j].z + v[j].w * v[j].w); }
        const float rstd = 1.f / sqrtf(wave_sum(s2) * (1.f / 1024.f) + LN_EPS);
#pragma unroll
        for (int j = 0; j < 4; ++j) { const f32x4 g = *(const GAS f32x4*)(F.clg + 4 * lane + 256 * j), b = *(const GAS f32x4*)(F.clb + 4 * lane + 256 * j);
            f32x4 y = v[j] * rstd * g + b;
            y.x *= pg8::sigmoidf_fast(y.x); y.y *= pg8::sigmoidf_fast(y.y); y.z *= pg8::sigmoidf_fast(y.z); y.w *= pg8::sigmoidf_fast(y.w);
            v2u o; o.x = pk2(y.x, y.y); o.y = pk2(y.z, y.w);
            *(GAS v2u*)(F.MIX + (size_t)(t0 + tt) * 2048 + 4 * lane + 256 * j) = o; }
    }
    __syncthreads();
}

__device__ __forceinline__ void p4_ln1(Frame& F) {
    const int gw = F.vcu * NWAVES + F.wave, NGW = F.G * NWAVES, lane = F.lane;
    for (int r = gw; r < S; r += NGW) {
        const GAS f32x4* yr = (const GAS f32x4*)(F.Y + (size_t)r * D) + lane;
        f32x4 v[8]; float s = 0.f;
#pragma unroll
        for (int j = 0; j < 8; ++j) { v[j] = yr[64 * j]; s += (v[j].x + v[j].y) + (v[j].z + v[j].w); }
        const float mean = wave_sum(s) * (1.f / D); float s2 = 0.f;
#pragma unroll
        for (int j = 0; j < 8; ++j) { v[j] = v[j] - mean; s2 += (v[j].x * v[j].x + v[j].y * v[j].y) + (v[j].z * v[j].z + v[j].w * v[j].w); }
        const float rstd = 1.f / sqrtf(wave_sum(s2) * (1.f / D) + LN_EPS);
        GAS v2u* o8 = (GAS v2u*)(F.X1 + (size_t)r * D) + lane;
#pragma unroll
        for (int j = 0; j < 8; ++j) { const f32x4 g = *(const GAS f32x4*)(F.ln1g + 4 * lane + 256 * j), b = *(const GAS f32x4*)(F.ln1b + 4 * lane + 256 * j);
            const f32x4 y = v[j] * rstd * g + b; v2u o; o.x = pk2(y.x, y.y); o.y = pk2(y.z, y.w); o8[64 * j] = o; }
    }
}

__device__ __forceinline__ int imax_(int a, int b) { return a > b ? a : b; }
__device__ __forceinline__ int imin_(int a, int b) { return a < b ? a : b; }
template <bool DESC> __device__ __forceinline__ void ce_i(int& a, int& b) { const int mx = imax_(a, b), mn = imin_(a, b); a = DESC ? mx : mn; b = DESC ? mn : mx; }
template <bool DESC> __device__ __forceinline__ void sort16_i(int (&v)[16]) {
#pragma unroll
    for (int k = 2; k <= 16; k <<= 1)
#pragma unroll
        for (int j = k >> 1; j > 0; j >>= 1)
#pragma unroll
            for (int i = 0; i < 16; ++i) { const int l = i ^ j; if (l > i) { const bool up = ((i & k) == 0); if (up != DESC) ce_i<false>(v[i], v[l]); else ce_i<true>(v[i], v[l]); } }
}
template <bool DESC> __device__ __forceinline__ void merge16_i(int (&v)[16]) {
#pragma unroll
    for (int j = 8; j > 0; j >>= 1)
#pragma unroll
        for (int i = 0; i < 16; ++i) { const int l = i ^ j; if (l > i) ce_i<DESC>(v[i], v[l]); }
}
template <bool DESC> __device__ __forceinline__ void ce_p(float& a, int& pa, float& b, int& pb) {
    const bool sw = DESC ? (a < b) : (a > b); const float ta = sw ? b : a, tb = sw ? a : b; const int qa = sw ? pb : pa, qb = sw ? pa : pb; a = ta; b = tb; pa = qa; pb = qb; }
template <bool DESC> __device__ __forceinline__ void sort16_p(float (&v)[16], int (&p)[16]) {
#pragma unroll
    for (int k = 2; k <= 16; k <<= 1)
#pragma unroll
        for (int j = k >> 1; j > 0; j >>= 1)
#pragma unroll
            for (int i = 0; i < 16; ++i) { const int l = i ^ j; if (l > i) { const bool up = ((i & k) == 0); if (up != DESC) ce_p<false>(v[i], p[i], v[l], p[l]); else ce_p<true>(v[i], p[i], v[l], p[l]); } }
}
template <bool DESC> __device__ __forceinline__ void merge16_p(float (&v)[16], int (&p)[16]) {
#pragma unroll
    for (int j = 8; j > 0; j >>= 1)
#pragma unroll
        for (int i = 0; i < 16; ++i) { const int l = i ^ j; if (l > i) ce_p<DESC>(v[i], p[i], v[l], p[l]); }
}
__device__ __forceinline__ int f2key(float f) { const int b = __float_as_int(f); return b ^ ((b >> 31) & 0x7fffffff); }
__device__ __forceinline__ float key2f(int k) { return __int_as_float(k ^ ((k >> 31) & 0x7fffffff)); }

__device__ __forceinline__ void p6_topk(Frame& F) {
    const int gw = F.vcu * NWAVES + F.wave, NGW = F.G * NWAVES, lane = F.lane;
    for (int it = gw; it < (S * 16) / 64; it += NGW) {
        const int prob = it * 64 + lane, t = prob >> 4, hp = prob & 15;
        const float* sp = F.SS + (size_t)t * 2048 + hp * 128;
        int top[16];
        {
            f32x4 r[4];
#pragma unroll
            for (int q = 0; q < 4; ++q) r[q] = *(const GAS f32x4*)(sp + 4 * q);
#pragma unroll
            for (int q = 0; q < 4; ++q)
#pragma unroll
                for (int e = 0; e < 4; ++e) top[4 * q + e] = (f2key(r[q][e]) & ~127) | (4 * q + e);
            sort16_i<true>(top);
        }
#pragma unroll 1
        for (int c = 1; c < 8; ++c) {
            f32x4 r[4]; int nw[16];
#pragma unroll
            for (int q = 0; q < 4; ++q) r[q] = *(const GAS f32x4*)(sp + 16 * c + 4 * q);
#pragma unroll
            for (int q = 0; q < 4; ++q)
#pragma unroll
                for (int e = 0; e < 4; ++e) nw[4 * q + e] = (f2key(r[q][e]) & ~127) | (16 * c + 4 * q + e);
            sort16_i<false>(nw);
#pragma unroll
            for (int i = 0; i < 16; ++i) top[i] = imax_(top[i], nw[i]);
            merge16_i<true>(top);
        }
        const bool odd = (lane & 1) != 0;
        float Av[16], Bv[16]; int Ai[16], Bi[16];
#pragma unroll
        for (int i = 0; i < 16; ++i) { const int mine = top[i]; const int other = __shfl_xor(mine, 1); const int ka = odd ? other : mine, kb = odd ? mine : other;
            Av[i] = key2f(ka & ~127); Ai[i] = ka & 127; Bv[i] = key2f(kb & ~127); Bi[i] = kb & 127; }
        float tv[16]; int tp[16];
#pragma unroll
        for (int j = 0; j < 16; ++j) { tv[j] = Av[0] + Bv[j]; tp[j] = Ai[0] * 128 + Bi[j]; }
        {
            float nv[16]; int np[16];
#pragma unroll
            for (int j = 0; j < 8; ++j) { nv[j] = Av[1] + Bv[j]; np[j] = Ai[1] * 128 + Bi[j]; }
#pragma unroll
            for (int j = 0; j < 5; ++j) { nv[8 + j] = Av[2] + Bv[j]; np[8 + j] = Ai[2] * 128 + Bi[j]; }
#pragma unroll
            for (int j = 0; j < 3; ++j) { nv[13 + j] = Av[3] + Bv[j]; np[13 + j] = Ai[3] * 128 + Bi[j]; }
            sort16_p<false>(nv, np);
#pragma unroll
            for (int i = 0; i < 16; ++i) { const bool g = nv[i] > tv[i]; tv[i] = g ? nv[i] : tv[i]; tp[i] = g ? np[i] : tp[i]; }
            merge16_p<true>(tv, tp);
        }
        {
            float nv[16]; int np[16];
            nv[0] = Av[3] + Bv[3]; np[0] = Ai[3] * 128 + Bi[3];
#pragma unroll
            for (int j = 0; j < 3; ++j) { nv[1 + j] = Av[4] + Bv[j]; np[1 + j] = Ai[4] * 128 + Bi[j]; }
#pragma unroll
            for (int i = 5; i < 8; ++i)
#pragma unroll
                for (int j = 0; j < 2; ++j) { nv[4 + 2 * (i - 5) + j] = Av[i] + Bv[j]; np[4 + 2 * (i - 5) + j] = Ai[i] * 128 + Bi[j]; }
#pragma unroll
            for (int i = 8; i < 14; ++i) { nv[10 + i - 8] = Av[i] + Bv[0]; np[10 + i - 8] = Ai[i] * 128 + Bi[0]; }
            sort16_p<false>(nv, np);
#pragma unroll
            for (int i = 0; i < 16; ++i) { const bool g = nv[i] > tv[i]; tv[i] = g ? nv[i] : tv[i]; tp[i] = g ? np[i] : tp[i]; }
            merge16_p<true>(tv, tp);
        }
        {
            const float hi = Av[14] + Bv[0], lo = Av[15] + Bv[0]; const int phi = Ai[14] * 128 + Bi[0], plo = Ai[15] * 128 + Bi[0];
            const float t14 = tv[14], t15 = tv[15]; const int q14 = tp[14], q15 = tp[15];
            const bool g14 = lo > t14, g15 = hi > t15;
            tv[14] = g14 ? lo : t14; tp[14] = g14 ? plo : q14; tv[15] = g15 ? hi : t15; tp[15] = g15 ? phi : q15;
        }
        float mx = tv[0];
#pragma unroll
        for (int i = 1; i < 16; ++i) mx = fmaxf(mx, tv[i]);
        float sum = 0.f;
#pragma unroll
        for (int i = 0; i < 16; ++i) { tv[i] = __expf(tv[i] - mx); sum += tv[i]; }
        const float rs = 1.f / sum;
        const size_t ob = (size_t)t * NPAIR + hp * 8;
        int oe[8]; float og[8], ou[8];
#pragma unroll
        for (int k = 0; k < 8; ++k) { const int pa = tp[k], pb = tp[8 + k]; const float va = tv[k], vb = tv[8 + k];
            oe[k] = odd ? pb : pa; const float g = (odd ? vb : va) * rs; og[k] = g * F.VSC[oe[k]]; ou[k] = F.USC[oe[k]]; }
        *(GAS v4u*)(F.IDX + ob) = (v4u){(unsigned)oe[0], (unsigned)oe[1], (unsigned)oe[2], (unsigned)oe[3]};
        *(GAS v4u*)(F.IDX + ob + 4) = (v4u){(unsigned)oe[4], (unsigned)oe[5], (unsigned)oe[6], (unsigned)oe[7]};
        *(GAS f32x4*)(F.GV + ob) = (f32x4){og[0], og[1], og[2], og[3]};
        *(GAS f32x4*)(F.GV + ob + 4) = (f32x4){og[4], og[5], og[6], og[7]};
        *(GAS f32x4*)(F.SU + ob) = (f32x4){ou[0], ou[1], ou[2], ou[3]};
        *(GAS f32x4*)(F.SU + ob + 4) = (f32x4){ou[4], ou[5], ou[6], ou[7]};
    }
}

constexpr int P7K = 2;
typedef unsigned u32x6 __attribute__((ext_vector_type(6)));
typedef float f32x32 __attribute__((ext_vector_type(32)));
struct RowsK { u32x6 u[P7K]; u32x6 v[P7K]; };
__device__ __forceinline__ u32x6 ld_row6(const unsigned char* p) {
    const v2u a = *(const GAS v2u*)(p), b = *(const GAS v2u*)(p + 8), c = *(const GAS v2u*)(p + 16);
    u32x6 r; r[0] = a.x; r[1] = a.y; r[2] = b.x; r[3] = b.y; r[4] = c.x; r[5] = c.y; return r;
}
__device__ __forceinline__ void p7_issue(Frame& F, RowsK& R, int ev, int c, int lane) {
#pragma unroll
    for (int k = 0; k < P7K; ++k) {
        const int e = __builtin_amdgcn_readlane(ev, ((P7K * c) & 63) + k);
        R.u[k] = ld_row6(F.U8 + (size_t)e * ROWB + 24 * lane);
        R.v[k] = ld_row6(F.V8 + (size_t)e * ROWB + 24 * lane);
    }
}
__device__ __forceinline__ float gelu_erf(float z) { return 0.5f * z * (1.0f + erff(z * 0.70710678118654752f)); }
__device__ __forceinline__ void p7_compute(const RowsK& R, const float (&xf)[32], float (&acc)[32], float suv, float gvv, int c, int lane) {
    static_assert(P7K == 4 || P7K == 2, "reduction below is written for 2 or 4 experts per chunk");
    float d[P7K];
#pragma unroll
    for (int k = 0; k < P7K; ++k) {
        const f32x32 uf = __builtin_amdgcn_cvt_scalef32_pk32_f32_fp6(R.u[k], 1.0f);
        float s0 = 0.f, s1 = 0.f;
#pragma unroll
        for (int r = 0; r < 32; r += 2) { s0 = fmaf(xf[r], uf[r], s0); s1 = fmaf(xf[r + 1], uf[r + 1], s1); }
        d[k] = s0 + s1;
    }
    float tot; int pl;
    if constexpr (P7K == 4) {
        const bool b5 = (lane & 32) != 0, b4 = (lane & 16) != 0;
        const float k0 = b5 ? d[2] : d[0], k1 = b5 ? d[P7K - 1] : d[1], s0 = b5 ? d[0] : d[2], s1 = b5 ? d[1] : d[P7K - 1];
        const float e0 = k0 + __shfl_xor(s0, 32), e1 = k1 + __shfl_xor(s1, 32);
        const float kk = b4 ? e1 : e0, ss = b4 ? e0 : e1;
        tot = kk + __shfl_xor(ss, 16);
        pl = ((P7K * c) & 63) + (lane >> 4);
    } else {
        const bool b5 = (lane & 32) != 0;
        const float keep = b5 ? d[1] : d[0], send = b5 ? d[0] : d[1];
        tot = keep + __shfl_xor(send, 32);
        tot += __shfl_xor(tot, 16);
        pl = ((P7K * c) & 63) + (lane >> 5);
    }
    tot += __shfl_xor(tot, 8); tot += __shfl_xor(tot, 4); tot += __shfl_xor(tot, 2); tot += __shfl_xor(tot, 1);
    const float my_su = __shfl(suv, pl), my_g = __shfl(gvv, pl);
    const float coef = gelu_erf(tot * my_su) * my_g;
#pragma unroll
    for (int k = 0; k < P7K; ++k) {
        const float ck = __int_as_float(__builtin_amdgcn_readlane(__float_as_int(coef), (64 / P7K) * k));
        const f32x32 vf = __builtin_amdgcn_cvt_scalef32_pk32_f32_fp6(R.v[k], 1.0f);
#pragma unroll
        for (int r = 0; r < 32; ++r) acc[r] = fmaf(ck, vf[r], acc[r]);
    }
}
__device__ __forceinline__ void p7_peer(Frame& F) {
    const int gw = F.vcu * NWAVES + F.wave, NGW = F.G * NWAVES, lane = F.lane;
    constexpr int NCH = NPAIR / P7K, HCH = NCH / 2;
#pragma unroll 1
    for (int t = gw; t < S; t += NGW) {
        const int e0 = F.IDX[(size_t)t * NPAIR + lane], e1 = F.IDX[(size_t)t * NPAIR + 64 + lane];
        const float g0 = F.GV[(size_t)t * NPAIR + lane], g1 = F.GV[(size_t)t * NPAIR + 64 + lane];
        const float u0 = F.SU[(size_t)t * NPAIR + lane], u1 = F.SU[(size_t)t * NPAIR + 64 + lane];
        float xf[32], acc[32];
        {
            const GAS v2u* xr = (const GAS v2u*)(F.X1 + (size_t)t * D) + lane;
#pragma unroll
            for (int j = 0; j < 8; ++j) { const v2u w = xr[64 * j]; xf[4 * j + 0] = bf_lo(w.x); xf[4 * j + 1] = bf_hi(w.x); xf[4 * j + 2] = bf_lo(w.y); xf[4 * j + 3] = bf_hi(w.y); }
        }
#pragma unroll
        for (int i = 0; i < 32; ++i) acc[i] = 0.f;
        RowsK RA, RB;
        p7_issue(F, RA, e0, 0, lane);
#pragma unroll 1
        for (int c = 0; c < NCH; c += 2) {
            const int ev = c < HCH ? e0 : e1; const float gvv = c < HCH ? g0 : g1, suv = c < HCH ? u0 : u1;
            p7_issue(F, RB, ev, c + 1, lane);
            p7_compute(RA, xf, acc, suv, gvv, c, lane);
            const int c2 = c + 2 < NCH ? c + 2 : 0;
            p7_issue(F, RA, c2 < HCH ? e0 : e1, c2, lane);
            p7_compute(RB, xf, acc, suv, gvv, c + 1, lane);
        }
        float s = 0.f;
#pragma unroll
        for (int i = 0; i < 32; ++i) { acc[i] = fmaf(ALPHA, xf[i], acc[i]); s += acc[i]; }
        const float mean = wave_sum(s) * (1.f / D); float s2 = 0.f;
#pragma unroll
        for (int i = 0; i < 32; ++i) { acc[i] -= mean; s2 = fmaf(acc[i], acc[i], s2); }
        const float rstd = 1.f / sqrtf(wave_sum(s2) * (1.f / D) + LN_EPS);
        GAS f32x4* orow = (GAS f32x4*)(F.out + (size_t)t * D) + lane;
#pragma unroll
        for (int j = 0; j < 8; ++j) { const f32x4 g = *((const GAS f32x4*)F.ln2g + lane + 64 * j), b = *((const GAS f32x4*)F.ln2b + lane + 64 * j);
            f32x4 o; o.x = acc[4 * j + 0] * rstd * g.x + b.x; o.y = acc[4 * j + 1] * rstd * g.y + b.y; o.z = acc[4 * j + 2] * rstd * g.z + b.z; o.w = acc[4 * j + 3] * rstd * g.w + b.w;
            orow[64 * j] = o; }
    }
}

struct Args { const float* in[19]; float* out; unsigned char* ws; int ph_lo, ph_hi, li, pad; };
__global__ void __launch_bounds__(NWAVES * 64, 2) peer_layer_fwd(Args args) {
    extern __shared__ __attribute__((aligned(16))) unsigned char lds[];
    Frame F;
    F.lds = (LAS unsigned char*)lds;
    F.MISC = (volatile LAS unsigned*)(F.lds + MISC_OFF);
    F.tid = threadIdx.x; F.lane = F.tid & 63; F.wave = __builtin_amdgcn_readfirstlane(F.tid >> 6);
    F.G = gridDim.x; { const int bx = blockIdx.x; F.vcu = (F.G % 8 == 0) ? (bx % 8) * (F.G / 8) + bx / 8 : bx; }
    unsigned char* ws = args.ws;
    F.ctl = (gu32*)(ws + WS_CTL);
    F.x = args.in[0]; F.w_in = args.in[1]; F.b_in = args.in[2]; F.ccw = args.in[3]; F.ccb = args.in[4]; F.clg = args.in[5]; F.clb = args.in[6];
    F.scw = args.in[7]; F.scbias = args.in[8]; F.w_out = args.in[9]; F.b_out = args.in[10]; F.ln1g = args.in[11]; F.ln1b = args.in[12];
    F.w_q = args.in[13]; F.sub_keys = args.in[14]; F.peer_u = args.in[15]; F.peer_v = args.in[16]; F.ln2g = args.in[17]; F.ln2b = args.in[18];
    F.out = args.out;
    F.XB = (bf16*)(ws + WS_XB); F.BT1 = (bf16*)(ws + WS_BT1); F.BT2 = (bf16*)(ws + WS_BT2); F.BT3 = (bf16*)(ws + WS_BT3);
    F.AGLU = (bf16*)(ws + WS_AGLU); F.CV = (bf16*)(ws + WS_CV); F.SCB = (bf16*)(ws + WS_SCB); F.MIX = (bf16*)(ws + WS_MIX); F.X1 = (bf16*)(ws + WS_X1);
    F.Y = (float*)(ws + WS_Y); F.SS = (float*)(ws + WS_S); F.IDX = (int*)(ws + WS_IDX); F.GV = (float*)(ws + WS_GV); F.SU = (float*)(ws + WS_SU);
    F.U8 = ws + WS_U8; F.V8 = ws + WS_V8; F.USC = (float*)(ws + WS_USC); F.VSC = (float*)(ws + WS_VSC);
    for (int u = F.tid; u < (LDS_BYTES - LDSCTL_OFF) / 4; u += NWAVES * 64) ((LAS unsigned*)(F.lds + LDSCTL_OFF))[u] = 0u;
    __syncthreads();
    XcdBarrier bar; bar.bar = (unsigned*)(F.ctl + CW_BAR); bar.x = 0; bar.st = nullptr;
    if (N_LAUNCHES == 1) bar = xcd_barrier_post((unsigned*)(F.ctl + CW_BAR), F.MISC + 8);
    const int lo = args.ph_lo, hi = args.ph_hi;
#ifndef ONLY_PHASE
#define ONLY_PHASE -1
#endif
#define IN(k) ((ONLY_PHASE < 0 || ONLY_PHASE == (k)) && lo <= (k) && (k) < hi)
#define SEAM(k) do { if (IN(k) && IN((k) + 1)) xcd_barrier(bar); } while (0)
#ifndef REPEAT_PHASE
#define REPEAT_PHASE -1
#endif
#define REPS(k) for (int rep_ = 0; rep_ < (REPEAT_PHASE == (k) ? 2 : 1); ++rep_)

    if (IN(0)) { REPS(0) p0_prologue(F); SEAM(0); }
    if (IN(1)) { REPS(1) {
        pg8::Gemm g{F.XB, F.BT1, S, NIN, D}; pg8::StaticOrder So; So.init(S, NIN, F.G, (int)blockIdx.x);
        pg8::EpiInProj E{F.AGLU, F.CV, F.SCB, F.b_in};
        pg8::gemm_phase<pg8::EpiInProj, pg8::StaticOrder, PG8_ALIGN, PG8_SP2>(F.lds + RING_OFF, g, So, E); }
        SEAM(1);
    }
    if (IN(2)) { REPS(2) for (int u = F.vcu; u < S / 32; u += F.G) p2_unit(F, u); SEAM(2); }
    if (IN(3)) { REPS(3) {
        pg8::Gemm g{F.MIX, F.BT2, S, D, D}; pg8::StaticOrder So; So.init(S, D, F.G, (int)blockIdx.x);
        pg8::EpiOutProj E{F.Y, F.b_out, F.x, ALPHA};
        pg8::gemm_phase<pg8::EpiOutProj, pg8::StaticOrder, PG8_ALIGN, PG8_SP2>(F.lds + RING_OFF, g, So, E); }
        SEAM(3);
    }
    if (IN(4)) { REPS(4) p4_ln1(F); SEAM(4); }
    if (IN(5)) { REPS(5) {
        pg8::Gemm g{F.X1, F.BT3, S, D, D}; pg8::StaticOrder So; So.init(S, D, F.G, (int)blockIdx.x);
        pg8::EpiF32 E{F.SS, D};
        pg8::gemm_phase<pg8::EpiF32, pg8::StaticOrder, PG8_ALIGN, PG8_SP2>(F.lds + RING_OFF, g, So, E); }
        SEAM(5);
    }
    if (IN(6)) { REPS(6) p6_topk(F); SEAM(6); }
    if (IN(7)) { REPS(7) p7_peer(F); }
#undef IN
#undef SEAM
}

extern "C" void kernel_launch(void* const* d_in, const int* in_sizes, int n_in, void* d_out, int out_size, void* d_ws, size_t ws_size, hipStream_t stream) {
    static int grid = 0;
    if (grid == 0) {
        if (n_in != 19 || in_sizes[0] != S * D || out_size != S * D || ws_size < WS_END) {
            fprintf(stderr, "kernel_launch: built for 19 inputs, x/out of %d floats, >= %zu bytes of workspace; got n_in %d, in0 %d, out %d, ws %zu; nothing launched\n", S * D, (size_t)WS_END, n_in, n_in > 0 ? in_sizes[0] : -1, out_size, ws_size);
            grid = -1; return; }
        int dev = 0, cus = 0, per_cu = 0;
        if (hipGetDevice(&dev) != hipSuccess || hipDeviceGetAttribute(&cus, hipDeviceAttributeMultiprocessorCount, dev) != hipSuccess) { fprintf(stderr, "kernel_launch: device query failed\n"); grid = -1; return; }
        if (hipFuncSetAttribute((const void*)peer_layer_fwd, hipFuncAttributeMaxDynamicSharedMemorySize, LDS_BYTES) != hipSuccess) { fprintf(stderr, "kernel_launch: hipFuncSetAttribute failed\n"); grid = -1; return; }
        if (hipOccupancyMaxActiveBlocksPerMultiprocessor(&per_cu, (const void*)peer_layer_fwd, NWAVES * 64, LDS_BYTES) != hipSuccess || per_cu < 1) {
            fprintf(stderr, "kernel_launch: occupancy query reports %d workgroups per CU; nothing launched\n", per_cu); (void)hipGetLastError(); grid = -1; return; }
        (void)hipGetLastError();
        grid = cus;
    }
    if (grid < 0) return;
    if (hipMemsetAsync((char*)d_ws + WS_CTL, 0, CTL_ZERO_BYTES, stream) != hipSuccess) { fprintf(stderr, "kernel_launch: hipMemsetAsync failed\n"); return; }
    Args a{};
    for (int i = 0; i < 19; ++i) a.in[i] = (const float*)d_in[i];
    a.out = (float*)d_out; a.ws = (unsigned char*)d_ws;
    for (int li = 0; li < N_LAUNCHES; ++li) {
        a.ph_lo = (N_LAUNCHES == 1) ? 0 : li; a.ph_hi = (N_LAUNCHES == 1) ? N_PHASES : li + 1; a.li = li;
        hipError_t le;
        if (N_LAUNCHES == 1) { void* kargs[] = {&a}; le = hipLaunchCooperativeKernel((const void*)peer_layer_fwd, dim3(grid), dim3(NWAVES * 64), kargs, LDS_BYTES, stream); }
        else { hipLaunchKernelGGL(peer_layer_fwd, dim3(grid), dim3(NWAVES * 64), LDS_BYTES, stream, a); le = hipPeekAtLastError(); }
        if (le != hipSuccess) { fprintf(stderr, "kernel_launch: launch %d failed: %s (grid %d x %d threads, %d B LDS)\n", li, hipGetErrorName(le), grid, NWAVES * 64, LDS_BYTES); break; }
    }
}
```

```cpp
#include <hip/hip_runtime.h>
#include <cstdio>
#include <cstdint>
namespace pg8 {
#define PG8_LAS __attribute__((address_space(3)))
typedef unsigned short bf16_t;
typedef short bf16x8 __attribute__((ext_vector_type(8)));
typedef float f32x4 __attribute__((ext_vector_type(4)));
typedef unsigned u32x4 __attribute__((ext_vector_type(4)));
constexpr int BM = 256, BK = 64, HALF = 128, HTB = HALF * BK * 2  , STAGE_BYTES = 8 * HTB, NXCD = 8, WGM = 8;

__host__ __device__ __forceinline__ int lds_byte(int r, int c) { const int st = (r >> 4) * 2 + (c >> 5), rr = r & 15, cc = c & 31, ob = rr * 64 + cc * 2; return st * 1024 + (ob ^ (((ob >> 9) & 1) << 5)); }
__host__ __device__ __forceinline__ void stage_rc(int b, int& R, int& C) { const int st = b / 1024, sb = b % 1024, swz = sb ^ (((sb >> 9) & 1) << 5); R = (st >> 1) * 16 + swz / 64; C = (st & 1) * 32 + (swz % 64) / 2; }
__host__ __device__ __forceinline__ int perm32(int rho) { const int n = rho >> 4, i = rho & 15; return 8 * (i >> 2) + 4 * n + (i & 3); }

struct Unit { int pm, pn; };
struct Gemm { const bf16_t* A; const bf16_t* Bt; int M, N, K; };

struct StaticOrder {
    int nM, nN, nwg, G, c;
    __host__ __device__ void init(int M, int N, int G_, int c_) { nM = M / BM; nN = N / BM; nwg = nM * nN; G = G_; c = c_; }
    __host__ __device__ bool next(int i, Unit& u) const {
        const long L = (long)i * G + c; if (L >= nwg) return false;
        int wgid = (int)L; { const int q = nwg / NXCD, r = nwg % NXCD, xcd = wgid % NXCD, off = wgid / NXCD; wgid = (xcd < r ? xcd * (q + 1) : r * (q + 1) + (xcd - r) * q) + off; }
        const int nig = WGM * nN, gid = wgid / nig, fm = gid * WGM, gsz = (nM - fm) < WGM ? (nM - fm) : WGM;
        u.pm = fm + ((wgid % nig) % gsz); u.pn = (wgid % nig) / gsz; return true;
    }
    __device__ __forceinline__ void a_ready(const Unit&) const {}
    __device__ __forceinline__ void done(const Unit&) const {}
};

__device__ __forceinline__ unsigned cvt_pk_bf16(float lo, float hi) { unsigned r; asm volatile("v_cvt_pk_bf16_f32 %0, %1, %2" : "=v"(r) : "v"(lo), "v"(hi)); return r; }
__device__ __forceinline__ float sigmoidf_fast(float g) { return __builtin_amdgcn_rcpf(1.0f + __expf(-g)); }

struct EpiInProj {
    static constexpr bool PERM = true, AFTER_DRAIN = false;
    bf16_t* aglu; bf16_t* cv; bf16_t* scb; const float* b_in;
    __device__ __forceinline__ void operator()(const f32x4 (&acc)[2][2][4][2], const Unit& u, int wr, int wc, int fr, int fq) const {
        const int row0 = u.pm * BM + wr * 64 + fr, cc = wc * 32 + 8 * fq;
        if (u.pn < 16) {
            const bool conf = u.pn < 8; const int j = conf ? u.pn : u.pn - 8;
            const float* b0 = b_in + (conf ? 0 : 3072) + 128 * j + cc;
            const float* b1 = b_in + (conf ? 1024 : 4096) + 128 * j + cc;
            bf16_t* O = (conf ? aglu : cv) + 128 * j + cc;
            f32x4 bv0[2], bv1[2];
#pragma unroll
            for (int n = 0; n < 2; ++n) { bv0[n] = *(const f32x4*)(b0 + 4 * n); bv1[n] = *(const f32x4*)(b1 + 4 * n); }
#pragma unroll
            for (int ai = 0; ai < 2; ++ai)
#pragma unroll
                for (int m = 0; m < 4; ++m) {
                    f32x4 r[2];
#pragma unroll
                    for (int n = 0; n < 2; ++n) { const f32x4 a = acc[ai][0][m][n] + bv0[n]; f32x4 g = acc[ai][1][m][n] + bv1[n];
                        if (conf) { g[0] = sigmoidf_fast(g[0]); g[1] = sigmoidf_fast(g[1]); g[2] = sigmoidf_fast(g[2]); g[3] = sigmoidf_fast(g[3]); }
                        r[n] = a * g; }
                    u32x4 w; w.x = cvt_pk_bf16(r[0][0], r[0][1]); w.y = cvt_pk_bf16(r[0][2], r[0][3]); w.z = cvt_pk_bf16(r[1][0], r[1][1]); w.w = cvt_pk_bf16(r[1][2], r[1][3]);
                    *(u32x4*)(O + (size_t)(row0 + ai * HALF + m * 16) * 1024) = w; }
        } else {
            const int j = u.pn - 16;
#pragma unroll
            for (int bj = 0; bj < 2; ++bj) {
                const float* b0 = b_in + 2048 + 256 * j + 128 * bj + cc; bf16_t* O = scb + 256 * j + 128 * bj + cc;
                const f32x4 bva = *(const f32x4*)(b0), bvb = *(const f32x4*)(b0 + 4);
#pragma unroll
                for (int ai = 0; ai < 2; ++ai)
#pragma unroll
                    for (int m = 0; m < 4; ++m) { const f32x4 v0 = acc[ai][bj][m][0] + bva, v1 = acc[ai][bj][m][1] + bvb;
                        u32x4 w; w.x = cvt_pk_bf16(v0[0], v0[1]); w.y = cvt_pk_bf16(v0[2], v0[3]); w.z = cvt_pk_bf16(v1[0], v1[1]); w.w = cvt_pk_bf16(v1[2], v1[3]);
                        *(u32x4*)(O + (size_t)(row0 + ai * HALF + m * 16) * 1024) = w; } }
        }
    }
};
struct EpiOutProj {
    static constexpr bool PERM = false, AFTER_DRAIN = false;
    float* Y; const float* bias; const float* x; float alpha;
    __device__ __forceinline__ void operator()(const f32x4 (&acc)[2][2][4][2], const Unit& u, int wr, int wc, int fr, int fq) const {
        const int row0 = u.pm * BM + wr * 64 + fr, col0 = u.pn * BM + wc * 32 + 4 * fq;
        f32x4 bv[2][2];
#pragma unroll
        for (int bj = 0; bj < 2; ++bj)
#pragma unroll
            for (int n = 0; n < 2; ++n) bv[bj][n] = *(const f32x4*)(bias + col0 + bj * HALF + n * 16);
#pragma unroll
        for (int ai = 0; ai < 2; ++ai)
#pragma unroll
            for (int m = 0; m < 4; ++m) { const size_t off = (size_t)(row0 + ai * HALF + m * 16) * 2048 + col0;
#pragma unroll
                for (int bj = 0; bj < 2; ++bj)
#pragma unroll
                    for (int n = 0; n < 2; ++n) { const f32x4 xv = *(const f32x4*)(x + off + bj * HALF + n * 16);
                        *(f32x4*)(Y + off + bj * HALF + n * 16) = acc[ai][bj][m][n] + bv[bj][n] + xv * alpha; }
                asm volatile("" ::: "memory"); }
    }
};
struct EpiF32 {
    static constexpr bool PERM = false, AFTER_DRAIN = false;
    float* C; int ldc;
    __device__ __forceinline__ void operator()(const f32x4 (&acc)[2][2][4][2], const Unit& u, int wr, int wc, int fr, int fq) const {
        const int row0 = u.pm * BM + wr * 64 + fr, col0 = u.pn * BM + wc * 32 + 4 * fq;
#pragma unroll
        for (int ai = 0; ai < 2; ++ai)
#pragma unroll
            for (int m = 0; m < 4; ++m) { float* rowp = C + (size_t)(row0 + ai * HALF + m * 16) * ldc + col0;
#pragma unroll
                for (int bj = 0; bj < 2; ++bj)
#pragma unroll
                    for (int n = 0; n < 2; ++n) *(f32x4*)(rowp + bj * HALF + n * 16) = acc[ai][bj][m][n]; }
    }
};

template <class Epi, class Sched, bool ALIGN_EPI = false, bool SP2 = false>
__device__ __forceinline__ void gemm_phase(PG8_LAS unsigned char* lds, const Gemm g, const Sched& S, const Epi& E) {
    const int tid = threadIdx.x, wid = __builtin_amdgcn_readfirstlane(tid >> 6), lane = tid & 63, wr = wid >> 2, wc = wid & 3, fr = lane & 15, fq = lane >> 4;
    const int K = g.K, nt = K / BK;
    unsigned voffA[2], voffB[2];
#pragma unroll
    for (int i = 0; i < 2; ++i) { int R, C; stage_rc(tid * 16 + i * 8192, R, C); const int Rb = Epi::PERM ? ((R & ~31) + perm32(R & 31)) : R;
        voffA[i] = (unsigned)(R * K + C) * 2u; voffB[i] = (unsigned)(Rb * K + C) * 2u; }
    const size_t kstep = (size_t)(BK * 2);
    const size_t hstep = (size_t)HALF * K * 2;
    const size_t tstep = 2 * hstep;
    const unsigned ldsw = (unsigned)wid * 1024u;
    const int aoff = lds_byte(wr * 64 + fr, fq * 8), boff = lds_byte(wc * 32 + fr, fq * 8);
#define PG8_SA(b, h) (((b) * 2 + (h)) * HTB)
#define PG8_SB(b, h) ((4 + (b) * 2 + (h)) * HTB)
#define PG8_STAGE(bufoff, gbase, voff) do { _Pragma("unroll") for (int _i = 0; _i < 2; ++_i) \
        __builtin_amdgcn_global_load_lds((const unsigned*)((const char*)(gbase) + (voff)[_i]), (PG8_LAS unsigned*)(lds + (bufoff) + ldsw + _i * 8192), 16, 0, 0); } while (0)
#define PG8_LDA(dst, b, h) do { _Pragma("unroll") for (int m = 0; m < 4; ++m) _Pragma("unroll") for (int k = 0; k < 2; ++k) dst[m][k] = *(const PG8_LAS bf16x8*)(lds + PG8_SA(b, h) + aoff + m * 2048 + k * 1024); } while (0)
#define PG8_LDB(dst, b, h) do { _Pragma("unroll") for (int n = 0; n < 2; ++n) _Pragma("unroll") for (int k = 0; k < 2; ++k) dst[n][k] = *(const PG8_LAS bf16x8*)(lds + PG8_SB(b, h) + boff + n * 2048 + k * 1024); } while (0)
#define PG8_MMA(ai, bj, At, Bt) do { __builtin_amdgcn_s_setprio(1); _Pragma("unroll") for (int m = 0; m < 4; ++m) _Pragma("unroll") for (int n = 0; n < 2; ++n) _Pragma("unroll") for (int k = 0; k < 2; ++k) \
        acc[ai][bj][m][n] = __builtin_amdgcn_mfma_f32_16x16x32_bf16(Bt[n][k], At[m][k], acc[ai][bj][m][n], 0, 0, 0); __builtin_amdgcn_s_setprio(0); } while (0)
#define PG8_WAIT_V(n) asm volatile("s_waitcnt vmcnt(" #n ")" ::: "memory")
#define PG8_WAIT_L(n) asm volatile("s_waitcnt lgkmcnt(" #n ")" ::: "memory")
#define PG8_BAR __builtin_amdgcn_s_barrier()
#define PG8_SCHED __builtin_amdgcn_sched_barrier(0)
    Unit cur, nxt; int ui = 0;
    if (!S.next(0, cur)) return;
    f32x4 acc[2][2][4][2];
#pragma unroll
    for (int a = 0; a < 2; ++a)
#pragma unroll
        for (int b = 0; b < 2; ++b)
#pragma unroll
            for (int m = 0; m < 4; ++m)
#pragma unroll
                for (int n = 0; n < 2; ++n) acc[a][b][m][n] = (f32x4){0.f, 0.f, 0.f, 0.f};
    bf16x8 At[4][2], B0[2][2], B1[2][2];
    const char* cA = (const char*)g.A + (size_t)cur.pm * tstep; const char* cB = (const char*)g.Bt + (size_t)cur.pn * tstep;
    S.a_ready(cur);
    if constexpr (SP2) {
        PG8_STAGE(PG8_SB(0, 0), cB, voffB); PG8_STAGE(PG8_SB(0, 1), cB + hstep, voffB); PG8_STAGE(PG8_SA(0, 0), cA, voffA); PG8_STAGE(PG8_SA(0, 1), cA + hstep, voffA);
        if (wr == 1) PG8_BAR;
        PG8_WAIT_V(2); PG8_BAR;
        PG8_STAGE(PG8_SB(1, 0), cB + kstep, voffB); PG8_STAGE(PG8_SA(1, 0), cA + kstep, voffA); PG8_STAGE(PG8_SB(1, 1), cB + hstep + kstep, voffB);
        PG8_WAIT_V(6); PG8_BAR;
    } else {
        PG8_STAGE(PG8_SB(0, 0), cB, voffB); PG8_STAGE(PG8_SA(0, 0), cA, voffA); PG8_STAGE(PG8_SB(0, 1), cB + hstep, voffB); PG8_STAGE(PG8_SA(0, 1), cA + hstep, voffA);
        if (wr == 1) PG8_BAR;
        PG8_WAIT_V(4); PG8_BAR;
        PG8_STAGE(PG8_SB(1, 0), cB + kstep, voffB); PG8_STAGE(PG8_SA(1, 0), cA + kstep, voffA); PG8_STAGE(PG8_SB(1, 1), cB + hstep + kstep, voffB);
        PG8_WAIT_V(6); PG8_BAR;
    }
    for (;;) {
        const bool has_next = S.next(ui + 1, nxt);
        const char* nA = has_next ? (const char*)g.A + (size_t)nxt.pm * tstep : cA; const char* nB = has_next ? (const char*)g.Bt + (size_t)nxt.pn * tstep : cB;
        for (int t = 0; t < nt; t += 2) {
            const bool last = (t == nt - 2);
            const char* a1 = cA + (size_t)(t + 1) * kstep;
            const char* a2 = last ? nA : cA + (size_t)(t + 2) * kstep; const char* b2 = last ? nB : cB + (size_t)(t + 2) * kstep;
            const char* a3 = a2 + kstep; const char* b3 = b2 + kstep;
            if (last && has_next) S.a_ready(nxt);
            if constexpr (SP2) {
            PG8_LDB(B0, 0, 0); PG8_LDB(B1, 0, 1); PG8_SCHED; PG8_LDA(At, 0, 0); PG8_STAGE(PG8_SA(1, 1), a1 + hstep, voffA);
            PG8_WAIT_V(8); PG8_WAIT_L(0); PG8_BAR; PG8_MMA(0, 0, At, B0); PG8_MMA(0, 1, At, B1); PG8_BAR; PG8_SCHED;
            PG8_LDA(At, 0, 1); PG8_STAGE(PG8_SB(0, 0), b2, voffB); PG8_STAGE(PG8_SB(0, 1), b2 + hstep, voffB); PG8_STAGE(PG8_SA(0, 0), a2, voffA);
            PG8_WAIT_V(8); PG8_WAIT_L(0); PG8_BAR; PG8_MMA(1, 0, At, B0); PG8_MMA(1, 1, At, B1); PG8_BAR; PG8_SCHED;
            PG8_LDB(B0, 1, 0); PG8_LDB(B1, 1, 1); PG8_SCHED; PG8_LDA(At, 1, 0); PG8_STAGE(PG8_SA(0, 1), a2 + hstep, voffA);
            PG8_WAIT_V(8); PG8_WAIT_L(0); PG8_BAR; PG8_MMA(0, 0, At, B0); PG8_MMA(0, 1, At, B1); PG8_BAR; PG8_SCHED;
            PG8_LDA(At, 1, 1); PG8_STAGE(PG8_SB(1, 0), b3, voffB); PG8_STAGE(PG8_SB(1, 1), b3 + hstep, voffB); PG8_STAGE(PG8_SA(1, 0), a3, voffA);
            PG8_WAIT_V(8); PG8_WAIT_L(0); PG8_BAR; PG8_MMA(1, 0, At, B0); PG8_MMA(1, 1, At, B1); PG8_BAR; PG8_SCHED;
            } else {
            PG8_LDB(B0, 0, 0); PG8_SCHED; PG8_LDA(At, 0, 0); PG8_STAGE(PG8_SA(1, 1), a1 + hstep, voffA);
            PG8_WAIT_L(8); PG8_BAR; PG8_WAIT_L(0); PG8_MMA(0, 0, At, B0); PG8_BAR; PG8_SCHED;
            PG8_LDB(B1, 0, 1); PG8_STAGE(PG8_SB(0, 0), b2, voffB);
            PG8_BAR; PG8_WAIT_L(0); PG8_MMA(0, 1, At, B1); PG8_BAR;
            PG8_LDA(At, 0, 1); PG8_STAGE(PG8_SA(0, 0), a2, voffA);
            PG8_BAR; PG8_WAIT_L(0); PG8_MMA(1, 0, At, B0); PG8_BAR; PG8_SCHED;
            PG8_STAGE(PG8_SB(0, 1), b2 + hstep, voffB);
            PG8_WAIT_V(6); PG8_BAR; PG8_MMA(1, 1, At, B1); PG8_BAR;
            PG8_LDB(B0, 1, 0); PG8_SCHED; PG8_LDA(At, 1, 0); PG8_STAGE(PG8_SA(0, 1), a2 + hstep, voffA);
            PG8_WAIT_L(8); PG8_BAR; PG8_WAIT_L(0); PG8_MMA(0, 0, At, B0); PG8_BAR; PG8_SCHED;
            PG8_LDB(B1, 1, 1); PG8_STAGE(PG8_SB(1, 0), b3, voffB);
            PG8_BAR; PG8_WAIT_L(0); PG8_MMA(0, 1, At, B1); PG8_BAR;
            PG8_LDA(At, 1, 1); PG8_STAGE(PG8_SA(1, 0), a3, voffA);
            PG8_BAR; PG8_WAIT_L(0); PG8_MMA(1, 0, At, B0); PG8_BAR; PG8_SCHED;
            PG8_STAGE(PG8_SB(1, 1), b3 + hstep, voffB);
            PG8_WAIT_V(6); PG8_BAR; PG8_MMA(1, 1, At, B1); PG8_BAR;
            }
        }
        if constexpr (ALIGN_EPI) { if (wr == 0) PG8_BAR; }
        if constexpr (!Epi::AFTER_DRAIN) { E(acc, cur, wr, wc, fr, fq); S.done(cur); }
        if (!has_next) break;
#pragma unroll
        for (int a = 0; a < 2; ++a)
#pragma unroll
            for (int b = 0; b < 2; ++b)
#pragma unroll
                for (int m = 0; m < 4; ++m)
#pragma unroll
                    for (int n = 0; n < 2; ++n) acc[a][b][m][n] = (f32x4){0.f, 0.f, 0.f, 0.f};
        cur = nxt; cA = nA; cB = nB; ++ui;
        if constexpr (ALIGN_EPI) { if (wr == 1) PG8_BAR; }
    }
    PG8_WAIT_V(0);
    if constexpr (!ALIGN_EPI) { if (wr == 0) PG8_BAR; }
    PG8_BAR;
    if constexpr (Epi::AFTER_DRAIN) { E.fused(acc, cur, wr, wc, fr, fq, lds, wid, lane); S.done(cur); }
#undef PG8_SA
#undef PG8_SB
#undef PG8_STAGE
#undef PG8_LDA
#undef PG8_LDB
#undef PG8_MMA
#undef PG8_WAIT_V
#undef PG8_WAIT_L
#undef PG8_BAR
#undef PG8_SCHED
}
}

#ifndef PG8_SP2
#define PG8_SP2 true
#endif
#ifndef PG8_ALIGN
#define PG8_ALIGN true
#endif
constexpr int NWAVES = 8;
#ifndef MK_N_LAUNCHES
#define MK_N_LAUNCHES 1
#endif
constexpr int N_PHASES = 8;
constexpr int N_LAUNCHES = MK_N_LAUNCHES;

constexpr int ROWB = 1536;
constexpr int S = 8192, D = 2048, NIN = 5120, DC = 1024, NE = 16384, NPAIR = 128;
constexpr float LN_EPS = 1e-5f;
constexpr float ALPHA = 1.189207115002721f;

constexpr size_t MiB = 1u << 20;
constexpr size_t WS_CTL = 0, CTL_ZERO_BYTES = 64 * 1024;
constexpr size_t WS_XB = 2 * MiB;
constexpr size_t WS_BT1 = 34 * MiB;
constexpr size_t WS_BT2 = 54 * MiB;
constexpr size_t WS_BT3 = 62 * MiB;
constexpr size_t WS_AGLU = 70 * MiB;
constexpr size_t WS_CV = 86 * MiB;
constexpr size_t WS_SCB = 102 * MiB;
constexpr size_t WS_MIX = 118 * MiB;
constexpr size_t WS_Y = 150 * MiB;
constexpr size_t WS_X1 = 214 * MiB;
constexpr size_t WS_S = 246 * MiB;
constexpr size_t WS_IDX = 310 * MiB;
constexpr size_t WS_GV = 314 * MiB;
constexpr size_t WS_SU = 318 * MiB;
constexpr size_t WS_U8 = 322 * MiB;
constexpr size_t WS_V8 = 354 * MiB;
constexpr size_t WS_USC = 386 * MiB;
constexpr size_t WS_VSC = 386 * MiB + 65536;
constexpr size_t WS_END = 387 * MiB;
constexpr int CW_BAR = 4096;

constexpr int RING_OFF = 0, RING_BYTES = 131072;
constexpr int LDSCTL_OFF = RING_BYTES, MISC_OFF = LDSCTL_OFF + 320;
constexpr int LDS_BYTES = 147456;

#define GAS __attribute__((address_space(1)))
#define LAS __attribute__((address_space(3)))
typedef unsigned short bf16;
typedef unsigned v4u __attribute__((ext_vector_type(4)));
typedef unsigned v2u __attribute__((ext_vector_type(2)));
typedef float f32x4 __attribute__((ext_vector_type(4)));
typedef float f32x2 __attribute__((ext_vector_type(2)));
typedef short bf16x8 __attribute__((ext_vector_type(8)));
typedef GAS unsigned gu32;
#define LDS_WAIT() asm volatile("s_waitcnt lgkmcnt(0)" ::: "memory")
#define VM_WAIT() asm volatile("s_waitcnt vmcnt(0)" ::: "memory")
__device__ __forceinline__ unsigned pk2(float lo, float hi) { return pg8::cvt_pk_bf16(lo, hi); }
__device__ __forceinline__ float bf_lo(unsigned w) { return __uint_as_float(w << 16); }
__device__ __forceinline__ float bf_hi(unsigned w) { return __uint_as_float(w & 0xffff0000u); }
__device__ __forceinline__ float wave_sum(float v) {
#pragma unroll
    for (int o = 1; o < 64; o <<= 1) v += __shfl_xor(v, o);
    return v;
}
__device__ __forceinline__ float wave_max(float v) {
#pragma unroll
    for (int o = 1; o < 64; o <<= 1) v = fmaxf(v, __shfl_xor(v, o));
    return v;
}

#define XB_TMO      128
#define XB_XCNT(j)  (256  + 64 * (j))
#define XB_XSUB(j)  (1280 + 64 * (j))
#define XB_XGEN(j)  (2304 + 64 * (j))
#define XB_TOP      3328
#define XB_TOPGEN   3392
#define XCD_BAR_WORDS 3456
#define XB_SPIN_CAP (1u << 18)

__device__ __forceinline__ unsigned xb_ld(unsigned* p)              { return __hip_atomic_load(p, __ATOMIC_RELAXED, __HIP_MEMORY_SCOPE_AGENT); }
__device__ __forceinline__ unsigned xb_add(unsigned* p, unsigned v) { return __hip_atomic_fetch_add(p, v, __ATOMIC_RELAXED, __HIP_MEMORY_SCOPE_AGENT); }
__device__ __forceinline__ unsigned xb_xcc_id() { return (unsigned)__builtin_amdgcn_s_getreg((3 << 11) | 20) & 0xFu; }
#define XB_SPIN(cond, bar) do { unsigned _sp = 0; while (cond) { __builtin_amdgcn_s_sleep(1); \
    if ((++_sp & 255u) == 0u) { if (xb_ld(&(bar)[XB_TMO])) break; if (_sp > XB_SPIN_CAP) { atomicAdd(&(bar)[XB_TMO], 1u); break; } } } } while (0)

struct XcdBarrier {
    unsigned* bar; unsigned x;
    volatile LAS unsigned* st;
};

__device__ __forceinline__ XcdBarrier xcd_barrier_post(unsigned* bar, volatile LAS unsigned* st) {
    XcdBarrier b; b.bar = bar; b.x = xb_xcc_id(); b.st = st;
    if (threadIdx.x == 0) (void)xb_add(&bar[XB_XCNT(b.x)], 1u);
    return b;
}
__device__ __forceinline__ void xcd_barrier_complete(unsigned* bar, unsigned x, unsigned& nloc, unsigned& nx) {
    const unsigned G = gridDim.x * gridDim.y * gridDim.z;
    unsigned sum, cnt, mine, sp = 0u;
    for (;;) {
        sum = 0u; cnt = 0u; mine = 0u;
#pragma unroll
        for (unsigned j = 0; j < 16; ++j) { const unsigned c = xb_ld(&bar[XB_XCNT(j)]); sum += c; cnt += (c > 0u) ? 1u : 0u; mine = (j == x) ? c : mine; }
        if (sum == G) break;
        __builtin_amdgcn_s_sleep(1);
        if ((++sp & 255u) == 0u) { if (xb_ld(&bar[XB_TMO])) break; if (sp > XB_SPIN_CAP) { atomicAdd(&bar[XB_TMO], 1u); break; } }
    }
    nloc = mine > 0u ? mine : 1u; nx = cnt > 0u ? cnt : 1u;
}

__device__ __forceinline__ void xcd_barrier(const XcdBarrier& b) {
    asm volatile("s_waitcnt vmcnt(0)" ::: "memory");
    __syncthreads();
    if (threadIdx.x == 0) {
        unsigned* bar = b.bar;
        __builtin_amdgcn_s_waitcnt(0);
        unsigned nloc = b.st[0], nx = b.st[1];
        if (nloc == 0u) { xcd_barrier_complete(bar, b.x, nloc, nx); b.st[0] = nloc; b.st[1] = nx; }
        const unsigned old = xb_add(&bar[XB_XSUB(b.x)], 1u);
        const unsigned gen = old / nloc;
        if (old + 1u == (gen + 1u) * nloc) {
            __builtin_amdgcn_fence(__ATOMIC_RELEASE, "agent");
            asm volatile("s_waitcnt vmcnt(0)" ::: "memory");
            const unsigned og = xb_add(&bar[XB_TOP], 1u);
            const unsigned tg = og / nx;
            if (og + 1u == (tg + 1u) * nx) xb_add(&bar[XB_TOPGEN], 1u);
            else XB_SPIN(xb_ld(&bar[XB_TOPGEN]) == tg, bar);
            __builtin_amdgcn_fence(__ATOMIC_ACQUIRE, "agent");
            xb_add(&bar[XB_XGEN(b.x)], 1u);
            asm volatile("s_waitcnt vmcnt(0)" ::: "memory");
        } else {
            XB_SPIN(xb_ld(&bar[XB_XGEN(b.x)]) == gen, bar);
            __builtin_amdgcn_fence(__ATOMIC_ACQUIRE, "agent");
            asm volatile("s_waitcnt vmcnt(0)" ::: "memory");
        }
    }
    __syncthreads();
}

struct Frame {
    LAS unsigned char* lds;
    volatile LAS unsigned* MISC;
    gu32* ctl;
    int tid, lane, wave, vcu, G;
    const float *x, *w_in, *b_in, *ccw, *ccb, *clg, *clb, *scw, *scbias, *w_out, *b_out, *ln1g, *ln1b, *w_q, *sub_keys, *peer_u, *peer_v, *ln2g, *ln2b;
    float* out;
    bf16 *XB, *BT1, *BT2, *BT3, *AGLU, *CV, *SCB, *MIX, *X1;
    float *Y, *SS; int* IDX; float *GV, *SU; unsigned char *U8, *V8; float *USC, *VSC;
};

__device__ __forceinline__ int bt1_row(int n0) {
    const int grp = n0 >> 10, c = n0 & 1023, j = c >> 7, r = c & 127;
    if (grp == 0) return 256 * j + r;
    if (grp == 1) return 256 * j + 128 + r;
    if (grp == 2) return 4096 + c;
    if (grp == 3) return 2048 + 256 * j + r;
    return 2048 + 256 * j + 128 + r;
}
template <bool PERM_IN>
__device__ __forceinline__ void p0_transpose_item(const float* W, int K, int N, bf16* WT, LAS float* scr, int item, int lane) {
    const int nblk = N / 32, kb = item / nblk, nb = item % nblk, k0 = 64 * kb, n0 = 32 * nb;
    const int drow = PERM_IN ? bt1_row(n0) : n0;
#pragma unroll 8
    for (int i = 0; i < 32; ++i) { const int kk = 2 * i + (lane >> 5); scr[kk * 33 + (lane & 31)] = W[(size_t)(k0 + kk) * N + n0 + (lane & 31)]; }
    LDS_WAIT(); asm volatile("" ::: "memory");
    const int c = lane & 7;
#pragma unroll
    for (int j = 0; j < 4; ++j) { const int n = (lane >> 3) + 8 * j; const LAS float* s = scr + (8 * c) * 33 + n;
        v4u o; o.x = pk2(s[0 * 33], s[1 * 33]); o.y = pk2(s[2 * 33], s[3 * 33]); o.z = pk2(s[4 * 33], s[5 * 33]); o.w = pk2(s[6 * 33], s[7 * 33]);
        *(GAS v4u*)(WT + (size_t)(drow + n) * K + k0 + 8 * c) = o; }
    LDS_WAIT(); asm volatile("" ::: "memory");
}
__device__ __forceinline__ bf16x8 ld8_bf16(const float* p) {
    const f32x4 a = *(const f32x4*)p, b = *(const f32x4*)(p + 4);
    v4u w; w.x = pk2(a.x, a.y); w.y = pk2(a.z, a.w); w.z = pk2(b.x, b.y); w.w = pk2(b.z, b.w);
    return __builtin_bit_cast(bf16x8, w);
}
__device__ __forceinline__ unsigned fp6_encode(float y) {
    const unsigned sb = (__float_as_uint(y) >> 31) << 5;
    const float a = fabsf(y);
    const unsigned sub = (unsigned)__builtin_rintf(a * 8.0f);
    unsigned b = __float_as_uint(a); b += 0x7FFFFu + ((b >> 20) & 1u); b >>= 20;
    unsigned nrm = b - 1008u; nrm = nrm > 31u ? 31u : nrm;
    return sb | (a < 1.0f ? sub : nrm);
}
__device__ __forceinline__ void p0_prologue(Frame& F) {
    LAS float* scr = (LAS float*)(F.lds + RING_OFF + F.wave * 16384);
    const int gw = F.vcu * NWAVES + F.wave, NGW = F.G * NWAVES, lane = F.lane;
    constexpr int I_IN = (D / 64) * (NIN / 32), I_OUT = (D / 64) * (D / 32);
    for (int it = gw; it < I_IN + I_OUT; it += NGW) {
        if (it < I_IN) p0_transpose_item<true>(F.w_in, D, NIN, F.BT1, scr, it, lane);
        else p0_transpose_item<false>(F.w_out, D, D, F.BT2, scr, it - I_IN, lane);
    }
    for (int it = gw; it < 4096; it += NGW) {
        const int hp = it >> 8, nb = (it >> 5) & 7, db = it & 31, n0 = nb * 16, d0 = db * 64;
        const float* sk = F.sub_keys + ((size_t)hp * 128 + n0 + (lane & 15)) * 128 + 8 * (lane >> 4);
        const float* wq = F.w_q + (size_t)(d0 + (lane & 15)) * 2048 + hp * 128 + 8 * (lane >> 4);
        f32x4 acc[4];
#pragma unroll
        for (int dt = 0; dt < 4; ++dt) acc[dt] = (f32x4){0.f, 0.f, 0.f, 0.f};
#pragma unroll
        for (int ks = 0; ks < 4; ++ks) {
            const bf16x8 yf = ld8_bf16(sk + 32 * ks);
#pragma unroll
            for (int dt = 0; dt < 4; ++dt) { const bf16x8 xf = ld8_bf16(wq + (size_t)dt * 16 * 2048 + 32 * ks);
                acc[dt] = __builtin_amdgcn_mfma_f32_16x16x32_bf16(xf, yf, acc[dt], 0, 0, 0); }
        }
        bf16* orow = F.BT3 + (size_t)(hp * 128 + n0 + (lane & 15)) * 2048 + d0 + 4 * (lane >> 4);
#pragma unroll
        for (int dt = 0; dt < 4; ++dt) { v2u o; o.x = pk2(acc[dt][0], acc[dt][1]); o.y = pk2(acc[dt][2], acc[dt][3]); *(GAS v2u*)(orow + 16 * dt) = o; }
    }
    for (int r = gw; r < S; r += NGW) {
        const GAS f32x4* src = (const GAS f32x4*)(F.x + (size_t)r * D) + 2 * lane;
        GAS v4u* dst = (GAS v4u*)(F.XB + (size_t)r * D) + lane;
#pragma unroll
        for (int j = 0; j < 4; ++j) { const f32x4 a = src[128 * j], b = src[128 * j + 1];
            v4u o; o.x = pk2(a.x, a.y); o.y = pk2(a.z, a.w); o.z = pk2(b.x, b.y); o.w = pk2(b.z, b.w); dst[64 * j] = o; }
    }
    for (int r = gw; r < 2 * NE; r += NGW) {
        const bool isv = r >= NE; const int e = isv ? r - NE : r;
        const GAS f32x4* src = (const GAS f32x4*)((isv ? F.peer_v : F.peer_u) + (size_t)e * D) + lane;
        f32x4 v[8]; float am = 0.f;
#pragma unroll
        for (int j = 0; j < 8; ++j) { v[j] = src[64 * j];
            am = fmaxf(am, fmaxf(fmaxf(fabsf(v[j].x), fabsf(v[j].y)), fmaxf(fabsf(v[j].z), fabsf(v[j].w)))); }
        am = wave_max(am);
        const float sc = am > 0.f ? 7.5f / am : 1.f, inv = am > 0.f ? am / 7.5f : 1.f;
        unsigned w[6];
#pragma unroll
        for (int h = 0; h < 2; ++h) {
            unsigned c[16];
#pragma unroll
            for (int i = 0; i < 16; ++i) c[i] = fp6_encode(v[4 * h + (i >> 2)][i & 3] * sc);
            w[3 * h + 0] = c[0] | (c[1] << 6) | (c[2] << 12) | (c[3] << 18) | (c[4] << 24) | (c[5] << 30);
            w[3 * h + 1] = (c[5] >> 2) | (c[6] << 4) | (c[7] << 10) | (c[8] << 16) | (c[9] << 22) | (c[10] << 28);
            w[3 * h + 2] = (c[10] >> 4) | (c[11] << 2) | (c[12] << 8) | (c[13] << 14) | (c[14] << 20) | (c[15] << 26);
        }
        unsigned char* dst = (isv ? F.V8 : F.U8) + (size_t)e * ROWB + 24 * lane;
        *(GAS v2u*)(dst) = (v2u){w[0], w[1]}; *(GAS v2u*)(dst + 8) = (v2u){w[2], w[3]}; *(GAS v2u*)(dst + 16) = (v2u){w[4], w[5]};
        if (lane == 0) (isv ? F.VSC : F.USC)[e] = inv;
    }
}

__device__ __forceinline__ void p2_unit(Frame& F, int unit) {
    const int t0 = unit * 32, tid = F.tid, lane = F.lane, c0 = 2 * tid;
    LAS float* cbuf = (LAS float*)(F.lds + RING_OFF);
    {
        f32x2 w[31];
#pragma unroll
        for (int k = 0; k < 31; ++k) w[k] = *(const GAS f32x2*)(F.ccw + k * 1024 + c0);
        const f32x2 bias = *(const GAS f32x2*)(F.ccb + c0);
#pragma unroll 1
        for (int g = 0; g < 4; ++g) {
            const int tb = t0 + 8 * g - 30;
            f32x2 in[38];
#pragma unroll
            for (int i = 0; i < 38; ++i) { const int t = tb + i; const int tc = t < 0 ? 0 : t;
                const unsigned raw = *(const GAS unsigned*)(F.AGLU + (size_t)tc * 1024 + c0);
                in[i] = t < 0 ? (f32x2){0.f, 0.f} : (f32x2){bf_lo(raw), bf_hi(raw)}; }
#pragma unroll
            for (int tt = 0; tt < 8; ++tt) { f32x2 a = bias;
#pragma unroll
                for (int k = 0; k < 31; ++k) a += w[k] * in[tt + k];
                *(LAS f32x2*)(cbuf + (8 * g + tt) * 1024 + c0) = a; }
        }
    }
    {
        const f32x2 w0 = *(const GAS f32x2*)(F.scw + c0), w1 = *(const GAS f32x2*)(F.scw + 1024 + c0), w2 = *(const GAS f32x2*)(F.scw + 2048 + c0), bias = *(const GAS f32x2*)(F.scbias + c0);
        f32x2 p2 = (f32x2){0.f, 0.f}, p1 = (f32x2){0.f, 0.f};
        if (t0 > 0) { const unsigned r2 = *(const GAS unsigned*)(F.CV + (size_t)(t0 - 2) * 1024 + c0), r1 = *(const GAS unsigned*)(F.CV + (size_t)(t0 - 1) * 1024 + c0);
            p2 = (f32x2){bf_lo(r2), bf_hi(r2)}; p1 = (f32x2){bf_lo(r1), bf_hi(r1)}; }
#pragma unroll 8
        for (int tt = 0; tt < 32; ++tt) {
            const unsigned rc = *(const GAS unsigned*)(F.CV + (size_t)(t0 + tt) * 1024 + c0), rg = *(const GAS unsigned*)(F.SCB + (size_t)(t0 + tt) * 1024 + c0);
            const f32x2 cur = (f32x2){bf_lo(rc), bf_hi(rc)}, gate = (f32x2){bf_lo(rg), bf_hi(rg)};
            const f32x2 o = gate * (bias + w0 * p2 + w1 * p1 + w2 * cur);
            *(GAS unsigned*)(F.MIX + (size_t)(t0 + tt) * 2048 + 1024 + c0) = pk2(o.x, o.y);
            p2 = p1; p1 = cur;
        }
    }
    LDS_WAIT(); __syncthreads();
#pragma unroll 1
    for (int q = 0; q < 4; ++q) {
        const int tt = F.wave * 4 + q;
        f32x4 v[4]; float s = 0.f;
#pragma unroll
        for (int j = 0; j < 4; ++j) { v[j] = *(const LAS f32x4*)(cbuf + tt * 1024 + 4 * lane + 256 * j); s += (v[j].x + v[j].y) + (v[j].z + v[j].w); }
        const float mean = wave_sum(s) * (1.f / 1024.f); float s2 = 0.f;
#pragma unroll
        for (int j = 0; j < 4; ++j) { v[j] = v[j] - mean; s2 += (v[j].x * v[j].x + v[j].y * v[j].y) + (v[j].z * v[j].z + v[j].w * v[j].w); }
        const float rstd = 1.f / sqrtf(wave_sum(s2) * (1.f / 1024.f) + LN_EPS);
#pragma unroll
        for (int j = 0; j < 4; ++j) { const f32x4 g = *(const GAS f32x4*)(F.clg + 4 * lane + 256 * j), b = *(const GAS f32x4*)(F.clb + 4 * lane + 256 * j);
            f32x4 y = v[j] * rstd * g + b;
            y.x *= pg8::sigmoidf_fast(y.x); y.y *= pg8::sigmoidf_fast(y.y); y.z *= pg8::sigmoidf_fast(y.z); y.w *= pg8::sigmoidf_fast(y.w);
            v2u o; o.x = pk2(y.x, y.y); o.y = pk2(y.z, y.w);
            *(GAS v2u*)(F.MIX + (size_t)(t0 + tt) * 2048 + 4 * lane + 256 * j) = o; }
    }
    __syncthreads();
}

__device__ __forceinline__ void p4_ln1(Frame& F) {
    const int gw = F.vcu * NWAVES + F.wave, NGW = F.G * NWAVES, lane = F.lane;
    for (int r = gw; r < S; r += NGW) {
        const GAS f32x4* yr = (const GAS f32x4*)(F.Y + (size_t)r * D) + lane;
        f32x4 v[8]; float s = 0.f;
#pragma unroll
        for (int j = 0; j < 8; ++j) { v[j] = yr[64 * j]; s += (v[j].x + v[j].y) + (v[j].z + v[j].w); }
        const float mean = wave_sum(s) * (1.f / D); float s2 = 0.f;
#pragma unroll
        for (int j = 0; j < 8; ++j) { v[j] = v[j] - mean; s2 += (v[j].x * v[j].x + v[j].y * v[j].y) + (v[j].z * v[j].z + v[j].w * v[j].w); }
        const float rstd = 1.f / sqrtf(wave_sum(s2) * (1.f / D) + LN_EPS);
        GAS v2u* o8 = (GAS v2u*)(F.X1 + (size_t)r * D) + lane;
#pragma unroll
        for (int j = 0; j < 8; ++j) { const f32x4 g = *(const GAS f32x4*)(F.ln1g + 4 * lane + 256 * j), b = *(const GAS f32x4*)(F.ln1b + 4 * lane + 256 * j);
            const f32x4 y = v[j] * rstd * g + b; v2u o; o.x = pk2(y.x, y.y); o.y = pk2(y.z, y.w); o8[64 * j] = o; }
    }
}

__device__ __forceinline__ int imax_(int a, int b) { return a > b ? a : b; }
__device__ __forceinline__ int imin_(int a, int b) { return a < b ? a : b; }
template <bool DESC> __device__ __forceinline__ void ce_i(int& a, int& b) { const int mx = imax_(a, b), mn = imin_(a, b); a = DESC ? mx : mn; b = DESC ? mn : mx; }
template <bool DESC> __device__ __forceinline__ void sort16_i(int (&v)[16]) {
#pragma unroll
    for (int k = 2; k <= 16; k <<= 1)
#pragma unroll
        for (int j = k >> 1; j > 0; j >>= 1)
#pragma unroll
            for (int i = 0; i < 16; ++i) { const int l = i ^ j; if (l > i) { const bool up = ((i & k) == 0); if (up != DESC) ce_i<false>(v[i], v[l]); else ce_i<true>(v[i], v[l]); } }
}
template <bool DESC> __device__ __forceinline__ void merge16_i(int (&v)[16]) {
#pragma unroll
    for (int j = 8; j > 0; j >>= 1)
#pragma unroll
        for (int i = 0; i < 16; ++i) { const int l = i ^ j; if (l > i) ce_i<DESC>(v[i], v[l]); }
}
template <bool DESC> __device__ __forceinline__ void ce_p(float& a, int& pa, float& b, int& pb) {
    const bool sw = DESC ? (a < b) : (a > b); const float ta = sw ? b : a, tb = sw ? a : b; const int qa = sw ? pb : pa, qb = sw ? pa : pb; a = ta; b = tb; pa = qa; pb = qb; }
template <bool DESC> __device__ __forceinline__ void sort16_p(float (&v)[16], int (&p)[16]) {
#pragma unroll
    for (int k = 2; k <= 16; k <<= 1)
#pragma unroll
        for (int j = k >> 1; j > 0; j >>= 1)
#pragma unroll
            for (int i = 0; i < 16; ++i) { const int l = i ^ j; if (l > i) { const bool up = ((i & k) == 0); if (up != DESC) ce_p<false>(v[i], p[i], v[l], p[l]); else ce_p<true>(v[i], p[i], v[l], p[l]); } }
}
template <bool DESC> __device__ __forceinline__ void merge16_p(float (&v)[16], int (&p)[16]) {
#pragma unroll
    for (int j = 8; j > 0; j >>= 1)
#pragma unroll
        for (int i = 0; i < 16; ++i) { const int l = i ^ j; if (l > i) ce_p<DESC>(v[i], p[i], v[l], p[l]); }
}
__device__ __forceinline__ int f2key(float f) { const int b = __float_as_int(f); return b ^ ((b >> 31) & 0x7fffffff); }
__device__ __forceinline__ float key2f(int k) { return __int_as_float(k ^ ((k >> 31) & 0x7fffffff)); }

__device__ __forceinline__ void p6_topk(Frame& F) {
    const int gw = F.vcu * NWAVES + F.wave, NGW = F.G * NWAVES, lane = F.lane;
    for (int it = gw; it < (S * 16) / 64; it += NGW) {
        const int prob = it * 64 + lane, t = prob >> 4, hp = prob & 15;
        const float* sp = F.SS + (size_t)t * 2048 + hp * 128;
        int top[16];
        {
            f32x4 r[4];
#pragma unroll
            for (int q = 0; q < 4; ++q) r[q] = *(const GAS f32x4*)(sp + 4 * q);
#pragma unroll
            for (int q = 0; q < 4; ++q)
#pragma unroll
                for (int e = 0; e < 4; ++e) top[4 * q + e] = (f2key(r[q][e]) & ~127) | (4 * q + e);
            sort16_i<true>(top);
        }
#pragma unroll 1
        for (int c = 1; c < 8; ++c) {
            f32x4 r[4]; int nw[16];
#pragma unroll
            for (int q = 0; q < 4; ++q) r[q] = *(const GAS f32x4*)(sp + 16 * c + 4 * q);
#pragma unroll
            for (int q = 0; q < 4; ++q)
#pragma unroll
                for (int e = 0; e < 4; ++e) nw[4 * q + e] = (f2key(r[q][e]) & ~127) | (16 * c + 4 * q + e);
            sort16_i<false>(nw);
#pragma unroll
            for (int i = 0; i < 16; ++i) top[i] = imax_(top[i], nw[i]);
            merge16_i<true>(top);
        }
        const bool odd = (lane & 1) != 0;
        float Av[16], Bv[16]; int Ai[16], Bi[16];
#pragma unroll
        for (int i = 0; i < 16; ++i) { const int mine = top[i]; const int other = __shfl_xor(mine, 1); const int ka = odd ? other : mine, kb = odd ? mine : other;
            Av[i] = key2f(ka & ~127); Ai[i] = ka & 127; Bv[i] = key2f(kb & ~127); Bi[i] = kb & 127; }
        float tv[16]; int tp[16];
#pragma unroll
        for (int j = 0; j < 16; ++j) { tv[j] = Av[0] + Bv[j]; tp[j] = Ai[0] * 128 + Bi[j]; }
        {
            float nv[16]; int np[16];
#pragma unroll
            for (int j = 0; j < 8; ++j) { nv[j] = Av[1] + Bv[j]; np[j] = Ai[1] * 128 + Bi[j]; }
#pragma unroll
            for (int j = 0; j < 5; ++j) { nv[8 + j] = Av[2] + Bv[j]; np[8 + j] = Ai[2] * 128 + Bi[j]; }
#pragma unroll
            for (int j = 0; j < 3; ++j) { nv[13 + j] = Av[3] + Bv[j]; np[13 + j] = Ai[3] * 128 + Bi[j]; }
            sort16_p<false>(nv, np);
#pragma unroll
            for (int i = 0; i < 16; ++i) { const bool g = nv[i] > tv[i]; tv[i] = g ? nv[i] : tv[i]; tp[i] = g ? np[i] : tp[i]; }
            merge16_p<true>(tv, tp);
        }
        {
            float nv[16]; int np[16];
            nv[0] = Av[3] + Bv[3]; np[0] = Ai[3] * 128 + Bi[3];
#pragma unroll
            for (int j = 0; j < 3; ++j) { nv[1 + j] = Av[4] + Bv[j]; np[1 + j] = Ai[4] * 128 + Bi[j]; }
#pragma unroll
            for (int i = 5; i < 8; ++i)
#pragma unroll
                for (int j = 0; j < 2; ++j) { nv[4 + 2 * (i - 5) + j] = Av[i] + Bv[j]; np[4 + 2 * (i - 5) + j] = Ai[i] * 128 + Bi[j]; }
#pragma unroll
            for (int i = 8; i < 14; ++i) { nv[10 + i - 8] = Av[i] + Bv[0]; np[10 + i - 8] = Ai[i] * 128 + Bi[0]; }
            sort16_p<false>(nv, np);
#pragma unroll
            for (int i = 0; i < 16; ++i) { const bool g = nv[i] > tv[i]; tv[i] = g ? nv[i] : tv[i]; tp[i] = g ? np[i] : tp[i]; }
            merge16_p<true>(tv, tp);
        }
        {
            const float hi = Av[14] + Bv[0], lo = Av[15] + Bv[0]; const int phi = Ai[14] * 128 + Bi[0], plo = Ai[15] * 128 + Bi[0];
            const float t14 = tv[14], t15 = tv[15]; const int q14 = tp[14], q15 = tp[15];
            const bool g14 = lo > t14, g15 = hi > t15;
            tv[14] = g14 ? lo : t14; tp[14] = g14 ? plo : q14; tv[15] = g15 ? hi : t15; tp[15] = g15 ? phi : q15;
        }
        float mx = tv[0];
#pragma unroll
        for (int i = 1; i < 16; ++i) mx = fmaxf(mx, tv[i]);
        float sum = 0.f;
#pragma unroll
        for (int i = 0; i < 16; ++i) { tv[i] = __expf(tv[i] - mx); sum += tv[i]; }
        const float rs = 1.f / sum;
        const size_t ob = (size_t)t * NPAIR + hp * 8;
        int oe[8]; float og[8], ou[8];
#pragma unroll
        for (int k = 0; k < 8; ++k) { const int pa = tp[k], pb = tp[8 + k]; const float va = tv[k], vb = tv[8 + k];
            oe[k] = odd ? pb : pa; const float g = (odd ? vb : va) * rs; og[k] = g * F.VSC[oe[k]]; ou[k] = F.USC[oe[k]]; }
        *(GAS v4u*)(F.IDX + ob) = (v4u){(unsigned)oe[0], (unsigned)oe[1], (unsigned)oe[2], (unsigned)oe[3]};
        *(GAS v4u*)(F.IDX + ob + 4) = (v4u){(unsigned)oe[4], (unsigned)oe[5], (unsigned)oe[6], (unsigned)oe[7]};
        *(GAS f32x4*)(F.GV + ob) = (f32x4){og[0], og[1], og[2], og[3]};
        *(GAS f32x4*)(F.GV + ob + 4) = (f32x4){og[4], og[5], og[6], og[7]};
        *(GAS f32x4*)(F.SU + ob) = (f32x4){ou[0], ou[1], ou[2], ou[3]};
        *(GAS f32x4*)(F.SU + ob + 4) = (f32x4){ou[4], ou[5], ou[6], ou[7]};
    }
}

constexpr int P7K = 2;
typedef unsigned u32x6 __attribute__((ext_vector_type(6)));
typedef float f32x32 __attribute__((ext_vector_type(32)));
struct RowsK { u32x6 u[P7K]; u32x6 v[P7K]; };
__device__ __forceinline__ u32x6 ld_row6(const unsigned char* p) {
    const v2u a = *(const GAS v2u*)(p), b = *(const GAS v2u*)(p + 8), c = *(const GAS v2u*)(p + 16);
    u32x6 r; r[0] = a.x; r[1] = a.y; r[2] = b.x; r[3] = b.y; r[4] = c.x; r[5] = c.y; return r;
}
__device__ __forceinline__ void p7_issue(Frame& F, RowsK& R, int ev, int c, int lane) {
#pragma unroll
    for (int k = 0; k < P7K; ++k) {
        const int e = __builtin_amdgcn_readlane(ev, ((P7K * c) & 63) + k) >> 7;
        R.u[k] = ld_row6(F.U8 + (size_t)e * ROWB + 24 * lane);
        R.v[k] = ld_row6(F.V8 + (size_t)e * ROWB + 24 * lane);
    }
}
__device__ __forceinline__ float gelu_erf(float z) { return 0.5f * z * (1.0f + erff(z * 0.70710678118654752f)); }
__device__ __forceinline__ void p7_compute(const RowsK& R, const float (&xf)[32], float (&acc)[32], int ev, float u0, float u1, float g0, float g1, int c, int lane) {
    static_assert(P7K == 4 || P7K == 2, "reduction below is written for 2 or 4 experts per chunk");
    float d[P7K];
#pragma unroll
    for (int k = 0; k < P7K; ++k) {
        const f32x32 uf = __builtin_amdgcn_cvt_scalef32_pk32_f32_fp6(R.u[k], 1.0f);
        float s0 = 0.f, s1 = 0.f;
#pragma unroll
        for (int r = 0; r < 32; r += 2) { s0 = fmaf(xf[r], uf[r], s0); s1 = fmaf(xf[r + 1], uf[r + 1], s1); }
        d[k] = s0 + s1;
    }
    float tot; int mykey;
    if constexpr (P7K == 4) {
        const bool b5 = (lane & 32) != 0, b4 = (lane & 16) != 0;
        const float k0 = b5 ? d[2] : d[0], k1 = b5 ? d[P7K - 1] : d[1], s0 = b5 ? d[0] : d[2], s1 = b5 ? d[1] : d[P7K - 1];
        const float e0 = k0 + __shfl_xor(s0, 32), e1 = k1 + __shfl_xor(s1, 32);
        const float kk = b4 ? e1 : e0, ss = b4 ? e0 : e1;
        tot = kk + __shfl_xor(ss, 16);
        mykey = __shfl(ev, ((P7K * c) & 63) + (lane >> 4));
    } else {
        const bool b5 = (lane & 32) != 0;
        const float keep = b5 ? d[1] : d[0], send = b5 ? d[0] : d[1];
        tot = keep + __shfl_xor(send, 32);
        tot += __shfl_xor(tot, 16);
        mykey = __shfl(ev, ((P7K * c) & 63) + (lane >> 5));
    }
    tot += __shfl_xor(tot, 8); tot += __shfl_xor(tot, 4); tot += __shfl_xor(tot, 2); tot += __shfl_xor(tot, 1);
    const int pi = mykey & 127;
    const float su_a = __shfl(u0, pi & 63), su_b = __shfl(u1, pi & 63), g_a = __shfl(g0, pi & 63), g_b = __shfl(g1, pi & 63);
    const float my_su = pi < 64 ? su_a : su_b, my_g = pi < 64 ? g_a : g_b;
    const float coef = gelu_erf(tot * my_su) * my_g;
#pragma unroll
    for (int k = 0; k < P7K; ++k) {
        const float ck = __int_as_float(__builtin_amdgcn_readlane(__float_as_int(coef), (64 / P7K) * k));
        const f32x32 vf = __builtin_amdgcn_cvt_scalef32_pk32_f32_fp6(R.v[k], 1.0f);
#pragma unroll
        for (int r = 0; r < 32; ++r) acc[r] = fmaf(ck, vf[r], acc[r]);
    }
}
__device__ __forceinline__ void p7_peer(Frame& F) {
    const int gw = F.vcu * NWAVES + F.wave, NGW = F.G * NWAVES, lane = F.lane;
    constexpr int NCH = NPAIR / P7K, HCH = NCH / 2;
#pragma unroll 1
    for (int t = gw; t < S; t += NGW) {
        const int e0 = F.IDX[(size_t)t * NPAIR + lane], e1 = F.IDX[(size_t)t * NPAIR + 64 + lane];
        const float g0 = F.GV[(size_t)t * NPAIR + lane], g1 = F.GV[(size_t)t * NPAIR + 64 + lane];
        const float u0 = F.SU[(size_t)t * NPAIR + lane], u1 = F.SU[(size_t)t * NPAIR + 64 + lane];
        float xf[32], acc[32];
        {
            const GAS v2u* xr = (const GAS v2u*)(F.X1 + (size_t)t * D) + lane;
#pragma unroll
            for (int j = 0; j < 8; ++j) { const v2u w = xr[64 * j]; xf[4 * j + 0] = bf_lo(w.x); xf[4 * j + 1] = bf_hi(w.x); xf[4 * j + 2] = bf_lo(w.y); xf[4 * j + 3] = bf_hi(w.y); }
        }
#pragma unroll
        for (int i = 0; i < 32; ++i) acc[i] = 0.f;
        int k0 = (e0 << 7) | lane, k1 = (e1 << 7) | (64 + lane);
#pragma unroll
        for (int k = 2; k <= 128; k <<= 1) {
#pragma unroll
            for (int j = k >> 1; j > 0; j >>= 1) {
                if (j == 64) { const int mn = imin_(k0, k1), mx = imax_(k0, k1); k0 = mn; k1 = mx; }
                else {
                    const int o0 = __shfl_xor(k0, j), o1 = __shfl_xor(k1, j);
                    const bool low = (lane & j) == 0;
                    const bool asc0 = (lane & k) == 0, asc1 = ((64 + lane) & k) == 0;
                    k0 = (low == asc0) ? imin_(k0, o0) : imax_(k0, o0);
                    k1 = (low == asc1) ? imin_(k1, o1) : imax_(k1, o1);
                }
            }
        }
        RowsK RA, RB;
        p7_issue(F, RA, k0, 0, lane);
#pragma unroll 1
        for (int c = 0; c < NCH; c += 2) {
            const int ev = c < HCH ? k0 : k1;
            p7_issue(F, RB, ev, c + 1, lane);
            p7_compute(RA, xf, acc, ev, u0, u1, g0, g1, c, lane);
            const int c2 = c + 2 < NCH ? c + 2 : 0;
            p7_issue(F, RA, c2 < HCH ? k0 : k1, c2, lane);
            p7_compute(RB, xf, acc, ev, u0, u1, g0, g1, c + 1, lane);
        }
        float s = 0.f;
#pragma unroll
        for (int i = 0; i < 32; ++i) { acc[i] = fmaf(ALPHA, xf[i], acc[i]); s += acc[i]; }
        const float mean = wave_sum(s) * (1.f / D); float s2 = 0.f;
#pragma unroll
        for (int i = 0; i < 32; ++i) { acc[i] -= mean; s2 = fmaf(acc[i], acc[i], s2); }
        const float rstd = 1.f / sqrtf(wave_sum(s2) * (1.f / D) + LN_EPS);
        GAS f32x4* orow = (GAS f32x4*)(F.out + (size_t)t * D) + lane;
#pragma unroll
        for (int j = 0; j < 8; ++j) { const f32x4 g = *((const GAS f32x4*)F.ln2g + lane + 64 * j), b = *((const GAS f32x4*)F.ln2b + lane + 64 * j);
            f32x4 o; o.x = acc[4 * j + 0] * rstd * g.x + b.x; o.y = acc[4 * j + 1] * rstd * g.y + b.y; o.z = acc[4 * j + 2] * rstd * g.z + b.z; o.w = acc[4 * j + 3] * rstd * g.w + b.w;
            orow[64 * j] = o; }
    }
}

struct Args { const float* in[19]; float* out; unsigned char* ws; int ph_lo, ph_hi, li, pad; };
__global__ void __launch_bounds__(NWAVES * 64, 2) peer_layer_fwd(Args args) {
    extern __shared__ __attribute__((aligned(16))) unsigned char lds[];
    Frame F;
    F.lds = (LAS unsigned char*)lds;
    F.MISC = (volatile LAS unsigned*)(F.lds + MISC_OFF);
    F.tid = threadIdx.x; F.lane = F.tid & 63; F.wave = __builtin_amdgcn_readfirstlane(F.tid >> 6);
    F.G = gridDim.x; { const int bx = blockIdx.x; F.vcu = (F.G % 8 == 0) ? (bx % 8) * (F.G / 8) + bx / 8 : bx; }
    unsigned char* ws = args.ws;
    F.ctl = (gu32*)(ws + WS_CTL);
    F.x = args.in[0]; F.w_in = args.in[1]; F.b_in = args.in[2]; F.ccw = args.in[3]; F.ccb = args.in[4]; F.clg = args.in[5]; F.clb = args.in[6];
    F.scw = args.in[7]; F.scbias = args.in[8]; F.w_out = args.in[9]; F.b_out = args.in[10]; F.ln1g = args.in[11]; F.ln1b = args.in[12];
    F.w_q = args.in[13]; F.sub_keys = args.in[14]; F.peer_u = args.in[15]; F.peer_v = args.in[16]; F.ln2g = args.in[17]; F.ln2b = args.in[18];
    F.out = args.out;
    F.XB = (bf16*)(ws + WS_XB); F.BT1 = (bf16*)(ws + WS_BT1); F.BT2 = (bf16*)(ws + WS_BT2); F.BT3 = (bf16*)(ws + WS_BT3);
    F.AGLU = (bf16*)(ws + WS_AGLU); F.CV = (bf16*)(ws + WS_CV); F.SCB = (bf16*)(ws + WS_SCB); F.MIX = (bf16*)(ws + WS_MIX); F.X1 = (bf16*)(ws + WS_X1);
    F.Y = (float*)(ws + WS_Y); F.SS = (float*)(ws + WS_S); F.IDX = (int*)(ws + WS_IDX); F.GV = (float*)(ws + WS_GV); F.SU = (float*)(ws + WS_SU);
    F.U8 = ws + WS_U8; F.V8 = ws + WS_V8; F.USC = (float*)(ws + WS_USC); F.VSC = (float*)(ws + WS_VSC);
    for (int u = F.tid; u < (LDS_BYTES - LDSCTL_OFF) / 4; u += NWAVES * 64) ((LAS unsigned*)(F.lds + LDSCTL_OFF))[u] = 0u;
    __syncthreads();
    XcdBarrier bar; bar.bar = (unsigned*)(F.ctl + CW_BAR); bar.x = 0; bar.st = nullptr;
    if (N_LAUNCHES == 1) bar = xcd_barrier_post((unsigned*)(F.ctl + CW_BAR), F.MISC + 8);
    const int lo = args.ph_lo, hi = args.ph_hi;
#ifndef ONLY_PHASE
#define ONLY_PHASE -1
#endif
#define IN(k) ((ONLY_PHASE < 0 || ONLY_PHASE == (k)) && lo <= (k) && (k) < hi)
#define SEAM(k) do { if (IN(k) && IN((k) + 1)) xcd_barrier(bar); } while (0)
#ifndef REPEAT_PHASE
#define REPEAT_PHASE -1
#endif
#define REPS(k) for (int rep_ = 0; rep_ < (REPEAT_PHASE == (k) ? 2 : 1); ++rep_)

    if (IN(0)) { REPS(0) p0_prologue(F); SEAM(0); }
    if (IN(1)) { REPS(1) {
        pg8::Gemm g{F.XB, F.BT1, S, NIN, D}; pg8::StaticOrder So; So.init(S, NIN, F.G, (int)blockIdx.x);
        pg8::EpiInProj E{F.AGLU, F.CV, F.SCB, F.b_in};
        pg8::gemm_phase<pg8::EpiInProj, pg8::StaticOrder, PG8_ALIGN, PG8_SP2>(F.lds + RING_OFF, g, So, E); }
        SEAM(1);
    }
    if (IN(2)) { REPS(2) for (int u = F.vcu; u < S / 32; u += F.G) p2_unit(F, u); SEAM(2); }
    if (IN(3)) { REPS(3) {
        pg8::Gemm g{F.MIX, F.BT2, S, D, D}; pg8::StaticOrder So; So.init(S, D, F.G, (int)blockIdx.x);
        pg8::EpiOutProj E{F.Y, F.b_out, F.x, ALPHA};
        pg8::gemm_phase<pg8::EpiOutProj, pg8::StaticOrder, PG8_ALIGN, PG8_SP2>(F.lds + RING_OFF, g, So, E); }
        SEAM(3);
    }
    if (IN(4)) { REPS(4) p4_ln1(F); SEAM(4); }
    if (IN(5)) { REPS(5) {
        pg8::Gemm g{F.X1, F.BT3, S, D, D}; pg8::StaticOrder So; So.init(S, D, F.G, (int)blockIdx.x);
        pg8::EpiF32 E{F.SS, D};
        pg8::gemm_phase<pg8::EpiF32, pg8::StaticOrder, PG8_ALIGN, PG8_SP2>(F.lds + RING_OFF, g, So, E); }
        SEAM(5);
    }
    if (IN(6)) { REPS(6) p6_topk(F); SEAM(6); }
    if (IN(7)) { REPS(7) p7_peer(F); }
#undef IN
#undef SEAM
}

extern "C" void kernel_launch(void* const* d_in, const int* in_sizes, int n_in, void* d_out, int out_size, void* d_ws, size_t ws_size, hipStream_t stream) {
    static int grid = 0;
    if (grid == 0) {
        if (n_in != 19 || in_sizes[0] != S * D || out_size != S * D || ws_size < WS_END) {
            fprintf(stderr, "kernel_launch: built for 19 inputs, x/out of %d floats, >= %zu bytes of workspace; got n_in %d, in0 %d, out %d, ws %zu; nothing launched\n", S * D, (size_t)WS_END, n_in, n_in > 0 ? in_sizes[0] : -1, out_size, ws_size);
            grid = -1; return; }
        int dev = 0, cus = 0, per_cu = 0;
        if (hipGetDevice(&dev) != hipSuccess || hipDeviceGetAttribute(&cus, hipDeviceAttributeMultiprocessorCount, dev) != hipSuccess) { fprintf(stderr, "kernel_launch: device query failed\n"); grid = -1; return; }
        if (hipFuncSetAttribute((const void*)peer_layer_fwd, hipFuncAttributeMaxDynamicSharedMemorySize, LDS_BYTES) != hipSuccess) { fprintf(stderr, "kernel_launch: hipFuncSetAttribute failed\n"); grid = -1; return; }
        if (hipOccupancyMaxActiveBlocksPerMultiprocessor(&per_cu, (const void*)peer_layer_fwd, NWAVES * 64, LDS_BYTES) != hipSuccess || per_cu < 1) {
            fprintf(stderr, "kernel_launch: occupancy query reports %d workgroups per CU; nothing launched\n", per_cu); (void)hipGetLastError(); grid = -1; return; }
        (void)hipGetLastError();
        grid = cus;
    }
    if (grid < 0) return;
    if (hipMemsetAsync((char*)d_ws + WS_CTL, 0, CTL_ZERO_BYTES, stream) != hipSuccess) { fprintf(stderr, "kernel_launch: hipMemsetAsync failed\n"); return; }
    Args a{};
    for (int i = 0; i < 19; ++i) a.in[i] = (const float*)d_in[i];
    a.out = (float*)d_out; a.ws = (unsigned char*)d_ws;
    for (int li = 0; li < N_LAUNCHES; ++li) {
        a.ph_lo = (N_LAUNCHES == 1) ? 0 : li; a.ph_hi = (N_LAUNCHES == 1) ? N_PHASES : li + 1; a.li = li;
        hipError_t le;
        if (N_LAUNCHES == 1) { void* kargs[] = {&a}; le = hipLaunchCooperativeKernel((const void*)peer_layer_fwd, dim3(grid), dim3(NWAVES * 64), kargs, LDS_BYTES, stream); }
        else { hipLaunchKernelGGL(peer_layer_fwd, dim3(grid), dim3(NWAVES * 64), LDS_BYTES, stream, a); le = hipPeekAtLastError(); }
        if (le != hipSuccess) { fprintf(stderr, "kernel_launch: launch %d failed: %s (grid %d x %d threads, %d B LDS)\n", li, hipGetErrorName(le), grid, NWAVES * 64, LDS_BYTES); break; }
    }
}
```

```cpp
#include <hip/hip_runtime.h>
#include <cstdio>
#include <cstdint>
namespace pg8 {
#define PG8_LAS __attribute__((address_space(3)))
typedef unsigned short bf16_t;
typedef short bf16x8 __attribute__((ext_vector_type(8)));
typedef float f32x4 __attribute__((ext_vector_type(4)));
typedef unsigned u32x4 __attribute__((ext_vector_type(4)));
constexpr int BM = 256, BK = 64, HALF = 128, HTB = HALF * BK * 2  , STAGE_BYTES = 8 * HTB, NXCD = 8, WGM = 8;

__host__ __device__ __forceinline__ int lds_byte(int r, int c) { const int st = (r >> 4) * 2 + (c >> 5), rr = r & 15, cc = c & 31, ob = rr * 64 + cc * 2; return st * 1024 + (ob ^ (((ob >> 9) & 1) << 5)); }
__host__ __device__ __forceinline__ void stage_rc(int b, int& R, int& C) { const int st = b / 1024, sb = b % 1024, swz = sb ^ (((sb >> 9) & 1) << 5); R = (st >> 1) * 16 + swz / 64; C = (st & 1) * 32 + (swz % 64) / 2; }
__host__ __device__ __forceinline__ int perm32(int rho) { const int n = rho >> 4, i = rho & 15; return 8 * (i >> 2) + 4 * n + (i & 3); }

struct Unit { int pm, pn; };
struct Gemm { const bf16_t* A; const bf16_t* Bt; int M, N, K; };

struct StaticOrder {
    int nM, nN, nwg, G, c;
    __host__ __device__ void init(int M, int N, int G_, int c_) { nM = M / BM; nN = N / BM; nwg = nM * nN; G = G_; c = c_; }
    __host__ __device__ bool next(int i, Unit& u) const {
        const long L = (long)i * G + c; if (L >= nwg) return false;
        int wgid = (int)L; { const int q = nwg / NXCD, r = nwg % NXCD, xcd = wgid % NXCD, off = wgid / NXCD; wgid = (xcd < r ? xcd * (q + 1) : r * (q + 1) + (xcd - r) * q) + off; }
        const int nig = WGM * nN, gid = wgid / nig, fm = gid * WGM, gsz = (nM - fm) < WGM ? (nM - fm) : WGM;
        u.pm = fm + ((wgid % nig) % gsz); u.pn = (wgid % nig) / gsz; return true;
    }
    __device__ __forceinline__ void a_ready(const Unit&) const {}
    __device__ __forceinline__ void done(const Unit&) const {}
};

__device__ __forceinline__ unsigned cvt_pk_bf16(float lo, float hi) { unsigned r; asm volatile("v_cvt_pk_bf16_f32 %0, %1, %2" : "=v"(r) : "v"(lo), "v"(hi)); return r; }
__device__ __forceinline__ float sigmoidf_fast(float g) { return __builtin_amdgcn_rcpf(1.0f + __expf(-g)); }

struct EpiInProj {
    static constexpr bool PERM = true, AFTER_DRAIN = false;
    bf16_t* aglu; bf16_t* cv; bf16_t* scb; const float* b_in;
    __device__ __forceinline__ void operator()(const f32x4 (&acc)[2][2][4][2], const Unit& u, int wr, int wc, int fr, int fq) const {
        const int row0 = u.pm * BM + wr * 64 + fr, cc = wc * 32 + 8 * fq;
        if (u.pn < 16) {
            const bool conf = u.pn < 8; const int j = conf ? u.pn : u.pn - 8;
            const float* b0 = b_in + (conf ? 0 : 3072) + 128 * j + cc;
            const float* b1 = b_in + (conf ? 1024 : 4096) + 128 * j + cc;
            bf16_t* O = (conf ? aglu : cv) + 128 * j + cc;
            f32x4 bv0[2], bv1[2];
#pragma unroll
            for (int n = 0; n < 2; ++n) { bv0[n] = *(const f32x4*)(b0 + 4 * n); bv1[n] = *(const f32x4*)(b1 + 4 * n); }
#pragma unroll
            for (int ai = 0; ai < 2; ++ai)
#pragma unroll
                for (int m = 0; m < 4; ++m) {
                    f32x4 r[2];
#pragma unroll
                    for (int n = 0; n < 2; ++n) { const f32x4 a = acc[ai][0][m][n] + bv0[n]; f32x4 g = acc[ai][1][m][n] + bv1[n];
                        if (conf) { g[0] = sigmoidf_fast(g[0]); g[1] = sigmoidf_fast(g[1]); g[2] = sigmoidf_fast(g[2]); g[3] = sigmoidf_fast(g[3]); }
                        r[n] = a * g; }
                    u32x4 w; w.x = cvt_pk_bf16(r[0][0], r[0][1]); w.y = cvt_pk_bf16(r[0][2], r[0][3]); w.z = cvt_pk_bf16(r[1][0], r[1][1]); w.w = cvt_pk_bf16(r[1][2], r[1][3]);
                    *(u32x4*)(O + (size_t)(row0 + ai * HALF + m * 16) * 1024) = w; }
        } else {
            const int j = u.pn - 16;
#pragma unroll
            for (int bj = 0; bj < 2; ++bj) {
                const float* b0 = b_in + 2048 + 256 * j + 128 * bj + cc; bf16_t* O = scb + 256 * j + 128 * bj + cc;
                const f32x4 bva = *(const f32x4*)(b0), bvb = *(const f32x4*)(b0 + 4);
#pragma unroll
                for (int ai = 0; ai < 2; ++ai)
#pragma unroll
                    for (int m = 0; m < 4; ++m) { const f32x4 v0 = acc[ai][bj][m][0] + bva, v1 = acc[ai][bj][m][1] + bvb;
                        u32x4 w; w.x = cvt_pk_bf16(v0[0], v0[1]); w.y = cvt_pk_bf16(v0[2], v0[3]); w.z = cvt_pk_bf16(v1[0], v1[1]); w.w = cvt_pk_bf16(v1[2], v1[3]);
                        *(u32x4*)(O + (size_t)(row0 + ai * HALF + m * 16) * 1024) = w; } }
        }
    }
};
struct EpiOutProj {
    static constexpr bool PERM = false, AFTER_DRAIN = false;
    float* Y; const float* bias; const float* x; float alpha;
    __device__ __forceinline__ void operator()(const f32x4 (&acc)[2][2][4][2], const Unit& u, int wr, int wc, int fr, int fq) const {
        const int row0 = u.pm * BM + wr * 64 + fr, col0 = u.pn * BM + wc * 32 + 4 * fq;
        f32x4 bv[2][2];
#pragma unroll
        for (int bj = 0; bj < 2; ++bj)
#pragma unroll
            for (int n = 0; n < 2; ++n) bv[bj][n] = *(const f32x4*)(bias + col0 + bj * HALF + n * 16);
#pragma unroll
        for (int ai = 0; ai < 2; ++ai)
#pragma unroll
            for (int m = 0; m < 4; ++m) { const size_t off = (size_t)(row0 + ai * HALF + m * 16) * 2048 + col0;
#pragma unroll
                for (int bj = 0; bj < 2; ++bj)
#pragma unroll
                    for (int n = 0; n < 2; ++n) { const f32x4 xv = *(const f32x4*)(x + off + bj * HALF + n * 16);
                        *(f32x4*)(Y + off + bj * HALF + n * 16) = acc[ai][bj][m][n] + bv[bj][n] + xv * alpha; }
                asm volatile("" ::: "memory"); }
    }
};
struct EpiF32 {
    static constexpr bool PERM = false, AFTER_DRAIN = false;
    float* C; int ldc;
    __device__ __forceinline__ void operator()(const f32x4 (&acc)[2][2][4][2], const Unit& u, int wr, int wc, int fr, int fq) const {
        const int row0 = u.pm * BM + wr * 64 + fr, col0 = u.pn * BM + wc * 32 + 4 * fq;
#pragma unroll
        for (int ai = 0; ai < 2; ++ai)
#pragma unroll
            for (int m = 0; m < 4; ++m) { float* rowp = C + (size_t)(row0 + ai * HALF + m * 16) * ldc + col0;
#pragma unroll
                for (int bj = 0; bj < 2; ++bj)
#pragma unroll
                    for (int n = 0; n < 2; ++n) *(f32x4*)(rowp + bj * HALF + n * 16) = acc[ai][bj][m][n]; }
    }
};

template <class Epi, class Sched, bool ALIGN_EPI = false, bool SP2 = false>
__device__ __forceinline__ void gemm_phase(PG8_LAS unsigned char* lds, const Gemm g, const Sched& S, const Epi& E) {
    const int tid = threadIdx.x, wid = __builtin_amdgcn_readfirstlane(tid >> 6), lane = tid & 63, wr = wid >> 2, wc = wid & 3, fr = lane & 15, fq = lane >> 4;
    const int K = g.K, nt = K / BK;
    unsigned voffA[2], voffB[2];
#pragma unroll
    for (int i = 0; i < 2; ++i) { int R, C; stage_rc(tid * 16 + i * 8192, R, C); const int Rb = Epi::PERM ? ((R & ~31) + perm32(R & 31)) : R;
        voffA[i] = (unsigned)(R * K + C) * 2u; voffB[i] = (unsigned)(Rb * K + C) * 2u; }
    const size_t kstep = (size_t)(BK * 2);
    const size_t hstep = (size_t)HALF * K * 2;
    const size_t tstep = 2 * hstep;
    const unsigned ldsw = (unsigned)wid * 1024u;
    const int aoff = lds_byte(wr * 64 + fr, fq * 8), boff = lds_byte(wc * 32 + fr, fq * 8);
#define PG8_SA(b, h) (((b) * 2 + (h)) * HTB)
#define PG8_SB(b, h) ((4 + (b) * 2 + (h)) * HTB)
#define PG8_STAGE(bufoff, gbase, voff) do { _Pragma("unroll") for (int _i = 0; _i < 2; ++_i) \
        __builtin_amdgcn_global_load_lds((const unsigned*)((const char*)(gbase) + (voff)[_i]), (PG8_LAS unsigned*)(lds + (bufoff) + ldsw + _i * 8192), 16, 0, 0); } while (0)
#define PG8_LDA(dst, b, h) do { _Pragma("unroll") for (int m = 0; m < 4; ++m) _Pragma("unroll") for (int k = 0; k < 2; ++k) dst[m][k] = *(const PG8_LAS bf16x8*)(lds + PG8_SA(b, h) + aoff + m * 2048 + k * 1024); } while (0)
#define PG8_LDB(dst, b, h) do { _Pragma("unroll") for (int n = 0; n < 2; ++n) _Pragma("unroll") for (int k = 0; k < 2; ++k) dst[n][k] = *(const PG8_LAS bf16x8*)(lds + PG8_SB(b, h) + boff + n * 2048 + k * 1024); } while (0)
#define PG8_MMA(ai, bj, At, Bt) do { __builtin_amdgcn_s_setprio(1); _Pragma("unroll") for (int m = 0; m < 4; ++m) _Pragma("unroll") for (int n = 0; n < 2; ++n) _Pragma("unroll") for (int k = 0; k < 2; ++k) \
        acc[ai][bj][m][n] = __builtin_amdgcn_mfma_f32_16x16x32_bf16(Bt[n][k], At[m][k], acc[ai][bj][m][n], 0, 0, 0); __builtin_amdgcn_s_setprio(0); } while (0)
#define PG8_WAIT_V(n) asm volatile("s_waitcnt vmcnt(" #n ")" ::: "memory")
#define PG8_WAIT_L(n) asm volatile("s_waitcnt lgkmcnt(" #n ")" ::: "memory")
#define PG8_BAR __builtin_amdgcn_s_barrier()
#define PG8_SCHED __builtin_amdgcn_sched_barrier(0)
    Unit cur, nxt; int ui = 0;
    if (!S.next(0, cur)) return;
    f32x4 acc[2][2][4][2];
#pragma unroll
    for (int a = 0; a < 2; ++a)
#pragma unroll
        for (int b = 0; b < 2; ++b)
#pragma unroll
            for (int m = 0; m < 4; ++m)
#pragma unroll
                for (int n = 0; n < 2; ++n) acc[a][b][m][n] = (f32x4){0.f, 0.f, 0.f, 0.f};
    bf16x8 At[4][2], B0[2][2], B1[2][2];
    const char* cA = (const char*)g.A + (size_t)cur.pm * tstep; const char* cB = (const char*)g.Bt + (size_t)cur.pn * tstep;
    S.a_ready(cur);
    if constexpr (SP2) {
        PG8_STAGE(PG8_SB(0, 0), cB, voffB); PG8_STAGE(PG8_SB(0, 1), cB + hstep, voffB); PG8_STAGE(PG8_SA(0, 0), cA, voffA); PG8_STAGE(PG8_SA(0, 1), cA + hstep, voffA);
        if (wr == 1) PG8_BAR;
        PG8_WAIT_V(2); PG8_BAR;
        PG8_STAGE(PG8_SB(1, 0), cB + kstep, voffB); PG8_STAGE(PG8_SA(1, 0), cA + kstep, voffA); PG8_STAGE(PG8_SB(1, 1), cB + hstep + kstep, voffB);
        PG8_WAIT_V(6); PG8_BAR;
    } else {
        PG8_STAGE(PG8_SB(0, 0), cB, voffB); PG8_STAGE(PG8_SA(0, 0), cA, voffA); PG8_STAGE(PG8_SB(0, 1), cB + hstep, voffB); PG8_STAGE(PG8_SA(0, 1), cA + hstep, voffA);
        if (wr == 1) PG8_BAR;
        PG8_WAIT_V(4); PG8_BAR;
        PG8_STAGE(PG8_SB(1, 0), cB + kstep, voffB); PG8_STAGE(PG8_SA(1, 0), cA + kstep, voffA); PG8_STAGE(PG8_SB(1, 1), cB + hstep + kstep, voffB);
        PG8_WAIT_V(6); PG8_BAR;
    }
    for (;;) {
        const bool has_next = S.next(ui + 1, nxt);
        const char* nA = has_next ? (const char*)g.A + (size_t)nxt.pm * tstep : cA; const char* nB = has_next ? (const char*)g.Bt + (size_t)nxt.pn * tstep : cB;
        for (int t = 0; t < nt; t += 2) {
            const bool last = (t == nt - 2);
            const char* a1 = cA + (size_t)(t + 1) * kstep;
            const char* a2 = last ? nA : cA + (size_t)(t + 2) * kstep; const char* b2 = last ? nB : cB + (size_t)(t + 2) * kstep;
            const char* a3 = a2 + kstep; const char* b3 = b2 + kstep;
            if (last && has_next) S.a_ready(nxt);
            if constexpr (SP2) {
            PG8_LDB(B0, 0, 0); PG8_LDB(B1, 0, 1); PG8_SCHED; PG8_LDA(At, 0, 0); PG8_STAGE(PG8_SA(1, 1), a1 + hstep, voffA);
            PG8_WAIT_V(8); PG8_WAIT_L(0); PG8_BAR; PG8_MMA(0, 0, At, B0); PG8_MMA(0, 1, At, B1); PG8_BAR; PG8_SCHED;
            PG8_LDA(At, 0, 1); PG8_STAGE(PG8_SB(0, 0), b2, voffB); PG8_STAGE(PG8_SB(0, 1), b2 + hstep, voffB); PG8_STAGE(PG8_SA(0, 0), a2, voffA);
            PG8_WAIT_V(8); PG8_WAIT_L(0); PG8_BAR; PG8_MMA(1, 0, At, B0); PG8_MMA(1, 1, At, B1); PG8_BAR; PG8_SCHED;
            PG8_LDB(B0, 1, 0); PG8_LDB(B1, 1, 1); PG8_SCHED; PG8_LDA(At, 1, 0); PG8_STAGE(PG8_SA(0, 1), a2 + hstep, voffA);
            PG8_WAIT_V(8); PG8_WAIT_L(0); PG8_BAR; PG8_MMA(0, 0, At, B0); PG8_MMA(0, 1, At, B1); PG8_BAR; PG8_SCHED;
            PG8_LDA(At, 1, 1); PG8_STAGE(PG8_SB(1, 0), b3, voffB); PG8_STAGE(PG8_SB(1, 1), b3 + hstep, voffB); PG8_STAGE(PG8_SA(1, 0), a3, voffA);
            PG8_WAIT_V(8); PG8_WAIT_L(0); PG8_BAR; PG8_MMA(1, 0, At, B0); PG8_MMA(1, 1, At, B1); PG8_BAR; PG8_SCHED;
            } else {
            PG8_LDB(B0, 0, 0); PG8_SCHED; PG8_LDA(At, 0, 0); PG8_STAGE(PG8_SA(1, 1), a1 + hstep, voffA);
            PG8_WAIT_L(8); PG8_BAR; PG8_WAIT_L(0); PG8_MMA(0, 0, At, B0); PG8_BAR; PG8_SCHED;
            PG8_LDB(B1, 0, 1); PG8_STAGE(PG8_SB(0, 0), b2, voffB);
            PG8_BAR; PG8_WAIT_L(0); PG8_MMA(0, 1, At, B1); PG8_BAR;
            PG8_LDA(At, 0, 1); PG8_STAGE(PG8_SA(0, 0), a2, voffA);
            PG8_BAR; PG8_WAIT_L(0); PG8_MMA(1, 0, At, B0); PG8_BAR; PG8_SCHED;
            PG8_STAGE(PG8_SB(0, 1), b2 + hstep, voffB);
            PG8_WAIT_V(6); PG8_BAR; PG8_MMA(1, 1, At, B1); PG8_BAR;
            PG8_LDB(B0, 1, 0); PG8_SCHED; PG8_LDA(At, 1, 0); PG8_STAGE(PG8_SA(0, 1), a2 + hstep, voffA);
            PG8_WAIT_L(8); PG8_BAR; PG8_WAIT_L(0); PG8_MMA(0, 0, At, B0); PG8_BAR; PG8_SCHED;
            PG8_LDB(B1, 1, 1); PG8_STAGE(PG8_SB(1, 0), b3, voffB);
            PG8_BAR; PG8_WAIT_L(0); PG8_MMA(0, 1, At, B1); PG8_BAR;
            PG8_LDA(At, 1, 1); PG8_STAGE(PG8_SA(1, 0), a3, voffA);
            PG8_BAR; PG8_WAIT_L(0); PG8_MMA(1, 0, At, B0); PG8_BAR; PG8_SCHED;
            PG8_STAGE(PG8_SB(1, 1), b3 + hstep, voffB);
            PG8_WAIT_V(6); PG8_BAR; PG8_MMA(1, 1, At, B1); PG8_BAR;
            }
        }
        if constexpr (ALIGN_EPI) { if (wr == 0) PG8_BAR; }
        if constexpr (!Epi::AFTER_DRAIN) { E(acc, cur, wr, wc, fr, fq); S.done(cur); }
        if (!has_next) break;
#pragma unroll
        for (int a = 0; a < 2; ++a)
#pragma unroll
            for (int b = 0; b < 2; ++b)
#pragma unroll
                for (int m = 0; m < 4; ++m)
#pragma unroll
                    for (int n = 0; n < 2; ++n) acc[a][b][m][n] = (f32x4){0.f, 0.f, 0.f, 0.f};
        cur = nxt; cA = nA; cB = nB; ++ui;
        if constexpr (ALIGN_EPI) { if (wr == 1) PG8_BAR; }
    }
    PG8_WAIT_V(0);
    if constexpr (!ALIGN_EPI) { if (wr == 0) PG8_BAR; }
    PG8_BAR;
    if constexpr (Epi::AFTER_DRAIN) { E.fused(acc, cur, wr, wc, fr, fq, lds, wid, lane); S.done(cur); }
#undef PG8_SA
#undef PG8_SB
#undef PG8_STAGE
#undef PG8_LDA
#undef PG8_LDB
#undef PG8_MMA
#undef PG8_WAIT_V
#undef PG8_WAIT_L
#undef PG8_BAR
#undef PG8_SCHED
}
}

#ifndef PG8_SP2
#define PG8_SP2 true
#endif
#ifndef PG8_ALIGN
#define PG8_ALIGN true
#endif
constexpr int NWAVES = 8;
#ifndef MK_N_LAUNCHES
#define MK_N_LAUNCHES 1
#endif
constexpr int N_PHASES = 8;
constexpr int N_LAUNCHES = MK_N_LAUNCHES;

constexpr int ROWB = 1536;
constexpr int S = 8192, D = 2048, NIN = 5120, DC = 1024, NE = 16384, NPAIR = 128;
constexpr float LN_EPS = 1e-5f;
constexpr float ALPHA = 1.189207115002721f;

constexpr size_t MiB = 1u << 20;
constexpr size_t WS_CTL = 0, CTL_ZERO_BYTES = 64 * 1024;
constexpr size_t WS_XB = 2 * MiB;
constexpr size_t WS_BT1 = 34 * MiB;
constexpr size_t WS_BT2 = 54 * MiB;
constexpr size_t WS_BT3 = 62 * MiB;
constexpr size_t WS_AGLU = 70 * MiB;
constexpr size_t WS_CV = 86 * MiB;
constexpr size_t WS_SCB = 102 * MiB;
constexpr size_t WS_MIX = 118 * MiB;
constexpr size_t WS_Y = 150 * MiB;
constexpr size_t WS_X1 = 214 * MiB;
constexpr size_t WS_S = 246 * MiB;
constexpr size_t WS_IDX = 310 * MiB;
constexpr size_t WS_GV = 314 * MiB;
constexpr size_t WS_SU = 318 * MiB;
constexpr size_t WS_U8 = 322 * MiB;
constexpr size_t WS_V8 = 354 * MiB;
constexpr size_t WS_USC = 386 * MiB;
constexpr size_t WS_VSC = 386 * MiB + 65536;
constexpr size_t WS_END = 387 * MiB;
constexpr int CW_BAR = 4096;

constexpr int RING_OFF = 0, RING_BYTES = 131072;
constexpr int LDSCTL_OFF = RING_BYTES, MISC_OFF = LDSCTL_OFF + 320;
constexpr int LNP_OFF = MISC_OFF + 128;
constexpr int LDS_BYTES = 155648;

#define GAS __attribute__((address_space(1)))
#define LAS __attribute__((address_space(3)))
typedef unsigned short bf16;
typedef unsigned v4u __attribute__((ext_vector_type(4)));
typedef unsigned v2u __attribute__((ext_vector_type(2)));
typedef float f32x4 __attribute__((ext_vector_type(4)));
typedef float f32x2 __attribute__((ext_vector_type(2)));
typedef short bf16x8 __attribute__((ext_vector_type(8)));
typedef GAS unsigned gu32;
#define LDS_WAIT() asm volatile("s_waitcnt lgkmcnt(0)" ::: "memory")
#define VM_WAIT() asm volatile("s_waitcnt vmcnt(0)" ::: "memory")
__device__ __forceinline__ unsigned pk2(float lo, float hi) { return pg8::cvt_pk_bf16(lo, hi); }
__device__ __forceinline__ float bf_lo(unsigned w) { return __uint_as_float(w << 16); }
__device__ __forceinline__ float bf_hi(unsigned w) { return __uint_as_float(w & 0xffff0000u); }
__device__ __forceinline__ float wave_sum(float v) {
#pragma unroll
    for (int o = 1; o < 64; o <<= 1) v += __shfl_xor(v, o);
    return v;
}
__device__ __forceinline__ float wave_max(float v) {
#pragma unroll
    for (int o = 1; o < 64; o <<= 1) v = fmaxf(v, __shfl_xor(v, o));
    return v;
}

#define XB_TMO      128
#define XB_XCNT(j)  (256  + 64 * (j))
#define XB_XSUB(j)  (1280 + 64 * (j))
#define XB_XGEN(j)  (2304 + 64 * (j))
#define XB_TOP      3328
#define XB_TOPGEN   3392
#define XCD_BAR_WORDS 3456
#define XB_SPIN_CAP (1u << 18)

__device__ __forceinline__ unsigned xb_ld(unsigned* p)              { return __hip_atomic_load(p, __ATOMIC_RELAXED, __HIP_MEMORY_SCOPE_AGENT); }
__device__ __forceinline__ unsigned xb_add(unsigned* p, unsigned v) { return __hip_atomic_fetch_add(p, v, __ATOMIC_RELAXED, __HIP_MEMORY_SCOPE_AGENT); }
__device__ __forceinline__ unsigned xb_xcc_id() { return (unsigned)__builtin_amdgcn_s_getreg((3 << 11) | 20) & 0xFu; }
#define XB_SPIN(cond, bar) do { unsigned _sp = 0; while (cond) { __builtin_amdgcn_s_sleep(1); \
    if ((++_sp & 255u) == 0u) { if (xb_ld(&(bar)[XB_TMO])) break; if (_sp > XB_SPIN_CAP) { atomicAdd(&(bar)[XB_TMO], 1u); break; } } } } while (0)

struct XcdBarrier {
    unsigned* bar; unsigned x;
    volatile LAS unsigned* st;
};

__device__ __forceinline__ XcdBarrier xcd_barrier_post(unsigned* bar, volatile LAS unsigned* st) {
    XcdBarrier b; b.bar = bar; b.x = xb_xcc_id(); b.st = st;
    if (threadIdx.x == 0) (void)xb_add(&bar[XB_XCNT(b.x)], 1u);
    return b;
}
__device__ __forceinline__ void xcd_barrier_complete(unsigned* bar, unsigned x, unsigned& nloc, unsigned& nx) {
    const unsigned G = gridDim.x * gridDim.y * gridDim.z;
    unsigned sum, cnt, mine, sp = 0u;
    for (;;) {
        sum = 0u; cnt = 0u; mine = 0u;
#pragma unroll
        for (unsigned j = 0; j < 16; ++j) { const unsigned c = xb_ld(&bar[XB_XCNT(j)]); sum += c; cnt += (c > 0u) ? 1u : 0u; mine = (j == x) ? c : mine; }
        if (sum == G) break;
        __builtin_amdgcn_s_sleep(1);
        if ((++sp & 255u) == 0u) { if (xb_ld(&bar[XB_TMO])) break; if (sp > XB_SPIN_CAP) { atomicAdd(&bar[XB_TMO], 1u); break; } }
    }
    nloc = mine > 0u ? mine : 1u; nx = cnt > 0u ? cnt : 1u;
}

__device__ __forceinline__ void xcd_barrier(const XcdBarrier& b) {
    asm volatile("s_waitcnt vmcnt(0)" ::: "memory");
    __syncthreads();
    if (threadIdx.x == 0) {
        unsigned* bar = b.bar;
        __builtin_amdgcn_s_waitcnt(0);
        unsigned nloc = b.st[0], nx = b.st[1];
        if (nloc == 0u) { xcd_barrier_complete(bar, b.x, nloc, nx); b.st[0] = nloc; b.st[1] = nx; }
        const unsigned old = xb_add(&bar[XB_XSUB(b.x)], 1u);
        const unsigned gen = old / nloc;
        if (old + 1u == (gen + 1u) * nloc) {
            __builtin_amdgcn_fence(__ATOMIC_RELEASE, "agent");
            asm volatile("s_waitcnt vmcnt(0)" ::: "memory");
            const unsigned og = xb_add(&bar[XB_TOP], 1u);
            const unsigned tg = og / nx;
            if (og + 1u == (tg + 1u) * nx) xb_add(&bar[XB_TOPGEN], 1u);
            else XB_SPIN(xb_ld(&bar[XB_TOPGEN]) == tg, bar);
            __builtin_amdgcn_fence(__ATOMIC_ACQUIRE, "agent");
            xb_add(&bar[XB_XGEN(b.x)], 1u);
            asm volatile("s_waitcnt vmcnt(0)" ::: "memory");
        } else {
            XB_SPIN(xb_ld(&bar[XB_XGEN(b.x)]) == gen, bar);
            __builtin_amdgcn_fence(__ATOMIC_ACQUIRE, "agent");
            asm volatile("s_waitcnt vmcnt(0)" ::: "memory");
        }
    }
    __syncthreads();
}

struct Frame {
    LAS unsigned char* lds;
    volatile LAS unsigned* MISC;
    gu32* ctl;
    int tid, lane, wave, vcu, G;
    const float *x, *w_in, *b_in, *ccw, *ccb, *clg, *clb, *scw, *scbias, *w_out, *b_out, *ln1g, *ln1b, *w_q, *sub_keys, *peer_u, *peer_v, *ln2g, *ln2b;
    float* out;
    bf16 *XB, *BT1, *BT2, *BT3, *AGLU, *CV, *SCB, *MIX, *X1;
    float *Y, *SS; int* IDX; float *GV, *SU; unsigned char *U8, *V8; float *USC, *VSC;
};

__device__ __forceinline__ int bt1_row(int n0) {
    const int grp = n0 >> 10, c = n0 & 1023, j = c >> 7, r = c & 127;
    if (grp == 0) return 256 * j + r;
    if (grp == 1) return 256 * j + 128 + r;
    if (grp == 2) return 4096 + c;
    if (grp == 3) return 2048 + 256 * j + r;
    return 2048 + 256 * j + 128 + r;
}
template <bool PERM_IN>
__device__ __forceinline__ void p0_transpose_item(const float* W, int K, int N, bf16* WT, LAS float* scr, int item, int lane) {
    const int nblk = N / 32, kb = item / nblk, nb = item % nblk, k0 = 64 * kb, n0 = 32 * nb;
    const int drow = PERM_IN ? bt1_row(n0) : n0;
#pragma unroll 8
    for (int i = 0; i < 32; ++i) { const int kk = 2 * i + (lane >> 5); scr[kk * 33 + (lane & 31)] = W[(size_t)(k0 + kk) * N + n0 + (lane & 31)]; }
    LDS_WAIT(); asm volatile("" ::: "memory");
    const int c = lane & 7;
#pragma unroll
    for (int j = 0; j < 4; ++j) { const int n = (lane >> 3) + 8 * j; const LAS float* s = scr + (8 * c) * 33 + n;
        v4u o; o.x = pk2(s[0 * 33], s[1 * 33]); o.y = pk2(s[2 * 33], s[3 * 33]); o.z = pk2(s[4 * 33], s[5 * 33]); o.w = pk2(s[6 * 33], s[7 * 33]);
        *(GAS v4u*)(WT + (size_t)(drow + n) * K + k0 + 8 * c) = o; }
    LDS_WAIT(); asm volatile("" ::: "memory");
}
__device__ __forceinline__ bf16x8 ld8_bf16(const float* p) {
    const f32x4 a = *(const f32x4*)p, b = *(const f32x4*)(p + 4);
    v4u w; w.x = pk2(a.x, a.y); w.y = pk2(a.z, a.w); w.z = pk2(b.x, b.y); w.w = pk2(b.z, b.w);
    return __builtin_bit_cast(bf16x8, w);
}
__device__ __forceinline__ unsigned fp6_encode(float y) {
    const unsigned sb = (__float_as_uint(y) >> 31) << 5;
    const float a = fabsf(y);
    const unsigned sub = (unsigned)__builtin_rintf(a * 8.0f);
    unsigned b = __float_as_uint(a); b += 0x7FFFFu + ((b >> 20) & 1u); b >>= 20;
    unsigned nrm = b - 1008u; nrm = nrm > 31u ? 31u : nrm;
    return sb | (a < 1.0f ? sub : nrm);
}
__device__ __forceinline__ void p0_prologue(Frame& F) {
    LAS float* scr = (LAS float*)(F.lds + RING_OFF + F.wave * 16384);
    const int gw = F.vcu * NWAVES + F.wave, NGW = F.G * NWAVES, lane = F.lane;
    constexpr int I_IN = (D / 64) * (NIN / 32), I_OUT = (D / 64) * (D / 32);
    for (int it = gw; it < I_IN + I_OUT; it += NGW) {
        if (it < I_IN) p0_transpose_item<true>(F.w_in, D, NIN, F.BT1, scr, it, lane);
        else p0_transpose_item<false>(F.w_out, D, D, F.BT2, scr, it - I_IN, lane);
    }
    for (int it = gw; it < 4096; it += NGW) {
        const int hp = it >> 8, nb = (it >> 5) & 7, db = it & 31, n0 = nb * 16, d0 = db * 64;
        const float* sk = F.sub_keys + ((size_t)hp * 128 + n0 + (lane & 15)) * 128 + 8 * (lane >> 4);
        const float* wq = F.w_q + (size_t)(d0 + (lane & 15)) * 2048 + hp * 128 + 8 * (lane >> 4);
        f32x4 acc[4];
#pragma unroll
        for (int dt = 0; dt < 4; ++dt) acc[dt] = (f32x4){0.f, 0.f, 0.f, 0.f};
#pragma unroll
        for (int ks = 0; ks < 4; ++ks) {
            const bf16x8 yf = ld8_bf16(sk + 32 * ks);
#pragma unroll
            for (int dt = 0; dt < 4; ++dt) { const bf16x8 xf = ld8_bf16(wq + (size_t)dt * 16 * 2048 + 32 * ks);
                acc[dt] = __builtin_amdgcn_mfma_f32_16x16x32_bf16(xf, yf, acc[dt], 0, 0, 0); }
        }
        bf16* orow = F.BT3 + (size_t)(hp * 128 + n0 + (lane & 15)) * 2048 + d0 + 4 * (lane >> 4);
#pragma unroll
        for (int dt = 0; dt < 4; ++dt) { v2u o; o.x = pk2(acc[dt][0], acc[dt][1]); o.y = pk2(acc[dt][2], acc[dt][3]); *(GAS v2u*)(orow + 16 * dt) = o; }
    }
    for (int r = gw; r < S; r += NGW) {
        const GAS f32x4* src = (const GAS f32x4*)(F.x + (size_t)r * D) + 2 * lane;
        GAS v4u* dst = (GAS v4u*)(F.XB + (size_t)r * D) + lane;
#pragma unroll
        for (int j = 0; j < 4; ++j) { const f32x4 a = src[128 * j], b = src[128 * j + 1];
            v4u o; o.x = pk2(a.x, a.y); o.y = pk2(a.z, a.w); o.z = pk2(b.x, b.y); o.w = pk2(b.z, b.w); dst[64 * j] = o; }
    }
    for (int r = gw; r < 2 * NE; r += NGW) {
        const bool isv = r >= NE; const int e = isv ? r - NE : r;
        const GAS f32x4* src = (const GAS f32x4*)((isv ? F.peer_v : F.peer_u) + (size_t)e * D) + lane;
        f32x4 v[8]; float am = 0.f;
#pragma unroll
        for (int j = 0; j < 8; ++j) { v[j] = src[64 * j];
            am = fmaxf(am, fmaxf(fmaxf(fabsf(v[j].x), fabsf(v[j].y)), fmaxf(fabsf(v[j].z), fabsf(v[j].w)))); }
        am = wave_max(am);
        const float sc = am > 0.f ? 7.5f / am : 1.f, inv = am > 0.f ? am / 7.5f : 1.f;
        unsigned w[6];
#pragma unroll
        for (int h = 0; h < 2; ++h) {
            unsigned c[16];
#pragma unroll
            for (int i = 0; i < 16; ++i) c[i] = fp6_encode(v[4 * h + (i >> 2)][i & 3] * sc);
            w[3 * h + 0] = c[0] | (c[1] << 6) | (c[2] << 12) | (c[3] << 18) | (c[4] << 24) | (c[5] << 30);
            w[3 * h + 1] = (c[5] >> 2) | (c[6] << 4) | (c[7] << 10) | (c[8] << 16) | (c[9] << 22) | (c[10] << 28);
            w[3 * h + 2] = (c[10] >> 4) | (c[11] << 2) | (c[12] << 8) | (c[13] << 14) | (c[14] << 20) | (c[15] << 26);
        }
        unsigned char* dst = (isv ? F.V8 : F.U8) + (size_t)e * ROWB + 24 * lane;
        *(GAS v2u*)(dst) = (v2u){w[0], w[1]}; *(GAS v2u*)(dst + 8) = (v2u){w[2], w[3]}; *(GAS v2u*)(dst + 16) = (v2u){w[4], w[5]};
        if (lane == 0) (isv ? F.VSC : F.USC)[e] = inv;
    }
}

__device__ __forceinline__ void p2_unit(Frame& F, int unit) {
    const int t0 = unit * 32, tid = F.tid, lane = F.lane, c0 = 2 * tid;
    LAS float* cbuf = (LAS float*)(F.lds + RING_OFF);
    {
        f32x2 w[31];
#pragma unroll
        for (int k = 0; k < 31; ++k) w[k] = *(const GAS f32x2*)(F.ccw + k * 1024 + c0);
        const f32x2 bias = *(const GAS f32x2*)(F.ccb + c0);
#pragma unroll 1
        for (int g = 0; g < 4; ++g) {
            const int tb = t0 + 8 * g - 30;
            f32x2 in[38];
#pragma unroll
            for (int i = 0; i < 38; ++i) { const int t = tb + i; const int tc = t < 0 ? 0 : t;
                const unsigned raw = *(const GAS unsigned*)(F.AGLU + (size_t)tc * 1024 + c0);
                in[i] = t < 0 ? (f32x2){0.f, 0.f} : (f32x2){bf_lo(raw), bf_hi(raw)}; }
#pragma unroll
            for (int tt = 0; tt < 8; ++tt) { f32x2 a = bias;
#pragma unroll
                for (int k = 0; k < 31; ++k) a += w[k] * in[tt + k];
                *(LAS f32x2*)(cbuf + (8 * g + tt) * 1024 + c0) = a; }
        }
    }
    {
        const f32x2 w0 = *(const GAS f32x2*)(F.scw + c0), w1 = *(const GAS f32x2*)(F.scw + 1024 + c0), w2 = *(const GAS f32x2*)(F.scw + 2048 + c0), bias = *(const GAS f32x2*)(F.scbias + c0);
        f32x2 p2 = (f32x2){0.f, 0.f}, p1 = (f32x2){0.f, 0.f};
        if (t0 > 0) { const unsigned r2 = *(const GAS unsigned*)(F.CV + (size_t)(t0 - 2) * 1024 + c0), r1 = *(const GAS unsigned*)(F.CV + (size_t)(t0 - 1) * 1024 + c0);
            p2 = (f32x2){bf_lo(r2), bf_hi(r2)}; p1 = (f32x2){bf_lo(r1), bf_hi(r1)}; }
#pragma unroll 8
        for (int tt = 0; tt < 32; ++tt) {
            const unsigned rc = *(const GAS unsigned*)(F.CV + (size_t)(t0 + tt) * 1024 + c0), rg = *(const GAS unsigned*)(F.SCB + (size_t)(t0 + tt) * 1024 + c0);
            const f32x2 cur = (f32x2){bf_lo(rc), bf_hi(rc)}, gate = (f32x2){bf_lo(rg), bf_hi(rg)};
            const f32x2 o = gate * (bias + w0 * p2 + w1 * p1 + w2 * cur);
            *(GAS unsigned*)(F.MIX + (size_t)(t0 + tt) * 2048 + 1024 + c0) = pk2(o.x, o.y);
            p2 = p1; p1 = cur;
        }
    }
    LDS_WAIT(); __syncthreads();
#pragma unroll 1
    for (int q = 0; q < 4; ++q) {
        const int tt = F.wave * 4 + q;
        f32x4 v[4]; float s = 0.f;
#pragma unroll
        for (int j = 0; j < 4; ++j) { v[j] = *(const LAS f32x4*)(cbuf + tt * 1024 + 4 * lane + 256 * j); s += (v[j].x + v[j].y) + (v[j].z + v[j].w); }
        const float mean = wave_sum(s) * (1.f / 1024.f); float s2 = 0.f;
#pragma unroll
        for (int j = 0; j < 4; ++j) { v[j] = v[j] - mean; s2 += (v[j].x * v[j].x + v[j].y * v[j].y) + (v[j].z * v[j].z + v[j].w * v[j].w); }
        const float rstd = 1.f / sqrtf(wave_sum(s2) * (1.f / 1024.f) + LN_EPS);
#pragma unroll
        for (int j = 0; j < 4; ++j) { const f32x4 g = *(const GAS f32x4*)(F.clg + 4 * lane + 256 * j), b = *(const GAS f32x4*)(F.clb + 4 * lane + 256 * j);
            f32x4 y = v[j] * rstd * g + b;
            y.x *= pg8::sigmoidf_fast(y.x); y.y *= pg8::sigmoidf_fast(y.y); y.z *= pg8::sigmoidf_fast(y.z); y.w *= pg8::sigmoidf_fast(y.w);
            v2u o; o.x = pk2(y.x, y.y); o.y = pk2(y.z, y.w);
            *(GAS v2u*)(F.MIX + (size_t)(t0 + tt) * 2048 + 4 * lane + 256 * j) = o; }
    }
    __syncthreads();
}

__device__ __forceinline__ void p4_ln1(Frame& F) {
    const int gw = F.vcu * NWAVES + F.wave, NGW = F.G * NWAVES, lane = F.lane;
    for (int r = gw; r < S; r += NGW) {
        const GAS f32x4* yr = (const GAS f32x4*)(F.Y + (size_t)r * D) + lane;
        f32x4 v[8]; float s = 0.f;
#pragma unroll
        for (int j = 0; j < 8; ++j) { v[j] = yr[64 * j]; s += (v[j].x + v[j].y) + (v[j].z + v[j].w); }
        const float mean = wave_sum(s) * (1.f / D); float s2 = 0.f;
#pragma unroll
        for (int j = 0; j < 8; ++j) { v[j] = v[j] - mean; s2 += (v[j].x * v[j].x + v[j].y * v[j].y) + (v[j].z * v[j].z + v[j].w * v[j].w); }
        const float rstd = 1.f / sqrtf(wave_sum(s2) * (1.f / D) + LN_EPS);
        GAS v2u* o8 = (GAS v2u*)(F.X1 + (size_t)r * D) + lane;
#pragma unroll
        for (int j = 0; j < 8; ++j) { const f32x4 g = *(const GAS f32x4*)(F.ln1g + 4 * lane + 256 * j), b = *(const GAS f32x4*)(F.ln1b + 4 * lane + 256 * j);
            const f32x4 y = v[j] * rstd * g + b; v2u o; o.x = pk2(y.x, y.y); o.y = pk2(y.z, y.w); o8[64 * j] = o; }
    }
}

__device__ __forceinline__ int imax_(int a, int b) { return a > b ? a : b; }
__device__ __forceinline__ int imin_(int a, int b) { return a < b ? a : b; }
template <bool DESC> __device__ __forceinline__ void ce_i(int& a, int& b) { const int mx = imax_(a, b), mn = imin_(a, b); a = DESC ? mx : mn; b = DESC ? mn : mx; }
template <bool DESC> __device__ __forceinline__ void sort16_i(int (&v)[16]) {
#pragma unroll
    for (int k = 2; k <= 16; k <<= 1)
#pragma unroll
        for (int j = k >> 1; j > 0; j >>= 1)
#pragma unroll
            for (int i = 0; i < 16; ++i) { const int l = i ^ j; if (l > i) { const bool up = ((i & k) == 0); if (up != DESC) ce_i<false>(v[i], v[l]); else ce_i<true>(v[i], v[l]); } }
}
template <bool DESC> __device__ __forceinline__ void merge16_i(int (&v)[16]) {
#pragma unroll
    for (int j = 8; j > 0; j >>= 1)
#pragma unroll
        for (int i = 0; i < 16; ++i) { const int l = i ^ j; if (l > i) ce_i<DESC>(v[i], v[l]); }
}
template <bool DESC> __device__ __forceinline__ void ce_p(float& a, int& pa, float& b, int& pb) {
    const bool sw = DESC ? (a < b) : (a > b); const float ta = sw ? b : a, tb = sw ? a : b; const int qa = sw ? pb : pa, qb = sw ? pa : pb; a = ta; b = tb; pa = qa; pb = qb; }
template <bool DESC> __device__ __forceinline__ void sort16_p(float (&v)[16], int (&p)[16]) {
#pragma unroll
    for (int k = 2; k <= 16; k <<= 1)
#pragma unroll
        for (int j = k >> 1; j > 0; j >>= 1)
#pragma unroll
            for (int i = 0; i < 16; ++i) { const int l = i ^ j; if (l > i) { const bool up = ((i & k) == 0); if (up != DESC) ce_p<false>(v[i], p[i], v[l], p[l]); else ce_p<true>(v[i], p[i], v[l], p[l]); } }
}
template <bool DESC> __device__ __forceinline__ void merge16_p(float (&v)[16], int (&p)[16]) {
#pragma unroll
    for (int j = 8; j > 0; j >>= 1)
#pragma unroll
        for (int i = 0; i < 16; ++i) { const int l = i ^ j; if (l > i) ce_p<DESC>(v[i], p[i], v[l], p[l]); }
}
__device__ __forceinline__ int f2key(float f) { const int b = __float_as_int(f); return b ^ ((b >> 31) & 0x7fffffff); }
__device__ __forceinline__ float key2f(int k) { return __int_as_float(k ^ ((k >> 31) & 0x7fffffff)); }

__device__ __forceinline__ void p6_topk(Frame& F) {
    const int gw = F.vcu * NWAVES + F.wave, NGW = F.G * NWAVES, lane = F.lane;
    for (int it = gw; it < (S * 16) / 64; it += NGW) {
        const int prob = it * 64 + lane, t = prob >> 4, hp = prob & 15;
        const float* sp = F.SS + (size_t)t * 2048 + hp * 128;
        int top[16];
        {
            f32x4 r[4];
#pragma unroll
            for (int q = 0; q < 4; ++q) r[q] = *(const GAS f32x4*)(sp + 4 * q);
#pragma unroll
            for (int q = 0; q < 4; ++q)
#pragma unroll
                for (int e = 0; e < 4; ++e) top[4 * q + e] = (f2key(r[q][e]) & ~127) | (4 * q + e);
            sort16_i<true>(top);
        }
#pragma unroll 1
        for (int c = 1; c < 8; ++c) {
            f32x4 r[4]; int nw[16];
#pragma unroll
            for (int q = 0; q < 4; ++q) r[q] = *(const GAS f32x4*)(sp + 16 * c + 4 * q);
#pragma unroll
            for (int q = 0; q < 4; ++q)
#pragma unroll
                for (int e = 0; e < 4; ++e) nw[4 * q + e] = (f2key(r[q][e]) & ~127) | (16 * c + 4 * q + e);
            sort16_i<false>(nw);
#pragma unroll
            for (int i = 0; i < 16; ++i) top[i] = imax_(top[i], nw[i]);
            merge16_i<true>(top);
        }
        const bool odd = (lane & 1) != 0;
        float Av[16], Bv[16]; int Ai[16], Bi[16];
#pragma unroll
        for (int i = 0; i < 16; ++i) { const int mine = top[i]; const int other = __shfl_xor(mine, 1); const int ka = odd ? other : mine, kb = odd ? mine : other;
            Av[i] = key2f(ka & ~127); Ai[i] = ka & 127; Bv[i] = key2f(kb & ~127); Bi[i] = kb & 127; }
        float tv[16]; int tp[16];
#pragma unroll
        for (int j = 0; j < 16; ++j) { tv[j] = Av[0] + Bv[j]; tp[j] = Ai[0] * 128 + Bi[j]; }
        {
            float nv[16]; int np[16];
#pragma unroll
            for (int j = 0; j < 8; ++j) { nv[j] = Av[1] + Bv[j]; np[j] = Ai[1] * 128 + Bi[j]; }
#pragma unroll
            for (int j = 0; j < 5; ++j) { nv[8 + j] = Av[2] + Bv[j]; np[8 + j] = Ai[2] * 128 + Bi[j]; }
#pragma unroll
            for (int j = 0; j < 3; ++j) { nv[13 + j] = Av[3] + Bv[j]; np[13 + j] = Ai[3] * 128 + Bi[j]; }
            sort16_p<false>(nv, np);
#pragma unroll
            for (int i = 0; i < 16; ++i) { const bool g = nv[i] > tv[i]; tv[i] = g ? nv[i] : tv[i]; tp[i] = g ? np[i] : tp[i]; }
            merge16_p<true>(tv, tp);
        }
        {
            float nv[16]; int np[16];
            nv[0] = Av[3] + Bv[3]; np[0] = Ai[3] * 128 + Bi[3];
#pragma unroll
            for (int j = 0; j < 3; ++j) { nv[1 + j] = Av[4] + Bv[j]; np[1 + j] = Ai[4] * 128 + Bi[j]; }
#pragma unroll
            for (int i = 5; i < 8; ++i)
#pragma unroll
                for (int j = 0; j < 2; ++j) { nv[4 + 2 * (i - 5) + j] = Av[i] + Bv[j]; np[4 + 2 * (i - 5) + j] = Ai[i] * 128 + Bi[j]; }
#pragma unroll
            for (int i = 8; i < 14; ++i) { nv[10 + i - 8] = Av[i] + Bv[0]; np[10 + i - 8] = Ai[i] * 128 + Bi[0]; }
            sort16_p<false>(nv, np);
#pragma unroll
            for (int i = 0; i < 16; ++i) { const bool g = nv[i] > tv[i]; tv[i] = g ? nv[i] : tv[i]; tp[i] = g ? np[i] : tp[i]; }
            merge16_p<true>(tv, tp);
        }
        {
            const float hi = Av[14] + Bv[0], lo = Av[15] + Bv[0]; const int phi = Ai[14] * 128 + Bi[0], plo = Ai[15] * 128 + Bi[0];
            const float t14 = tv[14], t15 = tv[15]; const int q14 = tp[14], q15 = tp[15];
            const bool g14 = lo > t14, g15 = hi > t15;
            tv[14] = g14 ? lo : t14; tp[14] = g14 ? plo : q14; tv[15] = g15 ? hi : t15; tp[15] = g15 ? phi : q15;
        }
        float mx = tv[0];
#pragma unroll
        for (int i = 1; i < 16; ++i) mx = fmaxf(mx, tv[i]);
        float sum = 0.f;
#pragma unroll
        for (int i = 0; i < 16; ++i) { tv[i] = __expf(tv[i] - mx); sum += tv[i]; }
        const float rs = 1.f / sum;
        const size_t ob = (size_t)t * NPAIR + hp * 8;
        int oe[8]; float og[8], ou[8];
#pragma unroll
        for (int k = 0; k < 8; ++k) { const int pa = tp[k], pb = tp[8 + k]; const float va = tv[k], vb = tv[8 + k];
            oe[k] = odd ? pb : pa; const float g = (odd ? vb : va) * rs; og[k] = g * F.VSC[oe[k]]; ou[k] = F.USC[oe[k]]; }
        *(GAS v4u*)(F.IDX + ob) = (v4u){(unsigned)oe[0], (unsigned)oe[1], (unsigned)oe[2], (unsigned)oe[3]};
        *(GAS v4u*)(F.IDX + ob + 4) = (v4u){(unsigned)oe[4], (unsigned)oe[5], (unsigned)oe[6], (unsigned)oe[7]};
        *(GAS f32x4*)(F.GV + ob) = (f32x4){og[0], og[1], og[2], og[3]};
        *(GAS f32x4*)(F.GV + ob + 4) = (f32x4){og[4], og[5], og[6], og[7]};
        *(GAS f32x4*)(F.SU + ob) = (f32x4){ou[0], ou[1], ou[2], ou[3]};
        *(GAS f32x4*)(F.SU + ob + 4) = (f32x4){ou[4], ou[5], ou[6], ou[7]};
    }
}

constexpr int NPS = 5;
constexpr int RING_W = NPS * 2 * ROWB;
static_assert(NWAVES * RING_W <= RING_BYTES, "rings fit the phase scratch region");
typedef unsigned u32x6 __attribute__((ext_vector_type(6)));
typedef float f32x32 __attribute__((ext_vector_type(32)));
typedef __bf16 bf16x32 __attribute__((ext_vector_type(32)));
typedef __bf16 bf16x2 __attribute__((ext_vector_type(2)));
__device__ __forceinline__ float gelu_erf(float z) { return 0.5f * z * (1.0f + erff(z * 0.70710678118654752f)); }
__device__ __forceinline__ float dpp_add(float v, int ctrl_sel) {
    int m;
    if (ctrl_sel == 0) m = __builtin_amdgcn_update_dpp(0, __float_as_int(v), 0x111, 0xf, 0xf, false);
    else if (ctrl_sel == 1) m = __builtin_amdgcn_update_dpp(0, __float_as_int(v), 0x112, 0xf, 0xf, false);
    else if (ctrl_sel == 2) m = __builtin_amdgcn_update_dpp(0, __float_as_int(v), 0x114, 0xf, 0xf, false);
    else if (ctrl_sel == 3) m = __builtin_amdgcn_update_dpp(0, __float_as_int(v), 0x118, 0xf, 0xf, false);
    else if (ctrl_sel == 4) m = __builtin_amdgcn_update_dpp(0, __float_as_int(v), 0x142, 0xa, 0xf, false);
    else m = __builtin_amdgcn_update_dpp(0, __float_as_int(v), 0x143, 0xc, 0xf, false);
    return v + __int_as_float(m);
}
__device__ __forceinline__ float wave_sum_lane63(float v) {
    v = dpp_add(v, 0); v = dpp_add(v, 1); v = dpp_add(v, 2); v = dpp_add(v, 3); v = dpp_add(v, 4); v = dpp_add(v, 5); return v;
}
__device__ __forceinline__ void p7_sort512(int (&key)[8], int lane) {
#pragma unroll
    for (int k = 2; k <= 512; k <<= 1) {
#pragma unroll
        for (int j = k >> 1; j > 0; j >>= 1) {
            if (j >= 64) {
                const int jr = j >> 6;
#pragma unroll
                for (int r = 0; r < 8; ++r) if ((r & jr) == 0) { const int rp = r | jr; const bool asc = ((64 * r) & k) == 0;
                    const int a = key[r], b = key[rp], mn = imin_(a, b), mx = imax_(a, b); key[r] = asc ? mn : mx; key[rp] = asc ? mx : mn; }
            } else {
#pragma unroll
                for (int r = 0; r < 8; ++r) { const int mine = key[r], o = __builtin_amdgcn_ds_bpermute((lane ^ j) << 2, mine); const bool low = (lane & j) == 0, asc = ((64 * r + lane) & k) == 0;
                    key[r] = (low == asc) ? imin_(mine, o) : imax_(mine, o); }
            }
        }
    }
}
__device__ __forceinline__ int sel8i(const int (&a)[8], int r) {
    const int a0 = a[0], a1 = a[1], a2 = a[2], a3 = a[3], a4 = a[4], a5 = a[5], a6 = a[6], a7 = a[7];
    int v = a0; v = r == 1 ? a1 : v; v = r == 2 ? a2 : v; v = r == 3 ? a3 : v; v = r == 4 ? a4 : v; v = r == 5 ? a5 : v; v = r == 6 ? a6 : v; v = r == 7 ? a7 : v; return v;
}
__device__ __forceinline__ float sel8f(const float (&a)[8], int r) {
    const float a0 = a[0], a1 = a[1], a2 = a[2], a3 = a[3], a4 = a[4], a5 = a[5], a6 = a[6], a7 = a[7];
    float v = a0; v = r == 1 ? a1 : v; v = r == 2 ? a2 : v; v = r == 3 ? a3 : v; v = r == 4 ? a4 : v; v = r == 5 ? a5 : v; v = r == 6 ? a6 : v; v = r == 7 ? a7 : v; return v;
}
struct P7Tabs { __amdgpu_buffer_rsrc_t u, v; };
__device__ __forceinline__ void p7_dma_pair(__amdgpu_buffer_rsrc_t rs, LAS unsigned char* slotp, int keya, int keyb, int lane) {
    const int oa = (keya >> 9) * ROWB, ob = (keyb >> 9) * ROWB;
    const int v16 = 16 * lane;
    const int vmid = lane < 32 ? oa + 1024 + v16 : ob + v16 - 512;
    __builtin_amdgcn_raw_ptr_buffer_load_lds(rs, (LAS void*)slotp, 16, v16, oa, 0, 0);
    __builtin_amdgcn_raw_ptr_buffer_load_lds(rs, (LAS void*)(slotp + 1024), 16, vmid, 0, 0, 0);
    __builtin_amdgcn_raw_ptr_buffer_load_lds(rs, (LAS void*)(slotp + 2048), 16, v16, ob + 512, 0, 0);
}
__device__ __forceinline__ u32x6 p7_read_row(const LAS unsigned char* slotp, int lane) {
    const LAS v2u* q = (const LAS v2u*)(slotp + 24 * lane); const v2u a = q[0], b = q[1], c = q[2];
    u32x6 r; r[0] = a.x; r[1] = a.y; r[2] = b.x; r[3] = b.y; r[4] = c.x; r[5] = c.y; return r;
}
__device__ __forceinline__ float p7_dot(const unsigned (&xp)[16], const bf16x32& uf) {
    float s0 = 0.f, s1 = 0.f;
#pragma unroll
    for (int m = 0; m < 16; m += 2) {
        bf16x2 a; a[0] = uf[2 * m]; a[1] = uf[2 * m + 1]; bf16x2 b; b[0] = uf[2 * m + 2]; b[1] = uf[2 * m + 3];
        const unsigned xa = xp[m], xb = xp[m + 1];
        s0 = __builtin_amdgcn_fdot2_f32_bf16(__builtin_bit_cast(bf16x2, xa), a, s0, false);
        s1 = __builtin_amdgcn_fdot2_f32_bf16(__builtin_bit_cast(bf16x2, xb), b, s1, false); }
    return s0 + s1;
}
__device__ __forceinline__ void p7_axpy(float (&acc)[32], float ck, const f32x32& vf) {
#pragma unroll
    for (int r = 0; r < 32; ++r) acc[r] = fmaf(ck, vf[r], acc[r]);
}
#define P7_WAIT_PAIR() asm volatile("s_waitcnt vmcnt(9)" ::: "memory")
static_assert(NPS == 5, "P7_WAIT_PAIR counts 3 * (NPS - 2)");
__device__ __forceinline__ void p7_peer(Frame& F) {
    const int gw = F.vcu * NWAVES + F.wave, NGW = F.G * NWAVES, lane_in = F.lane;
    LAS f32x4* lg = (LAS f32x4*)(F.lds + LNP_OFF); LAS f32x4* lb = lg + 512;
    for (int i = F.tid; i < 512; i += NWAVES * 64) { lg[i] = ((const GAS f32x4*)F.ln2g)[i]; lb[i] = ((const GAS f32x4*)F.ln2b)[i]; }
    LDS_WAIT(); __syncthreads();
    LAS unsigned char* ring = F.lds + RING_OFF + F.wave * RING_W;
    P7Tabs T; T.u = __builtin_amdgcn_make_buffer_rsrc((void*)F.U8, 0, NE * ROWB, 0x00020000); T.v = __builtin_amdgcn_make_buffer_rsrc((void*)F.V8, 0, NE * ROWB, 0x00020000);
#pragma unroll 1
    for (int tg = gw; tg < S / 4; tg += NGW) {
        const int tb = 4 * tg;
        int lane = lane_in; asm volatile("" : "+v"(lane));
        int key[8]; float gvv[8], suv[8];
#pragma unroll
        for (int s = 0; s < 4; ++s)
#pragma unroll
            for (int h = 0; h < 2; ++h) { const size_t o = (size_t)(tb + s) * NPAIR + 64 * h + lane;
                key[2 * s + h] = (F.IDX[o] << 9) | (s << 7) | (64 * h + lane); gvv[2 * s + h] = F.GV[o]; suv[2 * s + h] = F.SU[o]; }
        unsigned xp0[16], xp1[16], xp2[16], xp3[16];
#pragma unroll
        for (int j = 0; j < 8; ++j) {
            const v2u w0 = ((const GAS v2u*)(F.X1 + (size_t)(tb + 0) * D) + lane)[64 * j], w1 = ((const GAS v2u*)(F.X1 + (size_t)(tb + 1) * D) + lane)[64 * j];
            const v2u w2 = ((const GAS v2u*)(F.X1 + (size_t)(tb + 2) * D) + lane)[64 * j], w3 = ((const GAS v2u*)(F.X1 + (size_t)(tb + 3) * D) + lane)[64 * j];
            xp0[2 * j] = w0.x; xp0[2 * j + 1] = w0.y; xp1[2 * j] = w1.x; xp1[2 * j + 1] = w1.y; xp2[2 * j] = w2.x; xp2[2 * j + 1] = w2.y; xp3[2 * j] = w3.x; xp3[2 * j + 1] = w3.y; }
        p7_sort512(key, lane);
        VM_WAIT();
#pragma unroll
        for (int i = 0; i < NPS - 1; ++i) p7_dma_pair(T.u, ring + i * 2 * ROWB, __builtin_amdgcn_readlane(key[0], 2 * i), __builtin_amdgcn_readlane(key[0], 2 * i + 1), lane);
        int rs = 0, prev = NPS - 1;
        float coef[8];
#pragma unroll
        for (int q = 0; q < 8; ++q) coef[q] = 0.f;
#pragma unroll 1
        for (int r = 0; r < 8; ++r) {
            const int kcur = sel8i(key, r), knext = sel8i(key, (r + 1) & 7);
            int zreg = 0;
#pragma unroll 1
            for (int i = 0; i < 64; i += 2) {
                P7_WAIT_PAIR();
                const u32x6 rowa = p7_read_row(ring + rs * 2 * ROWB, lane), rowb = p7_read_row(ring + rs * 2 * ROWB + ROWB, lane);
                {
                    const int ln = (i + 2 * (NPS - 1)) & 63; const bool wrap = i + 2 * (NPS - 1) >= 64;
                    const int ka0 = __builtin_amdgcn_readlane(kcur, ln), ka1 = __builtin_amdgcn_readlane(kcur, ln + 1), kb0 = __builtin_amdgcn_readlane(knext, ln), kb1 = __builtin_amdgcn_readlane(knext, ln + 1);
                    const int k0 = wrap ? kb0 : ka0, k1 = wrap ? kb1 : ka1;
                    if (r == 7 && wrap) p7_dma_pair(T.v, ring + prev * 2 * ROWB, k0, k1, lane); else p7_dma_pair(T.u, ring + prev * 2 * ROWB, k0, k1, lane);
                }
#pragma unroll
                for (int h = 0; h < 2; ++h) {
                    const int kp = __builtin_amdgcn_readlane(kcur, i + h), s = (kp >> 7) & 3;
                    const bf16x32 uf = __builtin_amdgcn_cvt_scalef32_pk32_bf16_fp6(h ? rowb : rowa, 1.0f);
                    float d = 0.f;
                    int sa = s, sb = s, sc = s, sd = s; asm volatile("" : "+s"(sa)); asm volatile("" : "+s"(sb)); asm volatile("" : "+s"(sc)); asm volatile("" : "+s"(sd));
                    if (sa == 0) d = p7_dot(xp0, uf);
                    if (sb == 1) d = p7_dot(xp1, uf);
                    if (sc == 2) d = p7_dot(xp2, uf);
                    if (sd == 3) d = p7_dot(xp3, uf);
                    d = wave_sum_lane63(d);
                    { const int d63 = __builtin_amdgcn_readlane(__float_as_int(d), 63); zreg = lane == i + h ? d63 : zreg; }
                }
                prev = rs; rs = rs + 1 == NPS ? 0 : rs + 1;
            }
            const int s = (kcur >> 7) & 3, pr = kcur & 127, sel = 2 * s + (pr >> 6);
            float su = 0.f, gv = 0.f;
#pragma unroll
            for (int j = 0; j < 8; ++j) { const float a = __int_as_float(__builtin_amdgcn_ds_bpermute((pr & 63) << 2, __float_as_int(suv[j]))), b = __int_as_float(__builtin_amdgcn_ds_bpermute((pr & 63) << 2, __float_as_int(gvv[j]))); su = sel == j ? a : su; gv = sel == j ? b : gv; }
            const float cnew = gelu_erf(__int_as_float(zreg) * su) * gv;
#pragma unroll
            for (int q = 0; q < 8; ++q) { const float old = coef[q]; coef[q] = r == q ? cnew : old; }
        }
        float acc0[32], acc1[32], acc2[32], acc3[32];
#pragma unroll
        for (int q = 0; q < 32; ++q) { acc0[q] = 0.f; acc1[q] = 0.f; acc2[q] = 0.f; acc3[q] = 0.f; }
#pragma unroll 1
        for (int r = 0; r < 8; ++r) {
            const int kcur = sel8i(key, r), knext = sel8i(key, r < 7 ? r + 1 : 7); const float ccur = sel8f(coef, r);
#pragma unroll 1
            for (int i = 0; i < 64; i += 2) {
                P7_WAIT_PAIR();
                {
                    const int ln = (i + 2 * (NPS - 1)) & 63; const bool wrap = i + 2 * (NPS - 1) >= 64;
                    const int ka0 = __builtin_amdgcn_readlane(kcur, ln), ka1 = __builtin_amdgcn_readlane(kcur, ln + 1);
                    const int kb0 = __builtin_amdgcn_readlane(knext, r < 7 ? ln : 62), kb1 = __builtin_amdgcn_readlane(knext, r < 7 ? ln + 1 : 63);
                    p7_dma_pair(T.v, ring + prev * 2 * ROWB, wrap ? kb0 : ka0, wrap ? kb1 : ka1, lane);
                }
#pragma unroll
                for (int h = 0; h < 2; ++h) {
                    const int kp = __builtin_amdgcn_readlane(kcur, i + h), s = (kp >> 7) & 3;
                    const float ck = __int_as_float(__builtin_amdgcn_readlane(__float_as_int(ccur), i + h));
                    const u32x6 row = p7_read_row(ring + rs * 2 * ROWB + h * ROWB, lane);
                    const f32x32 vf = __builtin_amdgcn_cvt_scalef32_pk32_f32_fp6(row, 1.0f);
                    int sa = s, sb = s, sc = s, sd = s; asm volatile("" : "+s"(sa)); asm volatile("" : "+s"(sb)); asm volatile("" : "+s"(sc)); asm volatile("" : "+s"(sd));
                    if (sa == 0) p7_axpy(acc0, ck, vf);
                    if (sb == 1) p7_axpy(acc1, ck, vf);
                    if (sc == 2) p7_axpy(acc2, ck, vf);
                    if (sd == 3) p7_axpy(acc3, ck, vf);
                }
                prev = rs; rs = rs + 1 == NPS ? 0 : rs + 1;
            }
        }
        VM_WAIT();
#pragma unroll
        for (int s = 0; s < 4; ++s) {
            asm volatile("" ::: "memory"); __builtin_amdgcn_sched_barrier(0);
            float (&acc)[32] = s == 0 ? acc0 : s == 1 ? acc1 : s == 2 ? acc2 : acc3;
            const GAS v2u* xr = (const GAS v2u*)(F.X1 + (size_t)(tb + s) * D) + lane;
            float sum = 0.f;
#pragma unroll
            for (int j = 0; j < 8; ++j) { const v2u w = xr[64 * j];
                acc[4 * j + 0] = fmaf(ALPHA, bf_lo(w.x), acc[4 * j + 0]); acc[4 * j + 1] = fmaf(ALPHA, bf_hi(w.x), acc[4 * j + 1]);
                acc[4 * j + 2] = fmaf(ALPHA, bf_lo(w.y), acc[4 * j + 2]); acc[4 * j + 3] = fmaf(ALPHA, bf_hi(w.y), acc[4 * j + 3]); }
#pragma unroll
            for (int q = 0; q < 32; ++q) sum += acc[q];
            const float mean = __int_as_float(__builtin_amdgcn_readlane(__float_as_int(wave_sum_lane63(sum)), 63)) * (1.f / D); float s2 = 0.f;
#pragma unroll
            for (int q = 0; q < 32; ++q) { acc[q] -= mean; s2 = fmaf(acc[q], acc[q], s2); }
            const float rstd = 1.f / sqrtf(__int_as_float(__builtin_amdgcn_readlane(__float_as_int(wave_sum_lane63(s2)), 63)) * (1.f / D) + LN_EPS);
            GAS f32x4* orow = (GAS f32x4*)(F.out + (size_t)(tb + s) * D) + lane;
#pragma unroll
            for (int j = 0; j < 8; ++j) { const f32x4 g = lg[lane + 64 * j], b = lb[lane + 64 * j];
                f32x4 o; o.x = acc[4 * j + 0] * rstd * g.x + b.x; o.y = acc[4 * j + 1] * rstd * g.y + b.y; o.z = acc[4 * j + 2] * rstd * g.z + b.z; o.w = acc[4 * j + 3] * rstd * g.w + b.w;
                orow[64 * j] = o; }
        }
    }
}

struct Args { const float* in[19]; float* out; unsigned char* ws; int ph_lo, ph_hi, li, pad; };
__global__ void __launch_bounds__(NWAVES * 64, 2) peer_layer_fwd(Args args) {
    extern __shared__ __attribute__((aligned(16))) unsigned char lds[];
    Frame F;
    F.lds = (LAS unsigned char*)lds;
    F.MISC = (volatile LAS unsigned*)(F.lds + MISC_OFF);
    F.tid = threadIdx.x; F.lane = F.tid & 63; F.wave = __builtin_amdgcn_readfirstlane(F.tid >> 6);
    F.G = gridDim.x; { const int bx = blockIdx.x; F.vcu = (F.G % 8 == 0) ? (bx % 8) * (F.G / 8) + bx / 8 : bx; }
    unsigned char* ws = args.ws;
    F.ctl = (gu32*)(ws + WS_CTL);
    F.x = args.in[0]; F.w_in = args.in[1]; F.b_in = args.in[2]; F.ccw = args.in[3]; F.ccb = args.in[4]; F.clg = args.in[5]; F.clb = args.in[6];
    F.scw = args.in[7]; F.scbias = args.in[8]; F.w_out = args.in[9]; F.b_out = args.in[10]; F.ln1g = args.in[11]; F.ln1b = args.in[12];
    F.w_q = args.in[13]; F.sub_keys = args.in[14]; F.peer_u = args.in[15]; F.peer_v = args.in[16]; F.ln2g = args.in[17]; F.ln2b = args.in[18];
    F.out = args.out;
    F.XB = (bf16*)(ws + WS_XB); F.BT1 = (bf16*)(ws + WS_BT1); F.BT2 = (bf16*)(ws + WS_BT2); F.BT3 = (bf16*)(ws + WS_BT3);
    F.AGLU = (bf16*)(ws + WS_AGLU); F.CV = (bf16*)(ws + WS_CV); F.SCB = (bf16*)(ws + WS_SCB); F.MIX = (bf16*)(ws + WS_MIX); F.X1 = (bf16*)(ws + WS_X1);
    F.Y = (float*)(ws + WS_Y); F.SS = (float*)(ws + WS_S); F.IDX = (int*)(ws + WS_IDX); F.GV = (float*)(ws + WS_GV); F.SU = (float*)(ws + WS_SU);
    F.U8 = ws + WS_U8; F.V8 = ws + WS_V8; F.USC = (float*)(ws + WS_USC); F.VSC = (float*)(ws + WS_VSC);
    for (int u = F.tid; u < (LDS_BYTES - LDSCTL_OFF) / 4; u += NWAVES * 64) ((LAS unsigned*)(F.lds + LDSCTL_OFF))[u] = 0u;
    __syncthreads();
    XcdBarrier bar; bar.bar = (unsigned*)(F.ctl + CW_BAR); bar.x = 0; bar.st = nullptr;
    if (N_LAUNCHES == 1) bar = xcd_barrier_post((unsigned*)(F.ctl + CW_BAR), F.MISC + 8);
    const int lo = args.ph_lo, hi = args.ph_hi;
#ifndef ONLY_PHASE
#define ONLY_PHASE -1
#endif
#define IN(k) ((ONLY_PHASE < 0 || ONLY_PHASE == (k)) && lo <= (k) && (k) < hi)
#define SEAM(k) do { if (IN(k) && IN((k) + 1)) xcd_barrier(bar); } while (0)
#ifndef REPEAT_PHASE
#define REPEAT_PHASE -1
#endif
#define REPS(k) for (int rep_ = 0; rep_ < (REPEAT_PHASE == (k) ? 2 : 1); ++rep_)

    if (IN(0)) { REPS(0) p0_prologue(F); SEAM(0); }
    if (IN(1)) { REPS(1) {
        pg8::Gemm g{F.XB, F.BT1, S, NIN, D}; pg8::StaticOrder So; So.init(S, NIN, F.G, (int)blockIdx.x);
        pg8::EpiInProj E{F.AGLU, F.CV, F.SCB, F.b_in};
        pg8::gemm_phase<pg8::EpiInProj, pg8::StaticOrder, PG8_ALIGN, PG8_SP2>(F.lds + RING_OFF, g, So, E); }
        SEAM(1);
    }
    if (IN(2)) { REPS(2) for (int u = F.vcu; u < S / 32; u += F.G) p2_unit(F, u); SEAM(2); }
    if (IN(3)) { REPS(3) {
        pg8::Gemm g{F.MIX, F.BT2, S, D, D}; pg8::StaticOrder So; So.init(S, D, F.G, (int)blockIdx.x);
        pg8::EpiOutProj E{F.Y, F.b_out, F.x, ALPHA};
        pg8::gemm_phase<pg8::EpiOutProj, pg8::StaticOrder, PG8_ALIGN, PG8_SP2>(F.lds + RING_OFF, g, So, E); }
        SEAM(3);
    }
    if (IN(4)) { REPS(4) p4_ln1(F); SEAM(4); }
    if (IN(5)) { REPS(5) {
        pg8::Gemm g{F.X1, F.BT3, S, D, D}; pg8::StaticOrder So; So.init(S, D, F.G, (int)blockIdx.x);
        pg8::EpiF32 E{F.SS, D};
        pg8::gemm_phase<pg8::EpiF32, pg8::StaticOrder, PG8_ALIGN, PG8_SP2>(F.lds + RING_OFF, g, So, E); }
        SEAM(5);
    }
    if (IN(6)) { REPS(6) p6_topk(F); SEAM(6); }
    if (IN(7)) { REPS(7) p7_peer(F); }
#undef IN
#undef SEAM
}

extern "C" void kernel_launch(void* const* d_in, const int* in_sizes, int n_in, void* d_out, int out_size, void* d_ws, size_t ws_size, hipStream_t stream) {
    static int grid = 0;
    if (grid == 0) {
        if (n_in != 19 || in_sizes[0] != S * D || out_size != S * D || ws_size < WS_END) {
            fprintf(stderr, "kernel_launch: built for 19 inputs, x/out of %d floats, >= %zu bytes of workspace; got n_in %d, in0 %d, out %d, ws %zu; nothing launched\n", S * D, (size_t)WS_END, n_in, n_in > 0 ? in_sizes[0] : -1, out_size, ws_size);
            grid = -1; return; }
        int dev = 0, cus = 0, per_cu = 0;
        if (hipGetDevice(&dev) != hipSuccess || hipDeviceGetAttribute(&cus, hipDeviceAttributeMultiprocessorCount, dev) != hipSuccess) { fprintf(stderr, "kernel_launch: device query failed\n"); grid = -1; return; }
        if (hipFuncSetAttribute((const void*)peer_layer_fwd, hipFuncAttributeMaxDynamicSharedMemorySize, LDS_BYTES) != hipSuccess) { fprintf(stderr, "kernel_launch: hipFuncSetAttribute failed\n"); grid = -1; return; }
        if (hipOccupancyMaxActiveBlocksPerMultiprocessor(&per_cu, (const void*)peer_layer_fwd, NWAVES * 64, LDS_BYTES) != hipSuccess || per_cu < 1) {
            fprintf(stderr, "kernel_launch: occupancy query reports %d workgroups per CU; nothing launched\n", per_cu); (void)hipGetLastError(); grid = -1; return; }
        (void)hipGetLastError();
        grid = cus;
    }
    if (grid < 0) return;
    if (hipMemsetAsync((char*)d_ws + WS_CTL, 0, CTL_ZERO_BYTES, stream) != hipSuccess) { fprintf(stderr, "kernel_launch: hipMemsetAsync failed\n"); return; }
    Args a{};
    for (int i = 0; i < 19; ++i) a.in[i] = (const float*)d_in[i];
    a.out = (float*)d_out; a.ws = (unsigned char*)d_ws;
    for (int li = 0; li < N_LAUNCHES; ++li) {
        a.ph_lo = (N_LAUNCHES == 1) ? 0 : li; a.ph_hi = (N_LAUNCHES == 1) ? N_PHASES : li + 1; a.li = li;
        hipError_t le;
        if (N_LAUNCHES == 1) { void* kargs[] = {&a}; le = hipLaunchCooperativeKernel((const void*)peer_layer_fwd, dim3(grid), dim3(NWAVES * 64), kargs, LDS_BYTES, stream); }
        else { hipLaunchKernelGGL(peer_layer_fwd, dim3(grid), dim3(NWAVES * 64), LDS_BYTES, stream, a); le = hipPeekAtLastError(); }
        if (le != hipSuccess) { fprintf(stderr, "kernel_launch: launch %d failed: %s (grid %d x %d threads, %d B LDS)\n", li, hipGetErrorName(le), grid, NWAVES * 64, LDS_BYTES); break; }
    }
}
```

```cpp
#include <hip/hip_runtime.h>
#include <cstdio>
#include <cstdint>
namespace pg8 {
#define PG8_LAS __attribute__((address_space(3)))
typedef unsigned short bf16_t;
typedef short bf16x8 __attribute__((ext_vector_type(8)));
typedef float f32x4 __attribute__((ext_vector_type(4)));
typedef unsigned u32x4 __attribute__((ext_vector_type(4)));
constexpr int BM = 256, BK = 64, HALF = 128, HTB = HALF * BK * 2  , STAGE_BYTES = 8 * HTB, NXCD = 8, WGM = 8;

__host__ __device__ __forceinline__ int lds_byte(int r, int c) { const int st = (r >> 4) * 2 + (c >> 5), rr = r & 15, cc = c & 31, ob = rr * 64 + cc * 2; return st * 1024 + (ob ^ (((ob >> 9) & 1) << 5)); }
__host__ __device__ __forceinline__ void stage_rc(int b, int& R, int& C) { const int st = b / 1024, sb = b % 1024, swz = sb ^ (((sb >> 9) & 1) << 5); R = (st >> 1) * 16 + swz / 64; C = (st & 1) * 32 + (swz % 64) / 2; }
__host__ __device__ __forceinline__ int perm32(int rho) { const int n = rho >> 4, i = rho & 15; return 8 * (i >> 2) + 4 * n + (i & 3); }

struct Unit { int pm, pn; };
struct Gemm { const bf16_t* A; const bf16_t* Bt; int M, N, K; };

struct StaticOrder {
    int nM, nN, nwg, G, c;
    __host__ __device__ void init(int M, int N, int G_, int c_) { nM = M / BM; nN = N / BM; nwg = nM * nN; G = G_; c = c_; }
    __host__ __device__ bool next(int i, Unit& u) const {
        const long L = (long)i * G + c; if (L >= nwg) return false;
        int wgid = (int)L; { const int q = nwg / NXCD, r = nwg % NXCD, xcd = wgid % NXCD, off = wgid / NXCD; wgid = (xcd < r ? xcd * (q + 1) : r * (q + 1) + (xcd - r) * q) + off; }
        const int nig = WGM * nN, gid = wgid / nig, fm = gid * WGM, gsz = (nM - fm) < WGM ? (nM - fm) : WGM;
        u.pm = fm + ((wgid % nig) % gsz); u.pn = (wgid % nig) / gsz; return true;
    }
    __device__ __forceinline__ void a_ready(const Unit&) const {}
    __device__ __forceinline__ void done(const Unit&) const {}
};

__device__ __forceinline__ unsigned cvt_pk_bf16(float lo, float hi) { unsigned r; asm volatile("v_cvt_pk_bf16_f32 %0, %1, %2" : "=v"(r) : "v"(lo), "v"(hi)); return r; }
__device__ __forceinline__ float sigmoidf_fast(float g) { return __builtin_amdgcn_rcpf(1.0f + __expf(-g)); }

struct EpiInProj {
    static constexpr bool PERM = true, AFTER_DRAIN = false;
    bf16_t* aglu; bf16_t* cv; bf16_t* scb; const float* b_in;
    __device__ __forceinline__ void operator()(const f32x4 (&acc)[2][2][4][2], const Unit& u, int wr, int wc, int fr, int fq) const {
        const int row0 = u.pm * BM + wr * 64 + fr, cc = wc * 32 + 8 * fq;
        if (u.pn < 16) {
            const bool conf = u.pn < 8; const int j = conf ? u.pn : u.pn - 8;
            const float* b0 = b_in + (conf ? 0 : 3072) + 128 * j + cc;
            const float* b1 = b_in + (conf ? 1024 : 4096) + 128 * j + cc;
            bf16_t* O = (conf ? aglu : cv) + 128 * j + cc;
            f32x4 bv0[2], bv1[2];
#pragma unroll
            for (int n = 0; n < 2; ++n) { bv0[n] = *(const f32x4*)(b0 + 4 * n); bv1[n] = *(const f32x4*)(b1 + 4 * n); }
#pragma unroll
            for (int ai = 0; ai < 2; ++ai)
#pragma unroll
                for (int m = 0; m < 4; ++m) {
                    f32x4 r[2];
#pragma unroll
                    for (int n = 0; n < 2; ++n) { const f32x4 a = acc[ai][0][m][n] + bv0[n]; f32x4 g = acc[ai][1][m][n] + bv1[n];
                        if (conf) { g[0] = sigmoidf_fast(g[0]); g[1] = sigmoidf_fast(g[1]); g[2] = sigmoidf_fast(g[2]); g[3] = sigmoidf_fast(g[3]); }
                        r[n] = a * g; }
                    u32x4 w; w.x = cvt_pk_bf16(r[0][0], r[0][1]); w.y = cvt_pk_bf16(r[0][2], r[0][3]); w.z = cvt_pk_bf16(r[1][0], r[1][1]); w.w = cvt_pk_bf16(r[1][2], r[1][3]);
                    *(u32x4*)(O + (size_t)(row0 + ai * HALF + m * 16) * 1024) = w; }
        } else {
            const int j = u.pn - 16;
#pragma unroll
            for (int bj = 0; bj < 2; ++bj) {
                const float* b0 = b_in + 2048 + 256 * j + 128 * bj + cc; bf16_t* O = scb + 256 * j + 128 * bj + cc;
                const f32x4 bva = *(const f32x4*)(b0), bvb = *(const f32x4*)(b0 + 4);
#pragma unroll
                for (int ai = 0; ai < 2; ++ai)
#pragma unroll
                    for (int m = 0; m < 4; ++m) { const f32x4 v0 = acc[ai][bj][m][0] + bva, v1 = acc[ai][bj][m][1] + bvb;
                        u32x4 w; w.x = cvt_pk_bf16(v0[0], v0[1]); w.y = cvt_pk_bf16(v0[2], v0[3]); w.z = cvt_pk_bf16(v1[0], v1[1]); w.w = cvt_pk_bf16(v1[2], v1[3]);
                        *(u32x4*)(O + (size_t)(row0 + ai * HALF + m * 16) * 1024) = w; } }
        }
    }
};
struct EpiOutProj {
    static constexpr bool PERM = false, AFTER_DRAIN = false;
    float* Y; const float* bias; const float* x; float alpha;
    __device__ __forceinline__ void operator()(const f32x4 (&acc)[2][2][4][2], const Unit& u, int wr, int wc, int fr, int fq) const {
        const int row0 = u.pm * BM + wr * 64 + fr, col0 = u.pn * BM + wc * 32 + 4 * fq;
        f32x4 bv[2][2];
#pragma unroll
        for (int bj = 0; bj < 2; ++bj)
#pragma unroll
            for (int n = 0; n < 2; ++n) bv[bj][n] = *(const f32x4*)(bias + col0 + bj * HALF + n * 16);
#pragma unroll
        for (int ai = 0; ai < 2; ++ai)
#pragma unroll
            for (int m = 0; m < 4; ++m) { const size_t off = (size_t)(row0 + ai * HALF + m * 16) * 2048 + col0;
#pragma unroll
                for (int bj = 0; bj < 2; ++bj)
#pragma unroll
                    for (int n = 0; n < 2; ++n) { const f32x4 xv = *(const f32x4*)(x + off + bj * HALF + n * 16);
                        *(f32x4*)(Y + off + bj * HALF + n * 16) = acc[ai][bj][m][n] + bv[bj][n] + xv * alpha; }
                asm volatile("" ::: "memory"); }
    }
};
struct EpiF32 {
    static constexpr bool PERM = false, AFTER_DRAIN = false;
    float* C; int ldc;
    __device__ __forceinline__ void operator()(const f32x4 (&acc)[2][2][4][2], const Unit& u, int wr, int wc, int fr, int fq) const {
        const int row0 = u.pm * BM + wr * 64 + fr, col0 = u.pn * BM + wc * 32 + 4 * fq;
#pragma unroll
        for (int ai = 0; ai < 2; ++ai)
#pragma unroll
            for (int m = 0; m < 4; ++m) { float* rowp = C + (size_t)(row0 + ai * HALF + m * 16) * ldc + col0;
#pragma unroll
                for (int bj = 0; bj < 2; ++bj)
#pragma unroll
                    for (int n = 0; n < 2; ++n) *(f32x4*)(rowp + bj * HALF + n * 16) = acc[ai][bj][m][n]; }
    }
};

template <class Epi, class Sched, bool ALIGN_EPI = false, bool SP2 = false>
__device__ __forceinline__ void gemm_phase(PG8_LAS unsigned char* lds, const Gemm g, const Sched& S, const Epi& E) {
    const int tid = threadIdx.x, wid = __builtin_amdgcn_readfirstlane(tid >> 6), lane = tid & 63, wr = wid >> 2, wc = wid & 3, fr = lane & 15, fq = lane >> 4;
    const int K = g.K, nt = K / BK;
    unsigned voffA[2], voffB[2];
#pragma unroll
    for (int i = 0; i < 2; ++i) { int R, C; stage_rc(tid * 16 + i * 8192, R, C); const int Rb = Epi::PERM ? ((R & ~31) + perm32(R & 31)) : R;
        voffA[i] = (unsigned)(R * K + C) * 2u; voffB[i] = (unsigned)(Rb * K + C) * 2u; }
    const size_t kstep = (size_t)(BK * 2);
    const size_t hstep = (size_t)HALF * K * 2;
    const size_t tstep = 2 * hstep;
    const unsigned ldsw = (unsigned)wid * 1024u;
    const int aoff = lds_byte(wr * 64 + fr, fq * 8), boff = lds_byte(wc * 32 + fr, fq * 8);
#define PG8_SA(b, h) (((b) * 2 + (h)) * HTB)
#define PG8_SB(b, h) ((4 + (b) * 2 + (h)) * HTB)
#define PG8_STAGE(bufoff, gbase, voff) do { _Pragma("unroll") for (int _i = 0; _i < 2; ++_i) \
        __builtin_amdgcn_global_load_lds((const unsigned*)((const char*)(gbase) + (voff)[_i]), (PG8_LAS unsigned*)(lds + (bufoff) + ldsw + _i * 8192), 16, 0, 0); } while (0)
#define PG8_LDA(dst, b, h) do { _Pragma("unroll") for (int m = 0; m < 4; ++m) _Pragma("unroll") for (int k = 0; k < 2; ++k) dst[m][k] = *(const PG8_LAS bf16x8*)(lds + PG8_SA(b, h) + aoff + m * 2048 + k * 1024); } while (0)
#define PG8_LDB(dst, b, h) do { _Pragma("unroll") for (int n = 0; n < 2; ++n) _Pragma("unroll") for (int k = 0; k < 2; ++k) dst[n][k] = *(const PG8_LAS bf16x8*)(lds + PG8_SB(b, h) + boff + n * 2048 + k * 1024); } while (0)
#define PG8_MMA(ai, bj, At, Bt) do { __builtin_amdgcn_s_setprio(1); _Pragma("unroll") for (int m = 0; m < 4; ++m) _Pragma("unroll") for (int n = 0; n < 2; ++n) _Pragma("unroll") for (int k = 0; k < 2; ++k) \
        acc[ai][bj][m][n] = __builtin_amdgcn_mfma_f32_16x16x32_bf16(Bt[n][k], At[m][k], acc[ai][bj][m][n], 0, 0, 0); __builtin_amdgcn_s_setprio(0); } while (0)
#define PG8_WAIT_V(n) asm volatile("s_waitcnt vmcnt(" #n ")" ::: "memory")
#define PG8_WAIT_L(n) asm volatile("s_waitcnt lgkmcnt(" #n ")" ::: "memory")
#define PG8_BAR __builtin_amdgcn_s_barrier()
#define PG8_SCHED __builtin_amdgcn_sched_barrier(0)
    Unit cur, nxt; int ui = 0;
    if (!S.next(0, cur)) return;
    f32x4 acc[2][2][4][2];
#pragma unroll
    for (int a = 0; a < 2; ++a)
#pragma unroll
        for (int b = 0; b < 2; ++b)
#pragma unroll
            for (int m = 0; m < 4; ++m)
#pragma unroll
                for (int n = 0; n < 2; ++n) acc[a][b][m][n] = (f32x4){0.f, 0.f, 0.f, 0.f};
    bf16x8 At[4][2], B0[2][2], B1[2][2];
    const char* cA = (const char*)g.A + (size_t)cur.pm * tstep; const char* cB = (const char*)g.Bt + (size_t)cur.pn * tstep;
    S.a_ready(cur);
    if constexpr (SP2) {
        PG8_STAGE(PG8_SB(0, 0), cB, voffB); PG8_STAGE(PG8_SB(0, 1), cB + hstep, voffB); PG8_STAGE(PG8_SA(0, 0), cA, voffA); PG8_STAGE(PG8_SA(0, 1), cA + hstep, voffA);
        if (wr == 1) PG8_BAR;
        PG8_WAIT_V(2); PG8_BAR;
        PG8_STAGE(PG8_SB(1, 0), cB + kstep, voffB); PG8_STAGE(PG8_SA(1, 0), cA + kstep, voffA); PG8_STAGE(PG8_SB(1, 1), cB + hstep + kstep, voffB);
        PG8_WAIT_V(6); PG8_BAR;
    } else {
        PG8_STAGE(PG8_SB(0, 0), cB, voffB); PG8_STAGE(PG8_SA(0, 0), cA, voffA); PG8_STAGE(PG8_SB(0, 1), cB + hstep, voffB); PG8_STAGE(PG8_SA(0, 1), cA + hstep, voffA);
        if (wr == 1) PG8_BAR;
        PG8_WAIT_V(4); PG8_BAR;
        PG8_STAGE(PG8_SB(1, 0), cB + kstep, voffB); PG8_STAGE(PG8_SA(1, 0), cA + kstep, voffA); PG8_STAGE(PG8_SB(1, 1), cB + hstep + kstep, voffB);
        PG8_WAIT_V(6); PG8_BAR;
    }
    for (;;) {
        const bool has_next = S.next(ui + 1, nxt);
        const char* nA = has_next ? (const char*)g.A + (size_t)nxt.pm * tstep : cA; const char* nB = has_next ? (const char*)g.Bt + (size_t)nxt.pn * tstep : cB;
        for (int t = 0; t < nt; t += 2) {
            const bool last = (t == nt - 2);
            const char* a1 = cA + (size_t)(t + 1) * kstep;
            const char* a2 = last ? nA : cA + (size_t)(t + 2) * kstep; const char* b2 = last ? nB : cB + (size_t)(t + 2) * kstep;
            const char* a3 = a2 + kstep; const char* b3 = b2 + kstep;
            if (last && has_next) S.a_ready(nxt);
            if constexpr (SP2) {
            PG8_LDB(B0, 0, 0); PG8_LDB(B1, 0, 1); PG8_SCHED; PG8_LDA(At, 0, 0); PG8_STAGE(PG8_SA(1, 1), a1 + hstep, voffA);
            PG8_WAIT_V(8); PG8_WAIT_L(0); PG8_BAR; PG8_MMA(0, 0, At, B0); PG8_MMA(0, 1, At, B1); PG8_BAR; PG8_SCHED;
            PG8_LDA(At, 0, 1); PG8_STAGE(PG8_SB(0, 0), b2, voffB); PG8_STAGE(PG8_SB(0, 1), b2 + hstep, voffB); PG8_STAGE(PG8_SA(0, 0), a2, voffA);
            PG8_WAIT_V(8); PG8_WAIT_L(0); PG8_BAR; PG8_MMA(1, 0, At, B0); PG8_MMA(1, 1, At, B1); PG8_BAR; PG8_SCHED;
            PG8_LDB(B0, 1, 0); PG8_LDB(B1, 1, 1); PG8_SCHED; PG8_LDA(At, 1, 0); PG8_STAGE(PG8_SA(0, 1), a2 + hstep, voffA);
            PG8_WAIT_V(8); PG8_WAIT_L(0); PG8_BAR; PG8_MMA(0, 0, At, B0); PG8_MMA(0, 1, At, B1); PG8_BAR; PG8_SCHED;
            PG8_LDA(At, 1, 1); PG8_STAGE(PG8_SB(1, 0), b3, voffB); PG8_STAGE(PG8_SB(1, 1), b3 + hstep, voffB); PG8_STAGE(PG8_SA(1, 0), a3, voffA);
            PG8_WAIT_V(8); PG8_WAIT_L(0); PG8_BAR; PG8_MMA(1, 0, At, B0); PG8_MMA(1, 1, At, B1); PG8_BAR; PG8_SCHED;
            } else {
            PG8_LDB(B0, 0, 0); PG8_SCHED; PG8_LDA(At, 0, 0); PG8_STAGE(PG8_SA(1, 1), a1 + hstep, voffA);
            PG8_WAIT_L(8); PG8_BAR; PG8_WAIT_L(0); PG8_MMA(0, 0, At, B0); PG8_BAR; PG8_SCHED;
            PG8_LDB(B1, 0, 1); PG8_STAGE(PG8_SB(0, 0), b2, voffB);
            PG8_BAR; PG8_WAIT_L(0); PG8_MMA(0, 1, At, B1); PG8_BAR;
            PG8_LDA(At, 0, 1); PG8_STAGE(PG8_SA(0, 0), a2, voffA);
            PG8_BAR; PG8_WAIT_L(0); PG8_MMA(1, 0, At, B0); PG8_BAR; PG8_SCHED;
            PG8_STAGE(PG8_SB(0, 1), b2 + hstep, voffB);
            PG8_WAIT_V(6); PG8_BAR; PG8_MMA(1, 1, At, B1); PG8_BAR;
            PG8_LDB(B0, 1, 0); PG8_SCHED; PG8_LDA(At, 1, 0); PG8_STAGE(PG8_SA(0, 1), a2 + hstep, voffA);
            PG8_WAIT_L(8); PG8_BAR; PG8_WAIT_L(0); PG8_MMA(0, 0, At, B0); PG8_BAR; PG8_SCHED;
            PG8_LDB(B1, 1, 1); PG8_STAGE(PG8_SB(1, 0), b3, voffB);
            PG8_BAR; PG8_WAIT_L(0); PG8_MMA(0, 1, At, B1); PG8_BAR;
            PG8_LDA(At, 1, 1); PG8_STAGE(PG8_SA(1, 0), a3, voffA);
            PG8_BAR; PG8_WAIT_L(0); PG8_MMA(1, 0, At, B0); PG8_BAR; PG8_SCHED;
            PG8_STAGE(PG8_SB(1, 1), b3 + hstep, voffB);
            PG8_WAIT_V(6); PG8_BAR; PG8_MMA(1, 1, At, B1); PG8_BAR;
            }
        }
        if constexpr (ALIGN_EPI) { if (wr == 0) PG8_BAR; }
        if constexpr (!Epi::AFTER_DRAIN) { E(acc, cur, wr, wc, fr, fq); S.done(cur); }
        if (!has_next) break;
#pragma unroll
        for (int a = 0; a < 2; ++a)
#pragma unroll
            for (int b = 0; b < 2; ++b)
#pragma unroll
                for (int m = 0; m < 4; ++m)
#pragma unroll
                    for (int n = 0; n < 2; ++n) acc[a][b][m][n] = (f32x4){0.f, 0.f, 0.f, 0.f};
        cur = nxt; cA = nA; cB = nB; ++ui;
        if constexpr (ALIGN_EPI) { if (wr == 1) PG8_BAR; }
    }
    PG8_WAIT_V(0);
    if constexpr (!ALIGN_EPI) { if (wr == 0) PG8_BAR; }
    PG8_BAR;
    if constexpr (Epi::AFTER_DRAIN) { E.fused(acc, cur, wr, wc, fr, fq, lds, wid, lane); S.done(cur); }
#undef PG8_SA
#undef PG8_SB
#undef PG8_STAGE
#undef PG8_LDA
#undef PG8_LDB
#undef PG8_MMA
#undef PG8_WAIT_V
#undef PG8_WAIT_L
#undef PG8_BAR
#undef PG8_SCHED
}
}

#ifndef PG8_SP2
#define PG8_SP2 true
#endif
#ifndef PG8_ALIGN
#define PG8_ALIGN true
#endif
constexpr int NWAVES = 8;
#ifndef MK_N_LAUNCHES
#define MK_N_LAUNCHES 1
#endif
constexpr int N_PHASES = 8;
constexpr int N_LAUNCHES = MK_N_LAUNCHES;

constexpr int ROWB = 1536;
constexpr int S = 8192, D = 2048, NIN = 5120, DC = 1024, NE = 16384, NPAIR = 128;
constexpr float LN_EPS = 1e-5f;
constexpr float ALPHA = 1.189207115002721f;

constexpr size_t MiB = 1u << 20;
constexpr size_t WS_CTL = 0, CTL_ZERO_BYTES = 64 * 1024;
constexpr size_t WS_XB = 2 * MiB;
constexpr size_t WS_BT1 = 34 * MiB;
constexpr size_t WS_BT2 = 54 * MiB;
constexpr size_t WS_BT3 = 62 * MiB;
constexpr size_t WS_AGLU = 70 * MiB;
constexpr size_t WS_CV = 86 * MiB;
constexpr size_t WS_SCB = 102 * MiB;
constexpr size_t WS_MIX = 118 * MiB;
constexpr size_t WS_Y = 150 * MiB;
constexpr size_t WS_X1 = 214 * MiB;
constexpr size_t WS_S = 246 * MiB;
constexpr size_t WS_IDX = 310 * MiB;
constexpr size_t WS_GV = 314 * MiB;
constexpr size_t WS_SU = 318 * MiB;
constexpr size_t WS_U8 = 322 * MiB;
constexpr size_t WS_V8 = 354 * MiB;
constexpr size_t WS_USC = 386 * MiB;
constexpr size_t WS_VSC = 386 * MiB + 65536;
constexpr size_t WS_END = 387 * MiB;
constexpr int CW_BAR = 4096;

constexpr int RING_OFF = 0, RING_BYTES = 131072;
constexpr int LDSCTL_OFF = RING_BYTES, MISC_OFF = LDSCTL_OFF + 320;
constexpr int LNP_OFF = MISC_OFF + 128;
constexpr int LDS_BYTES = 155648;

#define GAS __attribute__((address_space(1)))
#define LAS __attribute__((address_space(3)))
typedef unsigned short bf16;
typedef unsigned v4u __attribute__((ext_vector_type(4)));
typedef unsigned v2u __attribute__((ext_vector_type(2)));
typedef float f32x4 __attribute__((ext_vector_type(4)));
typedef float f32x2 __attribute__((ext_vector_type(2)));
typedef short bf16x8 __attribute__((ext_vector_type(8)));
typedef GAS unsigned gu32;
#define LDS_WAIT() asm volatile("s_waitcnt lgkmcnt(0)" ::: "memory")
#define VM_WAIT() asm volatile("s_waitcnt vmcnt(0)" ::: "memory")
__device__ __forceinline__ unsigned pk2(float lo, float hi) { return pg8::cvt_pk_bf16(lo, hi); }
__device__ __forceinline__ float bf_lo(unsigned w) { return __uint_as_float(w << 16); }
__device__ __forceinline__ float bf_hi(unsigned w) { return __uint_as_float(w & 0xffff0000u); }
__device__ __forceinline__ float wave_sum(float v) {
#pragma unroll
    for (int o = 1; o < 64; o <<= 1) v += __shfl_xor(v, o);
    return v;
}
__device__ __forceinline__ float wave_max(float v) {
#pragma unroll
    for (int o = 1; o < 64; o <<= 1) v = fmaxf(v, __shfl_xor(v, o));
    return v;
}

#define XB_TMO      128
#define XB_XCNT(j)  (256  + 64 * (j))
#define XB_XSUB(j)  (1280 + 64 * (j))
#define XB_XGEN(j)  (2304 + 64 * (j))
#define XB_TOP      3328
#define XB_TOPGEN   3392
#define XCD_BAR_WORDS 3456
#define XB_SPIN_CAP (1u << 18)

__device__ __forceinline__ unsigned xb_ld(unsigned* p)              { return __hip_atomic_load(p, __ATOMIC_RELAXED, __HIP_MEMORY_SCOPE_AGENT); }
__device__ __forceinline__ unsigned xb_add(unsigned* p, unsigned v) { return __hip_atomic_fetch_add(p, v, __ATOMIC_RELAXED, __HIP_MEMORY_SCOPE_AGENT); }
__device__ __forceinline__ unsigned xb_xcc_id() { return (unsigned)__builtin_amdgcn_s_getreg((3 << 11) | 20) & 0xFu; }
#define XB_SPIN(cond, bar) do { unsigned _sp = 0; while (cond) { __builtin_amdgcn_s_sleep(1); \
    if ((++_sp & 255u) == 0u) { if (xb_ld(&(bar)[XB_TMO])) break; if (_sp > XB_SPIN_CAP) { atomicAdd(&(bar)[XB_TMO], 1u); break; } } } } while (0)

struct XcdBarrier {
    unsigned* bar; unsigned x;
    volatile LAS unsigned* st;
};

__device__ __forceinline__ XcdBarrier xcd_barrier_post(unsigned* bar, volatile LAS unsigned* st) {
    XcdBarrier b; b.bar = bar; b.x = xb_xcc_id(); b.st = st;
    if (threadIdx.x == 0) (void)xb_add(&bar[XB_XCNT(b.x)], 1u);
    return b;
}
__device__ __forceinline__ void xcd_barrier_complete(unsigned* bar, unsigned x, unsigned& nloc, unsigned& nx) {
    const unsigned G = gridDim.x * gridDim.y * gridDim.z;
    unsigned sum, cnt, mine, sp = 0u;
    for (;;) {
        sum = 0u; cnt = 0u; mine = 0u;
#pragma unroll
        for (unsigned j = 0; j < 16; ++j) { const unsigned c = xb_ld(&bar[XB_XCNT(j)]); sum += c; cnt += (c > 0u) ? 1u : 0u; mine = (j == x) ? c : mine; }
        if (sum == G) break;
        __builtin_amdgcn_s_sleep(1);
        if ((++sp & 255u) == 0u) { if (xb_ld(&bar[XB_TMO])) break; if (sp > XB_SPIN_CAP) { atomicAdd(&bar[XB_TMO], 1u); break; } }
    }
    nloc = mine > 0u ? mine : 1u; nx = cnt > 0u ? cnt : 1u;
}

__device__ __forceinline__ void xcd_barrier(const XcdBarrier& b) {
    asm volatile("s_waitcnt vmcnt(0)" ::: "memory");
    __syncthreads();
    if (threadIdx.x == 0) {
        unsigned* bar = b.bar;
        __builtin_amdgcn_s_waitcnt(0);
        unsigned nloc = b.st[0], nx = b.st[1];
        if (nloc == 0u) { xcd_barrier_complete(bar, b.x, nloc, nx); b.st[0] = nloc; b.st[1] = nx; }
        const unsigned old = xb_add(&bar[XB_XSUB(b.x)], 1u);
        const unsigned gen = old / nloc;
        if (old + 1u == (gen + 1u) * nloc) {
            __builtin_amdgcn_fence(__ATOMIC_RELEASE, "agent");
            asm volatile("s_waitcnt vmcnt(0)" ::: "memory");
            const unsigned og = xb_add(&bar[XB_TOP], 1u);
            const unsigned tg = og / nx;
            if (og + 1u == (tg + 1u) * nx) xb_add(&bar[XB_TOPGEN], 1u);
            else XB_SPIN(xb_ld(&bar[XB_TOPGEN]) == tg, bar);
            __builtin_amdgcn_fence(__ATOMIC_ACQUIRE, "agent");
            xb_add(&bar[XB_XGEN(b.x)], 1u);
            asm volatile("s_waitcnt vmcnt(0)" ::: "memory");
        } else {
            XB_SPIN(xb_ld(&bar[XB_XGEN(b.x)]) == gen, bar);
            __builtin_amdgcn_fence(__ATOMIC_ACQUIRE, "agent");
            asm volatile("s_waitcnt vmcnt(0)" ::: "memory");
        }
    }
    __syncthreads();
}

struct Frame {
    LAS unsigned char* lds;
    volatile LAS unsigned* MISC;
    gu32* ctl;
    int tid, lane, wave, vcu, G;
    const float *x, *w_in, *b_in, *ccw, *ccb, *clg, *clb, *scw, *scbias, *w_out, *b_out, *ln1g, *ln1b, *w_q, *sub_keys, *peer_u, *peer_v, *ln2g, *ln2b;
    float* out;
    bf16 *XB, *BT1, *BT2, *BT3, *AGLU, *CV, *SCB, *MIX, *X1;
    float *Y, *SS; int* IDX; float *GV, *SU; unsigned char *U8, *V8; float *USC, *VSC;
};

__device__ __forceinline__ int bt1_row(int n0) {
    const int grp = n0 >> 10, c = n0 & 1023, j = c >> 7, r = c & 127;
    if (grp == 0) return 256 * j + r;
    if (grp == 1) return 256 * j + 128 + r;
    if (grp == 2) return 4096 + c;
    if (grp == 3) return 2048 + 256 * j + r;
    return 2048 + 256 * j + 128 + r;
}
template <bool PERM_IN>
__device__ __forceinline__ void p0_transpose_item(const float* W, int K, int N, bf16* WT, LAS float* scr, int item, int lane) {
    const int nblk = N / 32, kb = item / nblk, nb = item % nblk, k0 = 64 * kb, n0 = 32 * nb;
    const int drow = PERM_IN ? bt1_row(n0) : n0;
#pragma unroll 8
    for (int i = 0; i < 32; ++i) { const int kk = 2 * i + (lane >> 5); scr[kk * 33 + (lane & 31)] = W[(size_t)(k0 + kk) * N + n0 + (lane & 31)]; }
    LDS_WAIT(); asm volatile("" ::: "memory");
    const int c = lane & 7;
#pragma unroll
    for (int j = 0; j < 4; ++j) { const int n = (lane >> 3) + 8 * j; const LAS float* s = scr + (8 * c) * 33 + n;
        v4u o; o.x = pk2(s[0 * 33], s[1 * 33]); o.y = pk2(s[2 * 33], s[3 * 33]); o.z = pk2(s[4 * 33], s[5 * 33]); o.w = pk2(s[6 * 33], s[7 * 33]);
        *(GAS v4u*)(WT + (size_t)(drow + n) * K + k0 + 8 * c) = o; }
    LDS_WAIT(); asm volatile("" ::: "memory");
}
__device__ __forceinline__ bf16x8 ld8_bf16(const float* p) {
    const f32x4 a = *(const f32x4*)p, b = *(const f32x4*)(p + 4);
    v4u w; w.x = pk2(a.x, a.y); w.y = pk2(a.z, a.w); w.z = pk2(b.x, b.y); w.w = pk2(b.z, b.w);
    return __builtin_bit_cast(bf16x8, w);
}
__device__ __forceinline__ unsigned fp6_encode(float y) {
    const unsigned sb = (__float_as_uint(y) >> 31) << 5;
    const float a = fabsf(y);
    const unsigned sub = (unsigned)__builtin_rintf(a * 8.0f);
    unsigned b = __float_as_uint(a); b += 0x7FFFFu + ((b >> 20) & 1u); b >>= 20;
    unsigned nrm = b - 1008u; nrm = nrm > 31u ? 31u : nrm;
    return sb | (a < 1.0f ? sub : nrm);
}
__device__ __forceinline__ void p0_prologue(Frame& F) {
    LAS float* scr = (LAS float*)(F.lds + RING_OFF + F.wave * 16384);
    const int gw = F.vcu * NWAVES + F.wave, NGW = F.G * NWAVES, lane = F.lane;
    constexpr int I_IN = (D / 64) * (NIN / 32), I_OUT = (D / 64) * (D / 32);
    for (int it = gw; it < I_IN + I_OUT; it += NGW) {
        if (it < I_IN) p0_transpose_item<true>(F.w_in, D, NIN, F.BT1, scr, it, lane);
        else p0_transpose_item<false>(F.w_out, D, D, F.BT2, scr, it - I_IN, lane);
    }
    for (int it = gw; it < 4096; it += NGW) {
        const int hp = it >> 8, nb = (it >> 5) & 7, db = it & 31, n0 = nb * 16, d0 = db * 64;
        const float* sk = F.sub_keys + ((size_t)hp * 128 + n0 + (lane & 15)) * 128 + 8 * (lane >> 4);
        const float* wq = F.w_q + (size_t)(d0 + (lane & 15)) * 2048 + hp * 128 + 8 * (lane >> 4);
        f32x4 acc[4];
#pragma unroll
        for (int dt = 0; dt < 4; ++dt) acc[dt] = (f32x4){0.f, 0.f, 0.f, 0.f};
#pragma unroll
        for (int ks = 0; ks < 4; ++ks) {
            const bf16x8 yf = ld8_bf16(sk + 32 * ks);
#pragma unroll
            for (int dt = 0; dt < 4; ++dt) { const bf16x8 xf = ld8_bf16(wq + (size_t)dt * 16 * 2048 + 32 * ks);
                acc[dt] = __builtin_amdgcn_mfma_f32_16x16x32_bf16(xf, yf, acc[dt], 0, 0, 0); }
        }
        bf16* orow = F.BT3 + (size_t)(hp * 128 + n0 + (lane & 15)) * 2048 + d0 + 4 * (lane >> 4);
#pragma unroll
        for (int dt = 0; dt < 4; ++dt) { v2u o; o.x = pk2(acc[dt][0], acc[dt][1]); o.y = pk2(acc[dt][2], acc[dt][3]); *(GAS v2u*)(orow + 16 * dt) = o; }
    }
    for (int r = gw; r < S; r += NGW) {
        const GAS f32x4* src = (const GAS f32x4*)(F.x + (size_t)r * D) + 2 * lane;
        GAS v4u* dst = (GAS v4u*)(F.XB + (size_t)r * D) + lane;
#pragma unroll
        for (int j = 0; j < 4; ++j) { const f32x4 a = src[128 * j], b = src[128 * j + 1];
            v4u o; o.x = pk2(a.x, a.y); o.y = pk2(a.z, a.w); o.z = pk2(b.x, b.y); o.w = pk2(b.z, b.w); dst[64 * j] = o; }
    }
}
__device__ __forceinline__ void p0_peer_tables(Frame& F, int wid, int nw) {
    const int lane = F.lane;
    f32x4 nx[8];
    if (wid < 2 * NE) { const GAS f32x4* src = (const GAS f32x4*)((wid >= NE ? F.peer_v : F.peer_u) + (size_t)(wid >= NE ? wid - NE : wid) * D) + lane;
#pragma unroll
        for (int j = 0; j < 8; ++j) nx[j] = src[64 * j]; }
#pragma unroll 1
    for (int r = wid; r < 2 * NE; r += nw) {
        const bool isv = r >= NE; const int e = isv ? r - NE : r;
        f32x4 v[8];
#pragma unroll
        for (int j = 0; j < 8; ++j) v[j] = nx[j];
        { const int rn = r + nw < 2 * NE ? r + nw : r; const GAS f32x4* src = (const GAS f32x4*)((rn >= NE ? F.peer_v : F.peer_u) + (size_t)(rn >= NE ? rn - NE : rn) * D) + lane;
#pragma unroll
          for (int j = 0; j < 8; ++j) nx[j] = src[64 * j]; }
        float am = 0.f;
#pragma unroll
        for (int j = 0; j < 8; ++j) am = fmaxf(am, fmaxf(fmaxf(fabsf(v[j].x), fabsf(v[j].y)), fmaxf(fabsf(v[j].z), fabsf(v[j].w))));
        am = wave_max(am);
        const float sc = am > 0.f ? 7.5f / am : 1.f, inv = am > 0.f ? am / 7.5f : 1.f;
        unsigned w[6];
#pragma unroll
        for (int h = 0; h < 2; ++h) {
            unsigned c[16];
#pragma unroll
            for (int i = 0; i < 16; ++i) c[i] = fp6_encode(v[4 * h + (i >> 2)][i & 3] * sc);
            w[3 * h + 0] = c[0] | (c[1] << 6) | (c[2] << 12) | (c[3] << 18) | (c[4] << 24) | (c[5] << 30);
            w[3 * h + 1] = (c[5] >> 2) | (c[6] << 4) | (c[7] << 10) | (c[8] << 16) | (c[9] << 22) | (c[10] << 28);
            w[3 * h + 2] = (c[10] >> 4) | (c[11] << 2) | (c[12] << 8) | (c[13] << 14) | (c[14] << 20) | (c[15] << 26);
        }
        unsigned char* dst = (isv ? F.V8 : F.U8) + (size_t)e * ROWB + 24 * lane;
        *(GAS v2u*)(dst) = (v2u){w[0], w[1]}; *(GAS v2u*)(dst + 8) = (v2u){w[2], w[3]}; *(GAS v2u*)(dst + 16) = (v2u){w[4], w[5]};
        if (lane == 0) (isv ? F.VSC : F.USC)[e] = inv;
    }
}

__device__ __forceinline__ void p2_unit(Frame& F, int unit) {
    const int t0 = unit * 32, tid = F.tid, lane = F.lane, c0 = 2 * tid;
    LAS float* cbuf = (LAS float*)(F.lds + RING_OFF);
    {
        f32x2 w[31];
#pragma unroll
        for (int k = 0; k < 31; ++k) w[k] = *(const GAS f32x2*)(F.ccw + k * 1024 + c0);
        const f32x2 bias = *(const GAS f32x2*)(F.ccb + c0);
#pragma unroll 1
        for (int g = 0; g < 4; ++g) {
            const int tb = t0 + 8 * g - 30;
            f32x2 in[38];
#pragma unroll
            for (int i = 0; i < 38; ++i) { const int t = tb + i; const int tc = t < 0 ? 0 : t;
                const unsigned raw = *(const GAS unsigned*)(F.AGLU + (size_t)tc * 1024 + c0);
                in[i] = t < 0 ? (f32x2){0.f, 0.f} : (f32x2){bf_lo(raw), bf_hi(raw)}; }
#pragma unroll
            for (int tt = 0; tt < 8; ++tt) { f32x2 a = bias;
#pragma unroll
                for (int k = 0; k < 31; ++k) a += w[k] * in[tt + k];
                *(LAS f32x2*)(cbuf + (8 * g + tt) * 1024 + c0) = a; }
        }
    }
    {
        const f32x2 w0 = *(const GAS f32x2*)(F.scw + c0), w1 = *(const GAS f32x2*)(F.scw + 1024 + c0), w2 = *(const GAS f32x2*)(F.scw + 2048 + c0), bias = *(const GAS f32x2*)(F.scbias + c0);
        f32x2 p2 = (f32x2){0.f, 0.f}, p1 = (f32x2){0.f, 0.f};
        if (t0 > 0) { const unsigned r2 = *(const GAS unsigned*)(F.CV + (size_t)(t0 - 2) * 1024 + c0), r1 = *(const GAS unsigned*)(F.CV + (size_t)(t0 - 1) * 1024 + c0);
            p2 = (f32x2){bf_lo(r2), bf_hi(r2)}; p1 = (f32x2){bf_lo(r1), bf_hi(r1)}; }
#pragma unroll 8
        for (int tt = 0; tt < 32; ++tt) {
            const unsigned rc = *(const GAS unsigned*)(F.CV + (size_t)(t0 + tt) * 1024 + c0), rg = *(const GAS unsigned*)(F.SCB + (size_t)(t0 + tt) * 1024 + c0);
            const f32x2 cur = (f32x2){bf_lo(rc), bf_hi(rc)}, gate = (f32x2){bf_lo(rg), bf_hi(rg)};
            const f32x2 o = gate * (bias + w0 * p2 + w1 * p1 + w2 * cur);
            *(GAS unsigned*)(F.MIX + (size_t)(t0 + tt) * 2048 + 1024 + c0) = pk2(o.x, o.y);
            p2 = p1; p1 = cur;
        }
    }
    LDS_WAIT(); __syncthreads();
#pragma unroll 1
    for (int q = 0; q < 4; ++q) {
        const int tt = F.wave * 4 + q;
        f32x4 v[4]; float s = 0.f;
#pragma unroll
        for (int j = 0; j < 4; ++j) { v[j] = *(const LAS f32x4*)(cbuf + tt * 1024 + 4 * lane + 256 * j); s += (v[j].x + v[j].y) + (v[j].z + v[j].w); }
        const float mean = wave_sum(s) * (1.f / 1024.f); float s2 = 0.f;
#pragma unroll
        for (int j = 0; j < 4; ++j) { v[j] = v[j] - mean; s2 += (v[j].x * v[j].x + v[j].y * v[j].y) + (v[j].z * v[j].z + v[j].w * v[j].w); }
        const float rstd = 1.f / sqrtf(wave_sum(s2) * (1.f / 1024.f) + LN_EPS);
#pragma unroll
        for (int j = 0; j < 4; ++j) { const f32x4 g = *(const GAS f32x4*)(F.clg + 4 * lane + 256 * j), b = *(const GAS f32x4*)(F.clb + 4 * lane + 256 * j);
            f32x4 y = v[j] * rstd * g + b;
            y.x *= pg8::sigmoidf_fast(y.x); y.y *= pg8::sigmoidf_fast(y.y); y.z *= pg8::sigmoidf_fast(y.z); y.w *= pg8::sigmoidf_fast(y.w);
            v2u o; o.x = pk2(y.x, y.y); o.y = pk2(y.z, y.w);
            *(GAS v2u*)(F.MIX + (size_t)(t0 + tt) * 2048 + 4 * lane + 256 * j) = o; }
    }
    __syncthreads();
}

__device__ __forceinline__ void p4_ln1(Frame& F) {
    const int gw = F.vcu * NWAVES + F.wave, NGW = F.G * NWAVES, lane = F.lane;
    for (int r = gw; r < S; r += NGW) {
        const GAS f32x4* yr = (const GAS f32x4*)(F.Y + (size_t)r * D) + lane;
        f32x4 v[8]; float s = 0.f;
#pragma unroll
        for (int j = 0; j < 8; ++j) { v[j] = yr[64 * j]; s += (v[j].x + v[j].y) + (v[j].z + v[j].w); }
        const float mean = wave_sum(s) * (1.f / D); float s2 = 0.f;
#pragma unroll
        for (int j = 0; j < 8; ++j) { v[j] = v[j] - mean; s2 += (v[j].x * v[j].x + v[j].y * v[j].y) + (v[j].z * v[j].z + v[j].w * v[j].w); }
        const float rstd = 1.f / sqrtf(wave_sum(s2) * (1.f / D) + LN_EPS);
        GAS v2u* o8 = (GAS v2u*)(F.X1 + (size_t)r * D) + lane;
#pragma unroll
        for (int j = 0; j < 8; ++j) { const f32x4 g = *(const GAS f32x4*)(F.ln1g + 4 * lane + 256 * j), b = *(const GAS f32x4*)(F.ln1b + 4 * lane + 256 * j);
            const f32x4 y = v[j] * rstd * g + b; v2u o; o.x = pk2(y.x, y.y); o.y = pk2(y.z, y.w); o8[64 * j] = o; }
    }
}

__device__ __forceinline__ int imax_(int a, int b) { return a > b ? a : b; }
__device__ __forceinline__ int imin_(int a, int b) { return a < b ? a : b; }
template <bool DESC> __device__ __forceinline__ void ce_i(int& a, int& b) { const int mx = imax_(a, b), mn = imin_(a, b); a = DESC ? mx : mn; b = DESC ? mn : mx; }
template <bool DESC> __device__ __forceinline__ void sort16_i(int (&v)[16]) {
#pragma unroll
    for (int k = 2; k <= 16; k <<= 1)
#pragma unroll
        for (int j = k >> 1; j > 0; j >>= 1)
#pragma unroll
            for (int i = 0; i < 16; ++i) { const int l = i ^ j; if (l > i) { const bool up = ((i & k) == 0); if (up != DESC) ce_i<false>(v[i], v[l]); else ce_i<true>(v[i], v[l]); } }
}
template <bool DESC> __device__ __forceinline__ void merge16_i(int (&v)[16]) {
#pragma unroll
    for (int j = 8; j > 0; j >>= 1)
#pragma unroll
        for (int i = 0; i < 16; ++i) { const int l = i ^ j; if (l > i) ce_i<DESC>(v[i], v[l]); }
}
template <bool DESC> __device__ __forceinline__ void ce_p(float& a, int& pa, float& b, int& pb) {
    const bool sw = DESC ? (a < b) : (a > b); const float ta = sw ? b : a, tb = sw ? a : b; const int qa = sw ? pb : pa, qb = sw ? pa : pb; a = ta; b = tb; pa = qa; pb = qb; }
template <bool DESC> __device__ __forceinline__ void sort16_p(float (&v)[16], int (&p)[16]) {
#pragma unroll
    for (int k = 2; k <= 16; k <<= 1)
#pragma unroll
        for (int j = k >> 1; j > 0; j >>= 1)
#pragma unroll
            for (int i = 0; i < 16; ++i) { const int l = i ^ j; if (l > i) { const bool up = ((i & k) == 0); if (up != DESC) ce_p<false>(v[i], p[i], v[l], p[l]); else ce_p<true>(v[i], p[i], v[l], p[l]); } }
}
template <bool DESC> __device__ __forceinline__ void merge16_p(float (&v)[16], int (&p)[16]) {
#pragma unroll
    for (int j = 8; j > 0; j >>= 1)
#pragma unroll
        for (int i = 0; i < 16; ++i) { const int l = i ^ j; if (l > i) ce_p<DESC>(v[i], p[i], v[l], p[l]); }
}
__device__ __forceinline__ int f2key(float f) { const int b = __float_as_int(f); return b ^ ((b >> 31) & 0x7fffffff); }
__device__ __forceinline__ float key2f(int k) { return __int_as_float(k ^ ((k >> 31) & 0x7fffffff)); }

__device__ __forceinline__ void p6_topk(Frame& F) {
    const int gw = F.vcu * NWAVES + F.wave, NGW = F.G * NWAVES, lane = F.lane;
    for (int it = gw; it < (S * 16) / 64; it += NGW) {
        const int prob = it * 64 + lane, t = prob >> 4, hp = prob & 15;
        const float* sp = F.SS + (size_t)t * 2048 + hp * 128;
        int top[16];
        {
            f32x4 r[4];
#pragma unroll
            for (int q = 0; q < 4; ++q) r[q] = *(const GAS f32x4*)(sp + 4 * q);
#pragma unroll
            for (int q = 0; q < 4; ++q)
#pragma unroll
                for (int e = 0; e < 4; ++e) top[4 * q + e] = (f2key(r[q][e]) & ~127) | (4 * q + e);
            sort16_i<true>(top);
        }
#pragma unroll 1
        for (int c = 1; c < 8; ++c) {
            f32x4 r[4]; int nw[16];
#pragma unroll
            for (int q = 0; q < 4; ++q) r[q] = *(const GAS f32x4*)(sp + 16 * c + 4 * q);
#pragma unroll
            for (int q = 0; q < 4; ++q)
#pragma unroll
                for (int e = 0; e < 4; ++e) nw[4 * q + e] = (f2key(r[q][e]) & ~127) | (16 * c + 4 * q + e);
            sort16_i<false>(nw);
#pragma unroll
            for (int i = 0; i < 16; ++i) top[i] = imax_(top[i], nw[i]);
            merge16_i<true>(top);
        }
        const bool odd = (lane & 1) != 0;
        float Av[16], Bv[16]; int Ai[16], Bi[16];
#pragma unroll
        for (int i = 0; i < 16; ++i) { const int mine = top[i]; const int other = __shfl_xor(mine, 1); const int ka = odd ? other : mine, kb = odd ? mine : other;
            Av[i] = key2f(ka & ~127); Ai[i] = ka & 127; Bv[i] = key2f(kb & ~127); Bi[i] = kb & 127; }
        float tv[16]; int tp[16];
#pragma unroll
        for (int j = 0; j < 16; ++j) { tv[j] = Av[0] + Bv[j]; tp[j] = Ai[0] * 128 + Bi[j]; }
        {
            float nv[16]; int np[16];
#pragma unroll
            for (int j = 0; j < 8; ++j) { nv[j] = Av[1] + Bv[j]; np[j] = Ai[1] * 128 + Bi[j]; }
#pragma unroll
            for (int j = 0; j < 5; ++j) { nv[8 + j] = Av[2] + Bv[j]; np[8 + j] = Ai[2] * 128 + Bi[j]; }
#pragma unroll
            for (int j = 0; j < 3; ++j) { nv[13 + j] = Av[3] + Bv[j]; np[13 + j] = Ai[3] * 128 + Bi[j]; }
            sort16_p<false>(nv, np);
#pragma unroll
            for (int i = 0; i < 16; ++i) { const bool g = nv[i] > tv[i]; tv[i] = g ? nv[i] : tv[i]; tp[i] = g ? np[i] : tp[i]; }
            merge16_p<true>(tv, tp);
        }
        {
            float nv[16]; int np[16];
            nv[0] = Av[3] + Bv[3]; np[0] = Ai[3] * 128 + Bi[3];
#pragma unroll
            for (int j = 0; j < 3; ++j) { nv[1 + j] = Av[4] + Bv[j]; np[1 + j] = Ai[4] * 128 + Bi[j]; }
#pragma unroll
            for (int i = 5; i < 8; ++i)
#pragma unroll
                for (int j = 0; j < 2; ++j) { nv[4 + 2 * (i - 5) + j] = Av[i] + Bv[j]; np[4 + 2 * (i - 5) + j] = Ai[i] * 128 + Bi[j]; }
#pragma unroll
            for (int i = 8; i < 14; ++i) { nv[10 + i - 8] = Av[i] + Bv[0]; np[10 + i - 8] = Ai[i] * 128 + Bi[0]; }
            sort16_p<false>(nv, np);
#pragma unroll
            for (int i = 0; i < 16; ++i) { const bool g = nv[i] > tv[i]; tv[i] = g ? nv[i] : tv[i]; tp[i] = g ? np[i] : tp[i]; }
            merge16_p<true>(tv, tp);
        }
        {
            const float hi = Av[14] + Bv[0], lo = Av[15] + Bv[0]; const int phi = Ai[14] * 128 + Bi[0], plo = Ai[15] * 128 + Bi[0];
            const float t14 = tv[14], t15 = tv[15]; const int q14 = tp[14], q15 = tp[15];
            const bool g14 = lo > t14, g15 = hi > t15;
            tv[14] = g14 ? lo : t14; tp[14] = g14 ? plo : q14; tv[15] = g15 ? hi : t15; tp[15] = g15 ? phi : q15;
        }
        float mx = tv[0];
#pragma unroll
        for (int i = 1; i < 16; ++i) mx = fmaxf(mx, tv[i]);
        float sum = 0.f;
#pragma unroll
        for (int i = 0; i < 16; ++i) { tv[i] = __expf(tv[i] - mx); sum += tv[i]; }
        const float rs = 1.f / sum;
        const size_t ob = (size_t)t * NPAIR + hp * 8;
        int oe[8]; float og[8], ou[8];
#pragma unroll
        for (int k = 0; k < 8; ++k) { const int pa = tp[k], pb = tp[8 + k]; const float va = tv[k], vb = tv[8 + k];
            oe[k] = odd ? pb : pa; const float g = (odd ? vb : va) * rs; og[k] = g * F.VSC[oe[k]]; ou[k] = F.USC[oe[k]]; }
        *(GAS v4u*)(F.IDX + ob) = (v4u){(unsigned)oe[0], (unsigned)oe[1], (unsigned)oe[2], (unsigned)oe[3]};
        *(GAS v4u*)(F.IDX + ob + 4) = (v4u){(unsigned)oe[4], (unsigned)oe[5], (unsigned)oe[6], (unsigned)oe[7]};
        *(GAS f32x4*)(F.GV + ob) = (f32x4){og[0], og[1], og[2], og[3]};
        *(GAS f32x4*)(F.GV + ob + 4) = (f32x4){og[4], og[5], og[6], og[7]};
        *(GAS f32x4*)(F.SU + ob) = (f32x4){ou[0], ou[1], ou[2], ou[3]};
        *(GAS f32x4*)(F.SU + ob + 4) = (f32x4){ou[4], ou[5], ou[6], ou[7]};
    }
}

constexpr int NPS = 5;
constexpr int RING_W = NPS * 2 * ROWB;
static_assert(NWAVES * RING_W <= RING_BYTES, "rings fit the phase scratch region");
typedef unsigned u32x6 __attribute__((ext_vector_type(6)));
typedef float f32x32 __attribute__((ext_vector_type(32)));
typedef __bf16 bf16x32 __attribute__((ext_vector_type(32)));
typedef __bf16 bf16x2 __attribute__((ext_vector_type(2)));
__device__ __forceinline__ float gelu_erf(float z) { return 0.5f * z * (1.0f + erff(z * 0.70710678118654752f)); }
__device__ __forceinline__ float dpp_add(float v, int ctrl_sel) {
    int m;
    if (ctrl_sel == 0) m = __builtin_amdgcn_update_dpp(0, __float_as_int(v), 0x111, 0xf, 0xf, false);
    else if (ctrl_sel == 1) m = __builtin_amdgcn_update_dpp(0, __float_as_int(v), 0x112, 0xf, 0xf, false);
    else if (ctrl_sel == 2) m = __builtin_amdgcn_update_dpp(0, __float_as_int(v), 0x114, 0xf, 0xf, false);
    else if (ctrl_sel == 3) m = __builtin_amdgcn_update_dpp(0, __float_as_int(v), 0x118, 0xf, 0xf, false);
    else if (ctrl_sel == 4) m = __builtin_amdgcn_update_dpp(0, __float_as_int(v), 0x142, 0xa, 0xf, false);
    else m = __builtin_amdgcn_update_dpp(0, __float_as_int(v), 0x143, 0xc, 0xf, false);
    return v + __int_as_float(m);
}
__device__ __forceinline__ float wave_sum_lane63(float v) {
    v = dpp_add(v, 0); v = dpp_add(v, 1); v = dpp_add(v, 2); v = dpp_add(v, 3); v = dpp_add(v, 4); v = dpp_add(v, 5); return v;
}
__device__ __forceinline__ void p7_sort512(int (&key)[8], int lane) {
#pragma unroll
    for (int k = 2; k <= 512; k <<= 1) {
#pragma unroll
        for (int j = k >> 1; j > 0; j >>= 1) {
            if (j >= 64) {
                const int jr = j >> 6;
#pragma unroll
                for (int r = 0; r < 8; ++r) if ((r & jr) == 0) { const int rp = r | jr; const bool asc = ((64 * r) & k) == 0;
                    const int a = key[r], b = key[rp], mn = imin_(a, b), mx = imax_(a, b); key[r] = asc ? mn : mx; key[rp] = asc ? mx : mn; }
            } else {
#pragma unroll
                for (int r = 0; r < 8; ++r) { const int mine = key[r], o = __builtin_amdgcn_ds_bpermute((lane ^ j) << 2, mine); const bool low = (lane & j) == 0, asc = ((64 * r + lane) & k) == 0;
                    key[r] = (low == asc) ? imin_(mine, o) : imax_(mine, o); }
            }
        }
    }
}
__device__ __forceinline__ int sel8i(const int (&a)[8], int r) {
    const int a0 = a[0], a1 = a[1], a2 = a[2], a3 = a[3], a4 = a[4], a5 = a[5], a6 = a[6], a7 = a[7];
    int v = a0; v = r == 1 ? a1 : v; v = r == 2 ? a2 : v; v = r == 3 ? a3 : v; v = r == 4 ? a4 : v; v = r == 5 ? a5 : v; v = r == 6 ? a6 : v; v = r == 7 ? a7 : v; return v;
}
__device__ __forceinline__ float sel8f(const float (&a)[8], int r) {
    const float a0 = a[0], a1 = a[1], a2 = a[2], a3 = a[3], a4 = a[4], a5 = a[5], a6 = a[6], a7 = a[7];
    float v = a0; v = r == 1 ? a1 : v; v = r == 2 ? a2 : v; v = r == 3 ? a3 : v; v = r == 4 ? a4 : v; v = r == 5 ? a5 : v; v = r == 6 ? a6 : v; v = r == 7 ? a7 : v; return v;
}
struct P7Tabs { __amdgpu_buffer_rsrc_t u, v; };
__device__ __forceinline__ void p7_dma_pair(__amdgpu_buffer_rsrc_t rs, LAS unsigned char* slotp, int keya, int keyb, int lane) {
    const int oa = (keya >> 9) * ROWB, ob = (keyb >> 9) * ROWB;
    const int v16 = 16 * lane;
    const int vmid = lane < 32 ? oa + 1024 + v16 : ob + v16 - 512;
    __builtin_amdgcn_raw_ptr_buffer_load_lds(rs, (LAS void*)slotp, 16, v16, oa, 0, 0);
    __builtin_amdgcn_raw_ptr_buffer_load_lds(rs, (LAS void*)(slotp + 1024), 16, vmid, 0, 0, 0);
    __builtin_amdgcn_raw_ptr_buffer_load_lds(rs, (LAS void*)(slotp + 2048), 16, v16, ob + 512, 0, 0);
}
__device__ __forceinline__ u32x6 p7_read_row(const LAS unsigned char* slotp, int lane) {
    const LAS v2u* q = (const LAS v2u*)(slotp + 24 * lane); const v2u a = q[0], b = q[1], c = q[2];
    u32x6 r; r[0] = a.x; r[1] = a.y; r[2] = b.x; r[3] = b.y; r[4] = c.x; r[5] = c.y; return r;
}
__device__ __forceinline__ float p7_dot(const unsigned (&xp)[16], const bf16x32& uf) {
    float s0 = 0.f, s1 = 0.f;
#pragma unroll
    for (int m = 0; m < 16; m += 2) {
        bf16x2 a; a[0] = uf[2 * m]; a[1] = uf[2 * m + 1]; bf16x2 b; b[0] = uf[2 * m + 2]; b[1] = uf[2 * m + 3];
        const unsigned xa = xp[m], xb = xp[m + 1];
        s0 = __builtin_amdgcn_fdot2_f32_bf16(__builtin_bit_cast(bf16x2, xa), a, s0, false);
        s1 = __builtin_amdgcn_fdot2_f32_bf16(__builtin_bit_cast(bf16x2, xb), b, s1, false); }
    return s0 + s1;
}
__device__ __forceinline__ void p7_axpy(float (&acc)[32], float ck, const f32x32& vf) {
#pragma unroll
    for (int r = 0; r < 32; ++r) acc[r] = fmaf(ck, vf[r], acc[r]);
}
#define P7_WAIT_PAIR() asm volatile("s_waitcnt vmcnt(9)" ::: "memory")
static_assert(NPS == 5, "P7_WAIT_PAIR counts 3 * (NPS - 2)");
__device__ __forceinline__ void p7_peer(Frame& F) {
    const int gw = F.vcu * NWAVES + F.wave, NGW = F.G * NWAVES, lane_in = F.lane;
    LAS f32x4* lg = (LAS f32x4*)(F.lds + LNP_OFF); LAS f32x4* lb = lg + 512;
    for (int i = F.tid; i < 512; i += NWAVES * 64) { lg[i] = ((const GAS f32x4*)F.ln2g)[i]; lb[i] = ((const GAS f32x4*)F.ln2b)[i]; }
    LDS_WAIT(); __syncthreads();
    LAS unsigned char* ring = F.lds + RING_OFF + F.wave * RING_W;
    P7Tabs T; T.u = __builtin_amdgcn_make_buffer_rsrc((void*)F.U8, 0, NE * ROWB, 0x00020000); T.v = __builtin_amdgcn_make_buffer_rsrc((void*)F.V8, 0, NE * ROWB, 0x00020000);
#pragma unroll 1
    for (int tg = gw; tg < S / 4; tg += NGW) {
        const int tb = 4 * tg;
        int lane = lane_in; asm volatile("" : "+v"(lane));
        int key[8]; float gvv[8], suv[8];
#pragma unroll
        for (int s = 0; s < 4; ++s)
#pragma unroll
            for (int h = 0; h < 2; ++h) { const size_t o = (size_t)(tb + s) * NPAIR + 64 * h + lane;
                key[2 * s + h] = (F.IDX[o] << 9) | (s << 7) | (64 * h + lane); gvv[2 * s + h] = F.GV[o]; suv[2 * s + h] = F.SU[o]; }
        unsigned xp0[16], xp1[16], xp2[16], xp3[16];
#pragma unroll
        for (int j = 0; j < 8; ++j) {
            const v2u w0 = ((const GAS v2u*)(F.X1 + (size_t)(tb + 0) * D) + lane)[64 * j], w1 = ((const GAS v2u*)(F.X1 + (size_t)(tb + 1) * D) + lane)[64 * j];
            const v2u w2 = ((const GAS v2u*)(F.X1 + (size_t)(tb + 2) * D) + lane)[64 * j], w3 = ((const GAS v2u*)(F.X1 + (size_t)(tb + 3) * D) + lane)[64 * j];
            xp0[2 * j] = w0.x; xp0[2 * j + 1] = w0.y; xp1[2 * j] = w1.x; xp1[2 * j + 1] = w1.y; xp2[2 * j] = w2.x; xp2[2 * j + 1] = w2.y; xp3[2 * j] = w3.x; xp3[2 * j + 1] = w3.y; }
        p7_sort512(key, lane);
        VM_WAIT();
#pragma unroll
        for (int i = 0; i < NPS - 1; ++i) p7_dma_pair(T.u, ring + i * 2 * ROWB, __builtin_amdgcn_readlane(key[0], 2 * i), __builtin_amdgcn_readlane(key[0], 2 * i + 1), lane);
        int rs = 0, prev = NPS - 1;
        float coef[8];
#pragma unroll
        for (int q = 0; q < 8; ++q) coef[q] = 0.f;
#pragma unroll 1
        for (int r = 0; r < 8; ++r) {
            const int kcur = sel8i(key, r), knext = sel8i(key, (r + 1) & 7);
            int zreg = 0;
#pragma unroll 1
            for (int i = 0; i < 64; i += 2) {
                P7_WAIT_PAIR();
                const u32x6 rowa = p7_read_row(ring + rs * 2 * ROWB, lane), rowb = p7_read_row(ring + rs * 2 * ROWB + ROWB, lane);
                {
                    const int ln = (i + 2 * (NPS - 1)) & 63; const bool wrap = i + 2 * (NPS - 1) >= 64;
                    const int ka0 = __builtin_amdgcn_readlane(kcur, ln), ka1 = __builtin_amdgcn_readlane(kcur, ln + 1), kb0 = __builtin_amdgcn_readlane(knext, ln), kb1 = __builtin_amdgcn_readlane(knext, ln + 1);
                    const int k0 = wrap ? kb0 : ka0, k1 = wrap ? kb1 : ka1;
                    if (r == 7 && wrap) p7_dma_pair(T.v, ring + prev * 2 * ROWB, k0, k1, lane); else p7_dma_pair(T.u, ring + prev * 2 * ROWB, k0, k1, lane);
                }
#pragma unroll
                for (int h = 0; h < 2; ++h) {
                    const int kp = __builtin_amdgcn_readlane(kcur, i + h), s = (kp >> 7) & 3;
                    const bf16x32 uf = __builtin_amdgcn_cvt_scalef32_pk32_bf16_fp6(h ? rowb : rowa, 1.0f);
                    float d = 0.f;
                    int sa = s, sb = s, sc = s, sd = s; asm volatile("" : "+s"(sa)); asm volatile("" : "+s"(sb)); asm volatile("" : "+s"(sc)); asm volatile("" : "+s"(sd));
                    if (sa == 0) d = p7_dot(xp0, uf);
                    if (sb == 1) d = p7_dot(xp1, uf);
                    if (sc == 2) d = p7_dot(xp2, uf);
                    if (sd == 3) d = p7_dot(xp3, uf);
                    d = wave_sum_lane63(d);
                    { const int d63 = __builtin_amdgcn_readlane(__float_as_int(d), 63); zreg = lane == i + h ? d63 : zreg; }
                }
                prev = rs; rs = rs + 1 == NPS ? 0 : rs + 1;
            }
            const int s = (kcur >> 7) & 3, pr = kcur & 127, sel = 2 * s + (pr >> 6);
            float su = 0.f, gv = 0.f;
#pragma unroll
            for (int j = 0; j < 8; ++j) { const float a = __int_as_float(__builtin_amdgcn_ds_bpermute((pr & 63) << 2, __float_as_int(suv[j]))), b = __int_as_float(__builtin_amdgcn_ds_bpermute((pr & 63) << 2, __float_as_int(gvv[j]))); su = sel == j ? a : su; gv = sel == j ? b : gv; }
            const float cnew = gelu_erf(__int_as_float(zreg) * su) * gv;
#pragma unroll
            for (int q = 0; q < 8; ++q) { const float old = coef[q]; coef[q] = r == q ? cnew : old; }
        }
        float acc0[32], acc1[32], acc2[32], acc3[32];
#pragma unroll
        for (int q = 0; q < 32; ++q) { acc0[q] = 0.f; acc1[q] = 0.f; acc2[q] = 0.f; acc3[q] = 0.f; }
#pragma unroll 1
        for (int r = 0; r < 8; ++r) {
            const int kcur = sel8i(key, r), knext = sel8i(key, r < 7 ? r + 1 : 7); const float ccur = sel8f(coef, r);
#pragma unroll 1
            for (int i = 0; i < 64; i += 2) {
                P7_WAIT_PAIR();
                {
                    const int ln = (i + 2 * (NPS - 1)) & 63; const bool wrap = i + 2 * (NPS - 1) >= 64;
                    const int ka0 = __builtin_amdgcn_readlane(kcur, ln), ka1 = __builtin_amdgcn_readlane(kcur, ln + 1);
                    const int kb0 = __builtin_amdgcn_readlane(knext, r < 7 ? ln : 62), kb1 = __builtin_amdgcn_readlane(knext, r < 7 ? ln + 1 : 63);
                    p7_dma_pair(T.v, ring + prev * 2 * ROWB, wrap ? kb0 : ka0, wrap ? kb1 : ka1, lane);
                }
#pragma unroll
                for (int h = 0; h < 2; ++h) {
                    const int kp = __builtin_amdgcn_readlane(kcur, i + h), s = (kp >> 7) & 3;
                    const float ck = __int_as_float(__builtin_amdgcn_readlane(__float_as_int(ccur), i + h));
                    const u32x6 row = p7_read_row(ring + rs * 2 * ROWB + h * ROWB, lane);
                    const f32x32 vf = __builtin_amdgcn_cvt_scalef32_pk32_f32_fp6(row, 1.0f);
                    int sa = s, sb = s, sc = s, sd = s; asm volatile("" : "+s"(sa)); asm volatile("" : "+s"(sb)); asm volatile("" : "+s"(sc)); asm volatile("" : "+s"(sd));
                    if (sa == 0) p7_axpy(acc0, ck, vf);
                    if (sb == 1) p7_axpy(acc1, ck, vf);
                    if (sc == 2) p7_axpy(acc2, ck, vf);
                    if (sd == 3) p7_axpy(acc3, ck, vf);
                }
                prev = rs; rs = rs + 1 == NPS ? 0 : rs + 1;
            }
        }
        VM_WAIT();
#pragma unroll
        for (int s = 0; s < 4; ++s) {
            asm volatile("" ::: "memory"); __builtin_amdgcn_sched_barrier(0);
            float (&acc)[32] = s == 0 ? acc0 : s == 1 ? acc1 : s == 2 ? acc2 : acc3;
            const GAS v2u* xr = (const GAS v2u*)(F.X1 + (size_t)(tb + s) * D) + lane;
            float sum = 0.f;
#pragma unroll
            for (int j = 0; j < 8; ++j) { const v2u w = xr[64 * j];
                acc[4 * j + 0] = fmaf(ALPHA, bf_lo(w.x), acc[4 * j + 0]); acc[4 * j + 1] = fmaf(ALPHA, bf_hi(w.x), acc[4 * j + 1]);
                acc[4 * j + 2] = fmaf(ALPHA, bf_lo(w.y), acc[4 * j + 2]); acc[4 * j + 3] = fmaf(ALPHA, bf_hi(w.y), acc[4 * j + 3]); }
#pragma unroll
            for (int q = 0; q < 32; ++q) sum += acc[q];
            const float mean = __int_as_float(__builtin_amdgcn_readlane(__float_as_int(wave_sum_lane63(sum)), 63)) * (1.f / D); float s2 = 0.f;
#pragma unroll
            for (int q = 0; q < 32; ++q) { acc[q] -= mean; s2 = fmaf(acc[q], acc[q], s2); }
            const float rstd = 1.f / sqrtf(__int_as_float(__builtin_amdgcn_readlane(__float_as_int(wave_sum_lane63(s2)), 63)) * (1.f / D) + LN_EPS);
            GAS f32x4* orow = (GAS f32x4*)(F.out + (size_t)(tb + s) * D) + lane;
#pragma unroll
            for (int j = 0; j < 8; ++j) { const f32x4 g = lg[lane + 64 * j], b = lb[lane + 64 * j];
                f32x4 o; o.x = acc[4 * j + 0] * rstd * g.x + b.x; o.y = acc[4 * j + 1] * rstd * g.y + b.y; o.z = acc[4 * j + 2] * rstd * g.z + b.z; o.w = acc[4 * j + 3] * rstd * g.w + b.w;
                orow[64 * j] = o; }
        }
    }
}

struct Args { const float* in[19]; float* out; unsigned char* ws; int ph_lo, ph_hi, li, pad; };
__global__ void __launch_bounds__(NWAVES * 64, 2) peer_layer_fwd(Args args) {
    extern __shared__ __attribute__((aligned(16))) unsigned char lds[];
    Frame F;
    F.lds = (LAS unsigned char*)lds;
    F.MISC = (volatile LAS unsigned*)(F.lds + MISC_OFF);
    F.tid = threadIdx.x; F.lane = F.tid & 63; F.wave = __builtin_amdgcn_readfirstlane(F.tid >> 6);
    F.G = gridDim.x; { const int bx = blockIdx.x; F.vcu = (F.G % 8 == 0) ? (bx % 8) * (F.G / 8) + bx / 8 : bx; }
    unsigned char* ws = args.ws;
    F.ctl = (gu32*)(ws + WS_CTL);
    F.x = args.in[0]; F.w_in = args.in[1]; F.b_in = args.in[2]; F.ccw = args.in[3]; F.ccb = args.in[4]; F.clg = args.in[5]; F.clb = args.in[6];
    F.scw = args.in[7]; F.scbias = args.in[8]; F.w_out = args.in[9]; F.b_out = args.in[10]; F.ln1g = args.in[11]; F.ln1b = args.in[12];
    F.w_q = args.in[13]; F.sub_keys = args.in[14]; F.peer_u = args.in[15]; F.peer_v = args.in[16]; F.ln2g = args.in[17]; F.ln2b = args.in[18];
    F.out = args.out;
    F.XB = (bf16*)(ws + WS_XB); F.BT1 = (bf16*)(ws + WS_BT1); F.BT2 = (bf16*)(ws + WS_BT2); F.BT3 = (bf16*)(ws + WS_BT3);
    F.AGLU = (bf16*)(ws + WS_AGLU); F.CV = (bf16*)(ws + WS_CV); F.SCB = (bf16*)(ws + WS_SCB); F.MIX = (bf16*)(ws + WS_MIX); F.X1 = (bf16*)(ws + WS_X1);
    F.Y = (float*)(ws + WS_Y); F.SS = (float*)(ws + WS_S); F.IDX = (int*)(ws + WS_IDX); F.GV = (float*)(ws + WS_GV); F.SU = (float*)(ws + WS_SU);
    F.U8 = ws + WS_U8; F.V8 = ws + WS_V8; F.USC = (float*)(ws + WS_USC); F.VSC = (float*)(ws + WS_VSC);
    for (int u = F.tid; u < (LDS_BYTES - LDSCTL_OFF) / 4; u += NWAVES * 64) ((LAS unsigned*)(F.lds + LDSCTL_OFF))[u] = 0u;
    __syncthreads();
    XcdBarrier bar; bar.bar = (unsigned*)(F.ctl + CW_BAR); bar.x = 0; bar.st = nullptr;
    if (N_LAUNCHES == 1) bar = xcd_barrier_post((unsigned*)(F.ctl + CW_BAR), F.MISC + 8);
    const int lo = args.ph_lo, hi = args.ph_hi;
#ifndef ONLY_PHASE
#define ONLY_PHASE -1
#endif
#define IN(k) ((ONLY_PHASE < 0 || ONLY_PHASE == (k)) && lo <= (k) && (k) < hi)
#define SEAM(k) do { if (IN(k) && IN((k) + 1)) xcd_barrier(bar); } while (0)
#ifndef REPEAT_PHASE
#define REPEAT_PHASE -1
#endif
#define REPS(k) for (int rep_ = 0; rep_ < (REPEAT_PHASE == (k) ? 2 : 1); ++rep_)

    if (IN(0)) { REPS(0) p0_prologue(F); SEAM(0); }
    if (IN(1)) { REPS(1) {
        if (F.G == 256) { if (blockIdx.x >= 128) p0_peer_tables(F, ((int)blockIdx.x - 128) * NWAVES + F.wave, 128 * NWAVES); }
        else p0_peer_tables(F, F.vcu * NWAVES + F.wave, F.G * NWAVES);
        __syncthreads();
        pg8::Gemm g{F.XB, F.BT1, S, NIN, D}; pg8::StaticOrder So; So.init(S, NIN, F.G, (int)blockIdx.x);
        pg8::EpiInProj E{F.AGLU, F.CV, F.SCB, F.b_in};
        pg8::gemm_phase<pg8::EpiInProj, pg8::StaticOrder, PG8_ALIGN, PG8_SP2>(F.lds + RING_OFF, g, So, E); }
        SEAM(1);
    }
    if (IN(2)) { REPS(2) for (int u = F.vcu; u < S / 32; u += F.G) p2_unit(F, u); SEAM(2); }
    if (IN(3)) { REPS(3) {
        pg8::Gemm g{F.MIX, F.BT2, S, D, D}; pg8::StaticOrder So; So.init(S, D, F.G, (int)blockIdx.x);
        pg8::EpiOutProj E{F.Y, F.b_out, F.x, ALPHA};
        pg8::gemm_phase<pg8::EpiOutProj, pg8::StaticOrder, PG8_ALIGN, PG8_SP2>(F.lds + RING_OFF, g, So, E); }
        SEAM(3);
    }
    if (IN(4)) { REPS(4) p4_ln1(F); SEAM(4); }
    if (IN(5)) { REPS(5) {
        pg8::Gemm g{F.X1, F.BT3, S, D, D}; pg8::StaticOrder So; So.init(S, D, F.G, (int)blockIdx.x);
        pg8::EpiF32 E{F.SS, D};
        pg8::gemm_phase<pg8::EpiF32, pg8::StaticOrder, PG8_ALIGN, PG8_SP2>(F.lds + RING_OFF, g, So, E); }
        SEAM(5);
    }
    if (IN(6)) { REPS(6) p6_topk(F); SEAM(6); }
    if (IN(7)) { REPS(7) p7_peer(F); }
#undef IN
#undef SEAM
}

extern "C" void kernel_launch(void* const* d_in, const int* in_sizes, int n_in, void* d_out, int out_size, void* d_ws, size_t ws_size, hipStream_t stream) {
    static int grid = 0;
    if (grid == 0) {
        if (n_in != 19 || in_sizes[0] != S * D || out_size != S * D || ws_size < WS_END) {
            fprintf(stderr, "kernel_launch: built for 19 inputs, x/out of %d floats, >= %zu bytes of workspace; got n_in %d, in0 %d, out %d, ws %zu; nothing launched\n", S * D, (size_t)WS_END, n_in, n_in > 0 ? in_sizes[0] : -1, out_size, ws_size);
            grid = -1; return; }
        int dev = 0, cus = 0, per_cu = 0;
        if (hipGetDevice(&dev) != hipSuccess || hipDeviceGetAttribute(&cus, hipDeviceAttributeMultiprocessorCount, dev) != hipSuccess) { fprintf(stderr, "kernel_launch: device query failed\n"); grid = -1; return; }
        if (hipFuncSetAttribute((const void*)peer_layer_fwd, hipFuncAttributeMaxDynamicSharedMemorySize, LDS_BYTES) != hipSuccess) { fprintf(stderr, "kernel_launch: hipFuncSetAttribute failed\n"); grid = -1; return; }
        if (hipOccupancyMaxActiveBlocksPerMultiprocessor(&per_cu, (const void*)peer_layer_fwd, NWAVES * 64, LDS_BYTES) != hipSuccess || per_cu < 1) {
            fprintf(stderr, "kernel_launch: occupancy query reports %d workgroups per CU; nothing launched\n", per_cu); (void)hipGetLastError(); grid = -1; return; }
        (void)hipGetLastError();
        grid = cus;
    }
    if (grid < 0) return;
    if (hipMemsetAsync((char*)d_ws + WS_CTL, 0, CTL_ZERO_BYTES, stream) != hipSuccess) { fprintf(stderr, "kernel_launch: hipMemsetAsync failed\n"); return; }
    Args a{};
    for (int i = 0; i < 19; ++i) a.in[i] = (const float*)d_in[i];
    a.out = (float*)d_out; a.ws = (unsigned char*)d_ws;
    for (int li = 0; li < N_LAUNCHES; ++li) {
        a.ph_lo = (N_LAUNCHES == 1) ? 0 : li; a.ph_hi = (N_LAUNCHES == 1) ? N_PHASES : li + 1; a.li = li;
        hipError_t le;
        if (N_LAUNCHES == 1) { void* kargs[] = {&a}; le = hipLaunchCooperativeKernel((const void*)peer_layer_fwd, dim3(grid), dim3(NWAVES * 64), kargs, LDS_BYTES, stream); }
        else { hipLaunchKernelGGL(peer_layer_fwd, dim3(grid), dim3(NWAVES * 64), LDS_BYTES, stream, a); le = hipPeekAtLastError(); }
        if (le != hipSuccess) { fprintf(stderr, "kernel_launch: launch %d failed: %s (grid %d x %d threads, %d B LDS)\n", li, hipGetErrorName(le), grid, NWAVES * 64, LDS_BYTES); break; }
    }
}
```

```cpp
#include <hip/hip_runtime.h>
#include <cstdio>
#include <cstdint>
namespace pg8 {
#define PG8_LAS __attribute__((address_space(3)))
typedef unsigned short bf16_t;
typedef short bf16x8 __attribute__((ext_vector_type(8)));
typedef float f32x4 __attribute__((ext_vector_type(4)));
typedef unsigned u32x4 __attribute__((ext_vector_type(4)));
constexpr int BM = 256, BK = 64, HALF = 128, HTB = HALF * BK * 2  , STAGE_BYTES = 8 * HTB, NXCD = 8, WGM = 8;

__host__ __device__ __forceinline__ int lds_byte(int r, int c) { const int st = (r >> 4) * 2 + (c >> 5), rr = r & 15, cc = c & 31, ob = rr * 64 + cc * 2; return st * 1024 + (ob ^ (((ob >> 9) & 1) << 5)); }
__host__ __device__ __forceinline__ void stage_rc(int b, int& R, int& C) { const int st = b / 1024, sb = b % 1024, swz = sb ^ (((sb >> 9) & 1) << 5); R = (st >> 1) * 16 + swz / 64; C = (st & 1) * 32 + (swz % 64) / 2; }
__host__ __device__ __forceinline__ int perm32(int rho) { const int n = rho >> 4, i = rho & 15; return 8 * (i >> 2) + 4 * n + (i & 3); }

struct Unit { int pm, pn; };
struct Gemm { const bf16_t* A; const bf16_t* Bt; int M, N, K; };

struct StaticOrder {
    int nM, nN, nwg, G, c;
    __host__ __device__ void init(int M, int N, int G_, int c_) { nM = M / BM; nN = N / BM; nwg = nM * nN; G = G_; c = c_; }
    __host__ __device__ bool next(int i, Unit& u) const {
        const long L = (long)i * G + c; if (L >= nwg) return false;
        int wgid = (int)L; { const int q = nwg / NXCD, r = nwg % NXCD, xcd = wgid % NXCD, off = wgid / NXCD; wgid = (xcd < r ? xcd * (q + 1) : r * (q + 1) + (xcd - r) * q) + off; }
        const int nig = WGM * nN, gid = wgid / nig, fm = gid * WGM, gsz = (nM - fm) < WGM ? (nM - fm) : WGM;
        u.pm = fm + ((wgid % nig) % gsz); u.pn = (wgid % nig) / gsz; return true;
    }
    __device__ __forceinline__ void a_ready(const Unit&) const {}
    __device__ __forceinline__ void done(const Unit&) const {}
};

__device__ __forceinline__ unsigned cvt_pk_bf16(float lo, float hi) { unsigned r; asm volatile("v_cvt_pk_bf16_f32 %0, %1, %2" : "=v"(r) : "v"(lo), "v"(hi)); return r; }
__device__ __forceinline__ float sigmoidf_fast(float g) { return __builtin_amdgcn_rcpf(1.0f + __expf(-g)); }

struct EpiInProj {
    static constexpr bool PERM = true, AFTER_DRAIN = false;
    bf16_t* aglu; bf16_t* cv; bf16_t* scb; const float* b_in;
    __device__ __forceinline__ void operator()(const f32x4 (&acc)[2][2][4][2], const Unit& u, int wr, int wc, int fr, int fq) const {
        const int row0 = u.pm * BM + wr * 64 + fr, cc = wc * 32 + 8 * fq;
        if (u.pn < 16) {
            const bool conf = u.pn < 8; const int j = conf ? u.pn : u.pn - 8;
            const float* b0 = b_in + (conf ? 0 : 3072) + 128 * j + cc;
            const float* b1 = b_in + (conf ? 1024 : 4096) + 128 * j + cc;
            bf16_t* O = (conf ? aglu : cv) + 128 * j + cc;
            f32x4 bv0[2], bv1[2];
#pragma unroll
            for (int n = 0; n < 2; ++n) { bv0[n] = *(const f32x4*)(b0 + 4 * n); bv1[n] = *(const f32x4*)(b1 + 4 * n); }
#pragma unroll
            for (int ai = 0; ai < 2; ++ai)
#pragma unroll
                for (int m = 0; m < 4; ++m) {
                    f32x4 r[2];
#pragma unroll
                    for (int n = 0; n < 2; ++n) { const f32x4 a = acc[ai][0][m][n] + bv0[n]; f32x4 g = acc[ai][1][m][n] + bv1[n];
                        if (conf) { g[0] = sigmoidf_fast(g[0]); g[1] = sigmoidf_fast(g[1]); g[2] = sigmoidf_fast(g[2]); g[3] = sigmoidf_fast(g[3]); }
                        r[n] = a * g; }
                    u32x4 w; w.x = cvt_pk_bf16(r[0][0], r[0][1]); w.y = cvt_pk_bf16(r[0][2], r[0][3]); w.z = cvt_pk_bf16(r[1][0], r[1][1]); w.w = cvt_pk_bf16(r[1][2], r[1][3]);
                    *(u32x4*)(O + (size_t)(row0 + ai * HALF + m * 16) * 1024) = w; }
        } else {
            const int j = u.pn - 16;
#pragma unroll
            for (int bj = 0; bj < 2; ++bj) {
                const float* b0 = b_in + 2048 + 256 * j + 128 * bj + cc; bf16_t* O = scb + 256 * j + 128 * bj + cc;
                const f32x4 bva = *(const f32x4*)(b0), bvb = *(const f32x4*)(b0 + 4);
#pragma unroll
                for (int ai = 0; ai < 2; ++ai)
#pragma unroll
                    for (int m = 0; m < 4; ++m) { const f32x4 v0 = acc[ai][bj][m][0] + bva, v1 = acc[ai][bj][m][1] + bvb;
                        u32x4 w; w.x = cvt_pk_bf16(v0[0], v0[1]); w.y = cvt_pk_bf16(v0[2], v0[3]); w.z = cvt_pk_bf16(v1[0], v1[1]); w.w = cvt_pk_bf16(v1[2], v1[3]);
                        *(u32x4*)(O + (size_t)(row0 + ai * HALF + m * 16) * 1024) = w; } }
        }
    }
};
struct EpiOutProj {
    static constexpr bool PERM = false, AFTER_DRAIN = false;
    float* Y; const float* bias; const float* x; float alpha;
    __device__ __forceinline__ void operator()(const f32x4 (&acc)[2][2][4][2], const Unit& u, int wr, int wc, int fr, int fq) const {
        const int row0 = u.pm * BM + wr * 64 + fr, col0 = u.pn * BM + wc * 32 + 4 * fq;
        f32x4 bv[2][2];
#pragma unroll
        for (int bj = 0; bj < 2; ++bj)
#pragma unroll
            for (int n = 0; n < 2; ++n) bv[bj][n] = *(const f32x4*)(bias + col0 + bj * HALF + n * 16);
#pragma unroll
        for (int ai = 0; ai < 2; ++ai)
#pragma unroll
            for (int m = 0; m < 4; ++m) { const size_t off = (size_t)(row0 + ai * HALF + m * 16) * 2048 + col0;
#pragma unroll
                for (int bj = 0; bj < 2; ++bj)
#pragma unroll
                    for (int n = 0; n < 2; ++n) { const f32x4 xv = *(const f32x4*)(x + off + bj * HALF + n * 16);
                        *(f32x4*)(Y + off + bj * HALF + n * 16) = acc[ai][bj][m][n] + bv[bj][n] + xv * alpha; }
                asm volatile("" ::: "memory"); }
    }
};
struct EpiF32 {
    static constexpr bool PERM = false, AFTER_DRAIN = false;
    float* C; int ldc;
    __device__ __forceinline__ void operator()(const f32x4 (&acc)[2][2][4][2], const Unit& u, int wr, int wc, int fr, int fq) const {
        const int row0 = u.pm * BM + wr * 64 + fr, col0 = u.pn * BM + wc * 32 + 4 * fq;
#pragma unroll
        for (int ai = 0; ai < 2; ++ai)
#pragma unroll
            for (int m = 0; m < 4; ++m) { float* rowp = C + (size_t)(row0 + ai * HALF + m * 16) * ldc + col0;
#pragma unroll
                for (int bj = 0; bj < 2; ++bj)
#pragma unroll
                    for (int n = 0; n < 2; ++n) *(f32x4*)(rowp + bj * HALF + n * 16) = acc[ai][bj][m][n]; }
    }
};

template <class Epi, class Sched, bool ALIGN_EPI = false, bool SP2 = false>
__device__ __forceinline__ void gemm_phase(PG8_LAS unsigned char* lds, const Gemm g, const Sched& S, const Epi& E) {
    const int tid = threadIdx.x, wid = __builtin_amdgcn_readfirstlane(tid >> 6), lane = tid & 63, wr = wid >> 2, wc = wid & 3, fr = lane & 15, fq = lane >> 4;
    const int K = g.K, nt = K / BK;
    unsigned voffA[2], voffB[2];
#pragma unroll
    for (int i = 0; i < 2; ++i) { int R, C; stage_rc(tid * 16 + i * 8192, R, C); const int Rb = Epi::PERM ? ((R & ~31) + perm32(R & 31)) : R;
        voffA[i] = (unsigned)(R * K + C) * 2u; voffB[i] = (unsigned)(Rb * K + C) * 2u; }
    const size_t kstep = (size_t)(BK * 2);
    const size_t hstep = (size_t)HALF * K * 2;
    const size_t tstep = 2 * hstep;
    const unsigned ldsw = (unsigned)wid * 1024u;
    const int aoff = lds_byte(wr * 64 + fr, fq * 8), boff = lds_byte(wc * 32 + fr, fq * 8);
#define PG8_SA(b, h) (((b) * 2 + (h)) * HTB)
#define PG8_SB(b, h) ((4 + (b) * 2 + (h)) * HTB)
#define PG8_STAGE(bufoff, gbase, voff) do { _Pragma("unroll") for (int _i = 0; _i < 2; ++_i) \
        __builtin_amdgcn_global_load_lds((const unsigned*)((const char*)(gbase) + (voff)[_i]), (PG8_LAS unsigned*)(lds + (bufoff) + ldsw + _i * 8192), 16, 0, 0); } while (0)
#define PG8_LDA(dst, b, h) do { _Pragma("unroll") for (int m = 0; m < 4; ++m) _Pragma("unroll") for (int k = 0; k < 2; ++k) dst[m][k] = *(const PG8_LAS bf16x8*)(lds + PG8_SA(b, h) + aoff + m * 2048 + k * 1024); } while (0)
#define PG8_LDB(dst, b, h) do { _Pragma("unroll") for (int n = 0; n < 2; ++n) _Pragma("unroll") for (int k = 0; k < 2; ++k) dst[n][k] = *(const PG8_LAS bf16x8*)(lds + PG8_SB(b, h) + boff + n * 2048 + k * 1024); } while (0)
#define PG8_MMA(ai, bj, At, Bt) do { __builtin_amdgcn_s_setprio(1); _Pragma("unroll") for (int m = 0; m < 4; ++m) _Pragma("unroll") for (int n = 0; n < 2; ++n) _Pragma("unroll") for (int k = 0; k < 2; ++k) \
        acc[ai][bj][m][n] = __builtin_amdgcn_mfma_f32_16x16x32_bf16(Bt[n][k], At[m][k], acc[ai][bj][m][n], 0, 0, 0); __builtin_amdgcn_s_setprio(0); } while (0)
#define PG8_WAIT_V(n) asm volatile("s_waitcnt vmcnt(" #n ")" ::: "memory")
#define PG8_WAIT_L(n) asm volatile("s_waitcnt lgkmcnt(" #n ")" ::: "memory")
#define PG8_BAR __builtin_amdgcn_s_barrier()
#define PG8_SCHED __builtin_amdgcn_sched_barrier(0)
    Unit cur, nxt; int ui = 0;
    if (!S.next(0, cur)) return;
    f32x4 acc[2][2][4][2];
#pragma unroll
    for (int a = 0; a < 2; ++a)
#pragma unroll
        for (int b = 0; b < 2; ++b)
#pragma unroll
            for (int m = 0; m < 4; ++m)
#pragma unroll
                for (int n = 0; n < 2; ++n) acc[a][b][m][n] = (f32x4){0.f, 0.f, 0.f, 0.f};
    bf16x8 At[4][2], B0[2][2], B1[2][2];
    const char* cA = (const char*)g.A + (size_t)cur.pm * tstep; const char* cB = (const char*)g.Bt + (size_t)cur.pn * tstep;
    S.a_ready(cur);
    if constexpr (SP2) {
        PG8_STAGE(PG8_SB(0, 0), cB, voffB); PG8_STAGE(PG8_SB(0, 1), cB + hstep, voffB); PG8_STAGE(PG8_SA(0, 0), cA, voffA); PG8_STAGE(PG8_SA(0, 1), cA + hstep, voffA);
        if (wr == 1) PG8_BAR;
        PG8_WAIT_V(2); PG8_BAR;
        PG8_STAGE(PG8_SB(1, 0), cB + kstep, voffB); PG8_STAGE(PG8_SA(1, 0), cA + kstep, voffA); PG8_STAGE(PG8_SB(1, 1), cB + hstep + kstep, voffB);
        PG8_WAIT_V(6); PG8_BAR;
    } else {
        PG8_STAGE(PG8_SB(0, 0), cB, voffB); PG8_STAGE(PG8_SA(0, 0), cA, voffA); PG8_STAGE(PG8_SB(0, 1), cB + hstep, voffB); PG8_STAGE(PG8_SA(0, 1), cA + hstep, voffA);
        if (wr == 1) PG8_BAR;
        PG8_WAIT_V(4); PG8_BAR;
        PG8_STAGE(PG8_SB(1, 0), cB + kstep, voffB); PG8_STAGE(PG8_SA(1, 0), cA + kstep, voffA); PG8_STAGE(PG8_SB(1, 1), cB + hstep + kstep, voffB);
        PG8_WAIT_V(6); PG8_BAR;
    }
    for (;;) {
        const bool has_next = S.next(ui + 1, nxt);
        const char* nA = has_next ? (const char*)g.A + (size_t)nxt.pm * tstep : cA; const char* nB = has_next ? (const char*)g.Bt + (size_t)nxt.pn * tstep : cB;
        for (int t = 0; t < nt; t += 2) {
            const bool last = (t == nt - 2);
            const char* a1 = cA + (size_t)(t + 1) * kstep;
            const char* a2 = last ? nA : cA + (size_t)(t + 2) * kstep; const char* b2 = last ? nB : cB + (size_t)(t + 2) * kstep;
            const char* a3 = a2 + kstep; const char* b3 = b2 + kstep;
            if (last && has_next) S.a_ready(nxt);
            if constexpr (SP2) {
            PG8_LDB(B0, 0, 0); PG8_LDB(B1, 0, 1); PG8_SCHED; PG8_LDA(At, 0, 0); PG8_STAGE(PG8_SA(1, 1), a1 + hstep, voffA);
            PG8_WAIT_V(8); PG8_WAIT_L(0); PG8_BAR; PG8_MMA(0, 0, At, B0); PG8_MMA(0, 1, At, B1); PG8_BAR; PG8_SCHED;
            PG8_LDA(At, 0, 1); PG8_STAGE(PG8_SB(0, 0), b2, voffB); PG8_STAGE(PG8_SB(0, 1), b2 + hstep, voffB); PG8_STAGE(PG8_SA(0, 0), a2, voffA);
            PG8_WAIT_V(8); PG8_WAIT_L(0); PG8_BAR; PG8_MMA(1, 0, At, B0); PG8_MMA(1, 1, At, B1); PG8_BAR; PG8_SCHED;
            PG8_LDB(B0, 1, 0); PG8_LDB(B1, 1, 1); PG8_SCHED; PG8_LDA(At, 1, 0); PG8_STAGE(PG8_SA(0, 1), a2 + hstep, voffA);
            PG8_WAIT_V(8); PG8_WAIT_L(0); PG8_BAR; PG8_MMA(0, 0, At, B0); PG8_MMA(0, 1, At, B1); PG8_BAR; PG8_SCHED;
            PG8_LDA(At, 1, 1); PG8_STAGE(PG8_SB(1, 0), b3, voffB); PG8_STAGE(PG8_SB(1, 1), b3 + hstep, voffB); PG8_STAGE(PG8_SA(1, 0), a3, voffA);
            PG8_WAIT_V(8); PG8_WAIT_L(0); PG8_BAR; PG8_MMA(1, 0, At, B0); PG8_MMA(1, 1, At, B1); PG8_BAR; PG8_SCHED;
            } else {
            PG8_LDB(B0, 0, 0); PG8_SCHED; PG8_LDA(At, 0, 0); PG8_STAGE(PG8_SA(1, 1), a1 + hstep, voffA);
            PG8_WAIT_L(8); PG8_BAR; PG8_WAIT_L(0); PG8_MMA(0, 0, At, B0); PG8_BAR; PG8_SCHED;
            PG8_LDB(B1, 0, 1); PG8_STAGE(PG8_SB(0, 0), b2, voffB);
            PG8_BAR; PG8_WAIT_L(0); PG8_MMA(0, 1, At, B1); PG8_BAR;
            PG8_LDA(At, 0, 1); PG8_STAGE(PG8_SA(0, 0), a2, voffA);
            PG8_BAR; PG8_WAIT_L(0); PG8_MMA(1, 0, At, B0); PG8_BAR; PG8_SCHED;
            PG8_STAGE(PG8_SB(0, 1), b2 + hstep, voffB);
            PG8_WAIT_V(6); PG8_BAR; PG8_MMA(1, 1, At, B1); PG8_BAR;
            PG8_LDB(B0, 1, 0); PG8_SCHED; PG8_LDA(At, 1, 0); PG8_STAGE(PG8_SA(0, 1), a2 + hstep, voffA);
            PG8_WAIT_L(8); PG8_BAR; PG8_WAIT_L(0); PG8_MMA(0, 0, At, B0); PG8_BAR; PG8_SCHED;
            PG8_LDB(B1, 1, 1); PG8_STAGE(PG8_SB(1, 0), b3, voffB);
            PG8_BAR; PG8_WAIT_L(0); PG8_MMA(0, 1, At, B1); PG8_BAR;
            PG8_LDA(At, 1, 1); PG8_STAGE(PG8_SA(1, 0), a3, voffA);
            PG8_BAR; PG8_WAIT_L(0); PG8_MMA(1, 0, At, B0); PG8_BAR; PG8_SCHED;
            PG8_STAGE(PG8_SB(1, 1), b3 + hstep, voffB);
            PG8_WAIT_V(6); PG8_BAR; PG8_MMA(1, 1, At, B1); PG8_BAR;
            }
        }
        if constexpr (ALIGN_EPI) { if (wr == 0) PG8_BAR; }
        if constexpr (!Epi::AFTER_DRAIN) { E(acc, cur, wr, wc, fr, fq); S.done(cur); }
        if (!has_next) break;
#pragma unroll
        for (int a = 0; a < 2; ++a)
#pragma unroll
            for (int b = 0; b < 2; ++b)
#pragma unroll
                for (int m = 0; m < 4; ++m)
#pragma unroll
                    for (int n = 0; n < 2; ++n) acc[a][b][m][n] = (f32x4){0.f, 0.f, 0.f, 0.f};
        cur = nxt; cA = nA; cB = nB; ++ui;
        if constexpr (ALIGN_EPI) { if (wr == 1) PG8_BAR; }
    }
    PG8_WAIT_V(0);
    if constexpr (!ALIGN_EPI) { if (wr == 0) PG8_BAR; }
    PG8_BAR;
    if constexpr (Epi::AFTER_DRAIN) { E.fused(acc, cur, wr, wc, fr, fq, lds, wid, lane); S.done(cur); }
#undef PG8_SA
#undef PG8_SB
#undef PG8_STAGE
#undef PG8_LDA
#undef PG8_LDB
#undef PG8_MMA
#undef PG8_WAIT_V
#undef PG8_WAIT_L
#undef PG8_BAR
#undef PG8_SCHED
}
}

#ifndef PG8_SP2
#define PG8_SP2 true
#endif
#ifndef PG8_ALIGN
#define PG8_ALIGN true
#endif
constexpr int NWAVES = 8;
#ifndef MK_N_LAUNCHES
#define MK_N_LAUNCHES 1
#endif
constexpr int N_PHASES = 8;
constexpr int N_LAUNCHES = MK_N_LAUNCHES;

constexpr int ROWB = 1536;
constexpr int S = 8192, D = 2048, NIN = 5120, DC = 1024, NE = 16384, NPAIR = 128;
constexpr float LN_EPS = 1e-5f;
constexpr float ALPHA = 1.189207115002721f;

constexpr size_t MiB = 1u << 20;
constexpr size_t WS_CTL = 0, CTL_ZERO_BYTES = 64 * 1024;
constexpr size_t WS_XB = 2 * MiB;
constexpr size_t WS_BT1 = 34 * MiB;
constexpr size_t WS_BT2 = 54 * MiB;
constexpr size_t WS_BT3 = 62 * MiB;
constexpr size_t WS_AGLU = 70 * MiB;
constexpr size_t WS_CV = 86 * MiB;
constexpr size_t WS_SCB = 102 * MiB;
constexpr size_t WS_MIX = 118 * MiB;
constexpr size_t WS_Y = 150 * MiB;
constexpr size_t WS_X1 = 214 * MiB;
constexpr size_t WS_S = 246 * MiB;
constexpr size_t WS_IDX = 310 * MiB;
constexpr size_t WS_GV = 314 * MiB;
constexpr size_t WS_SU = 318 * MiB;
constexpr size_t WS_U8 = 322 * MiB;
constexpr size_t WS_V8 = 354 * MiB;
constexpr size_t WS_USC = 386 * MiB;
constexpr size_t WS_VSC = 386 * MiB + 65536;
constexpr size_t WS_END = 387 * MiB;
constexpr int CW_BAR = 4096;

constexpr int RING_OFF = 0, RING_BYTES = 131072;
constexpr int LDSCTL_OFF = RING_BYTES, MISC_OFF = LDSCTL_OFF + 320;
constexpr int LNP_OFF = MISC_OFF + 128;
constexpr int LDS_BYTES = 155648;

#define GAS __attribute__((address_space(1)))
#define LAS __attribute__((address_space(3)))
typedef unsigned short bf16;
typedef unsigned v4u __attribute__((ext_vector_type(4)));
typedef unsigned v2u __attribute__((ext_vector_type(2)));
typedef float f32x4 __attribute__((ext_vector_type(4)));
typedef float f32x2 __attribute__((ext_vector_type(2)));
typedef short bf16x8 __attribute__((ext_vector_type(8)));
typedef GAS unsigned gu32;
#define LDS_WAIT() asm volatile("s_waitcnt lgkmcnt(0)" ::: "memory")
#define VM_WAIT() asm volatile("s_waitcnt vmcnt(0)" ::: "memory")
__device__ __forceinline__ unsigned pk2(float lo, float hi) { return pg8::cvt_pk_bf16(lo, hi); }
__device__ __forceinline__ float bf_lo(unsigned w) { return __uint_as_float(w << 16); }
__device__ __forceinline__ float bf_hi(unsigned w) { return __uint_as_float(w & 0xffff0000u); }
__device__ __forceinline__ float wave_sum(float v) {
#pragma unroll
    for (int o = 1; o < 64; o <<= 1) v += __shfl_xor(v, o);
    return v;
}
__device__ __forceinline__ float wave_max(float v) {
#pragma unroll
    for (int o = 1; o < 64; o <<= 1) v = fmaxf(v, __shfl_xor(v, o));
    return v;
}

#define XB_TMO      128
#define XB_XCNT(j)  (256  + 64 * (j))
#define XB_XSUB(j)  (1280 + 64 * (j))
#define XB_XGEN(j)  (2304 + 64 * (j))
#define XB_TOP      3328
#define XB_TOPGEN   3392
#define XCD_BAR_WORDS 3456
#define XB_SPIN_CAP (1u << 18)

__device__ __forceinline__ unsigned xb_ld(unsigned* p)              { return __hip_atomic_load(p, __ATOMIC_RELAXED, __HIP_MEMORY_SCOPE_AGENT); }
__device__ __forceinline__ unsigned xb_add(unsigned* p, unsigned v) { return __hip_atomic_fetch_add(p, v, __ATOMIC_RELAXED, __HIP_MEMORY_SCOPE_AGENT); }
__device__ __forceinline__ unsigned xb_xcc_id() { return (unsigned)__builtin_amdgcn_s_getreg((3 << 11) | 20) & 0xFu; }
#define XB_SPIN(cond, bar) do { unsigned _sp = 0; while (cond) { __builtin_amdgcn_s_sleep(1); \
    if ((++_sp & 255u) == 0u) { if (xb_ld(&(bar)[XB_TMO])) break; if (_sp > XB_SPIN_CAP) { atomicAdd(&(bar)[XB_TMO], 1u); break; } } } } while (0)

struct XcdBarrier {
    unsigned* bar; unsigned x;
    volatile LAS unsigned* st;
};

__device__ __forceinline__ XcdBarrier xcd_barrier_post(unsigned* bar, volatile LAS unsigned* st) {
    XcdBarrier b; b.bar = bar; b.x = xb_xcc_id(); b.st = st;
    if (threadIdx.x == 0) (void)xb_add(&bar[XB_XCNT(b.x)], 1u);
    return b;
}
__device__ __forceinline__ void xcd_barrier_complete(unsigned* bar, unsigned x, unsigned& nloc, unsigned& nx) {
    const unsigned G = gridDim.x * gridDim.y * gridDim.z;
    unsigned sum, cnt, mine, sp = 0u;
    for (;;) {
        sum = 0u; cnt = 0u; mine = 0u;
#pragma unroll
        for (unsigned j = 0; j < 16; ++j) { const unsigned c = xb_ld(&bar[XB_XCNT(j)]); sum += c; cnt += (c > 0u) ? 1u : 0u; mine = (j == x) ? c : mine; }
        if (sum == G) break;
        __builtin_amdgcn_s_sleep(1);
        if ((++sp & 255u) == 0u) { if (xb_ld(&bar[XB_TMO])) break; if (sp > XB_SPIN_CAP) { atomicAdd(&bar[XB_TMO], 1u); break; } }
    }
    nloc = mine > 0u ? mine : 1u; nx = cnt > 0u ? cnt : 1u;
}

__device__ __forceinline__ void xcd_barrier(const XcdBarrier& b) {
    asm volatile("s_waitcnt vmcnt(0)" ::: "memory");
    __syncthreads();
    if (threadIdx.x == 0) {
        unsigned* bar = b.bar;
        __builtin_amdgcn_s_waitcnt(0);
        unsigned nloc = b.st[0], nx = b.st[1];
        if (nloc == 0u) { xcd_barrier_complete(bar, b.x, nloc, nx); b.st[0] = nloc; b.st[1] = nx; }
        const unsigned old = xb_add(&bar[XB_XSUB(b.x)], 1u);
        const unsigned gen = old / nloc;
        if (old + 1u == (gen + 1u) * nloc) {
            __builtin_amdgcn_fence(__ATOMIC_RELEASE, "agent");
            asm volatile("s_waitcnt vmcnt(0)" ::: "memory");
            const unsigned og = xb_add(&bar[XB_TOP], 1u);
            const unsigned tg = og / nx;
            if (og + 1u == (tg + 1u) * nx) xb_add(&bar[XB_TOPGEN], 1u);
            else XB_SPIN(xb_ld(&bar[XB_TOPGEN]) == tg, bar);
            __builtin_amdgcn_fence(__ATOMIC_ACQUIRE, "agent");
            xb_add(&bar[XB_XGEN(b.x)], 1u);
            asm volatile("s_waitcnt vmcnt(0)" ::: "memory");
        } else {
            XB_SPIN(xb_ld(&bar[XB_XGEN(b.x)]) == gen, bar);
            __builtin_amdgcn_fence(__ATOMIC_ACQUIRE, "agent");
            asm volatile("s_waitcnt vmcnt(0)" ::: "memory");
        }
    }
    __syncthreads();
}

struct Frame {
    LAS unsigned char* lds;
    volatile LAS unsigned* MISC;
    gu32* ctl;
    int tid, lane, wave, vcu, G;
    const float *x, *w_in, *b_in, *ccw, *ccb, *clg, *clb, *scw, *scbias, *w_out, *b_out, *ln1g, *ln1b, *w_q, *sub_keys, *peer_u, *peer_v, *ln2g, *ln2b;
    float* out;
    bf16 *XB, *BT1, *BT2, *BT3, *AGLU, *CV, *SCB, *MIX, *X1;
    float *Y, *SS; int* IDX; float *GV, *SU; unsigned char *U8, *V8; float *USC, *VSC;
};

__device__ __forceinline__ int bt1_row(int n0) {
    const int grp = n0 >> 10, c = n0 & 1023, j = c >> 7, r = c & 127;
    if (grp == 0) return 256 * j + r;
    if (grp == 1) return 256 * j + 128 + r;
    if (grp == 2) return 4096 + c;
    if (grp == 3) return 2048 + 256 * j + r;
    return 2048 + 256 * j + 128 + r;
}
template <bool PERM_IN>
__device__ __forceinline__ void p0_transpose_item(const float* W, int K, int N, bf16* WT, LAS float* scr, int item, int lane) {
    const int nblk = N / 32, kb = item / nblk, nb = item % nblk, k0 = 64 * kb, n0 = 32 * nb;
    const int drow = PERM_IN ? bt1_row(n0) : n0;
#pragma unroll 8
    for (int i = 0; i < 32; ++i) { const int kk = 2 * i + (lane >> 5); scr[kk * 33 + (lane & 31)] = W[(size_t)(k0 + kk) * N + n0 + (lane & 31)]; }
    LDS_WAIT(); asm volatile("" ::: "memory");
    const int c = lane & 7;
#pragma unroll
    for (int j = 0; j < 4; ++j) { const int n = (lane >> 3) + 8 * j; const LAS float* s = scr + (8 * c) * 33 + n;
        v4u o; o.x = pk2(s[0 * 33], s[1 * 33]); o.y = pk2(s[2 * 33], s[3 * 33]); o.z = pk2(s[4 * 33], s[5 * 33]); o.w = pk2(s[6 * 33], s[7 * 33]);
        *(GAS v4u*)(WT + (size_t)(drow + n) * K + k0 + 8 * c) = o; }
    LDS_WAIT(); asm volatile("" ::: "memory");
}
__device__ __forceinline__ bf16x8 ld8_bf16(const float* p) {
    const f32x4 a = *(const f32x4*)p, b = *(const f32x4*)(p + 4);
    v4u w; w.x = pk2(a.x, a.y); w.y = pk2(a.z, a.w); w.z = pk2(b.x, b.y); w.w = pk2(b.z, b.w);
    return __builtin_bit_cast(bf16x8, w);
}
__device__ __forceinline__ unsigned fp6_encode(float y) {
    const unsigned sb = (__float_as_uint(y) >> 31) << 5;
    const float a = fabsf(y);
    const unsigned sub = (unsigned)__builtin_rintf(a * 8.0f);
    unsigned b = __float_as_uint(a); b += 0x7FFFFu + ((b >> 20) & 1u); b >>= 20;
    unsigned nrm = b - 1008u; nrm = nrm > 31u ? 31u : nrm;
    return sb | (a < 1.0f ? sub : nrm);
}
__device__ __forceinline__ void p0_prologue(Frame& F) {
    LAS float* scr = (LAS float*)(F.lds + RING_OFF + F.wave * 16384);
    const int gw = F.vcu * NWAVES + F.wave, NGW = F.G * NWAVES, lane = F.lane;
    constexpr int I_IN = (D / 64) * (NIN / 32), I_OUT = (D / 64) * (D / 32);
    for (int it = gw; it < I_IN + I_OUT; it += NGW) {
        if (it < I_IN) p0_transpose_item<true>(F.w_in, D, NIN, F.BT1, scr, it, lane);
        else p0_transpose_item<false>(F.w_out, D, D, F.BT2, scr, it - I_IN, lane);
    }
    for (int it = gw; it < 4096; it += NGW) {
        const int hp = it >> 8, nb = (it >> 5) & 7, db = it & 31, n0 = nb * 16, d0 = db * 64;
        const float* sk = F.sub_keys + ((size_t)hp * 128 + n0 + (lane & 15)) * 128 + 8 * (lane >> 4);
        const float* wq = F.w_q + (size_t)(d0 + (lane & 15)) * 2048 + hp * 128 + 8 * (lane >> 4);
        f32x4 acc[4];
#pragma unroll
        for (int dt = 0; dt < 4; ++dt) acc[dt] = (f32x4){0.f, 0.f, 0.f, 0.f};
#pragma unroll
        for (int ks = 0; ks < 4; ++ks) {
            const bf16x8 yf = ld8_bf16(sk + 32 * ks);
#pragma unroll
            for (int dt = 0; dt < 4; ++dt) { const bf16x8 xf = ld8_bf16(wq + (size_t)dt * 16 * 2048 + 32 * ks);
                acc[dt] = __builtin_amdgcn_mfma_f32_16x16x32_bf16(xf, yf, acc[dt], 0, 0, 0); }
        }
        bf16* orow = F.BT3 + (size_t)(hp * 128 + n0 + (lane & 15)) * 2048 + d0 + 4 * (lane >> 4);
#pragma unroll
        for (int dt = 0; dt < 4; ++dt) { v2u o; o.x = pk2(acc[dt][0], acc[dt][1]); o.y = pk2(acc[dt][2], acc[dt][3]); *(GAS v2u*)(orow + 16 * dt) = o; }
    }
    for (int r = gw; r < S; r += NGW) {
        const GAS f32x4* src = (const GAS f32x4*)(F.x + (size_t)r * D) + 2 * lane;
        GAS v4u* dst = (GAS v4u*)(F.XB + (size_t)r * D) + lane;
#pragma unroll
        for (int j = 0; j < 4; ++j) { const f32x4 a = src[128 * j], b = src[128 * j + 1];
            v4u o; o.x = pk2(a.x, a.y); o.y = pk2(a.z, a.w); o.z = pk2(b.x, b.y); o.w = pk2(b.z, b.w); dst[64 * j] = o; }
    }
}
__device__ __forceinline__ void p0_peer_tables(Frame& F, int wid, int nw) {
    const int lane = F.lane;
    f32x4 nx[8];
    if (wid < 2 * NE) { const GAS f32x4* src = (const GAS f32x4*)((wid >= NE ? F.peer_v : F.peer_u) + (size_t)(wid >= NE ? wid - NE : wid) * D) + lane;
#pragma unroll
        for (int j = 0; j < 8; ++j) nx[j] = src[64 * j]; }
#pragma unroll 1
    for (int r = wid; r < 2 * NE; r += nw) {
        const bool isv = r >= NE; const int e = isv ? r - NE : r;
        f32x4 v[8];
#pragma unroll
        for (int j = 0; j < 8; ++j) v[j] = nx[j];
        { const int rn = r + nw < 2 * NE ? r + nw : r; const GAS f32x4* src = (const GAS f32x4*)((rn >= NE ? F.peer_v : F.peer_u) + (size_t)(rn >= NE ? rn - NE : rn) * D) + lane;
#pragma unroll
          for (int j = 0; j < 8; ++j) nx[j] = src[64 * j]; }
        float am = 0.f;
#pragma unroll
        for (int j = 0; j < 8; ++j) am = fmaxf(am, fmaxf(fmaxf(fabsf(v[j].x), fabsf(v[j].y)), fmaxf(fabsf(v[j].z), fabsf(v[j].w))));
        am = wave_max(am);
        const float sc = am > 0.f ? 7.5f / am : 1.f, inv = am > 0.f ? am / 7.5f : 1.f;
        unsigned w[6];
#pragma unroll
        for (int h = 0; h < 2; ++h) {
            unsigned c[16];
#pragma unroll
            for (int i = 0; i < 16; ++i) c[i] = fp6_encode(v[4 * h + (i >> 2)][i & 3] * sc);
            w[3 * h + 0] = c[0] | (c[1] << 6) | (c[2] << 12) | (c[3] << 18) | (c[4] << 24) | (c[5] << 30);
            w[3 * h + 1] = (c[5] >> 2) | (c[6] << 4) | (c[7] << 10) | (c[8] << 16) | (c[9] << 22) | (c[10] << 28);
            w[3 * h + 2] = (c[10] >> 4) | (c[11] << 2) | (c[12] << 8) | (c[13] << 14) | (c[14] << 20) | (c[15] << 26);
        }
        unsigned char* dst = (isv ? F.V8 : F.U8) + (size_t)e * ROWB + 24 * lane;
        *(GAS v2u*)(dst) = (v2u){w[0], w[1]}; *(GAS v2u*)(dst + 8) = (v2u){w[2], w[3]}; *(GAS v2u*)(dst + 16) = (v2u){w[4], w[5]};
        if (lane == 0) (isv ? F.VSC : F.USC)[e] = inv;
    }
}

__device__ __forceinline__ float dpp_add(float v, int ctrl_sel) {
    int m;
    if (ctrl_sel == 0) m = __builtin_amdgcn_update_dpp(0, __float_as_int(v), 0x111, 0xf, 0xf, false);
    else if (ctrl_sel == 1) m = __builtin_amdgcn_update_dpp(0, __float_as_int(v), 0x112, 0xf, 0xf, false);
    else if (ctrl_sel == 2) m = __builtin_amdgcn_update_dpp(0, __float_as_int(v), 0x114, 0xf, 0xf, false);
    else if (ctrl_sel == 3) m = __builtin_amdgcn_update_dpp(0, __float_as_int(v), 0x118, 0xf, 0xf, false);
    else if (ctrl_sel == 4) m = __builtin_amdgcn_update_dpp(0, __float_as_int(v), 0x142, 0xa, 0xf, false);
    else m = __builtin_amdgcn_update_dpp(0, __float_as_int(v), 0x143, 0xc, 0xf, false);
    return v + __int_as_float(m);
}
__device__ __forceinline__ float wave_sum_lane63(float v) {
    v = dpp_add(v, 0); v = dpp_add(v, 1); v = dpp_add(v, 2); v = dpp_add(v, 3); v = dpp_add(v, 4); v = dpp_add(v, 5); return v;
}
__device__ __forceinline__ void p2_unit(Frame& F, int unit) {
    const int t0 = unit * 32, tid_in = F.tid, lane = F.lane;
    LAS unsigned char* abuf = F.lds + RING_OFF;
    LAS float* stat = (LAS float*)(F.lds + LNP_OFF);
    {
        int tid = tid_in; asm volatile("" : "+v"(tid));
#pragma unroll
        for (int h = 0; h < 2; ++h) {
            v4u st[8];
#pragma unroll
            for (int k = 8 * h; k < 8 * h + 8; ++k) { const int c = tid + 512 * k; int cc = c < 62 * 128 ? c : 62 * 128 - 1; cc = (t0 - 30) * 128 + cc < 0 ? (30 - t0) * 128 : cc;
                st[k - 8 * h] = ((const GAS v4u*)F.AGLU)[(size_t)((t0 - 30) * 128 + cc)]; }
#pragma unroll
            for (int k = 8 * h; k < 8 * h + 8; ++k) { const int c = tid + 512 * k; const bool ok = (t0 - 30) * 128 + c >= 0;
                const v4u v = ok ? st[k - 8 * h] : (v4u){0u, 0u, 0u, 0u};
                if (k < 15 || tid < 62 * 128 - 512 * 15) *(LAS v4u*)(abuf + 16 * c) = v; }
            asm volatile("" ::: "memory");
        }
    }
    asm volatile("" ::: "memory"); __builtin_amdgcn_sched_barrier(0);
    {
        int tid = tid_in; asm volatile("" : "+v"(tid));
        const int cg = tid & 127, tg = tid >> 7, tb = t0 + 8 * tg;
        float w0[8], w1[8], w2[8], bs[8];
#pragma unroll
        for (int h = 0; h < 2; ++h) { const f32x4 a = *(const GAS f32x4*)(F.scw + 8 * cg + 4 * h), b = *(const GAS f32x4*)(F.scw + 1024 + 8 * cg + 4 * h), c = *(const GAS f32x4*)(F.scw + 2048 + 8 * cg + 4 * h), d = *(const GAS f32x4*)(F.scbias + 8 * cg + 4 * h);
#pragma unroll
            for (int q = 0; q < 4; ++q) { w0[4 * h + q] = a[q]; w1[4 * h + q] = b[q]; w2[4 * h + q] = c[q]; bs[4 * h + q] = d[q]; } }
        v4u cvr[10], gtr[8];
#pragma unroll
        for (int i = 0; i < 10; ++i) { const int t = tb - 2 + i, tc = t < 0 ? 0 : t; const v4u v = *(const GAS v4u*)(F.CV + (size_t)tc * 1024 + 8 * cg); cvr[i] = t < 0 ? (v4u){0u, 0u, 0u, 0u} : v; }
#pragma unroll
        for (int i = 0; i < 4; ++i) gtr[i] = *(const GAS v4u*)(F.SCB + (size_t)(tb + i) * 1024 + 8 * cg);
#pragma unroll
        for (int tt = 0; tt < 8; ++tt) {
            if (tt == 3) {
#pragma unroll
                for (int i = 4; i < 8; ++i) gtr[i] = *(const GAS v4u*)(F.SCB + (size_t)(tb + i) * 1024 + 8 * cg); }
            v4u o;
#pragma unroll
            for (int q = 0; q < 4; ++q) {
                const unsigned a2 = cvr[tt][q], a1 = cvr[tt + 1][q], a0 = cvr[tt + 2][q], g = gtr[tt][q];
                const float lo = bf_lo(g) * (bs[2 * q] + w0[2 * q] * bf_lo(a2) + w1[2 * q] * bf_lo(a1) + w2[2 * q] * bf_lo(a0));
                const float hi = bf_hi(g) * (bs[2 * q + 1] + w0[2 * q + 1] * bf_hi(a2) + w1[2 * q + 1] * bf_hi(a1) + w2[2 * q + 1] * bf_hi(a0));
                o[q] = pk2(lo, hi);
            }
            *(GAS v4u*)(F.MIX + (size_t)(tb + tt) * 2048 + 1024 + 8 * cg) = o;
        }
    }
    asm volatile("" ::: "memory"); __builtin_amdgcn_sched_barrier(0);
    LDS_WAIT(); __syncthreads();
    {
        int tid = tid_in; asm volatile("" : "+v"(tid)); const int c0 = 2 * tid;
        f32x2 w[31];
#pragma unroll
        for (int k = 0; k < 31; ++k) w[k] = *(const GAS f32x2*)(F.ccw + k * 1024 + c0);
        const f32x2 bias = *(const GAS f32x2*)(F.ccb + c0), lng = *(const GAS f32x2*)(F.clg + c0), lnb = *(const GAS f32x2*)(F.clb + c0);
#pragma unroll 1
        for (int g = 0; g < 4; ++g) {
            f32x2 o[8];
#pragma unroll
            for (int tt = 0; tt < 8; ++tt) o[tt] = bias;
#pragma unroll
            for (int half = 0; half < 2; ++half) {
                constexpr int NR = 23; const int r0 = half ? 16 : 0, k0 = half ? 16 : 0, nk = half ? 15 : 16;
                f32x2 in[NR];
#pragma unroll
                for (int i = 0; i < NR; ++i) { const int row = r0 + i < 38 ? r0 + i : 37; const unsigned raw = *(const LAS unsigned*)(abuf + (8 * g + row) * 2048 + 4 * tid); in[i] = (f32x2){bf_lo(raw), bf_hi(raw)}; }
#pragma unroll
                for (int tt = 0; tt < 8; ++tt)
#pragma unroll
                    for (int k = 0; k < 16; ++k) if (k < nk) o[tt] += w[k0 + k] * in[tt + k + k0 - r0];
                asm volatile("" ::: "memory");
            }
#pragma unroll
            for (int tt = 0; tt < 8; ++tt) { const float s1 = wave_sum_lane63(o[tt].x + o[tt].y), s2 = wave_sum_lane63(o[tt].x * o[tt].x + o[tt].y * o[tt].y);
                if (lane == 63) { stat[(tt * 2 + 0) * 8 + F.wave] = s1; stat[(tt * 2 + 1) * 8 + F.wave] = s2; } }
            LDS_WAIT(); __syncthreads();
            float tot;
            { const f32x4 a0 = *(const LAS f32x4*)(stat + (lane & 15) * 8), a1 = *(const LAS f32x4*)(stat + (lane & 15) * 8 + 4); tot = ((a0.x + a0.y) + (a0.z + a0.w)) + ((a1.x + a1.y) + (a1.z + a1.w)); }
#pragma unroll
            for (int tt = 0; tt < 8; ++tt) {
                const float mean = __int_as_float(__builtin_amdgcn_readlane(__float_as_int(tot), 2 * tt)) * (1.f / 1024.f);
                const float ex2 = __int_as_float(__builtin_amdgcn_readlane(__float_as_int(tot), 2 * tt + 1)) * (1.f / 1024.f);
                const float rstd = 1.f / sqrtf(fmaxf(ex2 - mean * mean, 0.f) + LN_EPS);
                f32x2 y = (o[tt] - mean) * rstd * lng + lnb;
                y.x *= pg8::sigmoidf_fast(y.x); y.y *= pg8::sigmoidf_fast(y.y);
                *(GAS unsigned*)(F.MIX + (size_t)(t0 + 8 * g + tt) * 2048 + c0) = pk2(y.x, y.y);
            }
            __syncthreads();
        }
    }
}

__device__ __forceinline__ void p4_ln1(Frame& F) {
    const int gw = F.vcu * NWAVES + F.wave, NGW = F.G * NWAVES, lane = F.lane;
    for (int r = gw; r < S; r += NGW) {
        const GAS f32x4* yr = (const GAS f32x4*)(F.Y + (size_t)r * D) + lane;
        f32x4 v[8]; float s = 0.f;
#pragma unroll
        for (int j = 0; j < 8; ++j) { v[j] = yr[64 * j]; s += (v[j].x + v[j].y) + (v[j].z + v[j].w); }
        const float mean = wave_sum(s) * (1.f / D); float s2 = 0.f;
#pragma unroll
        for (int j = 0; j < 8; ++j) { v[j] = v[j] - mean; s2 += (v[j].x * v[j].x + v[j].y * v[j].y) + (v[j].z * v[j].z + v[j].w * v[j].w); }
        const float rstd = 1.f / sqrtf(wave_sum(s2) * (1.f / D) + LN_EPS);
        GAS v2u* o8 = (GAS v2u*)(F.X1 + (size_t)r * D) + lane;
#pragma unroll
        for (int j = 0; j < 8; ++j) { const f32x4 g = *(const GAS f32x4*)(F.ln1g + 4 * lane + 256 * j), b = *(const GAS f32x4*)(F.ln1b + 4 * lane + 256 * j);
            const f32x4 y = v[j] * rstd * g + b; v2u o; o.x = pk2(y.x, y.y); o.y = pk2(y.z, y.w); o8[64 * j] = o; }
    }
}

__device__ __forceinline__ int imax_(int a, int b) { return a > b ? a : b; }
__device__ __forceinline__ int imin_(int a, int b) { return a < b ? a : b; }
template <bool DESC> __device__ __forceinline__ void ce_i(int& a, int& b) { const int mx = imax_(a, b), mn = imin_(a, b); a = DESC ? mx : mn; b = DESC ? mn : mx; }
template <bool DESC> __device__ __forceinline__ void sort16_i(int (&v)[16]) {
#pragma unroll
    for (int k = 2; k <= 16; k <<= 1)
#pragma unroll
        for (int j = k >> 1; j > 0; j >>= 1)
#pragma unroll
            for (int i = 0; i < 16; ++i) { const int l = i ^ j; if (l > i) { const bool up = ((i & k) == 0); if (up != DESC) ce_i<false>(v[i], v[l]); else ce_i<true>(v[i], v[l]); } }
}
template <bool DESC> __device__ __forceinline__ void merge16_i(int (&v)[16]) {
#pragma unroll
    for (int j = 8; j > 0; j >>= 1)
#pragma unroll
        for (int i = 0; i < 16; ++i) { const int l = i ^ j; if (l > i) ce_i<DESC>(v[i], v[l]); }
}
template <bool DESC> __device__ __forceinline__ void ce_p(float& a, int& pa, float& b, int& pb) {
    const bool sw = DESC ? (a < b) : (a > b); const float ta = sw ? b : a, tb = sw ? a : b; const int qa = sw ? pb : pa, qb = sw ? pa : pb; a = ta; b = tb; pa = qa; pb = qb; }
template <bool DESC> __device__ __forceinline__ void sort16_p(float (&v)[16], int (&p)[16]) {
#pragma unroll
    for (int k = 2; k <= 16; k <<= 1)
#pragma unroll
        for (int j = k >> 1; j > 0; j >>= 1)
#pragma unroll
            for (int i = 0; i < 16; ++i) { const int l = i ^ j; if (l > i) { const bool up = ((i & k) == 0); if (up != DESC) ce_p<false>(v[i], p[i], v[l], p[l]); else ce_p<true>(v[i], p[i], v[l], p[l]); } }
}
template <bool DESC> __device__ __forceinline__ void merge16_p(float (&v)[16], int (&p)[16]) {
#pragma unroll
    for (int j = 8; j > 0; j >>= 1)
#pragma unroll
        for (int i = 0; i < 16; ++i) { const int l = i ^ j; if (l > i) ce_p<DESC>(v[i], p[i], v[l], p[l]); }
}
__device__ __forceinline__ int f2key(float f) { const int b = __float_as_int(f); return b ^ ((b >> 31) & 0x7fffffff); }
__device__ __forceinline__ float key2f(int k) { return __int_as_float(k ^ ((k >> 31) & 0x7fffffff)); }

__device__ __forceinline__ void p6_topk(Frame& F) {
    const int gw = F.vcu * NWAVES + F.wave, NGW = F.G * NWAVES, lane = F.lane;
    for (int it = gw; it < (S * 16) / 64; it += NGW) {
        const int prob = it * 64 + lane, t = prob >> 4, hp = prob & 15;
        const float* sp = F.SS + (size_t)t * 2048 + hp * 128;
        int top[16];
        {
            f32x4 r[4];
#pragma unroll
            for (int q = 0; q < 4; ++q) r[q] = *(const GAS f32x4*)(sp + 4 * q);
#pragma unroll
            for (int q = 0; q < 4; ++q)
#pragma unroll
                for (int e = 0; e < 4; ++e) top[4 * q + e] = (f2key(r[q][e]) & ~127) | (4 * q + e);
            sort16_i<true>(top);
        }
#pragma unroll 1
        for (int c = 1; c < 8; ++c) {
            f32x4 r[4]; int nw[16];
#pragma unroll
            for (int q = 0; q < 4; ++q) r[q] = *(const GAS f32x4*)(sp + 16 * c + 4 * q);
#pragma unroll
            for (int q = 0; q < 4; ++q)
#pragma unroll
                for (int e = 0; e < 4; ++e) nw[4 * q + e] = (f2key(r[q][e]) & ~127) | (16 * c + 4 * q + e);
            sort16_i<false>(nw);
#pragma unroll
            for (int i = 0; i < 16; ++i) top[i] = imax_(top[i], nw[i]);
            merge16_i<true>(top);
        }
        const bool odd = (lane & 1) != 0;
        float Av[16], Bv[16]; int Ai[16], Bi[16];
#pragma unroll
        for (int i = 0; i < 16; ++i) { const int mine = top[i]; const int other = __shfl_xor(mine, 1); const int ka = odd ? other : mine, kb = odd ? mine : other;
            Av[i] = key2f(ka & ~127); Ai[i] = ka & 127; Bv[i] = key2f(kb & ~127); Bi[i] = kb & 127; }
        float tv[16]; int tp[16];
#pragma unroll
        for (int j = 0; j < 16; ++j) { tv[j] = Av[0] + Bv[j]; tp[j] = Ai[0] * 128 + Bi[j]; }
        {
            float nv[16]; int np[16];
#pragma unroll
            for (int j = 0; j < 8; ++j) { nv[j] = Av[1] + Bv[j]; np[j] = Ai[1] * 128 + Bi[j]; }
#pragma unroll
            for (int j = 0; j < 5; ++j) { nv[8 + j] = Av[2] + Bv[j]; np[8 + j] = Ai[2] * 128 + Bi[j]; }
#pragma unroll
            for (int j = 0; j < 3; ++j) { nv[13 + j] = Av[3] + Bv[j]; np[13 + j] = Ai[3] * 128 + Bi[j]; }
            sort16_p<false>(nv, np);
#pragma unroll
            for (int i = 0; i < 16; ++i) { const bool g = nv[i] > tv[i]; tv[i] = g ? nv[i] : tv[i]; tp[i] = g ? np[i] : tp[i]; }
            merge16_p<true>(tv, tp);
        }
        {
            float nv[16]; int np[16];
            nv[0] = Av[3] + Bv[3]; np[0] = Ai[3] * 128 + Bi[3];
#pragma unroll
            for (int j = 0; j < 3; ++j) { nv[1 + j] = Av[4] + Bv[j]; np[1 + j] = Ai[4] * 128 + Bi[j]; }
#pragma unroll
            for (int i = 5; i < 8; ++i)
#pragma unroll
                for (int j = 0; j < 2; ++j) { nv[4 + 2 * (i - 5) + j] = Av[i] + Bv[j]; np[4 + 2 * (i - 5) + j] = Ai[i] * 128 + Bi[j]; }
#pragma unroll
            for (int i = 8; i < 14; ++i) { nv[10 + i - 8] = Av[i] + Bv[0]; np[10 + i - 8] = Ai[i] * 128 + Bi[0]; }
            sort16_p<false>(nv, np);
#pragma unroll
            for (int i = 0; i < 16; ++i) { const bool g = nv[i] > tv[i]; tv[i] = g ? nv[i] : tv[i]; tp[i] = g ? np[i] : tp[i]; }
            merge16_p<true>(tv, tp);
        }
        {
            const float hi = Av[14] + Bv[0], lo = Av[15] + Bv[0]; const int phi = Ai[14] * 128 + Bi[0], plo = Ai[15] * 128 + Bi[0];
            const float t14 = tv[14], t15 = tv[15]; const int q14 = tp[14], q15 = tp[15];
            const bool g14 = lo > t14, g15 = hi > t15;
            tv[14] = g14 ? lo : t14; tp[14] = g14 ? plo : q14; tv[15] = g15 ? hi : t15; tp[15] = g15 ? phi : q15;
        }
        float mx = tv[0];
#pragma unroll
        for (int i = 1; i < 16; ++i) mx = fmaxf(mx, tv[i]);
        float sum = 0.f;
#pragma unroll
        for (int i = 0; i < 16; ++i) { tv[i] = __expf(tv[i] - mx); sum += tv[i]; }
        const float rs = 1.f / sum;
        const size_t ob = (size_t)t * NPAIR + hp * 8;
        int oe[8]; float og[8], ou[8];
#pragma unroll
        for (int k = 0; k < 8; ++k) { const int pa = tp[k], pb = tp[8 + k]; const float va = tv[k], vb = tv[8 + k];
            oe[k] = odd ? pb : pa; const float g = (odd ? vb : va) * rs; og[k] = g * F.VSC[oe[k]]; ou[k] = F.USC[oe[k]]; }
        *(GAS v4u*)(F.IDX + ob) = (v4u){(unsigned)oe[0], (unsigned)oe[1], (unsigned)oe[2], (unsigned)oe[3]};
        *(GAS v4u*)(F.IDX + ob + 4) = (v4u){(unsigned)oe[4], (unsigned)oe[5], (unsigned)oe[6], (unsigned)oe[7]};
        *(GAS f32x4*)(F.GV + ob) = (f32x4){og[0], og[1], og[2], og[3]};
        *(GAS f32x4*)(F.GV + ob + 4) = (f32x4){og[4], og[5], og[6], og[7]};
        *(GAS f32x4*)(F.SU + ob) = (f32x4){ou[0], ou[1], ou[2], ou[3]};
        *(GAS f32x4*)(F.SU + ob + 4) = (f32x4){ou[4], ou[5], ou[6], ou[7]};
    }
}

constexpr int NPS = 5;
constexpr int RING_W = NPS * 2 * ROWB;
static_assert(NWAVES * RING_W <= RING_BYTES, "rings fit the phase scratch region");
typedef unsigned u32x6 __attribute__((ext_vector_type(6)));
typedef float f32x32 __attribute__((ext_vector_type(32)));
typedef __bf16 bf16x32 __attribute__((ext_vector_type(32)));
typedef __bf16 bf16x2 __attribute__((ext_vector_type(2)));
__device__ __forceinline__ float gelu_erf(float z) { return 0.5f * z * (1.0f + erff(z * 0.70710678118654752f)); }
__device__ __forceinline__ void p7_sort512(int (&key)[8], int lane) {
#pragma unroll
    for (int k = 2; k <= 512; k <<= 1) {
#pragma unroll
        for (int j = k >> 1; j > 0; j >>= 1) {
            if (j >= 64) {
                const int jr = j >> 6;
#pragma unroll
                for (int r = 0; r < 8; ++r) if ((r & jr) == 0) { const int rp = r | jr; const bool asc = ((64 * r) & k) == 0;
                    const int a = key[r], b = key[rp], mn = imin_(a, b), mx = imax_(a, b); key[r] = asc ? mn : mx; key[rp] = asc ? mx : mn; }
            } else {
#pragma unroll
                for (int r = 0; r < 8; ++r) { const int mine = key[r], o = __builtin_amdgcn_ds_bpermute((lane ^ j) << 2, mine); const bool low = (lane & j) == 0, asc = ((64 * r + lane) & k) == 0;
                    key[r] = (low == asc) ? imin_(mine, o) : imax_(mine, o); }
            }
        }
    }
}
__device__ __forceinline__ int sel8i(const int (&a)[8], int r) {
    const int a0 = a[0], a1 = a[1], a2 = a[2], a3 = a[3], a4 = a[4], a5 = a[5], a6 = a[6], a7 = a[7];
    int v = a0; v = r == 1 ? a1 : v; v = r == 2 ? a2 : v; v = r == 3 ? a3 : v; v = r == 4 ? a4 : v; v = r == 5 ? a5 : v; v = r == 6 ? a6 : v; v = r == 7 ? a7 : v; return v;
}
__device__ __forceinline__ float sel8f(const float (&a)[8], int r) {
    const float a0 = a[0], a1 = a[1], a2 = a[2], a3 = a[3], a4 = a[4], a5 = a[5], a6 = a[6], a7 = a[7];
    float v = a0; v = r == 1 ? a1 : v; v = r == 2 ? a2 : v; v = r == 3 ? a3 : v; v = r == 4 ? a4 : v; v = r == 5 ? a5 : v; v = r == 6 ? a6 : v; v = r == 7 ? a7 : v; return v;
}
struct P7Tabs { __amdgpu_buffer_rsrc_t u, v; };
__device__ __forceinline__ void p7_dma_pair(__amdgpu_buffer_rsrc_t rs, LAS unsigned char* slotp, int keya, int keyb, int lane) {
    const int oa = (keya >> 9) * ROWB, ob = (keyb >> 9) * ROWB;
    const int v16 = 16 * lane;
    const int vmid = lane < 32 ? oa + 1024 + v16 : ob + v16 - 512;
    __builtin_amdgcn_raw_ptr_buffer_load_lds(rs, (LAS void*)slotp, 16, v16, oa, 0, 0);
    __builtin_amdgcn_raw_ptr_buffer_load_lds(rs, (LAS void*)(slotp + 1024), 16, vmid, 0, 0, 0);
    __builtin_amdgcn_raw_ptr_buffer_load_lds(rs, (LAS void*)(slotp + 2048), 16, v16, ob + 512, 0, 0);
}
__device__ __forceinline__ u32x6 p7_read_row(const LAS unsigned char* slotp, int lane) {
    const LAS v2u* q = (const LAS v2u*)(slotp + 24 * lane); const v2u a = q[0], b = q[1], c = q[2];
    u32x6 r; r[0] = a.x; r[1] = a.y; r[2] = b.x; r[3] = b.y; r[4] = c.x; r[5] = c.y; return r;
}
__device__ __forceinline__ float p7_dot(const unsigned (&xp)[16], const bf16x32& uf) {
    float s0 = 0.f, s1 = 0.f;
#pragma unroll
    for (int m = 0; m < 16; m += 2) {
        bf16x2 a; a[0] = uf[2 * m]; a[1] = uf[2 * m + 1]; bf16x2 b; b[0] = uf[2 * m + 2]; b[1] = uf[2 * m + 3];
        const unsigned xa = xp[m], xb = xp[m + 1];
        s0 = __builtin_amdgcn_fdot2_f32_bf16(__builtin_bit_cast(bf16x2, xa), a, s0, false);
        s1 = __builtin_amdgcn_fdot2_f32_bf16(__builtin_bit_cast(bf16x2, xb), b, s1, false); }
    return s0 + s1;
}
__device__ __forceinline__ void p7_axpy(float (&acc)[32], float ck, const f32x32& vf) {
#pragma unroll
    for (int r = 0; r < 32; ++r) acc[r] = fmaf(ck, vf[r], acc[r]);
}
#define P7_WAIT_PAIR() asm volatile("s_waitcnt vmcnt(9)" ::: "memory")
static_assert(NPS == 5, "P7_WAIT_PAIR counts 3 * (NPS - 2)");
__device__ __forceinline__ void p7_peer(Frame& F) {
    const int gw = F.vcu * NWAVES + F.wave, NGW = F.G * NWAVES, lane_in = F.lane;
    LAS f32x4* lg = (LAS f32x4*)(F.lds + LNP_OFF); LAS f32x4* lb = lg + 512;
    for (int i = F.tid; i < 512; i += NWAVES * 64) { lg[i] = ((const GAS f32x4*)F.ln2g)[i]; lb[i] = ((const GAS f32x4*)F.ln2b)[i]; }
    LDS_WAIT(); __syncthreads();
    LAS unsigned char* ring = F.lds + RING_OFF + F.wave * RING_W;
    P7Tabs T; T.u = __builtin_amdgcn_make_buffer_rsrc((void*)F.U8, 0, NE * ROWB, 0x00020000); T.v = __builtin_amdgcn_make_buffer_rsrc((void*)F.V8, 0, NE * ROWB, 0x00020000);
#pragma unroll 1
    for (int tg = gw; tg < S / 4; tg += NGW) {
        const int tb = 4 * tg;
        int lane = lane_in; asm volatile("" : "+v"(lane));
        int key[8]; float gvv[8], suv[8];
#pragma unroll
        for (int s = 0; s < 4; ++s)
#pragma unroll
            for (int h = 0; h < 2; ++h) { const size_t o = (size_t)(tb + s) * NPAIR + 64 * h + lane;
                key[2 * s + h] = (F.IDX[o] << 9) | (s << 7) | (64 * h + lane); gvv[2 * s + h] = F.GV[o]; suv[2 * s + h] = F.SU[o]; }
        unsigned xp0[16], xp1[16], xp2[16], xp3[16];
#pragma unroll
        for (int j = 0; j < 8; ++j) {
            const v2u w0 = ((const GAS v2u*)(F.X1 + (size_t)(tb + 0) * D) + lane)[64 * j], w1 = ((const GAS v2u*)(F.X1 + (size_t)(tb + 1) * D) + lane)[64 * j];
            const v2u w2 = ((const GAS v2u*)(F.X1 + (size_t)(tb + 2) * D) + lane)[64 * j], w3 = ((const GAS v2u*)(F.X1 + (size_t)(tb + 3) * D) + lane)[64 * j];
            xp0[2 * j] = w0.x; xp0[2 * j + 1] = w0.y; xp1[2 * j] = w1.x; xp1[2 * j + 1] = w1.y; xp2[2 * j] = w2.x; xp2[2 * j + 1] = w2.y; xp3[2 * j] = w3.x; xp3[2 * j + 1] = w3.y; }
        p7_sort512(key, lane);
        VM_WAIT();
#pragma unroll
        for (int i = 0; i < NPS - 1; ++i) p7_dma_pair(T.u, ring + i * 2 * ROWB, __builtin_amdgcn_readlane(key[0], 2 * i), __builtin_amdgcn_readlane(key[0], 2 * i + 1), lane);
        int rs = 0, prev = NPS - 1;
        float coef[8];
#pragma unroll
        for (int q = 0; q < 8; ++q) coef[q] = 0.f;
#pragma unroll 1
        for (int r = 0; r < 8; ++r) {
            const int kcur = sel8i(key, r), knext = sel8i(key, (r + 1) & 7);
            int zreg = 0;
#pragma unroll 1
            for (int i = 0; i < 64; i += 2) {
                P7_WAIT_PAIR();
                const u32x6 rowa = p7_read_row(ring + rs * 2 * ROWB, lane), rowb = p7_read_row(ring + rs * 2 * ROWB + ROWB, lane);
                {
                    const int ln = (i + 2 * (NPS - 1)) & 63; const bool wrap = i + 2 * (NPS - 1) >= 64;
                    const int ka0 = __builtin_amdgcn_readlane(kcur, ln), ka1 = __builtin_amdgcn_readlane(kcur, ln + 1), kb0 = __builtin_amdgcn_readlane(knext, ln), kb1 = __builtin_amdgcn_readlane(knext, ln + 1);
                    const int k0 = wrap ? kb0 : ka0, k1 = wrap ? kb1 : ka1;
                    if (r == 7 && wrap) p7_dma_pair(T.v, ring + prev * 2 * ROWB, k0, k1, lane); else p7_dma_pair(T.u, ring + prev * 2 * ROWB, k0, k1, lane);
                }
#pragma unroll
                for (int h = 0; h < 2; ++h) {
                    const int kp = __builtin_amdgcn_readlane(kcur, i + h), s = (kp >> 7) & 3;
                    const bf16x32 uf = __builtin_amdgcn_cvt_scalef32_pk32_bf16_fp6(h ? rowb : rowa, 1.0f);
                    float d = 0.f;
                    int sa = s, sb = s, sc = s, sd = s; asm volatile("" : "+s"(sa)); asm volatile("" : "+s"(sb)); asm volatile("" : "+s"(sc)); asm volatile("" : "+s"(sd));
                    if (sa == 0) d = p7_dot(xp0, uf);
                    if (sb == 1) d = p7_dot(xp1, uf);
                    if (sc == 2) d = p7_dot(xp2, uf);
                    if (sd == 3) d = p7_dot(xp3, uf);
                    d = wave_sum_lane63(d);
                    { const int d63 = __builtin_amdgcn_readlane(__float_as_int(d), 63); zreg = lane == i + h ? d63 : zreg; }
                }
                prev = rs; rs = rs + 1 == NPS ? 0 : rs + 1;
            }
            const int s = (kcur >> 7) & 3, pr = kcur & 127, sel = 2 * s + (pr >> 6);
            float su = 0.f, gv = 0.f;
#pragma unroll
            for (int j = 0; j < 8; ++j) { const float a = __int_as_float(__builtin_amdgcn_ds_bpermute((pr & 63) << 2, __float_as_int(suv[j]))), b = __int_as_float(__builtin_amdgcn_ds_bpermute((pr & 63) << 2, __float_as_int(gvv[j]))); su = sel == j ? a : su; gv = sel == j ? b : gv; }
            const float cnew = gelu_erf(__int_as_float(zreg) * su) * gv;
#pragma unroll
            for (int q = 0; q < 8; ++q) { const float old = coef[q]; coef[q] = r == q ? cnew : old; }
        }
        float acc0[32], acc1[32], acc2[32], acc3[32];
#pragma unroll
        for (int q = 0; q < 32; ++q) { acc0[q] = 0.f; acc1[q] = 0.f; acc2[q] = 0.f; acc3[q] = 0.f; }
#pragma unroll 1
        for (int r = 0; r < 8; ++r) {
            const int kcur = sel8i(key, r), knext = sel8i(key, r < 7 ? r + 1 : 7); const float ccur = sel8f(coef, r);
#pragma unroll 1
            for (int i = 0; i < 64; i += 2) {
                P7_WAIT_PAIR();
                {
                    const int ln = (i + 2 * (NPS - 1)) & 63; const bool wrap = i + 2 * (NPS - 1) >= 64;
                    const int ka0 = __builtin_amdgcn_readlane(kcur, ln), ka1 = __builtin_amdgcn_readlane(kcur, ln + 1);
                    const int kb0 = __builtin_amdgcn_readlane(knext, r < 7 ? ln : 62), kb1 = __builtin_amdgcn_readlane(knext, r < 7 ? ln + 1 : 63);
                    p7_dma_pair(T.v, ring + prev * 2 * ROWB, wrap ? kb0 : ka0, wrap ? kb1 : ka1, lane);
                }
#pragma unroll
                for (int h = 0; h < 2; ++h) {
                    const int kp = __builtin_amdgcn_readlane(kcur, i + h), s = (kp >> 7) & 3;
                    const float ck = __int_as_float(__builtin_amdgcn_readlane(__float_as_int(ccur), i + h));
                    const u32x6 row = p7_read_row(ring + rs * 2 * ROWB + h * ROWB, lane);
                    const f32x32 vf = __builtin_amdgcn_cvt_scalef32_pk32_f32_fp6(row, 1.0f);
                    int sa = s, sb = s, sc = s, sd = s; asm volatile("" : "+s"(sa)); asm volatile("" : "+s"(sb)); asm volatile("" : "+s"(sc)); asm volatile("" : "+s"(sd));
                    if (sa == 0) p7_axpy(acc0, ck, vf);
                    if (sb == 1) p7_axpy(acc1, ck, vf);
                    if (sc == 2) p7_axpy(acc2, ck, vf);
                    if (sd == 3) p7_axpy(acc3, ck, vf);
                }
                prev = rs; rs = rs + 1 == NPS ? 0 : rs + 1;
            }
        }
        VM_WAIT();
#pragma unroll
        for (int s = 0; s < 4; ++s) {
            asm volatile("" ::: "memory"); __builtin_amdgcn_sched_barrier(0);
            float (&acc)[32] = s == 0 ? acc0 : s == 1 ? acc1 : s == 2 ? acc2 : acc3;
            const GAS v2u* xr = (const GAS v2u*)(F.X1 + (size_t)(tb + s) * D) + lane;
            float sum = 0.f;
#pragma unroll
            for (int j = 0; j < 8; ++j) { const v2u w = xr[64 * j];
                acc[4 * j + 0] = fmaf(ALPHA, bf_lo(w.x), acc[4 * j + 0]); acc[4 * j + 1] = fmaf(ALPHA, bf_hi(w.x), acc[4 * j + 1]);
                acc[4 * j + 2] = fmaf(ALPHA, bf_lo(w.y), acc[4 * j + 2]); acc[4 * j + 3] = fmaf(ALPHA, bf_hi(w.y), acc[4 * j + 3]); }
#pragma unroll
            for (int q = 0; q < 32; ++q) sum += acc[q];
            const float mean = __int_as_float(__builtin_amdgcn_readlane(__float_as_int(wave_sum_lane63(sum)), 63)) * (1.f / D); float s2 = 0.f;
#pragma unroll
            for (int q = 0; q < 32; ++q) { acc[q] -= mean; s2 = fmaf(acc[q], acc[q], s2); }
            const float rstd = 1.f / sqrtf(__int_as_float(__builtin_amdgcn_readlane(__float_as_int(wave_sum_lane63(s2)), 63)) * (1.f / D) + LN_EPS);
            GAS f32x4* orow = (GAS f32x4*)(F.out + (size_t)(tb + s) * D) + lane;
#pragma unroll
            for (int j = 0; j < 8; ++j) { const f32x4 g = lg[lane + 64 * j], b = lb[lane + 64 * j];
                f32x4 o; o.x = acc[4 * j + 0] * rstd * g.x + b.x; o.y = acc[4 * j + 1] * rstd * g.y + b.y; o.z = acc[4 * j + 2] * rstd * g.z + b.z; o.w = acc[4 * j + 3] * rstd * g.w + b.w;
                orow[64 * j] = o; }
        }
    }
}

struct Args { const float* in[19]; float* out; unsigned char* ws; int ph_lo, ph_hi, li, pad; };
__global__ void __launch_bounds__(NWAVES * 64, 2) peer_layer_fwd(Args args) {
    extern __shared__ __attribute__((aligned(16))) unsigned char lds[];
    Frame F;
    F.lds = (LAS unsigned char*)lds;
    F.MISC = (volatile LAS unsigned*)(F.lds + MISC_OFF);
    F.tid = threadIdx.x; F.lane = F.tid & 63; F.wave = __builtin_amdgcn_readfirstlane(F.tid >> 6);
    F.G = gridDim.x; { const int bx = blockIdx.x; F.vcu = (F.G % 8 == 0) ? (bx % 8) * (F.G / 8) + bx / 8 : bx; }
    unsigned char* ws = args.ws;
    F.ctl = (gu32*)(ws + WS_CTL);
    F.x = args.in[0]; F.w_in = args.in[1]; F.b_in = args.in[2]; F.ccw = args.in[3]; F.ccb = args.in[4]; F.clg = args.in[5]; F.clb = args.in[6];
    F.scw = args.in[7]; F.scbias = args.in[8]; F.w_out = args.in[9]; F.b_out = args.in[10]; F.ln1g = args.in[11]; F.ln1b = args.in[12];
    F.w_q = args.in[13]; F.sub_keys = args.in[14]; F.peer_u = args.in[15]; F.peer_v = args.in[16]; F.ln2g = args.in[17]; F.ln2b = args.in[18];
    F.out = args.out;
    F.XB = (bf16*)(ws + WS_XB); F.BT1 = (bf16*)(ws + WS_BT1); F.BT2 = (bf16*)(ws + WS_BT2); F.BT3 = (bf16*)(ws + WS_BT3);
    F.AGLU = (bf16*)(ws + WS_AGLU); F.CV = (bf16*)(ws + WS_CV); F.SCB = (bf16*)(ws + WS_SCB); F.MIX = (bf16*)(ws + WS_MIX); F.X1 = (bf16*)(ws + WS_X1);
    F.Y = (float*)(ws + WS_Y); F.SS = (float*)(ws + WS_S); F.IDX = (int*)(ws + WS_IDX); F.GV = (float*)(ws + WS_GV); F.SU = (float*)(ws + WS_SU);
    F.U8 = ws + WS_U8; F.V8 = ws + WS_V8; F.USC = (float*)(ws + WS_USC); F.VSC = (float*)(ws + WS_VSC);
    for (int u = F.tid; u < (LDS_BYTES - LDSCTL_OFF) / 4; u += NWAVES * 64) ((LAS unsigned*)(F.lds + LDSCTL_OFF))[u] = 0u;
    __syncthreads();
    XcdBarrier bar; bar.bar = (unsigned*)(F.ctl + CW_BAR); bar.x = 0; bar.st = nullptr;
    if (N_LAUNCHES == 1) bar = xcd_barrier_post((unsigned*)(F.ctl + CW_BAR), F.MISC + 8);
    const int lo = args.ph_lo, hi = args.ph_hi;
#ifndef ONLY_PHASE
#define ONLY_PHASE -1
#endif
#define IN(k) ((ONLY_PHASE < 0 || ONLY_PHASE == (k)) && lo <= (k) && (k) < hi)
#define SEAM(k) do { if (IN(k) && IN((k) + 1)) xcd_barrier(bar); } while (0)
#ifndef REPEAT_PHASE
#define REPEAT_PHASE -1
#endif
#define REPS(k) for (int rep_ = 0; rep_ < (REPEAT_PHASE == (k) ? 2 : 1); ++rep_)

    if (IN(0)) { REPS(0) p0_prologue(F); SEAM(0); }
    if (IN(1)) { REPS(1) {
        if (F.G == 256) { if (blockIdx.x >= 128) p0_peer_tables(F, ((int)blockIdx.x - 128) * NWAVES + F.wave, 128 * NWAVES); }
        else p0_peer_tables(F, F.vcu * NWAVES + F.wave, F.G * NWAVES);
        __syncthreads();
        pg8::Gemm g{F.XB, F.BT1, S, NIN, D}; pg8::StaticOrder So; So.init(S, NIN, F.G, (int)blockIdx.x);
        pg8::EpiInProj E{F.AGLU, F.CV, F.SCB, F.b_in};
        pg8::gemm_phase<pg8::EpiInProj, pg8::StaticOrder, PG8_ALIGN, PG8_SP2>(F.lds + RING_OFF, g, So, E); }
        SEAM(1);
    }
    if (IN(2)) { REPS(2) for (int u = F.vcu; u < S / 32; u += F.G) p2_unit(F, u); SEAM(2); }
    if (IN(3)) { REPS(3) {
        pg8::Gemm g{F.MIX, F.BT2, S, D, D}; pg8::StaticOrder So; So.init(S, D, F.G, (int)blockIdx.x);
        pg8::EpiOutProj E{F.Y, F.b_out, F.x, ALPHA};
        pg8::gemm_phase<pg8::EpiOutProj, pg8::StaticOrder, PG8_ALIGN, PG8_SP2>(F.lds + RING_OFF, g, So, E); }
        SEAM(3);
    }
    if (IN(4)) { REPS(4) p4_ln1(F); SEAM(4); }
    if (IN(5)) { REPS(5) {
        pg8::Gemm g{F.X1, F.BT3, S, D, D}; pg8::StaticOrder So; So.init(S, D, F.G, (int)blockIdx.x);
        pg8::EpiF32 E{F.SS, D};
        pg8::gemm_phase<pg8::EpiF32, pg8::StaticOrder, PG8_ALIGN, PG8_SP2>(F.lds + RING_OFF, g, So, E); }
        SEAM(5);
    }
    if (IN(6)) { REPS(6) p6_topk(F); SEAM(6); }
    if (IN(7)) { REPS(7) p7_peer(F); }
#undef IN
#undef SEAM
}

extern "C" void kernel_launch(void* const* d_in, const int* in_sizes, int n_in, void* d_out, int out_size, void* d_ws, size_t ws_size, hipStream_t stream) {
    static int grid = 0;
    if (grid == 0) {
        if (n_in != 19 || in_sizes[0] != S * D || out_size != S * D || ws_size < WS_END) {
            fprintf(stderr, "kernel_launch: built for 19 inputs, x/out of %d floats, >= %zu bytes of workspace; got n_in %d, in0 %d, out %d, ws %zu; nothing launched\n", S * D, (size_t)WS_END, n_in, n_in > 0 ? in_sizes[0] : -1, out_size, ws_size);
            grid = -1; return; }
        int dev = 0, cus = 0, per_cu = 0;
        if (hipGetDevice(&dev) != hipSuccess || hipDeviceGetAttribute(&cus, hipDeviceAttributeMultiprocessorCount, dev) != hipSuccess) { fprintf(stderr, "kernel_launch: device query failed\n"); grid = -1; return; }
        if (hipFuncSetAttribute((const void*)peer_layer_fwd, hipFuncAttributeMaxDynamicSharedMemorySize, LDS_BYTES) != hipSuccess) { fprintf(stderr, "kernel_launch: hipFuncSetAttribute failed\n"); grid = -1; return; }
        if (hipOccupancyMaxActiveBlocksPerMultiprocessor(&per_cu, (const void*)peer_layer_fwd, NWAVES * 64, LDS_BYTES) != hipSuccess || per_cu < 1) {
            fprintf(stderr, "kernel_launch: occupancy query reports %d workgroups per CU; nothing launched\n", per_cu); (void)hipGetLastError(); grid = -1; return; }
        (void)hipGetLastError();
        grid = cus;
    }
    if (grid < 0) return;
    if (hipMemsetAsync((char*)d_ws + WS_CTL, 0, CTL_ZERO_BYTES, stream) != hipSuccess) { fprintf(stderr, "kernel_launch: hipMemsetAsync failed\n"); return; }
    Args a{};
    for (int i = 0; i < 19; ++i) a.in[i] = (const float*)d_in[i];
    a.out = (float*)d_out; a.ws = (unsigned char*)d_ws;
    for (int li = 0; li < N_LAUNCHES; ++li) {
        a.ph_lo = (N_LAUNCHES == 1) ? 0 : li; a.ph_hi = (N_LAUNCHES == 1) ? N_PHASES : li + 1; a.li = li;
        hipError_t le;
        if (N_LAUNCHES == 1) { void* kargs[] = {&a}; le = hipLaunchCooperativeKernel((const void*)peer_layer_fwd, dim3(grid), dim3(NWAVES * 64), kargs, LDS_BYTES, stream); }
        else { hipLaunchKernelGGL(peer_layer_fwd, dim3(grid), dim3(NWAVES * 64), LDS_BYTES, stream, a); le = hipPeekAtLastError(); }
        if (le != hipSuccess) { fprintf(stderr, "kernel_launch: launch %d failed: %s (grid %d x %d threads, %d B LDS)\n", li, hipGetErrorName(le), grid, NWAVES * 64, LDS_BYTES); break; }
    }
}
```

```cpp
#include <hip/hip_runtime.h>
#include <cstdio>
#include <cstdint>
namespace pg8 {
#define PG8_LAS __attribute__((address_space(3)))
typedef unsigned short bf16_t;
typedef short bf16x8 __attribute__((ext_vector_type(8)));
typedef float f32x4 __attribute__((ext_vector_type(4)));
typedef unsigned u32x4 __attribute__((ext_vector_type(4)));
constexpr int BM = 256, BK = 64, HALF = 128, HTB = HALF * BK * 2  , STAGE_BYTES = 8 * HTB, NXCD = 8, WGM = 8;

__host__ __device__ __forceinline__ int lds_byte(int r, int c) { const int st = (r >> 4) * 2 + (c >> 5), rr = r & 15, cc = c & 31, ob = rr * 64 + cc * 2; return st * 1024 + (ob ^ (((ob >> 9) & 1) << 5)); }
__host__ __device__ __forceinline__ void stage_rc(int b, int& R, int& C) { const int st = b / 1024, sb = b % 1024, swz = sb ^ (((sb >> 9) & 1) << 5); R = (st >> 1) * 16 + swz / 64; C = (st & 1) * 32 + (swz % 64) / 2; }
__host__ __device__ __forceinline__ int perm32(int rho) { const int n = rho >> 4, i = rho & 15; return 8 * (i >> 2) + 4 * n + (i & 3); }

struct Unit { int pm, pn; };
struct Gemm { const bf16_t* A; const bf16_t* Bt; int M, N, K; };

struct StaticOrder {
    int nM, nN, nwg, G, c;
    __host__ __device__ void init(int M, int N, int G_, int c_) { nM = M / BM; nN = N / BM; nwg = nM * nN; G = G_; c = c_; }
    __host__ __device__ bool next(int i, Unit& u) const {
        const long L = (long)i * G + c; if (L >= nwg) return false;
        int wgid = (int)L; { const int q = nwg / NXCD, r = nwg % NXCD, xcd = wgid % NXCD, off = wgid / NXCD; wgid = (xcd < r ? xcd * (q + 1) : r * (q + 1) + (xcd - r) * q) + off; }
        const int nig = WGM * nN, gid = wgid / nig, fm = gid * WGM, gsz = (nM - fm) < WGM ? (nM - fm) : WGM;
        u.pm = fm + ((wgid % nig) % gsz); u.pn = (wgid % nig) / gsz; return true;
    }
    __device__ __forceinline__ void a_ready(const Unit&) const {}
    __device__ __forceinline__ void done(const Unit&) const {}
};

__device__ __forceinline__ unsigned cvt_pk_bf16(float lo, float hi) { unsigned r; asm volatile("v_cvt_pk_bf16_f32 %0, %1, %2" : "=v"(r) : "v"(lo), "v"(hi)); return r; }
__device__ __forceinline__ float sigmoidf_fast(float g) { return __builtin_amdgcn_rcpf(1.0f + __expf(-g)); }

struct EpiInProj {
    static constexpr bool PERM = true, AFTER_DRAIN = false;
    bf16_t* aglu; bf16_t* cv; bf16_t* scb; const float* b_in;
    __device__ __forceinline__ void operator()(const f32x4 (&acc)[2][2][4][2], const Unit& u, int wr, int wc, int fr, int fq) const {
        const int row0 = u.pm * BM + wr * 64 + fr, cc = wc * 32 + 8 * fq;
        if (u.pn < 16) {
            const bool conf = u.pn < 8; const int j = conf ? u.pn : u.pn - 8;
            const float* b0 = b_in + (conf ? 0 : 3072) + 128 * j + cc;
            const float* b1 = b_in + (conf ? 1024 : 4096) + 128 * j + cc;
            bf16_t* O = (conf ? aglu : cv) + 128 * j + cc;
            f32x4 bv0[2], bv1[2];
#pragma unroll
            for (int n = 0; n < 2; ++n) { bv0[n] = *(const f32x4*)(b0 + 4 * n); bv1[n] = *(const f32x4*)(b1 + 4 * n); }
#pragma unroll
            for (int ai = 0; ai < 2; ++ai)
#pragma unroll
                for (int m = 0; m < 4; ++m) {
                    f32x4 r[2];
#pragma unroll
                    for (int n = 0; n < 2; ++n) { const f32x4 a = acc[ai][0][m][n] + bv0[n]; f32x4 g = acc[ai][1][m][n] + bv1[n];
                        if (conf) { g[0] = sigmoidf_fast(g[0]); g[1] = sigmoidf_fast(g[1]); g[2] = sigmoidf_fast(g[2]); g[3] = sigmoidf_fast(g[3]); }
                        r[n] = a * g; }
                    u32x4 w; w.x = cvt_pk_bf16(r[0][0], r[0][1]); w.y = cvt_pk_bf16(r[0][2], r[0][3]); w.z = cvt_pk_bf16(r[1][0], r[1][1]); w.w = cvt_pk_bf16(r[1][2], r[1][3]);
                    *(u32x4*)(O + (size_t)(row0 + ai * HALF + m * 16) * 1024) = w; }
        } else {
            const int j = u.pn - 16;
#pragma unroll
            for (int bj = 0; bj < 2; ++bj) {
                const float* b0 = b_in + 2048 + 256 * j + 128 * bj + cc; bf16_t* O = scb + 256 * j + 128 * bj + cc;
                const f32x4 bva = *(const f32x4*)(b0), bvb = *(const f32x4*)(b0 + 4);
#pragma unroll
                for (int ai = 0; ai < 2; ++ai)
#pragma unroll
                    for (int m = 0; m < 4; ++m) { const f32x4 v0 = acc[ai][bj][m][0] + bva, v1 = acc[ai][bj][m][1] + bvb;
                        u32x4 w; w.x = cvt_pk_bf16(v0[0], v0[1]); w.y = cvt_pk_bf16(v0[2], v0[3]); w.z = cvt_pk_bf16(v1[0], v1[1]); w.w = cvt_pk_bf16(v1[2], v1[3]);
                        *(u32x4*)(O + (size_t)(row0 + ai * HALF + m * 16) * 1024) = w; } }
        }
    }
};
struct EpiOutProj {
    static constexpr bool PERM = true, AFTER_DRAIN = false;
    bf16_t* Y; const float* bias; const bf16_t* xb; float alpha;
    __device__ __forceinline__ void operator()(const f32x4 (&acc)[2][2][4][2], const Unit& u, int wr, int wc, int fr, int fq) const {
        const int row0 = u.pm * BM + wr * 64 + fr, col0 = u.pn * BM + wc * 32 + 8 * fq;
        f32x4 bv[2][2];
#pragma unroll
        for (int bj = 0; bj < 2; ++bj)
#pragma unroll
            for (int n = 0; n < 2; ++n) bv[bj][n] = *(const f32x4*)(bias + col0 + bj * HALF + 4 * n);
#pragma unroll
        for (int ai = 0; ai < 2; ++ai)
#pragma unroll
            for (int m = 0; m < 4; ++m) { const size_t off = (size_t)(row0 + ai * HALF + m * 16) * 2048 + col0;
#pragma unroll
                for (int bj = 0; bj < 2; ++bj) { const u32x4 xw = *(const u32x4*)(xb + off + bj * HALF);
                    f32x4 v0 = acc[ai][bj][m][0] + bv[bj][0], v1 = acc[ai][bj][m][1] + bv[bj][1];
                    v0[0] += alpha * __uint_as_float(xw.x << 16); v0[1] += alpha * __uint_as_float(xw.x & 0xffff0000u); v0[2] += alpha * __uint_as_float(xw.y << 16); v0[3] += alpha * __uint_as_float(xw.y & 0xffff0000u);
                    v1[0] += alpha * __uint_as_float(xw.z << 16); v1[1] += alpha * __uint_as_float(xw.z & 0xffff0000u); v1[2] += alpha * __uint_as_float(xw.w << 16); v1[3] += alpha * __uint_as_float(xw.w & 0xffff0000u);
                    u32x4 w; w.x = cvt_pk_bf16(v0[0], v0[1]); w.y = cvt_pk_bf16(v0[2], v0[3]); w.z = cvt_pk_bf16(v1[0], v1[1]); w.w = cvt_pk_bf16(v1[2], v1[3]);
                    *(u32x4*)(Y + off + bj * HALF) = w; }
                asm volatile("" ::: "memory"); }
    }
};
struct EpiF32 {
    static constexpr bool PERM = false, AFTER_DRAIN = false;
    float* C; int ldc;
    __device__ __forceinline__ void operator()(const f32x4 (&acc)[2][2][4][2], const Unit& u, int wr, int wc, int fr, int fq) const {
        const int row0 = u.pm * BM + wr * 64 + fr, col0 = u.pn * BM + wc * 32 + 4 * fq;
#pragma unroll
        for (int ai = 0; ai < 2; ++ai)
#pragma unroll
            for (int m = 0; m < 4; ++m) { float* rowp = C + (size_t)(row0 + ai * HALF + m * 16) * ldc + col0;
#pragma unroll
                for (int bj = 0; bj < 2; ++bj)
#pragma unroll
                    for (int n = 0; n < 2; ++n) *(f32x4*)(rowp + bj * HALF + n * 16) = acc[ai][bj][m][n]; }
    }
};

template <class Epi, class Sched, bool ALIGN_EPI = false, bool SP2 = false>
__device__ __forceinline__ void gemm_phase(PG8_LAS unsigned char* lds, const Gemm g, const Sched& S, const Epi& E) {
    const int tid = threadIdx.x, wid = __builtin_amdgcn_readfirstlane(tid >> 6), lane = tid & 63, wr = wid >> 2, wc = wid & 3, fr = lane & 15, fq = lane >> 4;
    const int K = g.K, nt = K / BK;
    unsigned voffA[2], voffB[2];
#pragma unroll
    for (int i = 0; i < 2; ++i) { int R, C; stage_rc(tid * 16 + i * 8192, R, C); const int Rb = Epi::PERM ? ((R & ~31) + perm32(R & 31)) : R;
        voffA[i] = (unsigned)(R * K + C) * 2u; voffB[i] = (unsigned)(Rb * K + C) * 2u; }
    const size_t kstep = (size_t)(BK * 2);
    const size_t hstep = (size_t)HALF * K * 2;
    const size_t tstep = 2 * hstep;
    const unsigned ldsw = (unsigned)wid * 1024u;
    const int aoff = lds_byte(wr * 64 + fr, fq * 8), boff = lds_byte(wc * 32 + fr, fq * 8);
#define PG8_SA(b, h) (((b) * 2 + (h)) * HTB)
#define PG8_SB(b, h) ((4 + (b) * 2 + (h)) * HTB)
#define PG8_STAGE(bufoff, gbase, voff) do { _Pragma("unroll") for (int _i = 0; _i < 2; ++_i) \
        __builtin_amdgcn_global_load_lds((const unsigned*)((const char*)(gbase) + (voff)[_i]), (PG8_LAS unsigned*)(lds + (bufoff) + ldsw + _i * 8192), 16, 0, 0); } while (0)
#define PG8_LDA(dst, b, h) do { _Pragma("unroll") for (int m = 0; m < 4; ++m) _Pragma("unroll") for (int k = 0; k < 2; ++k) dst[m][k] = *(const PG8_LAS bf16x8*)(lds + PG8_SA(b, h) + aoff + m * 2048 + k * 1024); } while (0)
#define PG8_LDB(dst, b, h) do { _Pragma("unroll") for (int n = 0; n < 2; ++n) _Pragma("unroll") for (int k = 0; k < 2; ++k) dst[n][k] = *(const PG8_LAS bf16x8*)(lds + PG8_SB(b, h) + boff + n * 2048 + k * 1024); } while (0)
#define PG8_MMA(ai, bj, At, Bt) do { __builtin_amdgcn_s_setprio(1); _Pragma("unroll") for (int m = 0; m < 4; ++m) _Pragma("unroll") for (int n = 0; n < 2; ++n) _Pragma("unroll") for (int k = 0; k < 2; ++k) \
        acc[ai][bj][m][n] = __builtin_amdgcn_mfma_f32_16x16x32_bf16(Bt[n][k], At[m][k], acc[ai][bj][m][n], 0, 0, 0); __builtin_amdgcn_s_setprio(0); } while (0)
#define PG8_WAIT_V(n) asm volatile("s_waitcnt vmcnt(" #n ")" ::: "memory")
#define PG8_WAIT_L(n) asm volatile("s_waitcnt lgkmcnt(" #n ")" ::: "memory")
#define PG8_BAR __builtin_amdgcn_s_barrier()
#define PG8_SCHED __builtin_amdgcn_sched_barrier(0)
    Unit cur, nxt; int ui = 0;
    if (!S.next(0, cur)) return;
    f32x4 acc[2][2][4][2];
#pragma unroll
    for (int a = 0; a < 2; ++a)
#pragma unroll
        for (int b = 0; b < 2; ++b)
#pragma unroll
            for (int m = 0; m < 4; ++m)
#pragma unroll
                for (int n = 0; n < 2; ++n) acc[a][b][m][n] = (f32x4){0.f, 0.f, 0.f, 0.f};
    bf16x8 At[4][2], B0[2][2], B1[2][2];
    const char* cA = (const char*)g.A + (size_t)cur.pm * tstep; const char* cB = (const char*)g.Bt + (size_t)cur.pn * tstep;
    S.a_ready(cur);
    if constexpr (SP2) {
        PG8_STAGE(PG8_SB(0, 0), cB, voffB); PG8_STAGE(PG8_SB(0, 1), cB + hstep, voffB); PG8_STAGE(PG8_SA(0, 0), cA, voffA); PG8_STAGE(PG8_SA(0, 1), cA + hstep, voffA);
        if (wr == 1) PG8_BAR;
        PG8_WAIT_V(2); PG8_BAR;
        PG8_STAGE(PG8_SB(1, 0), cB + kstep, voffB); PG8_STAGE(PG8_SA(1, 0), cA + kstep, voffA); PG8_STAGE(PG8_SB(1, 1), cB + hstep + kstep, voffB);
        PG8_WAIT_V(6); PG8_BAR;
    } else {
        PG8_STAGE(PG8_SB(0, 0), cB, voffB); PG8_STAGE(PG8_SA(0, 0), cA, voffA); PG8_STAGE(PG8_SB(0, 1), cB + hstep, voffB); PG8_STAGE(PG8_SA(0, 1), cA + hstep, voffA);
        if (wr == 1) PG8_BAR;
        PG8_WAIT_V(4); PG8_BAR;
        PG8_STAGE(PG8_SB(1, 0), cB + kstep, voffB); PG8_STAGE(PG8_SA(1, 0), cA + kstep, voffA); PG8_STAGE(PG8_SB(1, 1), cB + hstep + kstep, voffB);
        PG8_WAIT_V(6); PG8_BAR;
    }
    for (;;) {
        const bool has_next = S.next(ui + 1, nxt);
        const char* nA = has_next ? (const char*)g.A + (size_t)nxt.pm * tstep : cA; const char* nB = has_next ? (const char*)g.Bt + (size_t)nxt.pn * tstep : cB;
        for (int t = 0; t < nt; t += 2) {
            const bool last = (t == nt - 2);
            const char* a1 = cA + (size_t)(t + 1) * kstep;
            const char* a2 = last ? nA : cA + (size_t)(t + 2) * kstep; const char* b2 = last ? nB : cB + (size_t)(t + 2) * kstep;
            const char* a3 = a2 + kstep; const char* b3 = b2 + kstep;
            if (last && has_next) S.a_ready(nxt);
            if constexpr (SP2) {
            PG8_LDB(B0, 0, 0); PG8_LDB(B1, 0, 1); PG8_SCHED; PG8_LDA(At, 0, 0); PG8_STAGE(PG8_SA(1, 1), a1 + hstep, voffA);
            PG8_WAIT_V(8); PG8_WAIT_L(0); PG8_BAR; PG8_MMA(0, 0, At, B0); PG8_MMA(0, 1, At, B1); PG8_BAR; PG8_SCHED;
            PG8_LDA(At, 0, 1); PG8_STAGE(PG8_SB(0, 0), b2, voffB); PG8_STAGE(PG8_SB(0, 1), b2 + hstep, voffB); PG8_STAGE(PG8_SA(0, 0), a2, voffA);
            PG8_WAIT_V(8); PG8_WAIT_L(0); PG8_BAR; PG8_MMA(1, 0, At, B0); PG8_MMA(1, 1, At, B1); PG8_BAR; PG8_SCHED;
            PG8_LDB(B0, 1, 0); PG8_LDB(B1, 1, 1); PG8_SCHED; PG8_LDA(At, 1, 0); PG8_STAGE(PG8_SA(0, 1), a2 + hstep, voffA);
            PG8_WAIT_V(8); PG8_WAIT_L(0); PG8_BAR; PG8_MMA(0, 0, At, B0); PG8_MMA(0, 1, At, B1); PG8_BAR; PG8_SCHED;
            PG8_LDA(At, 1, 1); PG8_STAGE(PG8_SB(1, 0), b3, voffB); PG8_STAGE(PG8_SB(1, 1), b3 + hstep, voffB); PG8_STAGE(PG8_SA(1, 0), a3, voffA);
            PG8_WAIT_V(8); PG8_WAIT_L(0); PG8_BAR; PG8_MMA(1, 0, At, B0); PG8_MMA(1, 1, At, B1); PG8_BAR; PG8_SCHED;
            } else {
            PG8_LDB(B0, 0, 0); PG8_SCHED; PG8_LDA(At, 0, 0); PG8_STAGE(PG8_SA(1, 1), a1 + hstep, voffA);
            PG8_WAIT_L(8); PG8_BAR; PG8_WAIT_L(0); PG8_MMA(0, 0, At, B0); PG8_BAR; PG8_SCHED;
            PG8_LDB(B1, 0, 1); PG8_STAGE(PG8_SB(0, 0), b2, voffB);
            PG8_BAR; PG8_WAIT_L(0); PG8_MMA(0, 1, At, B1); PG8_BAR;
            PG8_LDA(At, 0, 1); PG8_STAGE(PG8_SA(0, 0), a2, voffA);
            PG8_BAR; PG8_WAIT_L(0); PG8_MMA(1, 0, At, B0); PG8_BAR; PG8_SCHED;
            PG8_STAGE(PG8_SB(0, 1), b2 + hstep, voffB);
            PG8_WAIT_V(6); PG8_BAR; PG8_MMA(1, 1, At, B1); PG8_BAR;
            PG8_LDB(B0, 1, 0); PG8_SCHED; PG8_LDA(At, 1, 0); PG8_STAGE(PG8_SA(0, 1), a2 + hstep, voffA);
            PG8_WAIT_L(8); PG8_BAR; PG8_WAIT_L(0); PG8_MMA(0, 0, At, B0); PG8_BAR; PG8_SCHED;
            PG8_LDB(B1, 1, 1); PG8_STAGE(PG8_SB(1, 0), b3, voffB);
            PG8_BAR; PG8_WAIT_L(0); PG8_MMA(0, 1, At, B1); PG8_BAR;
            PG8_LDA(At, 1, 1); PG8_STAGE(PG8_SA(1, 0), a3, voffA);
            PG8_BAR; PG8_WAIT_L(0); PG8_MMA(1, 0, At, B0); PG8_BAR; PG8_SCHED;
            PG8_STAGE(PG8_SB(1, 1), b3 + hstep, voffB);
            PG8_WAIT_V(6); PG8_BAR; PG8_MMA(1, 1, At, B1); PG8_BAR;
            }
        }
        if constexpr (ALIGN_EPI) { if (wr == 0) PG8_BAR; }
        if constexpr (!Epi::AFTER_DRAIN) { E(acc, cur, wr, wc, fr, fq); S.done(cur); }
        if (!has_next) break;
#pragma unroll
        for (int a = 0; a < 2; ++a)
#pragma unroll
            for (int b = 0; b < 2; ++b)
#pragma unroll
                for (int m = 0; m < 4; ++m)
#pragma unroll
                    for (int n = 0; n < 2; ++n) acc[a][b][m][n] = (f32x4){0.f, 0.f, 0.f, 0.f};
        cur = nxt; cA = nA; cB = nB; ++ui;
        if constexpr (ALIGN_EPI) { if (wr == 1) PG8_BAR; }
    }
    PG8_WAIT_V(0);
    if constexpr (!ALIGN_EPI) { if (wr == 0) PG8_BAR; }
    PG8_BAR;
    if constexpr (Epi::AFTER_DRAIN) { E.fused(acc, cur, wr, wc, fr, fq, lds, wid, lane); S.done(cur); }
#undef PG8_SA
#undef PG8_SB
#undef PG8_STAGE
#undef PG8_LDA
#undef PG8_LDB
#undef PG8_MMA
#undef PG8_WAIT_V
#undef PG8_WAIT_L
#undef PG8_BAR
#undef PG8_SCHED
}
}

#ifndef PG8_SP2
#define PG8_SP2 true
#endif
#ifndef PG8_ALIGN
#define PG8_ALIGN true
#endif
constexpr int NWAVES = 8;
#ifndef MK_N_LAUNCHES
#define MK_N_LAUNCHES 1
#endif
constexpr int N_PHASES = 8;
constexpr int N_LAUNCHES = MK_N_LAUNCHES;

constexpr int ROWB = 1536;
constexpr int S = 8192, D = 2048, NIN = 5120, DC = 1024, NE = 16384, NPAIR = 128;
constexpr float LN_EPS = 1e-5f;
constexpr float ALPHA = 1.189207115002721f;

constexpr size_t MiB = 1u << 20;
constexpr size_t WS_CTL = 0, CTL_ZERO_BYTES = 64 * 1024;
constexpr size_t WS_XB = 2 * MiB;
constexpr size_t WS_BT1 = 34 * MiB;
constexpr size_t WS_BT2 = 54 * MiB;
constexpr size_t WS_BT3 = 62 * MiB;
constexpr size_t WS_AGLU = 70 * MiB;
constexpr size_t WS_CV = 86 * MiB;
constexpr size_t WS_SCB = 102 * MiB;
constexpr size_t WS_MIX = 118 * MiB;
constexpr size_t WS_Y = 150 * MiB;
constexpr size_t WS_X1 = 214 * MiB;
constexpr size_t WS_S = 246 * MiB;
constexpr size_t WS_IDX = 310 * MiB;
constexpr size_t WS_GV = 314 * MiB;
constexpr size_t WS_SU = 318 * MiB;
constexpr size_t WS_U8 = 322 * MiB;
constexpr size_t WS_V8 = 354 * MiB;
constexpr size_t WS_USC = 386 * MiB;
constexpr size_t WS_VSC = 386 * MiB + 65536;
constexpr size_t WS_END = 387 * MiB;
constexpr int CW_BAR = 4096;

constexpr int RING_OFF = 0, RING_BYTES = 131072;
constexpr int LDSCTL_OFF = RING_BYTES, MISC_OFF = LDSCTL_OFF + 320;
constexpr int LNP_OFF = MISC_OFF + 128;
constexpr int LDS_BYTES = 155648;

#define GAS __attribute__((address_space(1)))
#define LAS __attribute__((address_space(3)))
typedef unsigned short bf16;
typedef unsigned v4u __attribute__((ext_vector_type(4)));
typedef unsigned v2u __attribute__((ext_vector_type(2)));
typedef float f32x4 __attribute__((ext_vector_type(4)));
typedef float f32x2 __attribute__((ext_vector_type(2)));
typedef short bf16x8 __attribute__((ext_vector_type(8)));
typedef GAS unsigned gu32;
#define LDS_WAIT() asm volatile("s_waitcnt lgkmcnt(0)" ::: "memory")
#define VM_WAIT() asm volatile("s_waitcnt vmcnt(0)" ::: "memory")
__device__ __forceinline__ unsigned pk2(float lo, float hi) { return pg8::cvt_pk_bf16(lo, hi); }
__device__ __forceinline__ float bf_lo(unsigned w) { return __uint_as_float(w << 16); }
__device__ __forceinline__ float bf_hi(unsigned w) { return __uint_as_float(w & 0xffff0000u); }
__device__ __forceinline__ float wave_sum(float v) {
#pragma unroll
    for (int o = 1; o < 64; o <<= 1) v += __shfl_xor(v, o);
    return v;
}
__device__ __forceinline__ float wave_max(float v) {
#pragma unroll
    for (int o = 1; o < 64; o <<= 1) v = fmaxf(v, __shfl_xor(v, o));
    return v;
}

#define XB_TMO      128
#define XB_XCNT(j)  (256  + 64 * (j))
#define XB_XSUB(j)  (1280 + 64 * (j))
#define XB_XGEN(j)  (2304 + 64 * (j))
#define XB_TOP      3328
#define XB_TOPGEN   3392
#define XCD_BAR_WORDS 3456
#define XB_SPIN_CAP (1u << 18)

__device__ __forceinline__ unsigned xb_ld(unsigned* p)              { return __hip_atomic_load(p, __ATOMIC_RELAXED, __HIP_MEMORY_SCOPE_AGENT); }
__device__ __forceinline__ unsigned xb_add(unsigned* p, unsigned v) { return __hip_atomic_fetch_add(p, v, __ATOMIC_RELAXED, __HIP_MEMORY_SCOPE_AGENT); }
__device__ __forceinline__ unsigned xb_xcc_id() { return (unsigned)__builtin_amdgcn_s_getreg((3 << 11) | 20) & 0xFu; }
#define XB_SPIN(cond, bar) do { unsigned _sp = 0; while (cond) { __builtin_amdgcn_s_sleep(1); \
    if ((++_sp & 255u) == 0u) { if (xb_ld(&(bar)[XB_TMO])) break; if (_sp > XB_SPIN_CAP) { atomicAdd(&(bar)[XB_TMO], 1u); break; } } } } while (0)

struct XcdBarrier {
    unsigned* bar; unsigned x;
    volatile LAS unsigned* st;
};

__device__ __forceinline__ XcdBarrier xcd_barrier_post(unsigned* bar, volatile LAS unsigned* st) {
    XcdBarrier b; b.bar = bar; b.x = xb_xcc_id(); b.st = st;
    if (threadIdx.x == 0) (void)xb_add(&bar[XB_XCNT(b.x)], 1u);
    return b;
}
__device__ __forceinline__ void xcd_barrier_complete(unsigned* bar, unsigned x, unsigned& nloc, unsigned& nx) {
    const unsigned G = gridDim.x * gridDim.y * gridDim.z;
    unsigned sum, cnt, mine, sp = 0u;
    for (;;) {
        sum = 0u; cnt = 0u; mine = 0u;
#pragma unroll
        for (unsigned j = 0; j < 16; ++j) { const unsigned c = xb_ld(&bar[XB_XCNT(j)]); sum += c; cnt += (c > 0u) ? 1u : 0u; mine = (j == x) ? c : mine; }
        if (sum == G) break;
        __builtin_amdgcn_s_sleep(1);
        if ((++sp & 255u) == 0u) { if (xb_ld(&bar[XB_TMO])) break; if (sp > XB_SPIN_CAP) { atomicAdd(&bar[XB_TMO], 1u); break; } }
    }
    nloc = mine > 0u ? mine : 1u; nx = cnt > 0u ? cnt : 1u;
}

__device__ __forceinline__ void xcd_barrier(const XcdBarrier& b) {
    asm volatile("s_waitcnt vmcnt(0)" ::: "memory");
    __syncthreads();
    if (threadIdx.x == 0) {
        unsigned* bar = b.bar;
        __builtin_amdgcn_s_waitcnt(0);
        unsigned nloc = b.st[0], nx = b.st[1];
        if (nloc == 0u) { xcd_barrier_complete(bar, b.x, nloc, nx); b.st[0] = nloc; b.st[1] = nx; }
        const unsigned old = xb_add(&bar[XB_XSUB(b.x)], 1u);
        const unsigned gen = old / nloc;
        if (old + 1u == (gen + 1u) * nloc) {
            __builtin_amdgcn_fence(__ATOMIC_RELEASE, "agent");
            asm volatile("s_waitcnt vmcnt(0)" ::: "memory");
            const unsigned og = xb_add(&bar[XB_TOP], 1u);
            const unsigned tg = og / nx;
            if (og + 1u == (tg + 1u) * nx) xb_add(&bar[XB_TOPGEN], 1u);
            else XB_SPIN(xb_ld(&bar[XB_TOPGEN]) == tg, bar);
            __builtin_amdgcn_fence(__ATOMIC_ACQUIRE, "agent");
            xb_add(&bar[XB_XGEN(b.x)], 1u);
            asm volatile("s_waitcnt vmcnt(0)" ::: "memory");
        } else {
            XB_SPIN(xb_ld(&bar[XB_XGEN(b.x)]) == gen, bar);
            __builtin_amdgcn_fence(__ATOMIC_ACQUIRE, "agent");
            asm volatile("s_waitcnt vmcnt(0)" ::: "memory");
        }
    }
    __syncthreads();
}

struct Frame {
    LAS unsigned char* lds;
    volatile LAS unsigned* MISC;
    gu32* ctl;
    int tid, lane, wave, vcu, G;
    const float *x, *w_in, *b_in, *ccw, *ccb, *clg, *clb, *scw, *scbias, *w_out, *b_out, *ln1g, *ln1b, *w_q, *sub_keys, *peer_u, *peer_v, *ln2g, *ln2b;
    float* out;
    bf16 *XB, *BT1, *BT2, *BT3, *AGLU, *CV, *SCB, *MIX, *X1;
    bf16* Y; float* SS; int* IDX; float *GV, *SU; unsigned char *U8, *V8; float *USC, *VSC;
};

__device__ __forceinline__ int bt1_row(int n0) {
    const int grp = n0 >> 10, c = n0 & 1023, j = c >> 7, r = c & 127;
    if (grp == 0) return 256 * j + r;
    if (grp == 1) return 256 * j + 128 + r;
    if (grp == 2) return 4096 + c;
    if (grp == 3) return 2048 + 256 * j + r;
    return 2048 + 256 * j + 128 + r;
}
template <bool PERM_IN>
__device__ __forceinline__ void p0_transpose_item(const float* W, int K, int N, bf16* WT, LAS float* scr, int item, int lane) {
    const int nblk = N / 32, kb = item / nblk, nb = item % nblk, k0 = 64 * kb, n0 = 32 * nb;
    const int drow = PERM_IN ? bt1_row(n0) : n0;
#pragma unroll 8
    for (int i = 0; i < 32; ++i) { const int kk = 2 * i + (lane >> 5); scr[kk * 33 + (lane & 31)] = W[(size_t)(k0 + kk) * N + n0 + (lane & 31)]; }
    LDS_WAIT(); asm volatile("" ::: "memory");
    const int c = lane & 7;
#pragma unroll
    for (int j = 0; j < 4; ++j) { const int n = (lane >> 3) + 8 * j; const LAS float* s = scr + (8 * c) * 33 + n;
        v4u o; o.x = pk2(s[0 * 33], s[1 * 33]); o.y = pk2(s[2 * 33], s[3 * 33]); o.z = pk2(s[4 * 33], s[5 * 33]); o.w = pk2(s[6 * 33], s[7 * 33]);
        *(GAS v4u*)(WT + (size_t)(drow + n) * K + k0 + 8 * c) = o; }
    LDS_WAIT(); asm volatile("" ::: "memory");
}
__device__ __forceinline__ bf16x8 ld8_bf16(const float* p) {
    const f32x4 a = *(const f32x4*)p, b = *(const f32x4*)(p + 4);
    v4u w; w.x = pk2(a.x, a.y); w.y = pk2(a.z, a.w); w.z = pk2(b.x, b.y); w.w = pk2(b.z, b.w);
    return __builtin_bit_cast(bf16x8, w);
}
__device__ __forceinline__ unsigned fp6_encode(float y) {
    const unsigned sb = (__float_as_uint(y) >> 31) << 5;
    const float a = fabsf(y);
    const unsigned sub = (unsigned)__builtin_rintf(a * 8.0f);
    unsigned b = __float_as_uint(a); b += 0x7FFFFu + ((b >> 20) & 1u); b >>= 20;
    unsigned nrm = b - 1008u; nrm = nrm > 31u ? 31u : nrm;
    return sb | (a < 1.0f ? sub : nrm);
}
__device__ __forceinline__ void p0_prologue(Frame& F) {
    LAS float* scr = (LAS float*)(F.lds + RING_OFF + F.wave * 16384);
    const int gw = F.vcu * NWAVES + F.wave, NGW = F.G * NWAVES, lane = F.lane;
    constexpr int I_IN = (D / 64) * (NIN / 32), I_OUT = (D / 64) * (D / 32);
    for (int it = gw; it < I_IN + I_OUT; it += NGW) {
        if (it < I_IN) p0_transpose_item<true>(F.w_in, D, NIN, F.BT1, scr, it, lane);
        else p0_transpose_item<false>(F.w_out, D, D, F.BT2, scr, it - I_IN, lane);
    }
    for (int it = gw; it < 4096; it += NGW) {
        const int hp = it >> 8, nb = (it >> 5) & 7, db = it & 31, n0 = nb * 16, d0 = db * 64;
        const float* sk = F.sub_keys + ((size_t)hp * 128 + n0 + (lane & 15)) * 128 + 8 * (lane >> 4);
        const float* wq = F.w_q + (size_t)(d0 + (lane & 15)) * 2048 + hp * 128 + 8 * (lane >> 4);
        f32x4 acc[4];
#pragma unroll
        for (int dt = 0; dt < 4; ++dt) acc[dt] = (f32x4){0.f, 0.f, 0.f, 0.f};
#pragma unroll
        for (int ks = 0; ks < 4; ++ks) {
            const bf16x8 yf = ld8_bf16(sk + 32 * ks);
#pragma unroll
            for (int dt = 0; dt < 4; ++dt) { const bf16x8 xf = ld8_bf16(wq + (size_t)dt * 16 * 2048 + 32 * ks);
                acc[dt] = __builtin_amdgcn_mfma_f32_16x16x32_bf16(xf, yf, acc[dt], 0, 0, 0); }
        }
        bf16* orow = F.BT3 + (size_t)(hp * 128 + n0 + (lane & 15)) * 2048 + d0 + 4 * (lane >> 4);
#pragma unroll
        for (int dt = 0; dt < 4; ++dt) { v2u o; o.x = pk2(acc[dt][0], acc[dt][1]); o.y = pk2(acc[dt][2], acc[dt][3]); *(GAS v2u*)(orow + 16 * dt) = o; }
    }
    for (int r = gw; r < S; r += NGW) {
        const GAS f32x4* src = (const GAS f32x4*)(F.x + (size_t)r * D) + 2 * lane;
        GAS v4u* dst = (GAS v4u*)(F.XB + (size_t)r * D) + lane;
#pragma unroll
        for (int j = 0; j < 4; ++j) { const f32x4 a = src[128 * j], b = src[128 * j + 1];
            v4u o; o.x = pk2(a.x, a.y); o.y = pk2(a.z, a.w); o.z = pk2(b.x, b.y); o.w = pk2(b.z, b.w); dst[64 * j] = o; }
    }
}
__device__ __forceinline__ void p0_encode_row(Frame& F, const f32x4 (&v)[8], int r, int lane) {
    const bool isv = r >= NE; const int e = isv ? r - NE : r;
    float am = 0.f;
#pragma unroll
    for (int j = 0; j < 8; ++j) am = fmaxf(am, fmaxf(fmaxf(fabsf(v[j].x), fabsf(v[j].y)), fmaxf(fabsf(v[j].z), fabsf(v[j].w))));
    am = wave_max(am);
    const float sc = am > 0.f ? 7.5f / am : 1.f, inv = am > 0.f ? am / 7.5f : 1.f;
    unsigned w[6];
#pragma unroll
    for (int h = 0; h < 2; ++h) {
        unsigned c[16];
#pragma unroll
        for (int i = 0; i < 16; ++i) c[i] = fp6_encode(v[4 * h + (i >> 2)][i & 3] * sc);
        w[3 * h + 0] = c[0] | (c[1] << 6) | (c[2] << 12) | (c[3] << 18) | (c[4] << 24) | (c[5] << 30);
        w[3 * h + 1] = (c[5] >> 2) | (c[6] << 4) | (c[7] << 10) | (c[8] << 16) | (c[9] << 22) | (c[10] << 28);
        w[3 * h + 2] = (c[10] >> 4) | (c[11] << 2) | (c[12] << 8) | (c[13] << 14) | (c[14] << 20) | (c[15] << 26);
    }
    unsigned char* dst = (isv ? F.V8 : F.U8) + (size_t)e * ROWB + 24 * lane;
    *(GAS v2u*)(dst) = (v2u){w[0], w[1]}; *(GAS v2u*)(dst + 8) = (v2u){w[2], w[3]}; *(GAS v2u*)(dst + 16) = (v2u){w[4], w[5]};
    if (lane == 0) (isv ? F.VSC : F.USC)[e] = inv;
}
__device__ __forceinline__ void p0_load_row(Frame& F, f32x4 (&v)[8], int r, int lane) {
    const int rc = r < 2 * NE ? r : 2 * NE - 1;
    const GAS f32x4* src = (const GAS f32x4*)((rc >= NE ? F.peer_v : F.peer_u) + (size_t)(rc >= NE ? rc - NE : rc) * D) + lane;
#pragma unroll
    for (int j = 0; j < 8; ++j) v[j] = src[64 * j];
}
__device__ __forceinline__ void p0_peer_tables(Frame& F, int wid, int nw) {
    const int lane = F.lane;
    f32x4 a[8], b[8], na[8], nb[8];
    p0_load_row(F, na, wid, lane); p0_load_row(F, nb, wid + nw, lane);
#pragma unroll 1
    for (int r = wid; r < 2 * NE; r += 2 * nw) {
#pragma unroll
        for (int j = 0; j < 8; ++j) { a[j] = na[j]; b[j] = nb[j]; }
        p0_load_row(F, na, r + 2 * nw, lane); p0_load_row(F, nb, r + 3 * nw, lane);
        p0_encode_row(F, a, r, lane);
        if (r + nw < 2 * NE) p0_encode_row(F, b, r + nw, lane);
    }
}

__device__ __forceinline__ float dpp_add(float v, int ctrl_sel) {
    int m;
    if (ctrl_sel == 0) m = __builtin_amdgcn_update_dpp(0, __float_as_int(v), 0x111, 0xf, 0xf, false);
    else if (ctrl_sel == 1) m = __builtin_amdgcn_update_dpp(0, __float_as_int(v), 0x112, 0xf, 0xf, false);
    else if (ctrl_sel == 2) m = __builtin_amdgcn_update_dpp(0, __float_as_int(v), 0x114, 0xf, 0xf, false);
    else if (ctrl_sel == 3) m = __builtin_amdgcn_update_dpp(0, __float_as_int(v), 0x118, 0xf, 0xf, false);
    else if (ctrl_sel == 4) m = __builtin_amdgcn_update_dpp(0, __float_as_int(v), 0x142, 0xa, 0xf, false);
    else m = __builtin_amdgcn_update_dpp(0, __float_as_int(v), 0x143, 0xc, 0xf, false);
    return v + __int_as_float(m);
}
__device__ __forceinline__ float wave_sum_lane63(float v) {
    v = dpp_add(v, 0); v = dpp_add(v, 1); v = dpp_add(v, 2); v = dpp_add(v, 3); v = dpp_add(v, 4); v = dpp_add(v, 5); return v;
}
__device__ __forceinline__ void p2_unit(Frame& F, int unit) {
    const int t0 = unit * 32, tid_in = F.tid, lane = F.lane;
    LAS unsigned char* abuf = F.lds + RING_OFF;
    LAS float* stat = (LAS float*)(F.lds + LNP_OFF);
    {
        int tid = tid_in; asm volatile("" : "+v"(tid));
#pragma unroll
        for (int h = 0; h < 2; ++h) {
            v4u st[8];
#pragma unroll
            for (int k = 8 * h; k < 8 * h + 8; ++k) { const int c = tid + 512 * k; int cc = c < 62 * 128 ? c : 62 * 128 - 1; cc = (t0 - 30) * 128 + cc < 0 ? (30 - t0) * 128 : cc;
                st[k - 8 * h] = ((const GAS v4u*)F.AGLU)[(size_t)((t0 - 30) * 128 + cc)]; }
#pragma unroll
            for (int k = 8 * h; k < 8 * h + 8; ++k) { const int c = tid + 512 * k; const bool ok = (t0 - 30) * 128 + c >= 0;
                const v4u v = ok ? st[k - 8 * h] : (v4u){0u, 0u, 0u, 0u};
                if (k < 15 || tid < 62 * 128 - 512 * 15) *(LAS v4u*)(abuf + 16 * c) = v; }
            asm volatile("" ::: "memory");
        }
    }
    asm volatile("" ::: "memory"); __builtin_amdgcn_sched_barrier(0);
    {
        int tid = tid_in; asm volatile("" : "+v"(tid));
        const int cg = tid & 127, tg = tid >> 7, tb = t0 + 8 * tg;
        float w0[8], w1[8], w2[8], bs[8];
#pragma unroll
        for (int h = 0; h < 2; ++h) { const f32x4 a = *(const GAS f32x4*)(F.scw + 8 * cg + 4 * h), b = *(const GAS f32x4*)(F.scw + 1024 + 8 * cg + 4 * h), c = *(const GAS f32x4*)(F.scw + 2048 + 8 * cg + 4 * h), d = *(const GAS f32x4*)(F.scbias + 8 * cg + 4 * h);
#pragma unroll
            for (int q = 0; q < 4; ++q) { w0[4 * h + q] = a[q]; w1[4 * h + q] = b[q]; w2[4 * h + q] = c[q]; bs[4 * h + q] = d[q]; } }
        v4u cvr[10], gtr[8];
#pragma unroll
        for (int i = 0; i < 10; ++i) { const int t = tb - 2 + i, tc = t < 0 ? 0 : t; const v4u v = *(const GAS v4u*)(F.CV + (size_t)tc * 1024 + 8 * cg); cvr[i] = t < 0 ? (v4u){0u, 0u, 0u, 0u} : v; }
#pragma unroll
        for (int i = 0; i < 4; ++i) gtr[i] = *(const GAS v4u*)(F.SCB + (size_t)(tb + i) * 1024 + 8 * cg);
#pragma unroll
        for (int tt = 0; tt < 8; ++tt) {
            if (tt == 3) {
#pragma unroll
                for (int i = 4; i < 8; ++i) gtr[i] = *(const GAS v4u*)(F.SCB + (size_t)(tb + i) * 1024 + 8 * cg); }
            v4u o;
#pragma unroll
            for (int q = 0; q < 4; ++q) {
                const unsigned a2 = cvr[tt][q], a1 = cvr[tt + 1][q], a0 = cvr[tt + 2][q], g = gtr[tt][q];
                const float lo = bf_lo(g) * (bs[2 * q] + w0[2 * q] * bf_lo(a2) + w1[2 * q] * bf_lo(a1) + w2[2 * q] * bf_lo(a0));
                const float hi = bf_hi(g) * (bs[2 * q + 1] + w0[2 * q + 1] * bf_hi(a2) + w1[2 * q + 1] * bf_hi(a1) + w2[2 * q + 1] * bf_hi(a0));
                o[q] = pk2(lo, hi);
            }
            *(GAS v4u*)(F.MIX + (size_t)(tb + tt) * 2048 + 1024 + 8 * cg) = o;
        }
    }
    asm volatile("" ::: "memory"); __builtin_amdgcn_sched_barrier(0);
    LDS_WAIT(); __syncthreads();
    {
        int tid = tid_in; asm volatile("" : "+v"(tid)); const int c0 = 2 * tid;
        f32x2 w[31];
#pragma unroll
        for (int k = 0; k < 31; ++k) w[k] = *(const GAS f32x2*)(F.ccw + k * 1024 + c0);
        const f32x2 bias = *(const GAS f32x2*)(F.ccb + c0), lng = *(const GAS f32x2*)(F.clg + c0), lnb = *(const GAS f32x2*)(F.clb + c0);
#pragma unroll 1
        for (int g = 0; g < 4; ++g) {
            f32x2 o[8];
#pragma unroll
            for (int tt = 0; tt < 8; ++tt) o[tt] = bias;
#pragma unroll
            for (int half = 0; half < 2; ++half) {
                constexpr int NR = 23; const int r0 = half ? 16 : 0, k0 = half ? 16 : 0, nk = half ? 15 : 16;
                f32x2 in[NR];
#pragma unroll
                for (int i = 0; i < NR; ++i) { const int row = r0 + i < 38 ? r0 + i : 37; const unsigned raw = *(const LAS unsigned*)(abuf + (8 * g + row) * 2048 + 4 * tid); in[i] = (f32x2){bf_lo(raw), bf_hi(raw)}; }
#pragma unroll
                for (int tt = 0; tt < 8; ++tt)
#pragma unroll
                    for (int k = 0; k < 16; ++k) if (k < nk) o[tt] += w[k0 + k] * in[tt + k + k0 - r0];
                asm volatile("" ::: "memory");
            }
#pragma unroll
            for (int tt = 0; tt < 8; ++tt) { const float s1 = wave_sum_lane63(o[tt].x + o[tt].y), s2 = wave_sum_lane63(o[tt].x * o[tt].x + o[tt].y * o[tt].y);
                if (lane == 63) { stat[(tt * 2 + 0) * 8 + F.wave] = s1; stat[(tt * 2 + 1) * 8 + F.wave] = s2; } }
            LDS_WAIT(); __syncthreads();
            float tot;
            { const f32x4 a0 = *(const LAS f32x4*)(stat + (lane & 15) * 8), a1 = *(const LAS f32x4*)(stat + (lane & 15) * 8 + 4); tot = ((a0.x + a0.y) + (a0.z + a0.w)) + ((a1.x + a1.y) + (a1.z + a1.w)); }
#pragma unroll
            for (int tt = 0; tt < 8; ++tt) {
                const float mean = __int_as_float(__builtin_amdgcn_readlane(__float_as_int(tot), 2 * tt)) * (1.f / 1024.f);
                const float ex2 = __int_as_float(__builtin_amdgcn_readlane(__float_as_int(tot), 2 * tt + 1)) * (1.f / 1024.f);
                const float rstd = 1.f / sqrtf(fmaxf(ex2 - mean * mean, 0.f) + LN_EPS);
                f32x2 y = (o[tt] - mean) * rstd * lng + lnb;
                y.x *= pg8::sigmoidf_fast(y.x); y.y *= pg8::sigmoidf_fast(y.y);
                *(GAS unsigned*)(F.MIX + (size_t)(t0 + 8 * g + tt) * 2048 + c0) = pk2(y.x, y.y);
            }
            __syncthreads();
        }
    }
}

__device__ __forceinline__ void p4_ln1(Frame& F) {
    const int gw = F.vcu * NWAVES + F.wave, NGW = F.G * NWAVES, lane = F.lane;
    for (int r = gw; r < S; r += NGW) {
        const GAS v4u* yr = (const GAS v4u*)(F.Y + (size_t)r * D) + lane;
        float v[32]; float s = 0.f;
#pragma unroll
        for (int j = 0; j < 4; ++j) { const v4u w = yr[64 * j];
#pragma unroll
            for (int q = 0; q < 4; ++q) { v[8 * j + 2 * q] = bf_lo(w[q]); v[8 * j + 2 * q + 1] = bf_hi(w[q]); s += v[8 * j + 2 * q] + v[8 * j + 2 * q + 1]; } }
        const float mean = wave_sum(s) * (1.f / D); float s2 = 0.f;
#pragma unroll
        for (int i = 0; i < 32; ++i) { v[i] -= mean; s2 = fmaf(v[i], v[i], s2); }
        const float rstd = 1.f / sqrtf(wave_sum(s2) * (1.f / D) + LN_EPS);
        GAS v4u* o16 = (GAS v4u*)(F.X1 + (size_t)r * D) + lane;
#pragma unroll
        for (int j = 0; j < 4; ++j) { const int col = 8 * lane + 512 * j;
            const f32x4 g0 = *(const GAS f32x4*)(F.ln1g + col), g1 = *(const GAS f32x4*)(F.ln1g + col + 4), b0 = *(const GAS f32x4*)(F.ln1b + col), b1 = *(const GAS f32x4*)(F.ln1b + col + 4);
            v4u o; o.x = pk2(v[8 * j + 0] * rstd * g0.x + b0.x, v[8 * j + 1] * rstd * g0.y + b0.y); o.y = pk2(v[8 * j + 2] * rstd * g0.z + b0.z, v[8 * j + 3] * rstd * g0.w + b0.w);
            o.z = pk2(v[8 * j + 4] * rstd * g1.x + b1.x, v[8 * j + 5] * rstd * g1.y + b1.y); o.w = pk2(v[8 * j + 6] * rstd * g1.z + b1.z, v[8 * j + 7] * rstd * g1.w + b1.w);
            o16[64 * j] = o; }
    }
}

__device__ __forceinline__ int imax_(int a, int b) { return a > b ? a : b; }
__device__ __forceinline__ int imin_(int a, int b) { return a < b ? a : b; }
template <bool DESC> __device__ __forceinline__ void ce_i(int& a, int& b) { const int mx = imax_(a, b), mn = imin_(a, b); a = DESC ? mx : mn; b = DESC ? mn : mx; }
template <bool DESC> __device__ __forceinline__ void sort16_i(int (&v)[16]) {
#pragma unroll
    for (int k = 2; k <= 16; k <<= 1)
#pragma unroll
        for (int j = k >> 1; j > 0; j >>= 1)
#pragma unroll
            for (int i = 0; i < 16; ++i) { const int l = i ^ j; if (l > i) { const bool up = ((i & k) == 0); if (up != DESC) ce_i<false>(v[i], v[l]); else ce_i<true>(v[i], v[l]); } }
}
template <bool DESC> __device__ __forceinline__ void merge16_i(int (&v)[16]) {
#pragma unroll
    for (int j = 8; j > 0; j >>= 1)
#pragma unroll
        for (int i = 0; i < 16; ++i) { const int l = i ^ j; if (l > i) ce_i<DESC>(v[i], v[l]); }
}
template <bool DESC> __device__ __forceinline__ void ce_p(float& a, int& pa, float& b, int& pb) {
    const bool sw = DESC ? (a < b) : (a > b); const float ta = sw ? b : a, tb = sw ? a : b; const int qa = sw ? pb : pa, qb = sw ? pa : pb; a = ta; b = tb; pa = qa; pb = qb; }
template <bool DESC> __device__ __forceinline__ void sort16_p(float (&v)[16], int (&p)[16]) {
#pragma unroll
    for (int k = 2; k <= 16; k <<= 1)
#pragma unroll
        for (int j = k >> 1; j > 0; j >>= 1)
#pragma unroll
            for (int i = 0; i < 16; ++i) { const int l = i ^ j; if (l > i) { const bool up = ((i & k) == 0); if (up != DESC) ce_p<false>(v[i], p[i], v[l], p[l]); else ce_p<true>(v[i], p[i], v[l], p[l]); } }
}
template <bool DESC> __device__ __forceinline__ void merge16_p(float (&v)[16], int (&p)[16]) {
#pragma unroll
    for (int j = 8; j > 0; j >>= 1)
#pragma unroll
        for (int i = 0; i < 16; ++i) { const int l = i ^ j; if (l > i) ce_p<DESC>(v[i], p[i], v[l], p[l]); }
}
__device__ __forceinline__ int f2key(float f) { const int b = __float_as_int(f); return b ^ ((b >> 31) & 0x7fffffff); }
__device__ __forceinline__ float key2f(int k) { return __int_as_float(k ^ ((k >> 31) & 0x7fffffff)); }

__device__ __forceinline__ void p6_topk(Frame& F) {
    const int gw = F.vcu * NWAVES + F.wave, NGW = F.G * NWAVES, lane = F.lane;
    for (int it = gw; it < (S * 16) / 64; it += NGW) {
        const int prob = it * 64 + lane, t = prob >> 4, hp = prob & 15;
        const float* sp = F.SS + (size_t)t * 2048 + hp * 128;
        int top[16];
        {
            f32x4 r[4];
#pragma unroll
            for (int q = 0; q < 4; ++q) r[q] = *(const GAS f32x4*)(sp + 4 * q);
#pragma unroll
            for (int q = 0; q < 4; ++q)
#pragma unroll
                for (int e = 0; e < 4; ++e) top[4 * q + e] = (f2key(r[q][e]) & ~127) | (4 * q + e);
            sort16_i<true>(top);
        }
#pragma unroll 1
        for (int c = 1; c < 8; ++c) {
            f32x4 r[4]; int nw[16];
#pragma unroll
            for (int q = 0; q < 4; ++q) r[q] = *(const GAS f32x4*)(sp + 16 * c + 4 * q);
#pragma unroll
            for (int q = 0; q < 4; ++q)
#pragma unroll
                for (int e = 0; e < 4; ++e) nw[4 * q + e] = (f2key(r[q][e]) & ~127) | (16 * c + 4 * q + e);
            sort16_i<false>(nw);
#pragma unroll
            for (int i = 0; i < 16; ++i) top[i] = imax_(top[i], nw[i]);
            merge16_i<true>(top);
        }
        const bool odd = (lane & 1) != 0;
        float Av[16], Bv[16]; int Ai[16], Bi[16];
#pragma unroll
        for (int i = 0; i < 16; ++i) { const int mine = top[i]; const int other = __shfl_xor(mine, 1); const int ka = odd ? other : mine, kb = odd ? mine : other;
            Av[i] = key2f(ka & ~127); Ai[i] = ka & 127; Bv[i] = key2f(kb & ~127); Bi[i] = kb & 127; }
        float tv[16]; int tp[16];
#pragma unroll
        for (int j = 0; j < 16; ++j) { tv[j] = Av[0] + Bv[j]; tp[j] = Ai[0] * 128 + Bi[j]; }
        {
            float nv[16]; int np[16];
#pragma unroll
            for (int j = 0; j < 8; ++j) { nv[j] = Av[1] + Bv[j]; np[j] = Ai[1] * 128 + Bi[j]; }
#pragma unroll
            for (int j = 0; j < 5; ++j) { nv[8 + j] = Av[2] + Bv[j]; np[8 + j] = Ai[2] * 128 + Bi[j]; }
#pragma unroll
            for (int j = 0; j < 3; ++j) { nv[13 + j] = Av[3] + Bv[j]; np[13 + j] = Ai[3] * 128 + Bi[j]; }
            sort16_p<false>(nv, np);
#pragma unroll
            for (int i = 0; i < 16; ++i) { const bool g = nv[i] > tv[i]; tv[i] = g ? nv[i] : tv[i]; tp[i] = g ? np[i] : tp[i]; }
            merge16_p<true>(tv, tp);
        }
        {
            float nv[16]; int np[16];
            nv[0] = Av[3] + Bv[3]; np[0] = Ai[3] * 128 + Bi[3];
#pragma unroll
            for (int j = 0; j < 3; ++j) { nv[1 + j] = Av[4] + Bv[j]; np[1 + j] = Ai[4] * 128 + Bi[j]; }
#pragma unroll
            for (int i = 5; i < 8; ++i)
#pragma unroll
                for (int j = 0; j < 2; ++j) { nv[4 + 2 * (i - 5) + j] = Av[i] + Bv[j]; np[4 + 2 * (i - 5) + j] = Ai[i] * 128 + Bi[j]; }
#pragma unroll
            for (int i = 8; i < 14; ++i) { nv[10 + i - 8] = Av[i] + Bv[0]; np[10 + i - 8] = Ai[i] * 128 + Bi[0]; }
            sort16_p<false>(nv, np);
#pragma unroll
            for (int i = 0; i < 16; ++i) { const bool g = nv[i] > tv[i]; tv[i] = g ? nv[i] : tv[i]; tp[i] = g ? np[i] : tp[i]; }
            merge16_p<true>(tv, tp);
        }
        {
            const float hi = Av[14] + Bv[0], lo = Av[15] + Bv[0]; const int phi = Ai[14] * 128 + Bi[0], plo = Ai[15] * 128 + Bi[0];
            const float t14 = tv[14], t15 = tv[15]; const int q14 = tp[14], q15 = tp[15];
            const bool g14 = lo > t14, g15 = hi > t15;
            tv[14] = g14 ? lo : t14; tp[14] = g14 ? plo : q14; tv[15] = g15 ? hi : t15; tp[15] = g15 ? phi : q15;
        }
        float mx = tv[0];
#pragma unroll
        for (int i = 1; i < 16; ++i) mx = fmaxf(mx, tv[i]);
        float sum = 0.f;
#pragma unroll
        for (int i = 0; i < 16; ++i) { tv[i] = __expf(tv[i] - mx); sum += tv[i]; }
        const float rs = 1.f / sum;
        const size_t ob = (size_t)t * NPAIR + hp * 8;
        int oe[8]; float og[8], ou[8];
#pragma unroll
        for (int k = 0; k < 8; ++k) { const int pa = tp[k], pb = tp[8 + k]; const float va = tv[k], vb = tv[8 + k];
            oe[k] = odd ? pb : pa; const float g = (odd ? vb : va) * rs; og[k] = g * F.VSC[oe[k]]; ou[k] = F.USC[oe[k]]; }
        *(GAS v4u*)(F.IDX + ob) = (v4u){(unsigned)oe[0], (unsigned)oe[1], (unsigned)oe[2], (unsigned)oe[3]};
        *(GAS v4u*)(F.IDX + ob + 4) = (v4u){(unsigned)oe[4], (unsigned)oe[5], (unsigned)oe[6], (unsigned)oe[7]};
        *(GAS f32x4*)(F.GV + ob) = (f32x4){og[0], og[1], og[2], og[3]};
        *(GAS f32x4*)(F.GV + ob + 4) = (f32x4){og[4], og[5], og[6], og[7]};
        *(GAS f32x4*)(F.SU + ob) = (f32x4){ou[0], ou[1], ou[2], ou[3]};
        *(GAS f32x4*)(F.SU + ob + 4) = (f32x4){ou[4], ou[5], ou[6], ou[7]};
    }
}

constexpr int NPS = 5;
constexpr int RING_W = NPS * 2 * ROWB;
static_assert(NWAVES * RING_W <= RING_BYTES, "rings fit the phase scratch region");
typedef unsigned u32x6 __attribute__((ext_vector_type(6)));
typedef float f32x32 __attribute__((ext_vector_type(32)));
typedef __bf16 bf16x32 __attribute__((ext_vector_type(32)));
typedef __bf16 bf16x2 __attribute__((ext_vector_type(2)));
__device__ __forceinline__ float gelu_erf(float z) { return 0.5f * z * (1.0f + erff(z * 0.70710678118654752f)); }
__device__ __forceinline__ void p7_sort512(int (&key)[8], int lane) {
#pragma unroll
    for (int k = 2; k <= 512; k <<= 1) {
#pragma unroll
        for (int j = k >> 1; j > 0; j >>= 1) {
            if (j >= 64) {
                const int jr = j >> 6;
#pragma unroll
                for (int r = 0; r < 8; ++r) if ((r & jr) == 0) { const int rp = r | jr; const bool asc = ((64 * r) & k) == 0;
                    const int a = key[r], b = key[rp], mn = imin_(a, b), mx = imax_(a, b); key[r] = asc ? mn : mx; key[rp] = asc ? mx : mn; }
            } else {
#pragma unroll
                for (int r = 0; r < 8; ++r) { const int mine = key[r], o = __builtin_amdgcn_ds_bpermute((lane ^ j) << 2, mine); const bool low = (lane & j) == 0, asc = ((64 * r + lane) & k) == 0;
                    key[r] = (low == asc) ? imin_(mine, o) : imax_(mine, o); }
            }
        }
    }
}
__device__ __forceinline__ int sel8i(const int (&a)[8], int r) {
    const int a0 = a[0], a1 = a[1], a2 = a[2], a3 = a[3], a4 = a[4], a5 = a[5], a6 = a[6], a7 = a[7];
    int v = a0; v = r == 1 ? a1 : v; v = r == 2 ? a2 : v; v = r == 3 ? a3 : v; v = r == 4 ? a4 : v; v = r == 5 ? a5 : v; v = r == 6 ? a6 : v; v = r == 7 ? a7 : v; return v;
}
__device__ __forceinline__ float sel8f(const float (&a)[8], int r) {
    const float a0 = a[0], a1 = a[1], a2 = a[2], a3 = a[3], a4 = a[4], a5 = a[5], a6 = a[6], a7 = a[7];
    float v = a0; v = r == 1 ? a1 : v; v = r == 2 ? a2 : v; v = r == 3 ? a3 : v; v = r == 4 ? a4 : v; v = r == 5 ? a5 : v; v = r == 6 ? a6 : v; v = r == 7 ? a7 : v; return v;
}
struct P7Tabs { __amdgpu_buffer_rsrc_t u, v; };
__device__ __forceinline__ void p7_dma_pair(__amdgpu_buffer_rsrc_t rs, LAS unsigned char* slotp, int keya, int keyb, int lane) {
    const int oa = (keya >> 9) * ROWB, ob = (keyb >> 9) * ROWB;
    const int v16 = 16 * lane;
    const int vmid = lane < 32 ? oa + 1024 + v16 : ob + v16 - 512;
    __builtin_amdgcn_raw_ptr_buffer_load_lds(rs, (LAS void*)slotp, 16, v16, oa, 0, 0);
    __builtin_amdgcn_raw_ptr_buffer_load_lds(rs, (LAS void*)(slotp + 1024), 16, vmid, 0, 0, 0);
    __builtin_amdgcn_raw_ptr_buffer_load_lds(rs, (LAS void*)(slotp + 2048), 16, v16, ob + 512, 0, 0);
}
__device__ __forceinline__ u32x6 p7_read_row(const LAS unsigned char* slotp, int lane) {
    const LAS v2u* q = (const LAS v2u*)(slotp + 24 * lane); const v2u a = q[0], b = q[1], c = q[2];
    u32x6 r; r[0] = a.x; r[1] = a.y; r[2] = b.x; r[3] = b.y; r[4] = c.x; r[5] = c.y; return r;
}
__device__ __forceinline__ float p7_dot(const unsigned (&xp)[16], const bf16x32& uf) {
    float s0 = 0.f, s1 = 0.f;
#pragma unroll
    for (int m = 0; m < 16; m += 2) {
        bf16x2 a; a[0] = uf[2 * m]; a[1] = uf[2 * m + 1]; bf16x2 b; b[0] = uf[2 * m + 2]; b[1] = uf[2 * m + 3];
        const unsigned xa = xp[m], xb = xp[m + 1];
        s0 = __builtin_amdgcn_fdot2_f32_bf16(__builtin_bit_cast(bf16x2, xa), a, s0, false);
        s1 = __builtin_amdgcn_fdot2_f32_bf16(__builtin_bit_cast(bf16x2, xb), b, s1, false); }
    return s0 + s1;
}
__device__ __forceinline__ void p7_axpy(float (&acc)[32], float ck, const f32x32& vf) {
#pragma unroll
    for (int r = 0; r < 32; ++r) acc[r] = fmaf(ck, vf[r], acc[r]);
}
#define P7_WAIT_PAIR() asm volatile("s_waitcnt vmcnt(9)" ::: "memory")
static_assert(NPS == 5, "P7_WAIT_PAIR counts 3 * (NPS - 2)");
__device__ __forceinline__ void p7_peer(Frame& F) {
    const int gw = F.vcu * NWAVES + F.wave, NGW = F.G * NWAVES, lane_in = F.lane;
    LAS f32x4* lg = (LAS f32x4*)(F.lds + LNP_OFF); LAS f32x4* lb = lg + 512;
    for (int i = F.tid; i < 512; i += NWAVES * 64) { lg[i] = ((const GAS f32x4*)F.ln2g)[i]; lb[i] = ((const GAS f32x4*)F.ln2b)[i]; }
    LDS_WAIT(); __syncthreads();
    LAS unsigned char* ring = F.lds + RING_OFF + F.wave * RING_W;
    P7Tabs T; T.u = __builtin_amdgcn_make_buffer_rsrc((void*)F.U8, 0, NE * ROWB, 0x00020000); T.v = __builtin_amdgcn_make_buffer_rsrc((void*)F.V8, 0, NE * ROWB, 0x00020000);
#pragma unroll 1
    for (int tg = gw; tg < S / 4; tg += NGW) {
        const int tb = 4 * tg;
        int lane = lane_in; asm volatile("" : "+v"(lane));
        int key[8]; float gvv[8], suv[8];
#pragma unroll
        for (int s = 0; s < 4; ++s)
#pragma unroll
            for (int h = 0; h < 2; ++h) { const size_t o = (size_t)(tb + s) * NPAIR + 64 * h + lane;
                key[2 * s + h] = (F.IDX[o] << 9) | (s << 7) | (64 * h + lane); gvv[2 * s + h] = F.GV[o]; suv[2 * s + h] = F.SU[o]; }
        unsigned xp0[16], xp1[16], xp2[16], xp3[16];
#pragma unroll
        for (int j = 0; j < 8; ++j) {
            const v2u w0 = ((const GAS v2u*)(F.X1 + (size_t)(tb + 0) * D) + lane)[64 * j], w1 = ((const GAS v2u*)(F.X1 + (size_t)(tb + 1) * D) + lane)[64 * j];
            const v2u w2 = ((const GAS v2u*)(F.X1 + (size_t)(tb + 2) * D) + lane)[64 * j], w3 = ((const GAS v2u*)(F.X1 + (size_t)(tb + 3) * D) + lane)[64 * j];
            xp0[2 * j] = w0.x; xp0[2 * j + 1] = w0.y; xp1[2 * j] = w1.x; xp1[2 * j + 1] = w1.y; xp2[2 * j] = w2.x; xp2[2 * j + 1] = w2.y; xp3[2 * j] = w3.x; xp3[2 * j + 1] = w3.y; }
        p7_sort512(key, lane);
        VM_WAIT();
#pragma unroll
        for (int i = 0; i < NPS - 1; ++i) p7_dma_pair(T.u, ring + i * 2 * ROWB, __builtin_amdgcn_readlane(key[0], 2 * i), __builtin_amdgcn_readlane(key[0], 2 * i + 1), lane);
        int rs = 0, prev = NPS - 1;
        float coef[8];
#pragma unroll
        for (int q = 0; q < 8; ++q) coef[q] = 0.f;
#pragma unroll 1
        for (int r = 0; r < 8; ++r) {
            const int kcur = sel8i(key, r), knext = sel8i(key, (r + 1) & 7);
            int zreg = 0;
#pragma unroll 1
            for (int i = 0; i < 64; i += 2) {
                P7_WAIT_PAIR();
                const u32x6 rowa = p7_read_row(ring + rs * 2 * ROWB, lane), rowb = p7_read_row(ring + rs * 2 * ROWB + ROWB, lane);
                {
                    const int ln = (i + 2 * (NPS - 1)) & 63; const bool wrap = i + 2 * (NPS - 1) >= 64;
                    const int ka0 = __builtin_amdgcn_readlane(kcur, ln), ka1 = __builtin_amdgcn_readlane(kcur, ln + 1), kb0 = __builtin_amdgcn_readlane(knext, ln), kb1 = __builtin_amdgcn_readlane(knext, ln + 1);
                    const int k0 = wrap ? kb0 : ka0, k1 = wrap ? kb1 : ka1;
                    if (r == 7 && wrap) p7_dma_pair(T.v, ring + prev * 2 * ROWB, k0, k1, lane); else p7_dma_pair(T.u, ring + prev * 2 * ROWB, k0, k1, lane);
                }
#pragma unroll
                for (int h = 0; h < 2; ++h) {
                    const int kp = __builtin_amdgcn_readlane(kcur, i + h), s = (kp >> 7) & 3;
                    const bf16x32 uf = __builtin_amdgcn_cvt_scalef32_pk32_bf16_fp6(h ? rowb : rowa, 1.0f);
                    float d = 0.f;
                    int sa = s, sb = s, sc = s, sd = s; asm volatile("" : "+s"(sa)); asm volatile("" : "+s"(sb)); asm volatile("" : "+s"(sc)); asm volatile("" : "+s"(sd));
                    if (sa == 0) d = p7_dot(xp0, uf);
                    if (sb == 1) d = p7_dot(xp1, uf);
                    if (sc == 2) d = p7_dot(xp2, uf);
                    if (sd == 3) d = p7_dot(xp3, uf);
                    d = wave_sum_lane63(d);
                    { const int d63 = __builtin_amdgcn_readlane(__float_as_int(d), 63); zreg = lane == i + h ? d63 : zreg; }
                }
                prev = rs; rs = rs + 1 == NPS ? 0 : rs + 1;
            }
            const int s = (kcur >> 7) & 3, pr = kcur & 127, sel = 2 * s + (pr >> 6);
            float su = 0.f, gv = 0.f;
#pragma unroll
            for (int j = 0; j < 8; ++j) { const float a = __int_as_float(__builtin_amdgcn_ds_bpermute((pr & 63) << 2, __float_as_int(suv[j]))), b = __int_as_float(__builtin_amdgcn_ds_bpermute((pr & 63) << 2, __float_as_int(gvv[j]))); su = sel == j ? a : su; gv = sel == j ? b : gv; }
            const float cnew = gelu_erf(__int_as_float(zreg) * su) * gv;
#pragma unroll
            for (int q = 0; q < 8; ++q) { const float old = coef[q]; coef[q] = r == q ? cnew : old; }
        }
        float acc0[32], acc1[32], acc2[32], acc3[32];
#pragma unroll
        for (int q = 0; q < 32; ++q) { acc0[q] = 0.f; acc1[q] = 0.f; acc2[q] = 0.f; acc3[q] = 0.f; }
#pragma unroll 1
        for (int r = 0; r < 8; ++r) {
            const int kcur = sel8i(key, r), knext = sel8i(key, r < 7 ? r + 1 : 7); const float ccur = sel8f(coef, r);
#pragma unroll 1
            for (int i = 0; i < 64; i += 2) {
                P7_WAIT_PAIR();
                {
                    const int ln = (i + 2 * (NPS - 1)) & 63; const bool wrap = i + 2 * (NPS - 1) >= 64;
                    const int ka0 = __builtin_amdgcn_readlane(kcur, ln), ka1 = __builtin_amdgcn_readlane(kcur, ln + 1);
                    const int kb0 = __builtin_amdgcn_readlane(knext, r < 7 ? ln : 62), kb1 = __builtin_amdgcn_readlane(knext, r < 7 ? ln + 1 : 63);
                    p7_dma_pair(T.v, ring + prev * 2 * ROWB, wrap ? kb0 : ka0, wrap ? kb1 : ka1, lane);
                }
#pragma unroll
                for (int h = 0; h < 2; ++h) {
                    const int kp = __builtin_amdgcn_readlane(kcur, i + h), s = (kp >> 7) & 3;
                    const float ck = __int_as_float(__builtin_amdgcn_readlane(__float_as_int(ccur), i + h));
                    const u32x6 row = p7_read_row(ring + rs * 2 * ROWB + h * ROWB, lane);
                    const f32x32 vf = __builtin_amdgcn_cvt_scalef32_pk32_f32_fp6(row, 1.0f);
                    int sa = s, sb = s, sc = s, sd = s; asm volatile("" : "+s"(sa)); asm volatile("" : "+s"(sb)); asm volatile("" : "+s"(sc)); asm volatile("" : "+s"(sd));
                    if (sa == 0) p7_axpy(acc0, ck, vf);
                    if (sb == 1) p7_axpy(acc1, ck, vf);
                    if (sc == 2) p7_axpy(acc2, ck, vf);
                    if (sd == 3) p7_axpy(acc3, ck, vf);
                }
                prev = rs; rs = rs + 1 == NPS ? 0 : rs + 1;
            }
        }
        VM_WAIT();
#pragma unroll
        for (int s = 0; s < 4; ++s) {
            asm volatile("" ::: "memory"); __builtin_amdgcn_sched_barrier(0);
            float (&acc)[32] = s == 0 ? acc0 : s == 1 ? acc1 : s == 2 ? acc2 : acc3;
            const GAS v2u* xr = (const GAS v2u*)(F.X1 + (size_t)(tb + s) * D) + lane;
            float sum = 0.f;
#pragma unroll
            for (int j = 0; j < 8; ++j) { const v2u w = xr[64 * j];
                acc[4 * j + 0] = fmaf(ALPHA, bf_lo(w.x), acc[4 * j + 0]); acc[4 * j + 1] = fmaf(ALPHA, bf_hi(w.x), acc[4 * j + 1]);
                acc[4 * j + 2] = fmaf(ALPHA, bf_lo(w.y), acc[4 * j + 2]); acc[4 * j + 3] = fmaf(ALPHA, bf_hi(w.y), acc[4 * j + 3]); }
#pragma unroll
            for (int q = 0; q < 32; ++q) sum += acc[q];
            const float mean = __int_as_float(__builtin_amdgcn_readlane(__float_as_int(wave_sum_lane63(sum)), 63)) * (1.f / D); float s2 = 0.f;
#pragma unroll
            for (int q = 0; q < 32; ++q) { acc[q] -= mean; s2 = fmaf(acc[q], acc[q], s2); }
            const float rstd = 1.f / sqrtf(__int_as_float(__builtin_amdgcn_readlane(__float_as_int(wave_sum_lane63(s2)), 63)) * (1.f / D) + LN_EPS);
            GAS f32x4* orow = (GAS f32x4*)(F.out + (size_t)(tb + s) * D) + lane;
#pragma unroll
            for (int j = 0; j < 8; ++j) { const f32x4 g = lg[lane + 64 * j], b = lb[lane + 64 * j];
                f32x4 o; o.x = acc[4 * j + 0] * rstd * g.x + b.x; o.y = acc[4 * j + 1] * rstd * g.y + b.y; o.z = acc[4 * j + 2] * rstd * g.z + b.z; o.w = acc[4 * j + 3] * rstd * g.w + b.w;
                orow[64 * j] = o; }
        }
    }
}

struct Args { const float* in[19]; float* out; unsigned char* ws; int ph_lo, ph_hi, li, pad; };
__global__ void __launch_bounds__(NWAVES * 64, 2) peer_layer_fwd(Args args) {
    extern __shared__ __attribute__((aligned(16))) unsigned char lds[];
    Frame F;
    F.lds = (LAS unsigned char*)lds;
    F.MISC = (volatile LAS unsigned*)(F.lds + MISC_OFF);
    F.tid = threadIdx.x; F.lane = F.tid & 63; F.wave = __builtin_amdgcn_readfirstlane(F.tid >> 6);
    F.G = gridDim.x; { const int bx = blockIdx.x; F.vcu = (F.G % 8 == 0) ? (bx % 8) * (F.G / 8) + bx / 8 : bx; }
    unsigned char* ws = args.ws;
    F.ctl = (gu32*)(ws + WS_CTL);
    F.x = args.in[0]; F.w_in = args.in[1]; F.b_in = args.in[2]; F.ccw = args.in[3]; F.ccb = args.in[4]; F.clg = args.in[5]; F.clb = args.in[6];
    F.scw = args.in[7]; F.scbias = args.in[8]; F.w_out = args.in[9]; F.b_out = args.in[10]; F.ln1g = args.in[11]; F.ln1b = args.in[12];
    F.w_q = args.in[13]; F.sub_keys = args.in[14]; F.peer_u = args.in[15]; F.peer_v = args.in[16]; F.ln2g = args.in[17]; F.ln2b = args.in[18];
    F.out = args.out;
    F.XB = (bf16*)(ws + WS_XB); F.BT1 = (bf16*)(ws + WS_BT1); F.BT2 = (bf16*)(ws + WS_BT2); F.BT3 = (bf16*)(ws + WS_BT3);
    F.AGLU = (bf16*)(ws + WS_AGLU); F.CV = (bf16*)(ws + WS_CV); F.SCB = (bf16*)(ws + WS_SCB); F.MIX = (bf16*)(ws + WS_MIX); F.X1 = (bf16*)(ws + WS_X1);
    F.Y = (bf16*)(ws + WS_Y); F.SS = (float*)(ws + WS_S); F.IDX = (int*)(ws + WS_IDX); F.GV = (float*)(ws + WS_GV); F.SU = (float*)(ws + WS_SU);
    F.U8 = ws + WS_U8; F.V8 = ws + WS_V8; F.USC = (float*)(ws + WS_USC); F.VSC = (float*)(ws + WS_VSC);
    for (int u = F.tid; u < (LDS_BYTES - LDSCTL_OFF) / 4; u += NWAVES * 64) ((LAS unsigned*)(F.lds + LDSCTL_OFF))[u] = 0u;
    __syncthreads();
    XcdBarrier bar; bar.bar = (unsigned*)(F.ctl + CW_BAR); bar.x = 0; bar.st = nullptr;
    if (N_LAUNCHES == 1) bar = xcd_barrier_post((unsigned*)(F.ctl + CW_BAR), F.MISC + 8);
    const int lo = args.ph_lo, hi = args.ph_hi;
#ifndef ONLY_PHASE
#define ONLY_PHASE -1
#endif
#define IN(k) ((ONLY_PHASE < 0 || ONLY_PHASE == (k)) && lo <= (k) && (k) < hi)
#define SEAM(k) do { if (IN(k) && IN((k) + 1)) xcd_barrier(bar); } while (0)
#ifndef REPEAT_PHASE
#define REPEAT_PHASE -1
#endif
#define REPS(k) for (int rep_ = 0; rep_ < (REPEAT_PHASE == (k) ? 2 : 1); ++rep_)

    if (IN(0)) { REPS(0) p0_prologue(F); SEAM(0); }
    if (IN(1)) { REPS(1) {
        if (F.G == 256) { if (blockIdx.x >= 128) p0_peer_tables(F, ((int)blockIdx.x - 128) * NWAVES + F.wave, 128 * NWAVES); }
        else p0_peer_tables(F, F.vcu * NWAVES + F.wave, F.G * NWAVES);
        __syncthreads();
        pg8::Gemm g{F.XB, F.BT1, S, NIN, D}; pg8::StaticOrder So; So.init(S, NIN, F.G, (int)blockIdx.x);
        pg8::EpiInProj E{F.AGLU, F.CV, F.SCB, F.b_in};
        pg8::gemm_phase<pg8::EpiInProj, pg8::StaticOrder, PG8_ALIGN, PG8_SP2>(F.lds + RING_OFF, g, So, E); }
        SEAM(1);
    }
    if (IN(2)) { REPS(2) for (int u = F.vcu; u < S / 32; u += F.G) p2_unit(F, u); SEAM(2); }
    if (IN(3)) { REPS(3) {
        pg8::Gemm g{F.MIX, F.BT2, S, D, D}; pg8::StaticOrder So; So.init(S, D, F.G, (int)blockIdx.x);
        pg8::EpiOutProj E{F.Y, F.b_out, F.XB, ALPHA};
        pg8::gemm_phase<pg8::EpiOutProj, pg8::StaticOrder, PG8_ALIGN, PG8_SP2>(F.lds + RING_OFF, g, So, E); }
        SEAM(3);
    }
    if (IN(4)) { REPS(4) p4_ln1(F); SEAM(4); }
    if (IN(5)) { REPS(5) {
        pg8::Gemm g{F.X1, F.BT3, S, D, D}; pg8::StaticOrder So; So.init(S, D, F.G, (int)blockIdx.x);
        pg8::EpiF32 E{F.SS, D};
        pg8::gemm_phase<pg8::EpiF32, pg8::StaticOrder, PG8_ALIGN, PG8_SP2>(F.lds + RING_OFF, g, So, E); }
        SEAM(5);
    }
    if (IN(6)) { REPS(6) p6_topk(F); SEAM(6); }
    if (IN(7)) { REPS(7) p7_peer(F); }
#undef IN
#undef SEAM
}

extern "C" void kernel_launch(void* const* d_in, const int* in_sizes, int n_in, void* d_out, int out_size, void* d_ws, size_t ws_size, hipStream_t stream) {
    static int grid = 0;
    if (grid == 0) {
        if (n_in != 19 || in_sizes[0] != S * D || out_size != S * D || ws_size < WS_END) {
            fprintf(stderr, "kernel_launch: built for 19 inputs, x/out of %d floats, >= %zu bytes of workspace; got n_in %d, in0 %d, out %d, ws %zu; nothing launched\n", S * D, (size_t)WS_END, n_in, n_in > 0 ? in_sizes[0] : -1, out_size, ws_size);
            grid = -1; return; }
        int dev = 0, cus = 0, per_cu = 0;
        if (hipGetDevice(&dev) != hipSuccess || hipDeviceGetAttribute(&cus, hipDeviceAttributeMultiprocessorCount, dev) != hipSuccess) { fprintf(stderr, "kernel_launch: device query failed\n"); grid = -1; return; }
        if (hipFuncSetAttribute((const void*)peer_layer_fwd, hipFuncAttributeMaxDynamicSharedMemorySize, LDS_BYTES) != hipSuccess) { fprintf(stderr, "kernel_launch: hipFuncSetAttribute failed\n"); grid = -1; return; }
        if (hipOccupancyMaxActiveBlocksPerMultiprocessor(&per_cu, (const void*)peer_layer_fwd, NWAVES * 64, LDS_BYTES) != hipSuccess || per_cu < 1) {
            fprintf(stderr, "kernel_launch: occupancy query reports %d workgroups per CU; nothing launched\n", per_cu); (void)hipGetLastError(); grid = -1; return; }
        (void)hipGetLastError();
        grid = cus;
    }
    if (grid < 0) return;
    if (hipMemsetAsync((char*)d_ws + WS_CTL, 0, CTL_ZERO_BYTES, stream) != hipSuccess) { fprintf(stderr, "kernel_launch: hipMemsetAsync failed\n"); return; }
    Args a{};
    for (int i = 0; i < 19; ++i) a.in[i] = (const float*)d_in[i];
    a.out = (float*)d_out; a.ws = (unsigned char*)d_ws;
    for (int li = 0; li < N_LAUNCHES; ++li) {
        a.ph_lo = (N_LAUNCHES == 1) ? 0 : li; a.ph_hi = (N_LAUNCHES == 1) ? N_PHASES : li + 1; a.li = li;
        hipError_t le;
        if (N_LAUNCHES == 1) { void* kargs[] = {&a}; le = hipLaunchCooperativeKernel((const void*)peer_layer_fwd, dim3(grid), dim3(NWAVES * 64), kargs, LDS_BYTES, stream); }
        else { hipLaunchKernelGGL(peer_layer_fwd, dim3(grid), dim3(NWAVES * 64), LDS_BYTES, stream, a); le = hipPeekAtLastError(); }
        if (le != hipSuccess) { fprintf(stderr, "kernel_launch: launch %d failed: %s (grid %d x %d threads, %d B LDS)\n", li, hipGetErrorName(le), grid, NWAVES * 64, LDS_BYTES); break; }
    }
}
```

```cpp
#include <hip/hip_runtime.h>
#include <cstdio>
#include <cstdint>
namespace pg8 {
#define PG8_LAS __attribute__((address_space(3)))
typedef unsigned short bf16_t;
typedef short bf16x8 __attribute__((ext_vector_type(8)));
typedef float f32x4 __attribute__((ext_vector_type(4)));
typedef unsigned u32x4 __attribute__((ext_vector_type(4)));
constexpr int BM = 256, BK = 64, HALF = 128, HTB = HALF * BK * 2  , STAGE_BYTES = 8 * HTB, NXCD = 8, WGM = 8;

__host__ __device__ __forceinline__ int lds_byte(int r, int c) { const int st = (r >> 4) * 2 + (c >> 5), rr = r & 15, cc = c & 31, ob = rr * 64 + cc * 2; return st * 1024 + (ob ^ (((ob >> 9) & 1) << 5)); }
__host__ __device__ __forceinline__ void stage_rc(int b, int& R, int& C) { const int st = b / 1024, sb = b % 1024, swz = sb ^ (((sb >> 9) & 1) << 5); R = (st >> 1) * 16 + swz / 64; C = (st & 1) * 32 + (swz % 64) / 2; }
__host__ __device__ __forceinline__ int perm32(int rho) { const int n = rho >> 4, i = rho & 15; return 8 * (i >> 2) + 4 * n + (i & 3); }

struct Unit { int pm, pn; };
struct Gemm { const bf16_t* A; const bf16_t* Bt; int M, N, K; };

struct StaticOrder {
    int nM, nN, nwg, G, c;
    __host__ __device__ void init(int M, int N, int G_, int c_) { nM = M / BM; nN = N / BM; nwg = nM * nN; G = G_; c = c_; }
    __host__ __device__ bool next(int i, Unit& u) const {
        const long L = (long)i * G + c; if (L >= nwg) return false;
        int wgid = (int)L; { const int q = nwg / NXCD, r = nwg % NXCD, xcd = wgid % NXCD, off = wgid / NXCD; wgid = (xcd < r ? xcd * (q + 1) : r * (q + 1) + (xcd - r) * q) + off; }
        const int nig = WGM * nN, gid = wgid / nig, fm = gid * WGM, gsz = (nM - fm) < WGM ? (nM - fm) : WGM;
        u.pm = fm + ((wgid % nig) % gsz); u.pn = (wgid % nig) / gsz; return true;
    }
    __device__ __forceinline__ void a_ready(const Unit&) const {}
    __device__ __forceinline__ void done(const Unit&) const {}
};

__device__ __forceinline__ unsigned cvt_pk_bf16(float lo, float hi) { unsigned r; asm volatile("v_cvt_pk_bf16_f32 %0, %1, %2" : "=v"(r) : "v"(lo), "v"(hi)); return r; }
__device__ __forceinline__ float sigmoidf_fast(float g) { return __builtin_amdgcn_rcpf(1.0f + __expf(-g)); }

struct EpiInProj {
    static constexpr bool PERM = true, AFTER_DRAIN = false;
    bf16_t* aglu; bf16_t* cv; bf16_t* scb; const float* b_in;
    __device__ __forceinline__ void operator()(const f32x4 (&acc)[2][2][4][2], const Unit& u, int wr, int wc, int fr, int fq) const {
        const int row0 = u.pm * BM + wr * 64 + fr, cc = wc * 32 + 8 * fq;
        if (u.pn < 16) {
            const bool conf = u.pn < 8; const int j = conf ? u.pn : u.pn - 8;
            const float* b0 = b_in + (conf ? 0 : 3072) + 128 * j + cc;
            const float* b1 = b_in + (conf ? 1024 : 4096) + 128 * j + cc;
            bf16_t* O = (conf ? aglu : cv) + 128 * j + cc;
            f32x4 bv0[2], bv1[2];
#pragma unroll
            for (int n = 0; n < 2; ++n) { bv0[n] = *(const f32x4*)(b0 + 4 * n); bv1[n] = *(const f32x4*)(b1 + 4 * n); }
#pragma unroll
            for (int ai = 0; ai < 2; ++ai)
#pragma unroll
                for (int m = 0; m < 4; ++m) {
                    f32x4 r[2];
#pragma unroll
                    for (int n = 0; n < 2; ++n) { const f32x4 a = acc[ai][0][m][n] + bv0[n]; f32x4 g = acc[ai][1][m][n] + bv1[n];
                        if (conf) { g[0] = sigmoidf_fast(g[0]); g[1] = sigmoidf_fast(g[1]); g[2] = sigmoidf_fast(g[2]); g[3] = sigmoidf_fast(g[3]); }
                        r[n] = a * g; }
                    u32x4 w; w.x = cvt_pk_bf16(r[0][0], r[0][1]); w.y = cvt_pk_bf16(r[0][2], r[0][3]); w.z = cvt_pk_bf16(r[1][0], r[1][1]); w.w = cvt_pk_bf16(r[1][2], r[1][3]);
                    *(u32x4*)(O + (size_t)(row0 + ai * HALF + m * 16) * 1024) = w; }
        } else {
            const int j = u.pn - 16;
#pragma unroll
            for (int bj = 0; bj < 2; ++bj) {
                const float* b0 = b_in + 2048 + 256 * j + 128 * bj + cc; bf16_t* O = scb + 256 * j + 128 * bj + cc;
                const f32x4 bva = *(const f32x4*)(b0), bvb = *(const f32x4*)(b0 + 4);
#pragma unroll
                for (int ai = 0; ai < 2; ++ai)
#pragma unroll
                    for (int m = 0; m < 4; ++m) { const f32x4 v0 = acc[ai][bj][m][0] + bva, v1 = acc[ai][bj][m][1] + bvb;
                        u32x4 w; w.x = cvt_pk_bf16(v0[0], v0[1]); w.y = cvt_pk_bf16(v0[2], v0[3]); w.z = cvt_pk_bf16(v1[0], v1[1]); w.w = cvt_pk_bf16(v1[2], v1[3]);
                        *(u32x4*)(O + (size_t)(row0 + ai * HALF + m * 16) * 1024) = w; } }
        }
    }
};
struct EpiOutProj {
    static constexpr bool PERM = true, AFTER_DRAIN = false;
    bf16_t* Y; const float* bias; const bf16_t* xb; float alpha;
    __device__ __forceinline__ void operator()(const f32x4 (&acc)[2][2][4][2], const Unit& u, int wr, int wc, int fr, int fq) const {
        const int row0 = u.pm * BM + wr * 64 + fr, col0 = u.pn * BM + wc * 32 + 8 * fq;
        f32x4 bv[2][2];
#pragma unroll
        for (int bj = 0; bj < 2; ++bj)
#pragma unroll
            for (int n = 0; n < 2; ++n) bv[bj][n] = *(const f32x4*)(bias + col0 + bj * HALF + 4 * n);
#pragma unroll
        for (int ai = 0; ai < 2; ++ai)
#pragma unroll
            for (int m = 0; m < 4; ++m) { const size_t off = (size_t)(row0 + ai * HALF + m * 16) * 2048 + col0;
#pragma unroll
                for (int bj = 0; bj < 2; ++bj) { const u32x4 xw = *(const u32x4*)(xb + off + bj * HALF);
                    f32x4 v0 = acc[ai][bj][m][0] + bv[bj][0], v1 = acc[ai][bj][m][1] + bv[bj][1];
                    v0[0] += alpha * __uint_as_float(xw.x << 16); v0[1] += alpha * __uint_as_float(xw.x & 0xffff0000u); v0[2] += alpha * __uint_as_float(xw.y << 16); v0[3] += alpha * __uint_as_float(xw.y & 0xffff0000u);
                    v1[0] += alpha * __uint_as_float(xw.z << 16); v1[1] += alpha * __uint_as_float(xw.z & 0xffff0000u); v1[2] += alpha * __uint_as_float(xw.w << 16); v1[3] += alpha * __uint_as_float(xw.w & 0xffff0000u);
                    u32x4 w; w.x = cvt_pk_bf16(v0[0], v0[1]); w.y = cvt_pk_bf16(v0[2], v0[3]); w.z = cvt_pk_bf16(v1[0], v1[1]); w.w = cvt_pk_bf16(v1[2], v1[3]);
                    *(u32x4*)(Y + off + bj * HALF) = w; }
                asm volatile("" ::: "memory"); }
    }
};
struct EpiF32 {
    static constexpr bool PERM = false, AFTER_DRAIN = false;
    float* C; int ldc;
    __device__ __forceinline__ void operator()(const f32x4 (&acc)[2][2][4][2], const Unit& u, int wr, int wc, int fr, int fq) const {
        const int row0 = u.pm * BM + wr * 64 + fr, col0 = u.pn * BM + wc * 32 + 4 * fq;
#pragma unroll
        for (int ai = 0; ai < 2; ++ai)
#pragma unroll
            for (int m = 0; m < 4; ++m) { float* rowp = C + (size_t)(row0 + ai * HALF + m * 16) * ldc + col0;
#pragma unroll
                for (int bj = 0; bj < 2; ++bj)
#pragma unroll
                    for (int n = 0; n < 2; ++n) *(f32x4*)(rowp + bj * HALF + n * 16) = acc[ai][bj][m][n]; }
    }
};

template <class Epi, class Sched, bool ALIGN_EPI = false, bool SP2 = false>
__device__ __forceinline__ void gemm_phase(PG8_LAS unsigned char* lds, const Gemm g, const Sched& S, const Epi& E) {
    const int tid = threadIdx.x, wid = __builtin_amdgcn_readfirstlane(tid >> 6), lane = tid & 63, wr = wid >> 2, wc = wid & 3, fr = lane & 15, fq = lane >> 4;
    const int K = g.K, nt = K / BK;
    unsigned voffA[2], voffB[2];
#pragma unroll
    for (int i = 0; i < 2; ++i) { int R, C; stage_rc(tid * 16 + i * 8192, R, C); const int Rb = Epi::PERM ? ((R & ~31) + perm32(R & 31)) : R;
        voffA[i] = (unsigned)(R * K + C) * 2u; voffB[i] = (unsigned)(Rb * K + C) * 2u; }
    const size_t kstep = (size_t)(BK * 2);
    const size_t hstep = (size_t)HALF * K * 2;
    const size_t tstep = 2 * hstep;
    const unsigned ldsw = (unsigned)wid * 1024u;
    const int aoff = lds_byte(wr * 64 + fr, fq * 8), boff = lds_byte(wc * 32 + fr, fq * 8);
#define PG8_SA(b, h) (((b) * 2 + (h)) * HTB)
#define PG8_SB(b, h) ((4 + (b) * 2 + (h)) * HTB)
#define PG8_STAGE(bufoff, gbase, voff) do { _Pragma("unroll") for (int _i = 0; _i < 2; ++_i) \
        __builtin_amdgcn_global_load_lds((const unsigned*)((const char*)(gbase) + (voff)[_i]), (PG8_LAS unsigned*)(lds + (bufoff) + ldsw + _i * 8192), 16, 0, 0); } while (0)
#define PG8_LDA(dst, b, h) do { _Pragma("unroll") for (int m = 0; m < 4; ++m) _Pragma("unroll") for (int k = 0; k < 2; ++k) dst[m][k] = *(const PG8_LAS bf16x8*)(lds + PG8_SA(b, h) + aoff + m * 2048 + k * 1024); } while (0)
#define PG8_LDB(dst, b, h) do { _Pragma("unroll") for (int n = 0; n < 2; ++n) _Pragma("unroll") for (int k = 0; k < 2; ++k) dst[n][k] = *(const PG8_LAS bf16x8*)(lds + PG8_SB(b, h) + boff + n * 2048 + k * 1024); } while (0)
#define PG8_MMA(ai, bj, At, Bt) do { __builtin_amdgcn_s_setprio(1); _Pragma("unroll") for (int m = 0; m < 4; ++m) _Pragma("unroll") for (int n = 0; n < 2; ++n) _Pragma("unroll") for (int k = 0; k < 2; ++k) \
        acc[ai][bj][m][n] = __builtin_amdgcn_mfma_f32_16x16x32_bf16(Bt[n][k], At[m][k], acc[ai][bj][m][n], 0, 0, 0); __builtin_amdgcn_s_setprio(0); } while (0)
#define PG8_WAIT_V(n) asm volatile("s_waitcnt vmcnt(" #n ")" ::: "memory")
#define PG8_WAIT_L(n) asm volatile("s_waitcnt lgkmcnt(" #n ")" ::: "memory")
#define PG8_BAR __builtin_amdgcn_s_barrier()
#define PG8_SCHED __builtin_amdgcn_sched_barrier(0)
    Unit cur, nxt; int ui = 0;
    if (!S.next(0, cur)) return;
    f32x4 acc[2][2][4][2];
#pragma unroll
    for (int a = 0; a < 2; ++a)
#pragma unroll
        for (int b = 0; b < 2; ++b)
#pragma unroll
            for (int m = 0; m < 4; ++m)
#pragma unroll
                for (int n = 0; n < 2; ++n) acc[a][b][m][n] = (f32x4){0.f, 0.f, 0.f, 0.f};
    bf16x8 At[4][2], B0[2][2], B1[2][2];
    const char* cA = (const char*)g.A + (size_t)cur.pm * tstep; const char* cB = (const char*)g.Bt + (size_t)cur.pn * tstep;
    S.a_ready(cur);
    if constexpr (SP2) {
        PG8_STAGE(PG8_SB(0, 0), cB, voffB); PG8_STAGE(PG8_SB(0, 1), cB + hstep, voffB); PG8_STAGE(PG8_SA(0, 0), cA, voffA); PG8_STAGE(PG8_SA(0, 1), cA + hstep, voffA);
        if (wr == 1) PG8_BAR;
        PG8_WAIT_V(2); PG8_BAR;
        PG8_STAGE(PG8_SB(1, 0), cB + kstep, voffB); PG8_STAGE(PG8_SA(1, 0), cA + kstep, voffA); PG8_STAGE(PG8_SB(1, 1), cB + hstep + kstep, voffB);
        PG8_WAIT_V(6); PG8_BAR;
    } else {
        PG8_STAGE(PG8_SB(0, 0), cB, voffB); PG8_STAGE(PG8_SA(0, 0), cA, voffA); PG8_STAGE(PG8_SB(0, 1), cB + hstep, voffB); PG8_STAGE(PG8_SA(0, 1), cA + hstep, voffA);
        if (wr == 1) PG8_BAR;
        PG8_WAIT_V(4); PG8_BAR;
        PG8_STAGE(PG8_SB(1, 0), cB + kstep, voffB); PG8_STAGE(PG8_SA(1, 0), cA + kstep, voffA); PG8_STAGE(PG8_SB(1, 1), cB + hstep + kstep, voffB);
        PG8_WAIT_V(6); PG8_BAR;
    }
    for (;;) {
        const bool has_next = S.next(ui + 1, nxt);
        const char* nA = has_next ? (const char*)g.A + (size_t)nxt.pm * tstep : cA; const char* nB = has_next ? (const char*)g.Bt + (size_t)nxt.pn * tstep : cB;
        for (int t = 0; t < nt; t += 2) {
            const bool last = (t == nt - 2);
            const char* a1 = cA + (size_t)(t + 1) * kstep;
            const char* a2 = last ? nA : cA + (size_t)(t + 2) * kstep; const char* b2 = last ? nB : cB + (size_t)(t + 2) * kstep;
            const char* a3 = a2 + kstep; const char* b3 = b2 + kstep;
            if (last && has_next) S.a_ready(nxt);
            if constexpr (SP2) {
            PG8_LDB(B0, 0, 0); PG8_LDB(B1, 0, 1); PG8_SCHED; PG8_LDA(At, 0, 0); PG8_STAGE(PG8_SA(1, 1), a1 + hstep, voffA);
            PG8_WAIT_V(8); PG8_WAIT_L(0); PG8_BAR; PG8_MMA(0, 0, At, B0); PG8_MMA(0, 1, At, B1); PG8_BAR; PG8_SCHED;
            PG8_LDA(At, 0, 1); PG8_STAGE(PG8_SB(0, 0), b2, voffB); PG8_STAGE(PG8_SB(0, 1), b2 + hstep, voffB); PG8_STAGE(PG8_SA(0, 0), a2, voffA);
            PG8_WAIT_V(8); PG8_WAIT_L(0); PG8_BAR; PG8_MMA(1, 0, At, B0); PG8_MMA(1, 1, At, B1); PG8_BAR; PG8_SCHED;
            PG8_LDB(B0, 1, 0); PG8_LDB(B1, 1, 1); PG8_SCHED; PG8_LDA(At, 1, 0); PG8_STAGE(PG8_SA(0, 1), a2 + hstep, voffA);
            PG8_WAIT_V(8); PG8_WAIT_L(0); PG8_BAR; PG8_MMA(0, 0, At, B0); PG8_MMA(0, 1, At, B1); PG8_BAR; PG8_SCHED;
            PG8_LDA(At, 1, 1); PG8_STAGE(PG8_SB(1, 0), b3, voffB); PG8_STAGE(PG8_SB(1, 1), b3 + hstep, voffB); PG8_STAGE(PG8_SA(1, 0), a3, voffA);
            PG8_WAIT_V(8); PG8_WAIT_L(0); PG8_BAR; PG8_MMA(1, 0, At, B0); PG8_MMA(1, 1, At, B1); PG8_BAR; PG8_SCHED;
            } else {
            PG8_LDB(B0, 0, 0); PG8_SCHED; PG8_LDA(At, 0, 0); PG8_STAGE(PG8_SA(1, 1), a1 + hstep, voffA);
            PG8_WAIT_L(8); PG8_BAR; PG8_WAIT_L(0); PG8_MMA(0, 0, At, B0); PG8_BAR; PG8_SCHED;
            PG8_LDB(B1, 0, 1); PG8_STAGE(PG8_SB(0, 0), b2, voffB);
            PG8_BAR; PG8_WAIT_L(0); PG8_MMA(0, 1, At, B1); PG8_BAR;
            PG8_LDA(At, 0, 1); PG8_STAGE(PG8_SA(0, 0), a2, voffA);
            PG8_BAR; PG8_WAIT_L(0); PG8_MMA(1, 0, At, B0); PG8_BAR; PG8_SCHED;
            PG8_STAGE(PG8_SB(0, 1), b2 + hstep, voffB);
            PG8_WAIT_V(6); PG8_BAR; PG8_MMA(1, 1, At, B1); PG8_BAR;
            PG8_LDB(B0, 1, 0); PG8_SCHED; PG8_LDA(At, 1, 0); PG8_STAGE(PG8_SA(0, 1), a2 + hstep, voffA);
            PG8_WAIT_L(8); PG8_BAR; PG8_WAIT_L(0); PG8_MMA(0, 0, At, B0); PG8_BAR; PG8_SCHED;
            PG8_LDB(B1, 1, 1); PG8_STAGE(PG8_SB(1, 0), b3, voffB);
            PG8_BAR; PG8_WAIT_L(0); PG8_MMA(0, 1, At, B1); PG8_BAR;
            PG8_LDA(At, 1, 1); PG8_STAGE(PG8_SA(1, 0), a3, voffA);
            PG8_BAR; PG8_WAIT_L(0); PG8_MMA(1, 0, At, B0); PG8_BAR; PG8_SCHED;
            PG8_STAGE(PG8_SB(1, 1), b3 + hstep, voffB);
            PG8_WAIT_V(6); PG8_BAR; PG8_MMA(1, 1, At, B1); PG8_BAR;
            }
        }
        if constexpr (ALIGN_EPI) { if (wr == 0) PG8_BAR; }
        if constexpr (!Epi::AFTER_DRAIN) { E(acc, cur, wr, wc, fr, fq); S.done(cur); }
        if (!has_next) break;
#pragma unroll
        for (int a = 0; a < 2; ++a)
#pragma unroll
            for (int b = 0; b < 2; ++b)
#pragma unroll
                for (int m = 0; m < 4; ++m)
#pragma unroll
                    for (int n = 0; n < 2; ++n) acc[a][b][m][n] = (f32x4){0.f, 0.f, 0.f, 0.f};
        cur = nxt; cA = nA; cB = nB; ++ui;
        if constexpr (ALIGN_EPI) { if (wr == 1) PG8_BAR; }
    }
    PG8_WAIT_V(0);
    if constexpr (!ALIGN_EPI) { if (wr == 0) PG8_BAR; }
    PG8_BAR;
    if constexpr (Epi::AFTER_DRAIN) { E.fused(acc, cur, wr, wc, fr, fq, lds, wid, lane); S.done(cur); }
#undef PG8_SA
#undef PG8_SB
#undef PG8_STAGE
#undef PG8_LDA
#undef PG8_LDB
#undef PG8_MMA
#undef PG8_WAIT_V
#undef PG8_WAIT_L
#undef PG8_BAR
#undef PG8_SCHED
}
}

#ifndef PG8_SP2
#define PG8_SP2 true
#endif
#ifndef PG8_ALIGN
#define PG8_ALIGN true
#endif
constexpr int NWAVES = 8;
#ifndef MK_N_LAUNCHES
#define MK_N_LAUNCHES 1
#endif
constexpr int N_PHASES = 8;
constexpr int N_LAUNCHES = MK_N_LAUNCHES;

constexpr int ROWB = 1536;
constexpr int S = 8192, D = 2048, NIN = 5120, DC = 1024, NE = 16384, NPAIR = 128;
constexpr float LN_EPS = 1e-5f;
constexpr float ALPHA = 1.189207115002721f;

constexpr size_t MiB = 1u << 20;
constexpr size_t WS_CTL = 0, CTL_ZERO_BYTES = 64 * 1024;
constexpr size_t WS_XB = 2 * MiB;
constexpr size_t WS_BT1 = 34 * MiB;
constexpr size_t WS_BT2 = 54 * MiB;
constexpr size_t WS_BT3 = 62 * MiB;
constexpr size_t WS_AGLU = 70 * MiB;
constexpr size_t WS_CV = 86 * MiB;
constexpr size_t WS_SCB = 102 * MiB;
constexpr size_t WS_MIX = 118 * MiB;
constexpr size_t WS_Y = 150 * MiB;
constexpr size_t WS_X1 = 214 * MiB;
constexpr size_t WS_S = 246 * MiB;
constexpr size_t WS_IDX = 310 * MiB;
constexpr size_t WS_GV = 314 * MiB;
constexpr size_t WS_SU = 318 * MiB;
constexpr size_t WS_U8 = 322 * MiB;
constexpr size_t WS_V8 = 354 * MiB;
constexpr size_t WS_USC = 386 * MiB;
constexpr size_t WS_VSC = 386 * MiB + 65536;
constexpr size_t WS_END = 387 * MiB;
constexpr int CW_BAR = 4096;

constexpr int RING_OFF = 0, RING_BYTES = 131072;
constexpr int LDSCTL_OFF = RING_BYTES, MISC_OFF = LDSCTL_OFF + 320;
constexpr int LNP_OFF = MISC_OFF + 128;
constexpr int LDS_BYTES = 155648;

#define GAS __attribute__((address_space(1)))
#define LAS __attribute__((address_space(3)))
typedef unsigned short bf16;
typedef unsigned v4u __attribute__((ext_vector_type(4)));
typedef unsigned v2u __attribute__((ext_vector_type(2)));
typedef float f32x4 __attribute__((ext_vector_type(4)));
typedef float f32x2 __attribute__((ext_vector_type(2)));
typedef short bf16x8 __attribute__((ext_vector_type(8)));
typedef GAS unsigned gu32;
#define LDS_WAIT() asm volatile("s_waitcnt lgkmcnt(0)" ::: "memory")
#define VM_WAIT() asm volatile("s_waitcnt vmcnt(0)" ::: "memory")
__device__ __forceinline__ unsigned pk2(float lo, float hi) { return pg8::cvt_pk_bf16(lo, hi); }
__device__ __forceinline__ float bf_lo(unsigned w) { return __uint_as_float(w << 16); }
__device__ __forceinline__ float bf_hi(unsigned w) { return __uint_as_float(w & 0xffff0000u); }
__device__ __forceinline__ float wave_sum(float v) {
#pragma unroll
    for (int o = 1; o < 64; o <<= 1) v += __shfl_xor(v, o);
    return v;
}
__device__ __forceinline__ float wave_max(float v) {
#pragma unroll
    for (int o = 1; o < 64; o <<= 1) v = fmaxf(v, __shfl_xor(v, o));
    return v;
}

#define XB_TMO      128
#define XB_XCNT(j)  (256  + 64 * (j))
#define XB_XSUB(j)  (1280 + 64 * (j))
#define XB_XGEN(j)  (2304 + 64 * (j))
#define XB_TOP      3328
#define XB_TOPGEN   3392
#define XCD_BAR_WORDS 3456
#define XB_SPIN_CAP (1u << 18)

__device__ __forceinline__ unsigned xb_ld(unsigned* p)              { return __hip_atomic_load(p, __ATOMIC_RELAXED, __HIP_MEMORY_SCOPE_AGENT); }
__device__ __forceinline__ unsigned xb_add(unsigned* p, unsigned v) { return __hip_atomic_fetch_add(p, v, __ATOMIC_RELAXED, __HIP_MEMORY_SCOPE_AGENT); }
__device__ __forceinline__ unsigned xb_xcc_id() { return (unsigned)__builtin_amdgcn_s_getreg((3 << 11) | 20) & 0xFu; }
#define XB_SPIN(cond, bar) do { unsigned _sp = 0; while (cond) { __builtin_amdgcn_s_sleep(1); \
    if ((++_sp & 255u) == 0u) { if (xb_ld(&(bar)[XB_TMO])) break; if (_sp > XB_SPIN_CAP) { atomicAdd(&(bar)[XB_TMO], 1u); break; } } } } while (0)

struct XcdBarrier {
    unsigned* bar; unsigned x;
    volatile LAS unsigned* st;
};

__device__ __forceinline__ XcdBarrier xcd_barrier_post(unsigned* bar, volatile LAS unsigned* st) {
    XcdBarrier b; b.bar = bar; b.x = xb_xcc_id(); b.st = st;
    if (threadIdx.x == 0) (void)xb_add(&bar[XB_XCNT(b.x)], 1u);
    return b;
}
__device__ __forceinline__ void xcd_barrier_complete(unsigned* bar, unsigned x, unsigned& nloc, unsigned& nx) {
    const unsigned G = gridDim.x * gridDim.y * gridDim.z;
    unsigned sum, cnt, mine, sp = 0u;
    for (;;) {
        sum = 0u; cnt = 0u; mine = 0u;
#pragma unroll
        for (unsigned j = 0; j < 16; ++j) { const unsigned c = xb_ld(&bar[XB_XCNT(j)]); sum += c; cnt += (c > 0u) ? 1u : 0u; mine = (j == x) ? c : mine; }
        if (sum == G) break;
        __builtin_amdgcn_s_sleep(1);
        if ((++sp & 255u) == 0u) { if (xb_ld(&bar[XB_TMO])) break; if (sp > XB_SPIN_CAP) { atomicAdd(&bar[XB_TMO], 1u); break; } }
    }
    nloc = mine > 0u ? mine : 1u; nx = cnt > 0u ? cnt : 1u;
}

__device__ __forceinline__ void xcd_barrier(const XcdBarrier& b) {
    asm volatile("s_waitcnt vmcnt(0)" ::: "memory");
    __syncthreads();
    if (threadIdx.x == 0) {
        unsigned* bar = b.bar;
        __builtin_amdgcn_s_waitcnt(0);
        unsigned nloc = b.st[0], nx = b.st[1];
        if (nloc == 0u) { xcd_barrier_complete(bar, b.x, nloc, nx); b.st[0] = nloc; b.st[1] = nx; }
        const unsigned old = xb_add(&bar[XB_XSUB(b.x)], 1u);
        const unsigned gen = old / nloc;
        if (old + 1u == (gen + 1u) * nloc) {
            __builtin_amdgcn_fence(__ATOMIC_RELEASE, "agent");
            asm volatile("s_waitcnt vmcnt(0)" ::: "memory");
            const unsigned og = xb_add(&bar[XB_TOP], 1u);
            const unsigned tg = og / nx;
            if (og + 1u == (tg + 1u) * nx) xb_add(&bar[XB_TOPGEN], 1u);
            else XB_SPIN(xb_ld(&bar[XB_TOPGEN]) == tg, bar);
            __builtin_amdgcn_fence(__ATOMIC_ACQUIRE, "agent");
            xb_add(&bar[XB_XGEN(b.x)], 1u);
            asm volatile("s_waitcnt vmcnt(0)" ::: "memory");
        } else {
            XB_SPIN(xb_ld(&bar[XB_XGEN(b.x)]) == gen, bar);
            __builtin_amdgcn_fence(__ATOMIC_ACQUIRE, "agent");
            asm volatile("s_waitcnt vmcnt(0)" ::: "memory");
        }
    }
    __syncthreads();
}

struct Frame {
    LAS unsigned char* lds;
    volatile LAS unsigned* MISC;
    gu32* ctl;
    int tid, lane, wave, vcu, G;
    const float *x, *w_in, *b_in, *ccw, *ccb, *clg, *clb, *scw, *scbias, *w_out, *b_out, *ln1g, *ln1b, *w_q, *sub_keys, *peer_u, *peer_v, *ln2g, *ln2b;
    float* out;
    bf16 *XB, *BT1, *BT2, *BT3, *AGLU, *CV, *SCB, *MIX, *X1;
    bf16* Y; float* SS; int* IDX; float *GV, *SU; unsigned char *U8, *V8; float *USC, *VSC;
};

__device__ __forceinline__ int bt1_row(int n0) {
    const int grp = n0 >> 10, c = n0 & 1023, j = c >> 7, r = c & 127;
    if (grp == 0) return 256 * j + r;
    if (grp == 1) return 256 * j + 128 + r;
    if (grp == 2) return 4096 + c;
    if (grp == 3) return 2048 + 256 * j + r;
    return 2048 + 256 * j + 128 + r;
}
template <bool PERM_IN>
__device__ __forceinline__ void p0_transpose_item(const float* W, int K, int N, bf16* WT, LAS float* scr, int item, int lane) {
    const int nblk = N / 32, kb = item / nblk, nb = item % nblk, k0 = 64 * kb, n0 = 32 * nb;
    const int drow = PERM_IN ? bt1_row(n0) : n0;
#pragma unroll 8
    for (int i = 0; i < 32; ++i) { const int kk = 2 * i + (lane >> 5); scr[kk * 33 + (lane & 31)] = W[(size_t)(k0 + kk) * N + n0 + (lane & 31)]; }
    LDS_WAIT(); asm volatile("" ::: "memory");
    const int c = lane & 7;
#pragma unroll
    for (int j = 0; j < 4; ++j) { const int n = (lane >> 3) + 8 * j; const LAS float* s = scr + (8 * c) * 33 + n;
        v4u o; o.x = pk2(s[0 * 33], s[1 * 33]); o.y = pk2(s[2 * 33], s[3 * 33]); o.z = pk2(s[4 * 33], s[5 * 33]); o.w = pk2(s[6 * 33], s[7 * 33]);
        *(GAS v4u*)(WT + (size_t)(drow + n) * K + k0 + 8 * c) = o; }
    LDS_WAIT(); asm volatile("" ::: "memory");
}
__device__ __forceinline__ bf16x8 ld8_bf16(const float* p) {
    const f32x4 a = *(const f32x4*)p, b = *(const f32x4*)(p + 4);
    v4u w; w.x = pk2(a.x, a.y); w.y = pk2(a.z, a.w); w.z = pk2(b.x, b.y); w.w = pk2(b.z, b.w);
    return __builtin_bit_cast(bf16x8, w);
}
__device__ __forceinline__ unsigned fp6_encode(float y) {
    const unsigned sb = (__float_as_uint(y) >> 31) << 5;
    const float a = fabsf(y);
    const unsigned sub = (unsigned)__builtin_rintf(a * 8.0f);
    unsigned b = __float_as_uint(a); b += 0x7FFFFu + ((b >> 20) & 1u); b >>= 20;
    unsigned nrm = b - 1008u; nrm = nrm > 31u ? 31u : nrm;
    return sb | (a < 1.0f ? sub : nrm);
}
__device__ __forceinline__ void p0_prologue(Frame& F) {
    LAS float* scr = (LAS float*)(F.lds + RING_OFF + F.wave * 16384);
    const int gw = F.vcu * NWAVES + F.wave, NGW = F.G * NWAVES, lane = F.lane;
    constexpr int I_IN = (D / 64) * (NIN / 32), I_OUT = (D / 64) * (D / 32);
    for (int it = gw; it < I_IN + I_OUT; it += NGW) {
        if (it < I_IN) p0_transpose_item<true>(F.w_in, D, NIN, F.BT1, scr, it, lane);
        else p0_transpose_item<false>(F.w_out, D, D, F.BT2, scr, it - I_IN, lane);
    }
    for (int it = gw; it < 4096; it += NGW) {
        const int hp = it >> 8, nb = (it >> 5) & 7, db = it & 31, n0 = nb * 16, d0 = db * 64;
        const float* sk = F.sub_keys + ((size_t)hp * 128 + n0 + (lane & 15)) * 128 + 8 * (lane >> 4);
        const float* wq = F.w_q + (size_t)(d0 + (lane & 15)) * 2048 + hp * 128 + 8 * (lane >> 4);
        f32x4 acc[4];
#pragma unroll
        for (int dt = 0; dt < 4; ++dt) acc[dt] = (f32x4){0.f, 0.f, 0.f, 0.f};
#pragma unroll
        for (int ks = 0; ks < 4; ++ks) {
            const bf16x8 yf = ld8_bf16(sk + 32 * ks);
#pragma unroll
            for (int dt = 0; dt < 4; ++dt) { const bf16x8 xf = ld8_bf16(wq + (size_t)dt * 16 * 2048 + 32 * ks);
                acc[dt] = __builtin_amdgcn_mfma_f32_16x16x32_bf16(xf, yf, acc[dt], 0, 0, 0); }
        }
        bf16* orow = F.BT3 + (size_t)(hp * 128 + n0 + (lane & 15)) * 2048 + d0 + 4 * (lane >> 4);
#pragma unroll
        for (int dt = 0; dt < 4; ++dt) { v2u o; o.x = pk2(acc[dt][0], acc[dt][1]); o.y = pk2(acc[dt][2], acc[dt][3]); *(GAS v2u*)(orow + 16 * dt) = o; }
    }
    for (int r = gw; r < S; r += NGW) {
        const GAS f32x4* src = (const GAS f32x4*)(F.x + (size_t)r * D) + 2 * lane;
        GAS v4u* dst = (GAS v4u*)(F.XB + (size_t)r * D) + lane;
#pragma unroll
        for (int j = 0; j < 4; ++j) { const f32x4 a = src[128 * j], b = src[128 * j + 1];
            v4u o; o.x = pk2(a.x, a.y); o.y = pk2(a.z, a.w); o.z = pk2(b.x, b.y); o.w = pk2(b.z, b.w); dst[64 * j] = o; }
    }
}
__device__ __forceinline__ void p0_encode_row(Frame& F, const f32x4 (&v)[8], int r, int lane) {
    const bool isv = r >= NE; const int e = isv ? r - NE : r;
    float am = 0.f;
#pragma unroll
    for (int j = 0; j < 8; ++j) am = fmaxf(am, fmaxf(fmaxf(fabsf(v[j].x), fabsf(v[j].y)), fmaxf(fabsf(v[j].z), fabsf(v[j].w))));
    am = wave_max(am);
    const float sc = am > 0.f ? 7.5f / am : 1.f, inv = am > 0.f ? am / 7.5f : 1.f;
    unsigned w[6];
#pragma unroll
    for (int h = 0; h < 2; ++h) {
        unsigned c[16];
#pragma unroll
        for (int i = 0; i < 16; ++i) c[i] = fp6_encode(v[4 * h + (i >> 2)][i & 3] * sc);
        w[3 * h + 0] = c[0] | (c[1] << 6) | (c[2] << 12) | (c[3] << 18) | (c[4] << 24) | (c[5] << 30);
        w[3 * h + 1] = (c[5] >> 2) | (c[6] << 4) | (c[7] << 10) | (c[8] << 16) | (c[9] << 22) | (c[10] << 28);
        w[3 * h + 2] = (c[10] >> 4) | (c[11] << 2) | (c[12] << 8) | (c[13] << 14) | (c[14] << 20) | (c[15] << 26);
    }
    unsigned char* dst = (isv ? F.V8 : F.U8) + (size_t)e * ROWB + 24 * lane;
    *(GAS v2u*)(dst) = (v2u){w[0], w[1]}; *(GAS v2u*)(dst + 8) = (v2u){w[2], w[3]}; *(GAS v2u*)(dst + 16) = (v2u){w[4], w[5]};
    if (lane == 0) (isv ? F.VSC : F.USC)[e] = inv;
}
__device__ __forceinline__ void p0_load_row(Frame& F, f32x4 (&v)[8], int r, int lane) {
    const int rc = r < 2 * NE ? r : 2 * NE - 1;
    const GAS f32x4* src = (const GAS f32x4*)((rc >= NE ? F.peer_v : F.peer_u) + (size_t)(rc >= NE ? rc - NE : rc) * D) + lane;
#pragma unroll
    for (int j = 0; j < 8; ++j) v[j] = src[64 * j];
}
__device__ __forceinline__ void p0_peer_tables(Frame& F, int wid, int nw) {
    const int lane = F.lane;
    f32x4 a[8], b[8], na[8], nb[8];
    p0_load_row(F, na, wid, lane); p0_load_row(F, nb, wid + nw, lane);
#pragma unroll 1
    for (int r = wid; r < 2 * NE; r += 2 * nw) {
#pragma unroll
        for (int j = 0; j < 8; ++j) { a[j] = na[j]; b[j] = nb[j]; }
        p0_load_row(F, na, r + 2 * nw, lane); p0_load_row(F, nb, r + 3 * nw, lane);
        p0_encode_row(F, a, r, lane);
        if (r + nw < 2 * NE) p0_encode_row(F, b, r + nw, lane);
    }
}

__device__ __forceinline__ float dpp_add(float v, int ctrl_sel) {
    int m;
    if (ctrl_sel == 0) m = __builtin_amdgcn_update_dpp(0, __float_as_int(v), 0x111, 0xf, 0xf, false);
    else if (ctrl_sel == 1) m = __builtin_amdgcn_update_dpp(0, __float_as_int(v), 0x112, 0xf, 0xf, false);
    else if (ctrl_sel == 2) m = __builtin_amdgcn_update_dpp(0, __float_as_int(v), 0x114, 0xf, 0xf, false);
    else if (ctrl_sel == 3) m = __builtin_amdgcn_update_dpp(0, __float_as_int(v), 0x118, 0xf, 0xf, false);
    else if (ctrl_sel == 4) m = __builtin_amdgcn_update_dpp(0, __float_as_int(v), 0x142, 0xa, 0xf, false);
    else m = __builtin_amdgcn_update_dpp(0, __float_as_int(v), 0x143, 0xc, 0xf, false);
    return v + __int_as_float(m);
}
__device__ __forceinline__ float wave_sum_lane63(float v) {
    v = dpp_add(v, 0); v = dpp_add(v, 1); v = dpp_add(v, 2); v = dpp_add(v, 3); v = dpp_add(v, 4); v = dpp_add(v, 5); return v;
}
__device__ __forceinline__ void p2_unit(Frame& F, int unit) {
    const int t0 = unit * 32, tid_in = F.tid, lane = F.lane;
    LAS unsigned char* abuf = F.lds + RING_OFF;
    LAS float* stat = (LAS float*)(F.lds + LNP_OFF);
    {
        int tid = tid_in; asm volatile("" : "+v"(tid));
#pragma unroll
        for (int h = 0; h < 2; ++h) {
            v4u st[8];
#pragma unroll
            for (int k = 8 * h; k < 8 * h + 8; ++k) { const int c = tid + 512 * k; int cc = c < 62 * 128 ? c : 62 * 128 - 1; cc = (t0 - 30) * 128 + cc < 0 ? (30 - t0) * 128 : cc;
                st[k - 8 * h] = ((const GAS v4u*)F.AGLU)[(size_t)((t0 - 30) * 128 + cc)]; }
#pragma unroll
            for (int k = 8 * h; k < 8 * h + 8; ++k) { const int c = tid + 512 * k; const bool ok = (t0 - 30) * 128 + c >= 0;
                const v4u v = ok ? st[k - 8 * h] : (v4u){0u, 0u, 0u, 0u};
                if (k < 15 || tid < 62 * 128 - 512 * 15) *(LAS v4u*)(abuf + 16 * c) = v; }
            asm volatile("" ::: "memory");
        }
    }
    asm volatile("" ::: "memory"); __builtin_amdgcn_sched_barrier(0);
    {
        int tid = tid_in; asm volatile("" : "+v"(tid));
        const int cg = tid & 127, tg = tid >> 7, tb = t0 + 8 * tg;
        float w0[8], w1[8], w2[8], bs[8];
#pragma unroll
        for (int h = 0; h < 2; ++h) { const f32x4 a = *(const GAS f32x4*)(F.scw + 8 * cg + 4 * h), b = *(const GAS f32x4*)(F.scw + 1024 + 8 * cg + 4 * h), c = *(const GAS f32x4*)(F.scw + 2048 + 8 * cg + 4 * h), d = *(const GAS f32x4*)(F.scbias + 8 * cg + 4 * h);
#pragma unroll
            for (int q = 0; q < 4; ++q) { w0[4 * h + q] = a[q]; w1[4 * h + q] = b[q]; w2[4 * h + q] = c[q]; bs[4 * h + q] = d[q]; } }
        v4u cvr[10], gtr[8];
#pragma unroll
        for (int i = 0; i < 10; ++i) { const int t = tb - 2 + i, tc = t < 0 ? 0 : t; const v4u v = *(const GAS v4u*)(F.CV + (size_t)tc * 1024 + 8 * cg); cvr[i] = t < 0 ? (v4u){0u, 0u, 0u, 0u} : v; }
#pragma unroll
        for (int i = 0; i < 4; ++i) gtr[i] = *(const GAS v4u*)(F.SCB + (size_t)(tb + i) * 1024 + 8 * cg);
#pragma unroll
        for (int tt = 0; tt < 8; ++tt) {
            if (tt == 3) {
#pragma unroll
                for (int i = 4; i < 8; ++i) gtr[i] = *(const GAS v4u*)(F.SCB + (size_t)(tb + i) * 1024 + 8 * cg); }
            v4u o;
#pragma unroll
            for (int q = 0; q < 4; ++q) {
                const unsigned a2 = cvr[tt][q], a1 = cvr[tt + 1][q], a0 = cvr[tt + 2][q], g = gtr[tt][q];
                const float lo = bf_lo(g) * (bs[2 * q] + w0[2 * q] * bf_lo(a2) + w1[2 * q] * bf_lo(a1) + w2[2 * q] * bf_lo(a0));
                const float hi = bf_hi(g) * (bs[2 * q + 1] + w0[2 * q + 1] * bf_hi(a2) + w1[2 * q + 1] * bf_hi(a1) + w2[2 * q + 1] * bf_hi(a0));
                o[q] = pk2(lo, hi);
            }
            *(GAS v4u*)(F.MIX + (size_t)(tb + tt) * 2048 + 1024 + 8 * cg) = o;
        }
    }
    asm volatile("" ::: "memory"); __builtin_amdgcn_sched_barrier(0);
    LDS_WAIT(); __syncthreads();
    {
        int tid = tid_in; asm volatile("" : "+v"(tid)); const int c0 = 2 * tid;
        f32x2 w[31];
#pragma unroll
        for (int k = 0; k < 31; ++k) w[k] = *(const GAS f32x2*)(F.ccw + k * 1024 + c0);
        const f32x2 bias = *(const GAS f32x2*)(F.ccb + c0), lng = *(const GAS f32x2*)(F.clg + c0), lnb = *(const GAS f32x2*)(F.clb + c0);
#pragma unroll 1
        for (int g = 0; g < 4; ++g) {
            f32x2 o[8];
#pragma unroll
            for (int tt = 0; tt < 8; ++tt) o[tt] = bias;
#pragma unroll
            for (int half = 0; half < 2; ++half) {
                constexpr int NR = 23; const int r0 = half ? 16 : 0, k0 = half ? 16 : 0, nk = half ? 15 : 16;
                f32x2 in[NR];
#pragma unroll
                for (int i = 0; i < NR; ++i) { const int row = r0 + i < 38 ? r0 + i : 37; const unsigned raw = *(const LAS unsigned*)(abuf + (8 * g + row) * 2048 + 4 * tid); in[i] = (f32x2){bf_lo(raw), bf_hi(raw)}; }
#pragma unroll
                for (int tt = 0; tt < 8; ++tt)
#pragma unroll
                    for (int k = 0; k < 16; ++k) if (k < nk) o[tt] += w[k0 + k] * in[tt + k + k0 - r0];
                asm volatile("" ::: "memory");
            }
#pragma unroll
            for (int tt = 0; tt < 8; ++tt) { const float s1 = wave_sum_lane63(o[tt].x + o[tt].y), s2 = wave_sum_lane63(o[tt].x * o[tt].x + o[tt].y * o[tt].y);
                if (lane == 63) { stat[(tt * 2 + 0) * 8 + F.wave] = s1; stat[(tt * 2 + 1) * 8 + F.wave] = s2; } }
            LDS_WAIT(); __syncthreads();
            float tot;
            { const f32x4 a0 = *(const LAS f32x4*)(stat + (lane & 15) * 8), a1 = *(const LAS f32x4*)(stat + (lane & 15) * 8 + 4); tot = ((a0.x + a0.y) + (a0.z + a0.w)) + ((a1.x + a1.y) + (a1.z + a1.w)); }
#pragma unroll
            for (int tt = 0; tt < 8; ++tt) {
                const float mean = __int_as_float(__builtin_amdgcn_readlane(__float_as_int(tot), 2 * tt)) * (1.f / 1024.f);
                const float ex2 = __int_as_float(__builtin_amdgcn_readlane(__float_as_int(tot), 2 * tt + 1)) * (1.f / 1024.f);
                const float rstd = 1.f / sqrtf(fmaxf(ex2 - mean * mean, 0.f) + LN_EPS);
                f32x2 y = (o[tt] - mean) * rstd * lng + lnb;
                y.x *= pg8::sigmoidf_fast(y.x); y.y *= pg8::sigmoidf_fast(y.y);
                *(GAS unsigned*)(F.MIX + (size_t)(t0 + 8 * g + tt) * 2048 + c0) = pk2(y.x, y.y);
            }
            __syncthreads();
        }
    }
}

__device__ __forceinline__ void p4_ln1(Frame& F) {
    const int gw = F.vcu * NWAVES + F.wave, NGW = F.G * NWAVES, lane = F.lane;
    for (int r = gw; r < S; r += NGW) {
        const GAS v4u* yr = (const GAS v4u*)(F.Y + (size_t)r * D) + lane;
        float v[32]; float s = 0.f;
#pragma unroll
        for (int j = 0; j < 4; ++j) { const v4u w = yr[64 * j];
#pragma unroll
            for (int q = 0; q < 4; ++q) { v[8 * j + 2 * q] = bf_lo(w[q]); v[8 * j + 2 * q + 1] = bf_hi(w[q]); s += v[8 * j + 2 * q] + v[8 * j + 2 * q + 1]; } }
        const float mean = wave_sum(s) * (1.f / D); float s2 = 0.f;
#pragma unroll
        for (int i = 0; i < 32; ++i) { v[i] -= mean; s2 = fmaf(v[i], v[i], s2); }
        const float rstd = 1.f / sqrtf(wave_sum(s2) * (1.f / D) + LN_EPS);
        GAS v4u* o16 = (GAS v4u*)(F.X1 + (size_t)r * D) + lane;
#pragma unroll
        for (int j = 0; j < 4; ++j) { const int col = 8 * lane + 512 * j;
            const f32x4 g0 = *(const GAS f32x4*)(F.ln1g + col), g1 = *(const GAS f32x4*)(F.ln1g + col + 4), b0 = *(const GAS f32x4*)(F.ln1b + col), b1 = *(const GAS f32x4*)(F.ln1b + col + 4);
            v4u o; o.x = pk2(v[8 * j + 0] * rstd * g0.x + b0.x, v[8 * j + 1] * rstd * g0.y + b0.y); o.y = pk2(v[8 * j + 2] * rstd * g0.z + b0.z, v[8 * j + 3] * rstd * g0.w + b0.w);
            o.z = pk2(v[8 * j + 4] * rstd * g1.x + b1.x, v[8 * j + 5] * rstd * g1.y + b1.y); o.w = pk2(v[8 * j + 6] * rstd * g1.z + b1.z, v[8 * j + 7] * rstd * g1.w + b1.w);
            o16[64 * j] = o; }
    }
}

__device__ __forceinline__ int imax_(int a, int b) { return a > b ? a : b; }
__device__ __forceinline__ int imin_(int a, int b) { return a < b ? a : b; }
template <bool DESC> __device__ __forceinline__ void ce_i(int& a, int& b) { const int mx = imax_(a, b), mn = imin_(a, b); a = DESC ? mx : mn; b = DESC ? mn : mx; }
template <bool DESC> __device__ __forceinline__ void sort16_i(int (&v)[16]) {
#pragma unroll
    for (int k = 2; k <= 16; k <<= 1)
#pragma unroll
        for (int j = k >> 1; j > 0; j >>= 1)
#pragma unroll
            for (int i = 0; i < 16; ++i) { const int l = i ^ j; if (l > i) { const bool up = ((i & k) == 0); if (up != DESC) ce_i<false>(v[i], v[l]); else ce_i<true>(v[i], v[l]); } }
}
template <bool DESC> __device__ __forceinline__ void merge16_i(int (&v)[16]) {
#pragma unroll
    for (int j = 8; j > 0; j >>= 1)
#pragma unroll
        for (int i = 0; i < 16; ++i) { const int l = i ^ j; if (l > i) ce_i<DESC>(v[i], v[l]); }
}
template <bool DESC> __device__ __forceinline__ void ce_p(float& a, int& pa, float& b, int& pb) {
    const bool sw = DESC ? (a < b) : (a > b); const float ta = sw ? b : a, tb = sw ? a : b; const int qa = sw ? pb : pa, qb = sw ? pa : pb; a = ta; b = tb; pa = qa; pb = qb; }
template <bool DESC> __device__ __forceinline__ void sort16_p(float (&v)[16], int (&p)[16]) {
#pragma unroll
    for (int k = 2; k <= 16; k <<= 1)
#pragma unroll
        for (int j = k >> 1; j > 0; j >>= 1)
#pragma unroll
            for (int i = 0; i < 16; ++i) { const int l = i ^ j; if (l > i) { const bool up = ((i & k) == 0); if (up != DESC) ce_p<false>(v[i], p[i], v[l], p[l]); else ce_p<true>(v[i], p[i], v[l], p[l]); } }
}
template <bool DESC> __device__ __forceinline__ void merge16_p(float (&v)[16], int (&p)[16]) {
#pragma unroll
    for (int j = 8; j > 0; j >>= 1)
#pragma unroll
        for (int i = 0; i < 16; ++i) { const int l = i ^ j; if (l > i) ce_p<DESC>(v[i], p[i], v[l], p[l]); }
}
__device__ __forceinline__ int f2key(float f) { const int b = __float_as_int(f); return b ^ ((b >> 31) & 0x7fffffff); }
__device__ __forceinline__ float key2f(int k) { return __int_as_float(k ^ ((k >> 31) & 0x7fffffff)); }

__device__ __forceinline__ void p6_topk(Frame& F) {
    const int gw = F.vcu * NWAVES + F.wave, NGW = F.G * NWAVES, lane = F.lane;
    for (int it = gw; it < (S * 16) / 64; it += NGW) {
        const int prob = it * 64 + lane, t = prob >> 4, hp = prob & 15;
        const float* sp = F.SS + (size_t)t * 2048 + hp * 128;
        int top[16];
        {
            f32x4 r[4];
#pragma unroll
            for (int q = 0; q < 4; ++q) r[q] = *(const GAS f32x4*)(sp + 4 * q);
#pragma unroll
            for (int q = 0; q < 4; ++q)
#pragma unroll
                for (int e = 0; e < 4; ++e) top[4 * q + e] = (f2key(r[q][e]) & ~127) | (4 * q + e);
            sort16_i<true>(top);
        }
#pragma unroll 1
        for (int c = 1; c < 8; ++c) {
            f32x4 r[4]; int nw[16];
#pragma unroll
            for (int q = 0; q < 4; ++q) r[q] = *(const GAS f32x4*)(sp + 16 * c + 4 * q);
#pragma unroll
            for (int q = 0; q < 4; ++q)
#pragma unroll
                for (int e = 0; e < 4; ++e) nw[4 * q + e] = (f2key(r[q][e]) & ~127) | (16 * c + 4 * q + e);
            sort16_i<false>(nw);
#pragma unroll
            for (int i = 0; i < 16; ++i) top[i] = imax_(top[i], nw[i]);
            merge16_i<true>(top);
        }
        const bool odd = (lane & 1) != 0;
        float Av[16], Bv[16]; int Ai[16], Bi[16];
#pragma unroll
        for (int i = 0; i < 16; ++i) { const int mine = top[i]; const int other = __shfl_xor(mine, 1); const int ka = odd ? other : mine, kb = odd ? mine : other;
            Av[i] = key2f(ka & ~127); Ai[i] = ka & 127; Bv[i] = key2f(kb & ~127); Bi[i] = kb & 127; }
        float tv[16]; int tp[16];
#pragma unroll
        for (int j = 0; j < 16; ++j) { tv[j] = Av[0] + Bv[j]; tp[j] = Ai[0] * 128 + Bi[j]; }
        {
            float nv[16]; int np[16];
#pragma unroll
            for (int j = 0; j < 8; ++j) { nv[j] = Av[1] + Bv[j]; np[j] = Ai[1] * 128 + Bi[j]; }
#pragma unroll
            for (int j = 0; j < 5; ++j) { nv[8 + j] = Av[2] + Bv[j]; np[8 + j] = Ai[2] * 128 + Bi[j]; }
#pragma unroll
            for (int j = 0; j < 3; ++j) { nv[13 + j] = Av[3] + Bv[j]; np[13 + j] = Ai[3] * 128 + Bi[j]; }
            sort16_p<false>(nv, np);
#pragma unroll
            for (int i = 0; i < 16; ++i) { const bool g = nv[i] > tv[i]; tv[i] = g ? nv[i] : tv[i]; tp[i] = g ? np[i] : tp[i]; }
            merge16_p<true>(tv, tp);
        }
        {
            float nv[16]; int np[16];
            nv[0] = Av[3] + Bv[3]; np[0] = Ai[3] * 128 + Bi[3];
#pragma unroll
            for (int j = 0; j < 3; ++j) { nv[1 + j] = Av[4] + Bv[j]; np[1 + j] = Ai[4] * 128 + Bi[j]; }
#pragma unroll
            for (int i = 5; i < 8; ++i)
#pragma unroll
                for (int j = 0; j < 2; ++j) { nv[4 + 2 * (i - 5) + j] = Av[i] + Bv[j]; np[4 + 2 * (i - 5) + j] = Ai[i] * 128 + Bi[j]; }
#pragma unroll
            for (int i = 8; i < 14; ++i) { nv[10 + i - 8] = Av[i] + Bv[0]; np[10 + i - 8] = Ai[i] * 128 + Bi[0]; }
            sort16_p<false>(nv, np);
#pragma unroll
            for (int i = 0; i < 16; ++i) { const bool g = nv[i] > tv[i]; tv[i] = g ? nv[i] : tv[i]; tp[i] = g ? np[i] : tp[i]; }
            merge16_p<true>(tv, tp);
        }
        {
            const float hi = Av[14] + Bv[0], lo = Av[15] + Bv[0]; const int phi = Ai[14] * 128 + Bi[0], plo = Ai[15] * 128 + Bi[0];
            const float t14 = tv[14], t15 = tv[15]; const int q14 = tp[14], q15 = tp[15];
            const bool g14 = lo > t14, g15 = hi > t15;
            tv[14] = g14 ? lo : t14; tp[14] = g14 ? plo : q14; tv[15] = g15 ? hi : t15; tp[15] = g15 ? phi : q15;
        }
        float mx = tv[0];
#pragma unroll
        for (int i = 1; i < 16; ++i) mx = fmaxf(mx, tv[i]);
        float sum = 0.f;
#pragma unroll
        for (int i = 0; i < 16; ++i) { tv[i] = __expf(tv[i] - mx); sum += tv[i]; }
        const float rs = 1.f / sum;
        const size_t ob = (size_t)t * NPAIR + hp * 8;
        int oe[8]; float og[8], ou[8];
#pragma unroll
        for (int k = 0; k < 8; ++k) { const int pa = tp[k], pb = tp[8 + k]; const float va = tv[k], vb = tv[8 + k];
            oe[k] = odd ? pb : pa; const float g = (odd ? vb : va) * rs; og[k] = g * F.VSC[oe[k]]; ou[k] = F.USC[oe[k]]; }
        *(GAS v4u*)(F.IDX + ob) = (v4u){(unsigned)oe[0], (unsigned)oe[1], (unsigned)oe[2], (unsigned)oe[3]};
        *(GAS v4u*)(F.IDX + ob + 4) = (v4u){(unsigned)oe[4], (unsigned)oe[5], (unsigned)oe[6], (unsigned)oe[7]};
        *(GAS f32x4*)(F.GV + ob) = (f32x4){og[0], og[1], og[2], og[3]};
        *(GAS f32x4*)(F.GV + ob + 4) = (f32x4){og[4], og[5], og[6], og[7]};
        *(GAS f32x4*)(F.SU + ob) = (f32x4){ou[0], ou[1], ou[2], ou[3]};
        *(GAS f32x4*)(F.SU + ob + 4) = (f32x4){ou[4], ou[5], ou[6], ou[7]};
    }
}

constexpr int NSL = 10;
constexpr int RING_W = NSL * ROWB;
constexpr int TAB_V_OFS = (int)(WS_V8 - WS_U8);
static_assert(NWAVES * RING_W <= RING_BYTES, "rings fit the phase scratch region");
typedef unsigned u32x6 __attribute__((ext_vector_type(6)));
typedef float f32x32 __attribute__((ext_vector_type(32)));
typedef __bf16 bf16x32 __attribute__((ext_vector_type(32)));
typedef __bf16 bf16x2 __attribute__((ext_vector_type(2)));
__device__ __forceinline__ float gelu_erf(float z) { return 0.5f * z * (1.0f + erff(z * 0.70710678118654752f)); }
__device__ __forceinline__ void p7_sort512(int (&key)[8], int lane) {
#pragma unroll
    for (int k = 2; k <= 512; k <<= 1) {
#pragma unroll
        for (int j = k >> 1; j > 0; j >>= 1) {
            if (j >= 64) {
                const int jr = j >> 6;
#pragma unroll
                for (int r = 0; r < 8; ++r) if ((r & jr) == 0) { const int rp = r | jr; const bool asc = ((64 * r) & k) == 0;
                    const int a = key[r], b = key[rp], mn = imin_(a, b), mx = imax_(a, b); key[r] = asc ? mn : mx; key[rp] = asc ? mx : mn; }
            } else {
#pragma unroll
                for (int r = 0; r < 8; ++r) { const int mine = key[r], o = __builtin_amdgcn_ds_bpermute((lane ^ j) << 2, mine); const bool low = (lane & j) == 0, asc = ((64 * r + lane) & k) == 0;
                    key[r] = (low == asc) ? imin_(mine, o) : imax_(mine, o); }
            }
        }
    }
}
__device__ __forceinline__ int mbcnt64(unsigned long long m) { return (int)__builtin_amdgcn_mbcnt_hi((unsigned)(m >> 32), __builtin_amdgcn_mbcnt_lo((unsigned)m, 0u)); }
__device__ __forceinline__ int p7_group_by_slot(int kv) {
    const int s = (kv >> 7) & 3;
    const unsigned long long m0 = __ballot(s == 0), m1 = __ballot(s == 1), m2 = __ballot(s == 2), m3 = __ballot(s == 3);
    const int c0 = __popcll(m0), c1 = __popcll(m1), c2 = __popcll(m2);
    const int p0 = mbcnt64(m0), p1 = c0 + mbcnt64(m1), p2 = c0 + c1 + mbcnt64(m2), p3 = c0 + c1 + c2 + mbcnt64(m3);
    const int pos = s == 0 ? p0 : s == 1 ? p1 : s == 2 ? p2 : p3;
    return __builtin_amdgcn_ds_permute(pos << 2, kv);
}
__device__ __forceinline__ int sel8i(const int (&a)[8], int r) {
    const int a0 = a[0], a1 = a[1], a2 = a[2], a3 = a[3], a4 = a[4], a5 = a[5], a6 = a[6], a7 = a[7];
    int v = a0; v = r == 1 ? a1 : v; v = r == 2 ? a2 : v; v = r == 3 ? a3 : v; v = r == 4 ? a4 : v; v = r == 5 ? a5 : v; v = r == 6 ? a6 : v; v = r == 7 ? a7 : v; return v;
}
__device__ __forceinline__ float sel8f(const float (&a)[8], int r) {
    const float a0 = a[0], a1 = a[1], a2 = a[2], a3 = a[3], a4 = a[4], a5 = a[5], a6 = a[6], a7 = a[7];
    float v = a0; v = r == 1 ? a1 : v; v = r == 2 ? a2 : v; v = r == 3 ? a3 : v; v = r == 4 ? a4 : v; v = r == 5 ? a5 : v; v = r == 6 ? a6 : v; v = r == 7 ? a7 : v; return v;
}
__device__ __forceinline__ void p7_dma_row(__amdgpu_buffer_rsrc_t rs, LAS unsigned char* slotp, int soff, int v16) {
    __builtin_amdgcn_raw_ptr_buffer_load_lds(rs, (LAS void*)slotp, 16, v16, soff, 0, 0);
    if (v16 < 512) __builtin_amdgcn_raw_ptr_buffer_load_lds(rs, (LAS void*)(slotp + 1024), 16, v16, soff + 1024, 0, 0);
}
__device__ __forceinline__ u32x6 p7_read_row(const LAS unsigned char* slotp, int lane) {
    const LAS v2u* q = (const LAS v2u*)(slotp + 24 * lane); const v2u a = q[0], b = q[1], c = q[2];
    u32x6 r; r[0] = a.x; r[1] = a.y; r[2] = b.x; r[3] = b.y; r[4] = c.x; r[5] = c.y; return r;
}
__device__ __forceinline__ float p7_dot(const unsigned (&xp)[16], const bf16x32& uf) {
    float s0 = 0.f, s1 = 0.f;
#pragma unroll
    for (int m = 0; m < 16; m += 2) {
        bf16x2 a; a[0] = uf[2 * m]; a[1] = uf[2 * m + 1]; bf16x2 b; b[0] = uf[2 * m + 2]; b[1] = uf[2 * m + 3];
        const unsigned xa = xp[m], xb = xp[m + 1];
        s0 = __builtin_amdgcn_fdot2_f32_bf16(__builtin_bit_cast(bf16x2, xa), a, s0, false);
        s1 = __builtin_amdgcn_fdot2_f32_bf16(__builtin_bit_cast(bf16x2, xb), b, s1, false); }
    return s0 + s1;
}
__device__ __forceinline__ void p7_axpy(float (&acc)[32], float ck, const f32x32& vf) {
#pragma unroll
    for (int r = 0; r < 32; ++r) acc[r] = fmaf(ck, vf[r], acc[r]);
}
#define P7_WAIT_2ROWS() asm volatile("s_waitcnt vmcnt(16)" ::: "memory")
#define P7_WAIT_1ROW() asm volatile("s_waitcnt vmcnt(18)" ::: "memory")
#define P7_READS_DONE() asm volatile("s_waitcnt lgkmcnt(0)" ::: "memory")
static_assert(NSL == 10, "the counted waits above assume NSL = 10");
struct P7Stream { __amdgpu_buffer_rsrc_t tab; LAS unsigned char* ring; int rs; int v16; };
__device__ __forceinline__ LAS unsigned char* p7_slot(const P7Stream& St, int k) { int s = St.rs + k; s = s >= NSL ? s - NSL : s; return St.ring + s * ROWB; }
__device__ __forceinline__ void p7_advance(P7Stream& St, int k) { int s = St.rs + k; St.rs = s >= NSL ? s - NSL : s; }
__device__ __forceinline__ int p7_ahead(int koc, int kon, int tofs, int tofs_n, int j) {
    const int ln = (j + NSL) & 63; const int a = __builtin_amdgcn_readlane(koc, ln) + tofs, b = __builtin_amdgcn_readlane(kon, ln) + tofs_n;
    return j + NSL >= 64 ? b : a;
}
template <bool USWEEP>
__device__ __forceinline__ void p7_rows(P7Stream& St, const unsigned (&xp)[16], float (&acc)[32], int& zreg, int ccur, int koc, int kon, int tofs, int tofs_n, int j, int end, int lane) {
#pragma unroll 1
    for (; j + 1 < end; j += 2) {
        P7_WAIT_2ROWS();
        const u32x6 rowa = p7_read_row(p7_slot(St, 0), lane), rowb = p7_read_row(p7_slot(St, 1), lane);
        P7_READS_DONE();
        p7_dma_row(St.tab, p7_slot(St, 0), p7_ahead(koc, kon, tofs, tofs_n, j), St.v16);
        p7_dma_row(St.tab, p7_slot(St, 1), p7_ahead(koc, kon, tofs, tofs_n, j + 1), St.v16);
        p7_advance(St, 2);
        if constexpr (USWEEP) {
            const bf16x32 ua = __builtin_amdgcn_cvt_scalef32_pk32_bf16_fp6(rowa, 1.0f), ub = __builtin_amdgcn_cvt_scalef32_pk32_bf16_fp6(rowb, 1.0f);
            const float da = p7_dot(xp, ua), db = p7_dot(xp, ub);
            const v2u sw = __builtin_amdgcn_permlane32_swap(__float_as_uint(da), __float_as_uint(db), false, false);
            float t = __uint_as_float(sw.x) + __uint_as_float(sw.y);
            t = dpp_add(t, 0); t = dpp_add(t, 1); t = dpp_add(t, 2); t = dpp_add(t, 3); t = dpp_add(t, 4);
            const int za = __builtin_amdgcn_readlane(__float_as_int(t), 31), zb = __builtin_amdgcn_readlane(__float_as_int(t), 63);
            zreg = lane == j ? za : zreg; zreg = lane == j + 1 ? zb : zreg;
        } else {
            const float cka = __int_as_float(__builtin_amdgcn_readlane(ccur, j)), ckb = __int_as_float(__builtin_amdgcn_readlane(ccur, j + 1));
            { const f32x32 va = __builtin_amdgcn_cvt_scalef32_pk32_f32_fp6(rowa, 1.0f); p7_axpy(acc, cka, va); }
            { const f32x32 vb = __builtin_amdgcn_cvt_scalef32_pk32_f32_fp6(rowb, 1.0f); p7_axpy(acc, ckb, vb); }
        }
    }
    if (j < end) {
        P7_WAIT_1ROW();
        const u32x6 rowa = p7_read_row(p7_slot(St, 0), lane);
        P7_READS_DONE();
        p7_dma_row(St.tab, p7_slot(St, 0), p7_ahead(koc, kon, tofs, tofs_n, j), St.v16);
        p7_advance(St, 1);
        if constexpr (USWEEP) {
            const bf16x32 ua = __builtin_amdgcn_cvt_scalef32_pk32_bf16_fp6(rowa, 1.0f);
            const float da = wave_sum_lane63(p7_dot(xp, ua));
            const int za = __builtin_amdgcn_readlane(__float_as_int(da), 63);
            zreg = lane == j ? za : zreg;
        } else {
            const float cka = __int_as_float(__builtin_amdgcn_readlane(ccur, j));
            const f32x32 va = __builtin_amdgcn_cvt_scalef32_pk32_f32_fp6(rowa, 1.0f); p7_axpy(acc, cka, va);
        }
    }
}
__device__ __forceinline__ void p7_peer(Frame& F) {
    const int gw = F.vcu * NWAVES + F.wave, NGW = F.G * NWAVES, lane_in = F.lane;
    LAS f32x4* lg = (LAS f32x4*)(F.lds + LNP_OFF); LAS f32x4* lb = lg + 512;
    for (int i = F.tid; i < 512; i += NWAVES * 64) { lg[i] = ((const GAS f32x4*)F.ln2g)[i]; lb[i] = ((const GAS f32x4*)F.ln2b)[i]; }
    LDS_WAIT(); __syncthreads();
    P7Stream St; St.ring = F.lds + RING_OFF + F.wave * RING_W; St.rs = 0;
    St.tab = __builtin_amdgcn_make_buffer_rsrc((void*)F.U8, 0, TAB_V_OFS + NE * ROWB, 0x00020000);
#pragma unroll 1
    for (int tg = gw; tg < S / 4; tg += NGW) {
        const int tb = 4 * tg;
        int lane = lane_in; asm volatile("" : "+v"(lane));
        St.v16 = 16 * lane;
        int key[8]; float gvv[8], suv[8];
#pragma unroll
        for (int s = 0; s < 4; ++s)
#pragma unroll
            for (int h = 0; h < 2; ++h) { const size_t o = (size_t)(tb + s) * NPAIR + 64 * h + lane;
                key[2 * s + h] = (F.IDX[o] << 9) | (s << 7) | (64 * h + lane); gvv[2 * s + h] = F.GV[o]; suv[2 * s + h] = F.SU[o]; }
        unsigned xp0[16], xp1[16], xp2[16], xp3[16];
#pragma unroll
        for (int j = 0; j < 8; ++j) {
            const v2u w0 = ((const GAS v2u*)(F.X1 + (size_t)(tb + 0) * D) + lane)[64 * j], w1 = ((const GAS v2u*)(F.X1 + (size_t)(tb + 1) * D) + lane)[64 * j];
            const v2u w2 = ((const GAS v2u*)(F.X1 + (size_t)(tb + 2) * D) + lane)[64 * j], w3 = ((const GAS v2u*)(F.X1 + (size_t)(tb + 3) * D) + lane)[64 * j];
            xp0[2 * j] = w0.x; xp0[2 * j + 1] = w0.y; xp1[2 * j] = w1.x; xp1[2 * j + 1] = w1.y; xp2[2 * j] = w2.x; xp2[2 * j + 1] = w2.y; xp3[2 * j] = w3.x; xp3[2 * j + 1] = w3.y; }
        p7_sort512(key, lane);
#pragma unroll
        for (int r = 0; r < 8; ++r) key[r] = p7_group_by_slot(key[r]);
        VM_WAIT();
        { const int ko0 = (key[0] >> 9) * ROWB;
#pragma unroll
          for (int i = 0; i < NSL; ++i) p7_dma_row(St.tab, St.ring + i * ROWB, __builtin_amdgcn_readlane(ko0, i), St.v16); }
        St.rs = 0;
        float coef[8];
#pragma unroll
        for (int q = 0; q < 8; ++q) coef[q] = 0.f;
        float dummy_acc[32];
#pragma unroll
        for (int q = 0; q < 32; ++q) dummy_acc[q] = 0.f;
#pragma unroll 1
        for (int r = 0; r < 8; ++r) {
            const int kcur = sel8i(key, r), knext = sel8i(key, (r + 1) & 7);
            const int koc = (kcur >> 9) * ROWB, kon = (knext >> 9) * ROWB, tofs_n = r == 7 ? TAB_V_OFS : 0;
            const int sl = (kcur >> 7) & 3;
            const int e0 = __popcll(__ballot(sl == 0)), e1 = e0 + __popcll(__ballot(sl == 1)), e2 = e1 + __popcll(__ballot(sl == 2));
            int zreg = 0;
            p7_rows<true>(St, xp0, dummy_acc, zreg, 0, koc, kon, 0, tofs_n, 0, e0, lane);
            p7_rows<true>(St, xp1, dummy_acc, zreg, 0, koc, kon, 0, tofs_n, e0, e1, lane);
            p7_rows<true>(St, xp2, dummy_acc, zreg, 0, koc, kon, 0, tofs_n, e1, e2, lane);
            p7_rows<true>(St, xp3, dummy_acc, zreg, 0, koc, kon, 0, tofs_n, e2, 64, lane);
            const int pr = kcur & 127, sel = 2 * sl + (pr >> 6);
            float su = 0.f, gv = 0.f;
#pragma unroll
            for (int j = 0; j < 8; ++j) { const float a = __int_as_float(__builtin_amdgcn_ds_bpermute((pr & 63) << 2, __float_as_int(suv[j]))), b = __int_as_float(__builtin_amdgcn_ds_bpermute((pr & 63) << 2, __float_as_int(gvv[j]))); su = sel == j ? a : su; gv = sel == j ? b : gv; }
            const float cnew = gelu_erf(__int_as_float(zreg) * su) * gv;
#pragma unroll
            for (int q = 0; q < 8; ++q) { const float old = coef[q]; coef[q] = r == q ? cnew : old; }
        }
        float acc0[32], acc1[32], acc2[32], acc3[32];
#pragma unroll
        for (int q = 0; q < 32; ++q) { acc0[q] = 0.f; acc1[q] = 0.f; acc2[q] = 0.f; acc3[q] = 0.f; }
        int zdummy = 0;
#pragma unroll 1
        for (int r = 0; r < 8; ++r) {
            const int kcur = sel8i(key, r), knext = sel8i(key, r < 7 ? r + 1 : 7); const int ccur = __float_as_int(sel8f(coef, r));
            const int koc = (kcur >> 9) * ROWB, kon = (knext >> 9) * ROWB;
            const int sl = (kcur >> 7) & 3;
            const int e0 = __popcll(__ballot(sl == 0)), e1 = e0 + __popcll(__ballot(sl == 1)), e2 = e1 + __popcll(__ballot(sl == 2));
            p7_rows<false>(St, xp0, acc0, zdummy, ccur, koc, kon, TAB_V_OFS, TAB_V_OFS, 0, e0, lane);
            p7_rows<false>(St, xp0, acc1, zdummy, ccur, koc, kon, TAB_V_OFS, TAB_V_OFS, e0, e1, lane);
            p7_rows<false>(St, xp0, acc2, zdummy, ccur, koc, kon, TAB_V_OFS, TAB_V_OFS, e1, e2, lane);
            p7_rows<false>(St, xp0, acc3, zdummy, ccur, koc, kon, TAB_V_OFS, TAB_V_OFS, e2, 64, lane);
        }
        VM_WAIT();
#pragma unroll
        for (int s = 0; s < 4; ++s) {
            asm volatile("" ::: "memory"); __builtin_amdgcn_sched_barrier(0);
            float (&acc)[32] = s == 0 ? acc0 : s == 1 ? acc1 : s == 2 ? acc2 : acc3;
            const GAS v2u* xr = (const GAS v2u*)(F.X1 + (size_t)(tb + s) * D) + lane;
            float sum = 0.f;
#pragma unroll
            for (int j = 0; j < 8; ++j) { const v2u w = xr[64 * j];
                acc[4 * j + 0] = fmaf(ALPHA, bf_lo(w.x), acc[4 * j + 0]); acc[4 * j + 1] = fmaf(ALPHA, bf_hi(w.x), acc[4 * j + 1]);
                acc[4 * j + 2] = fmaf(ALPHA, bf_lo(w.y), acc[4 * j + 2]); acc[4 * j + 3] = fmaf(ALPHA, bf_hi(w.y), acc[4 * j + 3]); }
#pragma unroll
            for (int q = 0; q < 32; ++q) sum += acc[q];
            const float mean = __int_as_float(__builtin_amdgcn_readlane(__float_as_int(wave_sum_lane63(sum)), 63)) * (1.f / D); float s2 = 0.f;
#pragma unroll
            for (int q = 0; q < 32; ++q) { acc[q] -= mean; s2 = fmaf(acc[q], acc[q], s2); }
            const float rstd = 1.f / sqrtf(__int_as_float(__builtin_amdgcn_readlane(__float_as_int(wave_sum_lane63(s2)), 63)) * (1.f / D) + LN_EPS);
            GAS f32x4* orow = (GAS f32x4*)(F.out + (size_t)(tb + s) * D) + lane;
#pragma unroll
            for (int j = 0; j < 8; ++j) { const f32x4 g = lg[lane + 64 * j], b = lb[lane + 64 * j];
                f32x4 o; o.x = acc[4 * j + 0] * rstd * g.x + b.x; o.y = acc[4 * j + 1] * rstd * g.y + b.y; o.z = acc[4 * j + 2] * rstd * g.z + b.z; o.w = acc[4 * j + 3] * rstd * g.w + b.w;
                orow[64 * j] = o; }
        }
    }
}

struct Args { const float* in[19]; float* out; unsigned char* ws; int ph_lo, ph_hi, li, pad; };
__global__ void __launch_bounds__(NWAVES * 64, 2) peer_layer_fwd(Args args) {
    extern __shared__ __attribute__((aligned(16))) unsigned char lds[];
    Frame F;
    F.lds = (LAS unsigned char*)lds;
    F.MISC = (volatile LAS unsigned*)(F.lds + MISC_OFF);
    F.tid = threadIdx.x; F.lane = F.tid & 63; F.wave = __builtin_amdgcn_readfirstlane(F.tid >> 6);
    F.G = gridDim.x; { const int bx = blockIdx.x; F.vcu = (F.G % 8 == 0) ? (bx % 8) * (F.G / 8) + bx / 8 : bx; }
    unsigned char* ws = args.ws;
    F.ctl = (gu32*)(ws + WS_CTL);
    F.x = args.in[0]; F.w_in = args.in[1]; F.b_in = args.in[2]; F.ccw = args.in[3]; F.ccb = args.in[4]; F.clg = args.in[5]; F.clb = args.in[6];
    F.scw = args.in[7]; F.scbias = args.in[8]; F.w_out = args.in[9]; F.b_out = args.in[10]; F.ln1g = args.in[11]; F.ln1b = args.in[12];
    F.w_q = args.in[13]; F.sub_keys = args.in[14]; F.peer_u = args.in[15]; F.peer_v = args.in[16]; F.ln2g = args.in[17]; F.ln2b = args.in[18];
    F.out = args.out;
    F.XB = (bf16*)(ws + WS_XB); F.BT1 = (bf16*)(ws + WS_BT1); F.BT2 = (bf16*)(ws + WS_BT2); F.BT3 = (bf16*)(ws + WS_BT3);
    F.AGLU = (bf16*)(ws + WS_AGLU); F.CV = (bf16*)(ws + WS_CV); F.SCB = (bf16*)(ws + WS_SCB); F.MIX = (bf16*)(ws + WS_MIX); F.X1 = (bf16*)(ws + WS_X1);
    F.Y = (bf16*)(ws + WS_Y); F.SS = (float*)(ws + WS_S); F.IDX = (int*)(ws + WS_IDX); F.GV = (float*)(ws + WS_GV); F.SU = (float*)(ws + WS_SU);
    F.U8 = ws + WS_U8; F.V8 = ws + WS_V8; F.USC = (float*)(ws + WS_USC); F.VSC = (float*)(ws + WS_VSC);
    for (int u = F.tid; u < (LDS_BYTES - LDSCTL_OFF) / 4; u += NWAVES * 64) ((LAS unsigned*)(F.lds + LDSCTL_OFF))[u] = 0u;
    __syncthreads();
    XcdBarrier bar; bar.bar = (unsigned*)(F.ctl + CW_BAR); bar.x = 0; bar.st = nullptr;
    if (N_LAUNCHES == 1) bar = xcd_barrier_post((unsigned*)(F.ctl + CW_BAR), F.MISC + 8);
    const int lo = args.ph_lo, hi = args.ph_hi;
#ifndef ONLY_PHASE
#define ONLY_PHASE -1
#endif
#define IN(k) ((ONLY_PHASE < 0 || ONLY_PHASE == (k)) && lo <= (k) && (k) < hi)
#define SEAM(k) do { if (IN(k) && IN((k) + 1)) xcd_barrier(bar); } while (0)
#ifndef REPEAT_PHASE
#define REPEAT_PHASE -1
#endif
#define REPS(k) for (int rep_ = 0; rep_ < (REPEAT_PHASE == (k) ? 2 : 1); ++rep_)

    if (IN(0)) { REPS(0) p0_prologue(F); SEAM(0); }
    if (IN(1)) { REPS(1) {
        if (F.G == 256) { if (blockIdx.x >= 128) p0_peer_tables(F, ((int)blockIdx.x - 128) * NWAVES + F.wave, 128 * NWAVES); }
        else p0_peer_tables(F, F.vcu * NWAVES + F.wave, F.G * NWAVES);
        __syncthreads();
        pg8::Gemm g{F.XB, F.BT1, S, NIN, D}; pg8::StaticOrder So; So.init(S, NIN, F.G, (int)blockIdx.x);
        pg8::EpiInProj E{F.AGLU, F.CV, F.SCB, F.b_in};
        pg8::gemm_phase<pg8::EpiInProj, pg8::StaticOrder, PG8_ALIGN, PG8_SP2>(F.lds + RING_OFF, g, So, E); }
        SEAM(1);
    }
    if (IN(2)) { REPS(2) for (int u = F.vcu; u < S / 32; u += F.G) p2_unit(F, u); SEAM(2); }
    if (IN(3)) { REPS(3) {
        pg8::Gemm g{F.MIX, F.BT2, S, D, D}; pg8::StaticOrder So; So.init(S, D, F.G, (int)blockIdx.x);
        pg8::EpiOutProj E{F.Y, F.b_out, F.XB, ALPHA};
        pg8::gemm_phase<pg8::EpiOutProj, pg8::StaticOrder, PG8_ALIGN, PG8_SP2>(F.lds + RING_OFF, g, So, E); }
        SEAM(3);
    }
    if (IN(4)) { REPS(4) p4_ln1(F); SEAM(4); }
    if (IN(5)) { REPS(5) {
        pg8::Gemm g{F.X1, F.BT3, S, D, D}; pg8::StaticOrder So; So.init(S, D, F.G, (int)blockIdx.x);
        pg8::EpiF32 E{F.SS, D};
        pg8::gemm_phase<pg8::EpiF32, pg8::StaticOrder, PG8_ALIGN, PG8_SP2>(F.lds + RING_OFF, g, So, E); }
        SEAM(5);
    }
    if (IN(6)) { REPS(6) p6_topk(F); SEAM(6); }
    if (IN(7)) { REPS(7) p7_peer(F); }
#undef IN
#undef SEAM
}

extern "C" void kernel_launch(void* const* d_in, const int* in_sizes, int n_in, void* d_out, int out_size, void* d_ws, size_t ws_size, hipStream_t stream) {
    static int grid = 0;
    if (grid == 0) {
        if (n_in != 19 || in_sizes[0] != S * D || out_size != S * D || ws_size < WS_END) {
            fprintf(stderr, "kernel_launch: built for 19 inputs, x/out of %d floats, >= %zu bytes of workspace; got n_in %d, in0 %d, out %d, ws %zu; nothing launched\n", S * D, (size_t)WS_END, n_in, n_in > 0 ? in_sizes[0] : -1, out_size, ws_size);
            grid = -1; return; }
        int dev = 0, cus = 0, per_cu = 0;
        if (hipGetDevice(&dev) != hipSuccess || hipDeviceGetAttribute(&cus, hipDeviceAttributeMultiprocessorCount, dev) != hipSuccess) { fprintf(stderr, "kernel_launch: device query failed\n"); grid = -1; return; }
        if (hipFuncSetAttribute((const void*)peer_layer_fwd, hipFuncAttributeMaxDynamicSharedMemorySize, LDS_BYTES) != hipSuccess) { fprintf(stderr, "kernel_launch: hipFuncSetAttribute failed\n"); grid = -1; return; }
        if (hipOccupancyMaxActiveBlocksPerMultiprocessor(&per_cu, (const void*)peer_layer_fwd, NWAVES * 64, LDS_BYTES) != hipSuccess || per_cu < 1) {
            fprintf(stderr, "kernel_launch: occupancy query reports %d workgroups per CU; nothing launched\n", per_cu); (void)hipGetLastError(); grid = -1; return; }
        (void)hipGetLastError();
        grid = cus;
    }
    if (grid < 0) return;
    if (hipMemsetAsync((char*)d_ws + WS_CTL, 0, CTL_ZERO_BYTES, stream) != hipSuccess) { fprintf(stderr, "kernel_launch: hipMemsetAsync failed\n"); return; }
    Args a{};
    for (int i = 0; i < 19; ++i) a.in[i] = (const float*)d_in[i];
    a.out = (float*)d_out; a.ws = (unsigned char*)d_ws;
    for (int li = 0; li < N_LAUNCHES; ++li) {
        a.ph_lo = (N_LAUNCHES == 1) ? 0 : li; a.ph_hi = (N_LAUNCHES == 1) ? N_PHASES : li + 1; a.li = li;
        hipError_t le;
        if (N_LAUNCHES == 1) { void* kargs[] = {&a}; le = hipLaunchCooperativeKernel((const void*)peer_layer_fwd, dim3(grid), dim3(NWAVES * 64), kargs, LDS_BYTES, stream); }
        else { hipLaunchKernelGGL(peer_layer_fwd, dim3(grid), dim3(NWAVES * 64), LDS_BYTES, stream, a); le = hipPeekAtLastError(); }
        if (le != hipSuccess) { fprintf(stderr, "kernel_launch: launch %d failed: %s (grid %d x %d threads, %d B LDS)\n", li, hipGetErrorName(le), grid, NWAVES * 64, LDS_BYTES); break; }
    }
}
```

```cpp
#include <hip/hip_runtime.h>
#include <cstdio>
#include <cstdint>
namespace pg8 {
#define PG8_LAS __attribute__((address_space(3)))
typedef unsigned short bf16_t;
typedef short bf16x8 __attribute__((ext_vector_type(8)));
typedef float f32x4 __attribute__((ext_vector_type(4)));
typedef unsigned u32x4 __attribute__((ext_vector_type(4)));
constexpr int BM = 256, BK = 64, HALF = 128, HTB = HALF * BK * 2  , STAGE_BYTES = 8 * HTB, NXCD = 8, WGM = 8;

__host__ __device__ __forceinline__ int lds_byte(int r, int c) { const int st = (r >> 4) * 2 + (c >> 5), rr = r & 15, cc = c & 31, ob = rr * 64 + cc * 2; return st * 1024 + (ob ^ (((ob >> 9) & 1) << 5)); }
__host__ __device__ __forceinline__ void stage_rc(int b, int& R, int& C) { const int st = b / 1024, sb = b % 1024, swz = sb ^ (((sb >> 9) & 1) << 5); R = (st >> 1) * 16 + swz / 64; C = (st & 1) * 32 + (swz % 64) / 2; }
__host__ __device__ __forceinline__ int perm32(int rho) { const int n = rho >> 4, i = rho & 15; return 8 * (i >> 2) + 4 * n + (i & 3); }

struct Unit { int pm, pn; };
struct Gemm { const bf16_t* A; const bf16_t* Bt; int M, N, K; };

struct StaticOrder {
    int nM, nN, nwg, G, c;
    __host__ __device__ void init(int M, int N, int G_, int c_) { nM = M / BM; nN = N / BM; nwg = nM * nN; G = G_; c = c_; }
    __host__ __device__ bool next(int i, Unit& u) const {
        const long L = (long)i * G + c; if (L >= nwg) return false;
        int wgid = (int)L; { const int q = nwg / NXCD, r = nwg % NXCD, xcd = wgid % NXCD, off = wgid / NXCD; wgid = (xcd < r ? xcd * (q + 1) : r * (q + 1) + (xcd - r) * q) + off; }
        const int nig = WGM * nN, gid = wgid / nig, fm = gid * WGM, gsz = (nM - fm) < WGM ? (nM - fm) : WGM;
        u.pm = fm + ((wgid % nig) % gsz); u.pn = (wgid % nig) / gsz; return true;
    }
    __device__ __forceinline__ void a_ready(const Unit&) const {}
    __device__ __forceinline__ void done(const Unit&) const {}
};

__device__ __forceinline__ unsigned cvt_pk_bf16(float lo, float hi) { unsigned r; asm volatile("v_cvt_pk_bf16_f32 %0, %1, %2" : "=v"(r) : "v"(lo), "v"(hi)); return r; }
__device__ __forceinline__ float sigmoidf_fast(float g) { return __builtin_amdgcn_rcpf(1.0f + __expf(-g)); }

struct EpiInProj {
    static constexpr bool PERM = true, AFTER_DRAIN = false;
    bf16_t* aglu; bf16_t* cv; bf16_t* scb; const float* b_in;
    __device__ __forceinline__ void operator()(const f32x4 (&acc)[2][2][4][2], const Unit& u, int wr, int wc, int fr, int fq) const {
        const int row0 = u.pm * BM + wr * 64 + fr, cc = wc * 32 + 8 * fq;
        if (u.pn < 16) {
            const bool conf = u.pn < 8; const int j = conf ? u.pn : u.pn - 8;
            const float* b0 = b_in + (conf ? 0 : 3072) + 128 * j + cc;
            const float* b1 = b_in + (conf ? 1024 : 4096) + 128 * j + cc;
            bf16_t* O = (conf ? aglu : cv) + 128 * j + cc;
            f32x4 bv0[2], bv1[2];
#pragma unroll
            for (int n = 0; n < 2; ++n) { bv0[n] = *(const f32x4*)(b0 + 4 * n); bv1[n] = *(const f32x4*)(b1 + 4 * n); }
#pragma unroll
            for (int ai = 0; ai < 2; ++ai)
#pragma unroll
                for (int m = 0; m < 4; ++m) {
                    f32x4 r[2];
#pragma unroll
                    for (int n = 0; n < 2; ++n) { const f32x4 a = acc[ai][0][m][n] + bv0[n]; f32x4 g = acc[ai][1][m][n] + bv1[n];
                        if (conf) { g[0] = sigmoidf_fast(g[0]); g[1] = sigmoidf_fast(g[1]); g[2] = sigmoidf_fast(g[2]); g[3] = sigmoidf_fast(g[3]); }
                        r[n] = a * g; }
                    u32x4 w; w.x = cvt_pk_bf16(r[0][0], r[0][1]); w.y = cvt_pk_bf16(r[0][2], r[0][3]); w.z = cvt_pk_bf16(r[1][0], r[1][1]); w.w = cvt_pk_bf16(r[1][2], r[1][3]);
                    *(u32x4*)(O + (size_t)(row0 + ai * HALF + m * 16) * 1024) = w; }
        } else {
            const int j = u.pn - 16;
#pragma unroll
            for (int bj = 0; bj < 2; ++bj) {
                const float* b0 = b_in + 2048 + 256 * j + 128 * bj + cc; bf16_t* O = scb + 256 * j + 128 * bj + cc;
                const f32x4 bva = *(const f32x4*)(b0), bvb = *(const f32x4*)(b0 + 4);
#pragma unroll
                for (int ai = 0; ai < 2; ++ai)
#pragma unroll
                    for (int m = 0; m < 4; ++m) { const f32x4 v0 = acc[ai][bj][m][0] + bva, v1 = acc[ai][bj][m][1] + bvb;
                        u32x4 w; w.x = cvt_pk_bf16(v0[0], v0[1]); w.y = cvt_pk_bf16(v0[2], v0[3]); w.z = cvt_pk_bf16(v1[0], v1[1]); w.w = cvt_pk_bf16(v1[2], v1[3]);
                        *(u32x4*)(O + (size_t)(row0 + ai * HALF + m * 16) * 1024) = w; } }
        }
    }
};
struct EpiOutProj {
    static constexpr bool PERM = true, AFTER_DRAIN = false;
    bf16_t* Y; const float* bias; const bf16_t* xb; float alpha;
    __device__ __forceinline__ void operator()(const f32x4 (&acc)[2][2][4][2], const Unit& u, int wr, int wc, int fr, int fq) const {
        const int row0 = u.pm * BM + wr * 64 + fr, col0 = u.pn * BM + wc * 32 + 8 * fq;
        f32x4 bv[2][2];
#pragma unroll
        for (int bj = 0; bj < 2; ++bj)
#pragma unroll
            for (int n = 0; n < 2; ++n) bv[bj][n] = *(const f32x4*)(bias + col0 + bj * HALF + 4 * n);
#pragma unroll
        for (int ai = 0; ai < 2; ++ai)
#pragma unroll
            for (int m = 0; m < 4; ++m) { const size_t off = (size_t)(row0 + ai * HALF + m * 16) * 2048 + col0;
#pragma unroll
                for (int bj = 0; bj < 2; ++bj) { const u32x4 xw = *(const u32x4*)(xb + off + bj * HALF);
                    f32x4 v0 = acc[ai][bj][m][0] + bv[bj][0], v1 = acc[ai][bj][m][1] + bv[bj][1];
                    v0[0] += alpha * __uint_as_float(xw.x << 16); v0[1] += alpha * __uint_as_float(xw.x & 0xffff0000u); v0[2] += alpha * __uint_as_float(xw.y << 16); v0[3] += alpha * __uint_as_float(xw.y & 0xffff0000u);
                    v1[0] += alpha * __uint_as_float(xw.z << 16); v1[1] += alpha * __uint_as_float(xw.z & 0xffff0000u); v1[2] += alpha * __uint_as_float(xw.w << 16); v1[3] += alpha * __uint_as_float(xw.w & 0xffff0000u);
                    u32x4 w; w.x = cvt_pk_bf16(v0[0], v0[1]); w.y = cvt_pk_bf16(v0[2], v0[3]); w.z = cvt_pk_bf16(v1[0], v1[1]); w.w = cvt_pk_bf16(v1[2], v1[3]);
                    *(u32x4*)(Y + off + bj * HALF) = w; }
                asm volatile("" ::: "memory"); }
    }
};
struct EpiF32 {
    static constexpr bool PERM = false, AFTER_DRAIN = false;
    float* C; int ldc;
    __device__ __forceinline__ void operator()(const f32x4 (&acc)[2][2][4][2], const Unit& u, int wr, int wc, int fr, int fq) const {
        const int row0 = u.pm * BM + wr * 64 + fr, col0 = u.pn * BM + wc * 32 + 4 * fq;
#pragma unroll
        for (int ai = 0; ai < 2; ++ai)
#pragma unroll
            for (int m = 0; m < 4; ++m) { float* rowp = C + (size_t)(row0 + ai * HALF + m * 16) * ldc + col0;
#pragma unroll
                for (int bj = 0; bj < 2; ++bj)
#pragma unroll
                    for (int n = 0; n < 2; ++n) *(f32x4*)(rowp + bj * HALF + n * 16) = acc[ai][bj][m][n]; }
    }
};

template <class Epi, class Sched, bool ALIGN_EPI = false, bool SP2 = false>
__device__ __forceinline__ void gemm_phase(PG8_LAS unsigned char* lds, const Gemm g, const Sched& S, const Epi& E) {
    const int tid = threadIdx.x, wid = __builtin_amdgcn_readfirstlane(tid >> 6), lane = tid & 63, wr = wid >> 2, wc = wid & 3, fr = lane & 15, fq = lane >> 4;
    const int K = g.K, nt = K / BK;
    unsigned voffA[2], voffB[2];
#pragma unroll
    for (int i = 0; i < 2; ++i) { int R, C; stage_rc(tid * 16 + i * 8192, R, C); const int Rb = Epi::PERM ? ((R & ~31) + perm32(R & 31)) : R;
        voffA[i] = (unsigned)(R * K + C) * 2u; voffB[i] = (unsigned)(Rb * K + C) * 2u; }
    const size_t kstep = (size_t)(BK * 2);
    const size_t hstep = (size_t)HALF * K * 2;
    const size_t tstep = 2 * hstep;
    const unsigned ldsw = (unsigned)wid * 1024u;
    const int aoff = lds_byte(wr * 64 + fr, fq * 8), boff = lds_byte(wc * 32 + fr, fq * 8);
#define PG8_SA(b, h) (((b) * 2 + (h)) * HTB)
#define PG8_SB(b, h) ((4 + (b) * 2 + (h)) * HTB)
#define PG8_STAGE(bufoff, gbase, voff) do { _Pragma("unroll") for (int _i = 0; _i < 2; ++_i) \
        __builtin_amdgcn_global_load_lds((const unsigned*)((const char*)(gbase) + (voff)[_i]), (PG8_LAS unsigned*)(lds + (bufoff) + ldsw + _i * 8192), 16, 0, 0); } while (0)
#define PG8_LDA(dst, b, h) do { _Pragma("unroll") for (int m = 0; m < 4; ++m) _Pragma("unroll") for (int k = 0; k < 2; ++k) dst[m][k] = *(const PG8_LAS bf16x8*)(lds + PG8_SA(b, h) + aoff + m * 2048 + k * 1024); } while (0)
#define PG8_LDB(dst, b, h) do { _Pragma("unroll") for (int n = 0; n < 2; ++n) _Pragma("unroll") for (int k = 0; k < 2; ++k) dst[n][k] = *(const PG8_LAS bf16x8*)(lds + PG8_SB(b, h) + boff + n * 2048 + k * 1024); } while (0)
#define PG8_MMA(ai, bj, At, Bt) do { __builtin_amdgcn_s_setprio(1); _Pragma("unroll") for (int m = 0; m < 4; ++m) _Pragma("unroll") for (int n = 0; n < 2; ++n) _Pragma("unroll") for (int k = 0; k < 2; ++k) \
        acc[ai][bj][m][n] = __builtin_amdgcn_mfma_f32_16x16x32_bf16(Bt[n][k], At[m][k], acc[ai][bj][m][n], 0, 0, 0); __builtin_amdgcn_s_setprio(0); } while (0)
#define PG8_WAIT_V(n) asm volatile("s_waitcnt vmcnt(" #n ")" ::: "memory")
#define PG8_WAIT_L(n) asm volatile("s_waitcnt lgkmcnt(" #n ")" ::: "memory")
#define PG8_BAR __builtin_amdgcn_s_barrier()
#define PG8_SCHED __builtin_amdgcn_sched_barrier(0)
    Unit cur, nxt; int ui = 0;
    if (!S.next(0, cur)) return;
    f32x4 acc[2][2][4][2];
#pragma unroll
    for (int a = 0; a < 2; ++a)
#pragma unroll
        for (int b = 0; b < 2; ++b)
#pragma unroll
            for (int m = 0; m < 4; ++m)
#pragma unroll
                for (int n = 0; n < 2; ++n) acc[a][b][m][n] = (f32x4){0.f, 0.f, 0.f, 0.f};
    bf16x8 At[4][2], B0[2][2], B1[2][2];
    const char* cA = (const char*)g.A + (size_t)cur.pm * tstep; const char* cB = (const char*)g.Bt + (size_t)cur.pn * tstep;
    S.a_ready(cur);
    if constexpr (SP2) {
        PG8_STAGE(PG8_SB(0, 0), cB, voffB); PG8_STAGE(PG8_SB(0, 1), cB + hstep, voffB); PG8_STAGE(PG8_SA(0, 0), cA, voffA); PG8_STAGE(PG8_SA(0, 1), cA + hstep, voffA);
        if (wr == 1) PG8_BAR;
        PG8_WAIT_V(2); PG8_BAR;
        PG8_STAGE(PG8_SB(1, 0), cB + kstep, voffB); PG8_STAGE(PG8_SA(1, 0), cA + kstep, voffA); PG8_STAGE(PG8_SB(1, 1), cB + hstep + kstep, voffB);
        PG8_WAIT_V(6); PG8_BAR;
    } else {
        PG8_STAGE(PG8_SB(0, 0), cB, voffB); PG8_STAGE(PG8_SA(0, 0), cA, voffA); PG8_STAGE(PG8_SB(0, 1), cB + hstep, voffB); PG8_STAGE(PG8_SA(0, 1), cA + hstep, voffA);
        if (wr == 1) PG8_BAR;
        PG8_WAIT_V(4); PG8_BAR;
        PG8_STAGE(PG8_SB(1, 0), cB + kstep, voffB); PG8_STAGE(PG8_SA(1, 0), cA + kstep, voffA); PG8_STAGE(PG8_SB(1, 1), cB + hstep + kstep, voffB);
        PG8_WAIT_V(6); PG8_BAR;
    }
    for (;;) {
        const bool has_next = S.next(ui + 1, nxt);
        const char* nA = has_next ? (const char*)g.A + (size_t)nxt.pm * tstep : cA; const char* nB = has_next ? (const char*)g.Bt + (size_t)nxt.pn * tstep : cB;
        for (int t = 0; t < nt; t += 2) {
            const bool last = (t == nt - 2);
            const char* a1 = cA + (size_t)(t + 1) * kstep;
            const char* a2 = last ? nA : cA + (size_t)(t + 2) * kstep; const char* b2 = last ? nB : cB + (size_t)(t + 2) * kstep;
            const char* a3 = a2 + kstep; const char* b3 = b2 + kstep;
            if (last && has_next) S.a_ready(nxt);
            if constexpr (SP2) {
            PG8_LDB(B0, 0, 0); PG8_LDB(B1, 0, 1); PG8_SCHED; PG8_LDA(At, 0, 0); PG8_STAGE(PG8_SA(1, 1), a1 + hstep, voffA);
            PG8_WAIT_V(8); PG8_WAIT_L(0); PG8_BAR; PG8_MMA(0, 0, At, B0); PG8_MMA(0, 1, At, B1); PG8_BAR; PG8_SCHED;
            PG8_LDA(At, 0, 1); PG8_STAGE(PG8_SB(0, 0), b2, voffB); PG8_STAGE(PG8_SB(0, 1), b2 + hstep, voffB); PG8_STAGE(PG8_SA(0, 0), a2, voffA);
            PG8_WAIT_V(8); PG8_WAIT_L(0); PG8_BAR; PG8_MMA(1, 0, At, B0); PG8_MMA(1, 1, At, B1); PG8_BAR; PG8_SCHED;
            PG8_LDB(B0, 1, 0); PG8_LDB(B1, 1, 1); PG8_SCHED; PG8_LDA(At, 1, 0); PG8_STAGE(PG8_SA(0, 1), a2 + hstep, voffA);
            PG8_WAIT_V(8); PG8_WAIT_L(0); PG8_BAR; PG8_MMA(0, 0, At, B0); PG8_MMA(0, 1, At, B1); PG8_BAR; PG8_SCHED;
            PG8_LDA(At, 1, 1); PG8_STAGE(PG8_SB(1, 0), b3, voffB); PG8_STAGE(PG8_SB(1, 1), b3 + hstep, voffB); PG8_STAGE(PG8_SA(1, 0), a3, voffA);
            PG8_WAIT_V(8); PG8_WAIT_L(0); PG8_BAR; PG8_MMA(1, 0, At, B0); PG8_MMA(1, 1, At, B1); PG8_BAR; PG8_SCHED;
            } else {
            PG8_LDB(B0, 0, 0); PG8_SCHED; PG8_LDA(At, 0, 0); PG8_STAGE(PG8_SA(1, 1), a1 + hstep, voffA);
            PG8_WAIT_L(8); PG8_BAR; PG8_WAIT_L(0); PG8_MMA(0, 0, At, B0); PG8_BAR; PG8_SCHED;
            PG8_LDB(B1, 0, 1); PG8_STAGE(PG8_SB(0, 0), b2, voffB);
            PG8_BAR; PG8_WAIT_L(0); PG8_MMA(0, 1, At, B1); PG8_BAR;
            PG8_LDA(At, 0, 1); PG8_STAGE(PG8_SA(0, 0), a2, voffA);
            PG8_BAR; PG8_WAIT_L(0); PG8_MMA(1, 0, At, B0); PG8_BAR; PG8_SCHED;
            PG8_STAGE(PG8_SB(0, 1), b2 + hstep, voffB);
            PG8_WAIT_V(6); PG8_BAR; PG8_MMA(1, 1, At, B1); PG8_BAR;
            PG8_LDB(B0, 1, 0); PG8_SCHED; PG8_LDA(At, 1, 0); PG8_STAGE(PG8_SA(0, 1), a2 + hstep, voffA);
            PG8_WAIT_L(8); PG8_BAR; PG8_WAIT_L(0); PG8_MMA(0, 0, At, B0); PG8_BAR; PG8_SCHED;
            PG8_LDB(B1, 1, 1); PG8_STAGE(PG8_SB(1, 0), b3, voffB);
            PG8_BAR; PG8_WAIT_L(0); PG8_MMA(0, 1, At, B1); PG8_BAR;
            PG8_LDA(At, 1, 1); PG8_STAGE(PG8_SA(1, 0), a3, voffA);
            PG8_BAR; PG8_WAIT_L(0); PG8_MMA(1, 0, At, B0); PG8_BAR; PG8_SCHED;
            PG8_STAGE(PG8_SB(1, 1), b3 + hstep, voffB);
            PG8_WAIT_V(6); PG8_BAR; PG8_MMA(1, 1, At, B1); PG8_BAR;
            }
        }
        if constexpr (ALIGN_EPI) { if (wr == 0) PG8_BAR; }
        if constexpr (!Epi::AFTER_DRAIN) { E(acc, cur, wr, wc, fr, fq); S.done(cur); }
        if (!has_next) break;
#pragma unroll
        for (int a = 0; a < 2; ++a)
#pragma unroll
            for (int b = 0; b < 2; ++b)
#pragma unroll
                for (int m = 0; m < 4; ++m)
#pragma unroll
                    for (int n = 0; n < 2; ++n) acc[a][b][m][n] = (f32x4){0.f, 0.f, 0.f, 0.f};
        cur = nxt; cA = nA; cB = nB; ++ui;
        if constexpr (ALIGN_EPI) { if (wr == 1) PG8_BAR; }
    }
    PG8_WAIT_V(0);
    if constexpr (!ALIGN_EPI) { if (wr == 0) PG8_BAR; }
    PG8_BAR;
    if constexpr (Epi::AFTER_DRAIN) { E.fused(acc, cur, wr, wc, fr, fq, lds, wid, lane); S.done(cur); }
#undef PG8_SA
#undef PG8_SB
#undef PG8_STAGE
#undef PG8_LDA
#undef PG8_LDB
#undef PG8_MMA
#undef PG8_WAIT_V
#undef PG8_WAIT_L
#undef PG8_BAR
#undef PG8_SCHED
}
}

#ifndef PG8_SP2
#define PG8_SP2 true
#endif
#ifndef PG8_ALIGN
#define PG8_ALIGN true
#endif
constexpr int NWAVES = 8;
#ifndef MK_N_LAUNCHES
#define MK_N_LAUNCHES 1
#endif
constexpr int N_PHASES = 8;
constexpr int N_LAUNCHES = MK_N_LAUNCHES;

constexpr int ROWB = 1536;
constexpr int S = 8192, D = 2048, NIN = 5120, DC = 1024, NE = 16384, NPAIR = 128;
constexpr float LN_EPS = 1e-5f;
constexpr float ALPHA = 1.189207115002721f;

constexpr size_t MiB = 1u << 20;
constexpr size_t WS_CTL = 0, CTL_ZERO_BYTES = 64 * 1024;
constexpr size_t WS_XB = 2 * MiB;
constexpr size_t WS_BT1 = 34 * MiB;
constexpr size_t WS_BT2 = 54 * MiB;
constexpr size_t WS_BT3 = 62 * MiB;
constexpr size_t WS_AGLU = 70 * MiB;
constexpr size_t WS_CV = 86 * MiB;
constexpr size_t WS_SCB = 102 * MiB;
constexpr size_t WS_MIX = 118 * MiB;
constexpr size_t WS_Y = 150 * MiB;
constexpr size_t WS_X1 = 214 * MiB;
constexpr size_t WS_S = 246 * MiB;
constexpr size_t WS_IDX = 310 * MiB;
constexpr size_t WS_GV = 314 * MiB;
constexpr size_t WS_SU = 318 * MiB;
constexpr size_t WS_U8 = 322 * MiB;
constexpr size_t WS_V8 = 354 * MiB;
constexpr size_t WS_USC = 386 * MiB;
constexpr size_t WS_VSC = 386 * MiB + 65536;
constexpr size_t WS_END = 387 * MiB;
constexpr int CW_BAR = 4096;

constexpr int RING_OFF = 0, RING_BYTES = 131072;
constexpr int LDSCTL_OFF = RING_BYTES, MISC_OFF = LDSCTL_OFF + 320;
constexpr int LNP_OFF = MISC_OFF + 128;
constexpr int LDS_BYTES = 155648;

#define GAS __attribute__((address_space(1)))
#define LAS __attribute__((address_space(3)))
typedef unsigned short bf16;
typedef unsigned v4u __attribute__((ext_vector_type(4)));
typedef unsigned v2u __attribute__((ext_vector_type(2)));
typedef float f32x4 __attribute__((ext_vector_type(4)));
typedef float f32x2 __attribute__((ext_vector_type(2)));
typedef short bf16x8 __attribute__((ext_vector_type(8)));
typedef GAS unsigned gu32;
#define LDS_WAIT() asm volatile("s_waitcnt lgkmcnt(0)" ::: "memory")
#define VM_WAIT() asm volatile("s_waitcnt vmcnt(0)" ::: "memory")
__device__ __forceinline__ unsigned pk2(float lo, float hi) { return pg8::cvt_pk_bf16(lo, hi); }
__device__ __forceinline__ float bf_lo(unsigned w) { return __uint_as_float(w << 16); }
__device__ __forceinline__ float bf_hi(unsigned w) { return __uint_as_float(w & 0xffff0000u); }
__device__ __forceinline__ float wave_sum(float v) {
#pragma unroll
    for (int o = 1; o < 64; o <<= 1) v += __shfl_xor(v, o);
    return v;
}
__device__ __forceinline__ float wave_max(float v) {
#pragma unroll
    for (int o = 1; o < 64; o <<= 1) v = fmaxf(v, __shfl_xor(v, o));
    return v;
}

#define XB_TMO      128
#define XB_XCNT(j)  (256  + 64 * (j))
#define XB_XSUB(j)  (1280 + 64 * (j))
#define XB_XGEN(j)  (2304 + 64 * (j))
#define XB_TOP      3328
#define XB_TOPGEN   3392
#define XCD_BAR_WORDS 3456
#define XB_SPIN_CAP (1u << 18)

__device__ __forceinline__ unsigned xb_ld(unsigned* p)              { return __hip_atomic_load(p, __ATOMIC_RELAXED, __HIP_MEMORY_SCOPE_AGENT); }
__device__ __forceinline__ unsigned xb_add(unsigned* p, unsigned v) { return __hip_atomic_fetch_add(p, v, __ATOMIC_RELAXED, __HIP_MEMORY_SCOPE_AGENT); }
__device__ __forceinline__ unsigned xb_xcc_id() { return (unsigned)__builtin_amdgcn_s_getreg((3 << 11) | 20) & 0xFu; }
#define XB_SPIN(cond, bar) do { unsigned _sp = 0; while (cond) { __builtin_amdgcn_s_sleep(1); \
    if ((++_sp & 255u) == 0u) { if (xb_ld(&(bar)[XB_TMO])) break; if (_sp > XB_SPIN_CAP) { atomicAdd(&(bar)[XB_TMO], 1u); break; } } } } while (0)

struct XcdBarrier {
    unsigned* bar; unsigned x;
    volatile LAS unsigned* st;
};

__device__ __forceinline__ XcdBarrier xcd_barrier_post(unsigned* bar, volatile LAS unsigned* st) {
    XcdBarrier b; b.bar = bar; b.x = xb_xcc_id(); b.st = st;
    if (threadIdx.x == 0) (void)xb_add(&bar[XB_XCNT(b.x)], 1u);
    return b;
}
__device__ __forceinline__ void xcd_barrier_complete(unsigned* bar, unsigned x, unsigned& nloc, unsigned& nx) {
    const unsigned G = gridDim.x * gridDim.y * gridDim.z;
    unsigned sum, cnt, mine, sp = 0u;
    for (;;) {
        sum = 0u; cnt = 0u; mine = 0u;
#pragma unroll
        for (unsigned j = 0; j < 16; ++j) { const unsigned c = xb_ld(&bar[XB_XCNT(j)]); sum += c; cnt += (c > 0u) ? 1u : 0u; mine = (j == x) ? c : mine; }
        if (sum == G) break;
        __builtin_amdgcn_s_sleep(1);
        if ((++sp & 255u) == 0u) { if (xb_ld(&bar[XB_TMO])) break; if (sp > XB_SPIN_CAP) { atomicAdd(&bar[XB_TMO], 1u); break; } }
    }
    nloc = mine > 0u ? mine : 1u; nx = cnt > 0u ? cnt : 1u;
}

__device__ __forceinline__ void xcd_barrier(const XcdBarrier& b) {
    asm volatile("s_waitcnt vmcnt(0)" ::: "memory");
    __syncthreads();
    if (threadIdx.x == 0) {
        unsigned* bar = b.bar;
        __builtin_amdgcn_s_waitcnt(0);
        unsigned nloc = b.st[0], nx = b.st[1];
        if (nloc == 0u) { xcd_barrier_complete(bar, b.x, nloc, nx); b.st[0] = nloc; b.st[1] = nx; }
        const unsigned old = xb_add(&bar[XB_XSUB(b.x)], 1u);
        const unsigned gen = old / nloc;
        if (old + 1u == (gen + 1u) * nloc) {
            __builtin_amdgcn_fence(__ATOMIC_RELEASE, "agent");
            asm volatile("s_waitcnt vmcnt(0)" ::: "memory");
            const unsigned og = xb_add(&bar[XB_TOP], 1u);
            const unsigned tg = og / nx;
            if (og + 1u == (tg + 1u) * nx) xb_add(&bar[XB_TOPGEN], 1u);
            else XB_SPIN(xb_ld(&bar[XB_TOPGEN]) == tg, bar);
            __builtin_amdgcn_fence(__ATOMIC_ACQUIRE, "agent");
            xb_add(&bar[XB_XGEN(b.x)], 1u);
            asm volatile("s_waitcnt vmcnt(0)" ::: "memory");
        } else {
            XB_SPIN(xb_ld(&bar[XB_XGEN(b.x)]) == gen, bar);
            __builtin_amdgcn_fence(__ATOMIC_ACQUIRE, "agent");
            asm volatile("s_waitcnt vmcnt(0)" ::: "memory");
        }
    }
    __syncthreads();
}

struct Frame {
    LAS unsigned char* lds;
    volatile LAS unsigned* MISC;
    gu32* ctl;
    int tid, lane, wave, vcu, G;
    const float *x, *w_in, *b_in, *ccw, *ccb, *clg, *clb, *scw, *scbias, *w_out, *b_out, *ln1g, *ln1b, *w_q, *sub_keys, *peer_u, *peer_v, *ln2g, *ln2b;
    float* out;
    bf16 *XB, *BT1, *BT2, *BT3, *AGLU, *CV, *SCB, *MIX, *X1;
    bf16* Y; float* SS; int* IDX; float *GV, *SU; unsigned char *U8, *V8; float *USC, *VSC;
};

__device__ __forceinline__ int bt1_row(int n0) {
    const int grp = n0 >> 10, c = n0 & 1023, j = c >> 7, r = c & 127;
    if (grp == 0) return 256 * j + r;
    if (grp == 1) return 256 * j + 128 + r;
    if (grp == 2) return 4096 + c;
    if (grp == 3) return 2048 + 256 * j + r;
    return 2048 + 256 * j + 128 + r;
}
template <bool PERM_IN>
__device__ __forceinline__ void p0_transpose_item(const float* W, int K, int N, bf16* WT, LAS float* scr, int item, int lane) {
    const int nblk = N / 32, kb = item / nblk, nb = item % nblk, k0 = 64 * kb, n0 = 32 * nb;
    const int drow = PERM_IN ? bt1_row(n0) : n0;
#pragma unroll 8
    for (int i = 0; i < 32; ++i) { const int kk = 2 * i + (lane >> 5); scr[kk * 33 + (lane & 31)] = W[(size_t)(k0 + kk) * N + n0 + (lane & 31)]; }
    LDS_WAIT(); asm volatile("" ::: "memory");
    const int c = lane & 7;
#pragma unroll
    for (int j = 0; j < 4; ++j) { const int n = (lane >> 3) + 8 * j; const LAS float* s = scr + (8 * c) * 33 + n;
        v4u o; o.x = pk2(s[0 * 33], s[1 * 33]); o.y = pk2(s[2 * 33], s[3 * 33]); o.z = pk2(s[4 * 33], s[5 * 33]); o.w = pk2(s[6 * 33], s[7 * 33]);
        *(GAS v4u*)(WT + (size_t)(drow + n) * K + k0 + 8 * c) = o; }
    LDS_WAIT(); asm volatile("" ::: "memory");
}
__device__ __forceinline__ bf16x8 ld8_bf16(const float* p) {
    const f32x4 a = *(const f32x4*)p, b = *(const f32x4*)(p + 4);
    v4u w; w.x = pk2(a.x, a.y); w.y = pk2(a.z, a.w); w.z = pk2(b.x, b.y); w.w = pk2(b.z, b.w);
    return __builtin_bit_cast(bf16x8, w);
}
__device__ __forceinline__ unsigned fp6_encode(float y) {
    const unsigned sb = (__float_as_uint(y) >> 31) << 5;
    const float a = fabsf(y);
    const unsigned sub = (unsigned)__builtin_rintf(a * 8.0f);
    unsigned b = __float_as_uint(a); b += 0x7FFFFu + ((b >> 20) & 1u); b >>= 20;
    unsigned nrm = b - 1008u; nrm = nrm > 31u ? 31u : nrm;
    return sb | (a < 1.0f ? sub : nrm);
}
__device__ __forceinline__ void p0_prologue(Frame& F) {
    LAS float* scr = (LAS float*)(F.lds + RING_OFF + F.wave * 16384);
    const int gw = F.vcu * NWAVES + F.wave, NGW = F.G * NWAVES, lane = F.lane;
    constexpr int I_IN = (D / 64) * (NIN / 32), I_OUT = (D / 64) * (D / 32);
    for (int it = gw; it < I_IN + I_OUT; it += NGW) {
        if (it < I_IN) p0_transpose_item<true>(F.w_in, D, NIN, F.BT1, scr, it, lane);
        else p0_transpose_item<false>(F.w_out, D, D, F.BT2, scr, it - I_IN, lane);
    }
    for (int it = gw; it < 4096; it += NGW) {
        const int hp = it >> 8, nb = (it >> 5) & 7, db = it & 31, n0 = nb * 16, d0 = db * 64;
        const float* sk = F.sub_keys + ((size_t)hp * 128 + n0 + (lane & 15)) * 128 + 8 * (lane >> 4);
        const float* wq = F.w_q + (size_t)(d0 + (lane & 15)) * 2048 + hp * 128 + 8 * (lane >> 4);
        f32x4 acc[4];
#pragma unroll
        for (int dt = 0; dt < 4; ++dt) acc[dt] = (f32x4){0.f, 0.f, 0.f, 0.f};
#pragma unroll
        for (int ks = 0; ks < 4; ++ks) {
            const bf16x8 yf = ld8_bf16(sk + 32 * ks);
#pragma unroll
            for (int dt = 0; dt < 4; ++dt) { const bf16x8 xf = ld8_bf16(wq + (size_t)dt * 16 * 2048 + 32 * ks);
                acc[dt] = __builtin_amdgcn_mfma_f32_16x16x32_bf16(xf, yf, acc[dt], 0, 0, 0); }
        }
        bf16* orow = F.BT3 + (size_t)(hp * 128 + n0 + (lane & 15)) * 2048 + d0 + 4 * (lane >> 4);
#pragma unroll
        for (int dt = 0; dt < 4; ++dt) { v2u o; o.x = pk2(acc[dt][0], acc[dt][1]); o.y = pk2(acc[dt][2], acc[dt][3]); *(GAS v2u*)(orow + 16 * dt) = o; }
    }
    for (int r = gw; r < S; r += NGW) {
        const GAS f32x4* src = (const GAS f32x4*)(F.x + (size_t)r * D) + 2 * lane;
        GAS v4u* dst = (GAS v4u*)(F.XB + (size_t)r * D) + lane;
#pragma unroll
        for (int j = 0; j < 4; ++j) { const f32x4 a = src[128 * j], b = src[128 * j + 1];
            v4u o; o.x = pk2(a.x, a.y); o.y = pk2(a.z, a.w); o.z = pk2(b.x, b.y); o.w = pk2(b.z, b.w); dst[64 * j] = o; }
    }
}
__device__ __forceinline__ void p0_encode_row(Frame& F, const f32x4 (&v)[8], int r, int lane) {
    const bool isv = r >= NE; const int e = isv ? r - NE : r;
    float am = 0.f;
#pragma unroll
    for (int j = 0; j < 8; ++j) am = fmaxf(am, fmaxf(fmaxf(fabsf(v[j].x), fabsf(v[j].y)), fmaxf(fabsf(v[j].z), fabsf(v[j].w))));
    am = wave_max(am);
    const float sc = am > 0.f ? 7.5f / am : 1.f, inv = am > 0.f ? am / 7.5f : 1.f;
    typedef float f32x16 __attribute__((ext_vector_type(16))); typedef unsigned u32x6v __attribute__((ext_vector_type(6)));
    f32x16 lo16, hi16;
#pragma unroll
    for (int i = 0; i < 16; ++i) {
        lo16[i] = v[(2 * i) >> 2][(2 * i) & 3] * sc; hi16[i] = v[(2 * i + 1) >> 2][(2 * i + 1) & 3] * sc;
    }
    const u32x6v pk = __builtin_amdgcn_cvt_scalef32_2xpk16_fp6_f32(lo16, hi16, 1.0f);
    unsigned w[6];
#pragma unroll
    for (int i = 0; i < 6; ++i) w[i] = pk[i];
    unsigned char* dst = (isv ? F.V8 : F.U8) + (size_t)e * ROWB + 24 * lane;
    *(GAS v2u*)(dst) = (v2u){w[0], w[1]}; *(GAS v2u*)(dst + 8) = (v2u){w[2], w[3]}; *(GAS v2u*)(dst + 16) = (v2u){w[4], w[5]};
    if (lane == 0) (isv ? F.VSC : F.USC)[e] = inv;
}
__device__ __forceinline__ void p0_load_row(Frame& F, f32x4 (&v)[8], int r, int lane) {
    const int rc = r < 2 * NE ? r : 2 * NE - 1;
    const GAS f32x4* src = (const GAS f32x4*)((rc >= NE ? F.peer_v : F.peer_u) + (size_t)(rc >= NE ? rc - NE : rc) * D) + lane;
#pragma unroll
    for (int j = 0; j < 8; ++j) v[j] = src[64 * j];
}
__device__ __forceinline__ void p0_peer_tables(Frame& F, int wid, int nw) {
    const int lane = F.lane;
    f32x4 a[8], b[8], na[8], nb[8];
    p0_load_row(F, na, wid, lane); p0_load_row(F, nb, wid + nw, lane);
#pragma unroll 1
    for (int r = wid; r < 2 * NE; r += 2 * nw) {
#pragma unroll
        for (int j = 0; j < 8; ++j) { a[j] = na[j]; b[j] = nb[j]; }
        p0_load_row(F, na, r + 2 * nw, lane); p0_load_row(F, nb, r + 3 * nw, lane);
        p0_encode_row(F, a, r, lane);
        if (r + nw < 2 * NE) p0_encode_row(F, b, r + nw, lane);
    }
}

__device__ __forceinline__ float dpp_add(float v, int ctrl_sel) {
    int m;
    if (ctrl_sel == 0) m = __builtin_amdgcn_update_dpp(0, __float_as_int(v), 0x111, 0xf, 0xf, false);
    else if (ctrl_sel == 1) m = __builtin_amdgcn_update_dpp(0, __float_as_int(v), 0x112, 0xf, 0xf, false);
    else if (ctrl_sel == 2) m = __builtin_amdgcn_update_dpp(0, __float_as_int(v), 0x114, 0xf, 0xf, false);
    else if (ctrl_sel == 3) m = __builtin_amdgcn_update_dpp(0, __float_as_int(v), 0x118, 0xf, 0xf, false);
    else if (ctrl_sel == 4) m = __builtin_amdgcn_update_dpp(0, __float_as_int(v), 0x142, 0xa, 0xf, false);
    else m = __builtin_amdgcn_update_dpp(0, __float_as_int(v), 0x143, 0xc, 0xf, false);
    return v + __int_as_float(m);
}
__device__ __forceinline__ float wave_sum_lane63(float v) {
    v = dpp_add(v, 0); v = dpp_add(v, 1); v = dpp_add(v, 2); v = dpp_add(v, 3); v = dpp_add(v, 4); v = dpp_add(v, 5); return v;
}
__device__ __forceinline__ void p2_unit(Frame& F, int unit) {
    const int t0 = unit * 32, tid_in = F.tid, lane = F.lane;
    LAS unsigned char* abuf = F.lds + RING_OFF;
    LAS float* stat = (LAS float*)(F.lds + LNP_OFF);
    {
        int tid = tid_in; asm volatile("" : "+v"(tid));
#pragma unroll
        for (int h = 0; h < 2; ++h) {
            v4u st[8];
#pragma unroll
            for (int k = 8 * h; k < 8 * h + 8; ++k) { const int c = tid + 512 * k; int cc = c < 62 * 128 ? c : 62 * 128 - 1; cc = (t0 - 30) * 128 + cc < 0 ? (30 - t0) * 128 : cc;
                st[k - 8 * h] = ((const GAS v4u*)F.AGLU)[(size_t)((t0 - 30) * 128 + cc)]; }
#pragma unroll
            for (int k = 8 * h; k < 8 * h + 8; ++k) { const int c = tid + 512 * k; const bool ok = (t0 - 30) * 128 + c >= 0;
                const v4u v = ok ? st[k - 8 * h] : (v4u){0u, 0u, 0u, 0u};
                if (k < 15 || tid < 62 * 128 - 512 * 15) *(LAS v4u*)(abuf + 16 * c) = v; }
            asm volatile("" ::: "memory");
        }
    }
    asm volatile("" ::: "memory"); __builtin_amdgcn_sched_barrier(0);
    {
        int tid = tid_in; asm volatile("" : "+v"(tid));
        const int cg = tid & 127, tg = tid >> 7, tb = t0 + 8 * tg;
        float w0[8], w1[8], w2[8], bs[8];
#pragma unroll
        for (int h = 0; h < 2; ++h) { const f32x4 a = *(const GAS f32x4*)(F.scw + 8 * cg + 4 * h), b = *(const GAS f32x4*)(F.scw + 1024 + 8 * cg + 4 * h), c = *(const GAS f32x4*)(F.scw + 2048 + 8 * cg + 4 * h), d = *(const GAS f32x4*)(F.scbias + 8 * cg + 4 * h);
#pragma unroll
            for (int q = 0; q < 4; ++q) { w0[4 * h + q] = a[q]; w1[4 * h + q] = b[q]; w2[4 * h + q] = c[q]; bs[4 * h + q] = d[q]; } }
        v4u cvr[10], gtr[8];
#pragma unroll
        for (int i = 0; i < 10; ++i) { const int t = tb - 2 + i, tc = t < 0 ? 0 : t; const v4u v = *(const GAS v4u*)(F.CV + (size_t)tc * 1024 + 8 * cg); cvr[i] = t < 0 ? (v4u){0u, 0u, 0u, 0u} : v; }
#pragma unroll
        for (int i = 0; i < 4; ++i) gtr[i] = *(const GAS v4u*)(F.SCB + (size_t)(tb + i) * 1024 + 8 * cg);
#pragma unroll
        for (int tt = 0; tt < 8; ++tt) {
            if (tt == 3) {
#pragma unroll
                for (int i = 4; i < 8; ++i) gtr[i] = *(const GAS v4u*)(F.SCB + (size_t)(tb + i) * 1024 + 8 * cg); }
            v4u o;
#pragma unroll
            for (int q = 0; q < 4; ++q) {
                const unsigned a2 = cvr[tt][q], a1 = cvr[tt + 1][q], a0 = cvr[tt + 2][q], g = gtr[tt][q];
                const float lo = bf_lo(g) * (bs[2 * q] + w0[2 * q] * bf_lo(a2) + w1[2 * q] * bf_lo(a1) + w2[2 * q] * bf_lo(a0));
                const float hi = bf_hi(g) * (bs[2 * q + 1] + w0[2 * q + 1] * bf_hi(a2) + w1[2 * q + 1] * bf_hi(a1) + w2[2 * q + 1] * bf_hi(a0));
                o[q] = pk2(lo, hi);
            }
            *(GAS v4u*)(F.MIX + (size_t)(tb + tt) * 2048 + 1024 + 8 * cg) = o;
        }
    }
    asm volatile("" ::: "memory"); __builtin_amdgcn_sched_barrier(0);
    LDS_WAIT(); __syncthreads();
    {
        int tid = tid_in; asm volatile("" : "+v"(tid)); const int c0 = 2 * tid;
        f32x2 w[31];
#pragma unroll
        for (int k = 0; k < 31; ++k) w[k] = *(const GAS f32x2*)(F.ccw + k * 1024 + c0);
        const f32x2 bias = *(const GAS f32x2*)(F.ccb + c0), lng = *(const GAS f32x2*)(F.clg + c0), lnb = *(const GAS f32x2*)(F.clb + c0);
#pragma unroll 1
        for (int g = 0; g < 4; ++g) {
            f32x2 o[8];
#pragma unroll
            for (int tt = 0; tt < 8; ++tt) o[tt] = bias;
#pragma unroll
            for (int half = 0; half < 2; ++half) {
                constexpr int NR = 23; const int r0 = half ? 16 : 0, k0 = half ? 16 : 0, nk = half ? 15 : 16;
                f32x2 in[NR];
#pragma unroll
                for (int i = 0; i < NR; ++i) { const int row = r0 + i < 38 ? r0 + i : 37; const unsigned raw = *(const LAS unsigned*)(abuf + (8 * g + row) * 2048 + 4 * tid); in[i] = (f32x2){bf_lo(raw), bf_hi(raw)}; }
#pragma unroll
                for (int tt = 0; tt < 8; ++tt)
#pragma unroll
                    for (int k = 0; k < 16; ++k) if (k < nk) o[tt] += w[k0 + k] * in[tt + k + k0 - r0];
                asm volatile("" ::: "memory");
            }
#pragma unroll
            for (int tt = 0; tt < 8; ++tt) { const float s1 = wave_sum_lane63(o[tt].x + o[tt].y), s2 = wave_sum_lane63(o[tt].x * o[tt].x + o[tt].y * o[tt].y);
                if (lane == 63) { stat[(tt * 2 + 0) * 8 + F.wave] = s1; stat[(tt * 2 + 1) * 8 + F.wave] = s2; } }
            LDS_WAIT(); __syncthreads();
            float tot;
            { const f32x4 a0 = *(const LAS f32x4*)(stat + (lane & 15) * 8), a1 = *(const LAS f32x4*)(stat + (lane & 15) * 8 + 4); tot = ((a0.x + a0.y) + (a0.z + a0.w)) + ((a1.x + a1.y) + (a1.z + a1.w)); }
#pragma unroll
            for (int tt = 0; tt < 8; ++tt) {
                const float mean = __int_as_float(__builtin_amdgcn_readlane(__float_as_int(tot), 2 * tt)) * (1.f / 1024.f);
                const float ex2 = __int_as_float(__builtin_amdgcn_readlane(__float_as_int(tot), 2 * tt + 1)) * (1.f / 1024.f);
                const float rstd = 1.f / sqrtf(fmaxf(ex2 - mean * mean, 0.f) + LN_EPS);
                f32x2 y = (o[tt] - mean) * rstd * lng + lnb;
                y.x *= pg8::sigmoidf_fast(y.x); y.y *= pg8::sigmoidf_fast(y.y);
                *(GAS unsigned*)(F.MIX + (size_t)(t0 + 8 * g + tt) * 2048 + c0) = pk2(y.x, y.y);
            }
            __syncthreads();
        }
    }
}

__device__ __forceinline__ void p4_ln1(Frame& F) {
    const int gw = F.vcu * NWAVES + F.wave, NGW = F.G * NWAVES, lane = F.lane;
    for (int r = gw; r < S; r += NGW) {
        const GAS v4u* yr = (const GAS v4u*)(F.Y + (size_t)r * D) + lane;
        float v[32]; float s = 0.f;
#pragma unroll
        for (int j = 0; j < 4; ++j) { const v4u w = yr[64 * j];
#pragma unroll
            for (int q = 0; q < 4; ++q) { v[8 * j + 2 * q] = bf_lo(w[q]); v[8 * j + 2 * q + 1] = bf_hi(w[q]); s += v[8 * j + 2 * q] + v[8 * j + 2 * q + 1]; } }
        const float mean = wave_sum(s) * (1.f / D); float s2 = 0.f;
#pragma unroll
        for (int i = 0; i < 32; ++i) { v[i] -= mean; s2 = fmaf(v[i], v[i], s2); }
        const float rstd = 1.f / sqrtf(wave_sum(s2) * (1.f / D) + LN_EPS);
        GAS v4u* o16 = (GAS v4u*)(F.X1 + (size_t)r * D) + lane;
#pragma unroll
        for (int j = 0; j < 4; ++j) { const int col = 8 * lane + 512 * j;
            const f32x4 g0 = *(const GAS f32x4*)(F.ln1g + col), g1 = *(const GAS f32x4*)(F.ln1g + col + 4), b0 = *(const GAS f32x4*)(F.ln1b + col), b1 = *(const GAS f32x4*)(F.ln1b + col + 4);
            v4u o; o.x = pk2(v[8 * j + 0] * rstd * g0.x + b0.x, v[8 * j + 1] * rstd * g0.y + b0.y); o.y = pk2(v[8 * j + 2] * rstd * g0.z + b0.z, v[8 * j + 3] * rstd * g0.w + b0.w);
            o.z = pk2(v[8 * j + 4] * rstd * g1.x + b1.x, v[8 * j + 5] * rstd * g1.y + b1.y); o.w = pk2(v[8 * j + 6] * rstd * g1.z + b1.z, v[8 * j + 7] * rstd * g1.w + b1.w);
            o16[64 * j] = o; }
    }
}

__device__ __forceinline__ int imax_(int a, int b) { return a > b ? a : b; }
__device__ __forceinline__ int imin_(int a, int b) { return a < b ? a : b; }
template <bool DESC> __device__ __forceinline__ void ce_i(int& a, int& b) { const int mx = imax_(a, b), mn = imin_(a, b); a = DESC ? mx : mn; b = DESC ? mn : mx; }
template <bool DESC> __device__ __forceinline__ void sort16_i(int (&v)[16]) {
#pragma unroll
    for (int k = 2; k <= 16; k <<= 1)
#pragma unroll
        for (int j = k >> 1; j > 0; j >>= 1)
#pragma unroll
            for (int i = 0; i < 16; ++i) { const int l = i ^ j; if (l > i) { const bool up = ((i & k) == 0); if (up != DESC) ce_i<false>(v[i], v[l]); else ce_i<true>(v[i], v[l]); } }
}
template <bool DESC> __device__ __forceinline__ void merge16_i(int (&v)[16]) {
#pragma unroll
    for (int j = 8; j > 0; j >>= 1)
#pragma unroll
        for (int i = 0; i < 16; ++i) { const int l = i ^ j; if (l > i) ce_i<DESC>(v[i], v[l]); }
}
template <bool DESC> __device__ __forceinline__ void ce_p(float& a, int& pa, float& b, int& pb) {
    const bool sw = DESC ? (a < b) : (a > b); const float ta = sw ? b : a, tb = sw ? a : b; const int qa = sw ? pb : pa, qb = sw ? pa : pb; a = ta; b = tb; pa = qa; pb = qb; }
template <bool DESC> __device__ __forceinline__ void sort16_p(float (&v)[16], int (&p)[16]) {
#pragma unroll
    for (int k = 2; k <= 16; k <<= 1)
#pragma unroll
        for (int j = k >> 1; j > 0; j >>= 1)
#pragma unroll
            for (int i = 0; i < 16; ++i) { const int l = i ^ j; if (l > i) { const bool up = ((i & k) == 0); if (up != DESC) ce_p<false>(v[i], p[i], v[l], p[l]); else ce_p<true>(v[i], p[i], v[l], p[l]); } }
}
template <bool DESC> __device__ __forceinline__ void merge16_p(float (&v)[16], int (&p)[16]) {
#pragma unroll
    for (int j = 8; j > 0; j >>= 1)
#pragma unroll
        for (int i = 0; i < 16; ++i) { const int l = i ^ j; if (l > i) ce_p<DESC>(v[i], p[i], v[l], p[l]); }
}
__device__ __forceinline__ int f2key(float f) { const int b = __float_as_int(f); return b ^ ((b >> 31) & 0x7fffffff); }
__device__ __forceinline__ float key2f(int k) { return __int_as_float(k ^ ((k >> 31) & 0x7fffffff)); }

__device__ __forceinline__ void p6_topk(Frame& F) {
    const int gw = F.vcu * NWAVES + F.wave, NGW = F.G * NWAVES, lane = F.lane;
    for (int it = gw; it < (S * 16) / 64; it += NGW) {
        const int prob = it * 64 + lane, t = prob >> 4, hp = prob & 15;
        const float* sp = F.SS + (size_t)t * 2048 + hp * 128;
        int top[16];
        {
            f32x4 r[4];
#pragma unroll
            for (int q = 0; q < 4; ++q) r[q] = *(const GAS f32x4*)(sp + 4 * q);
#pragma unroll
            for (int q = 0; q < 4; ++q)
#pragma unroll
                for (int e = 0; e < 4; ++e) top[4 * q + e] = (f2key(r[q][e]) & ~127) | (4 * q + e);
            sort16_i<true>(top);
        }
#pragma unroll 1
        for (int c = 1; c < 8; ++c) {
            f32x4 r[4]; int nw[16];
#pragma unroll
            for (int q = 0; q < 4; ++q) r[q] = *(const GAS f32x4*)(sp + 16 * c + 4 * q);
#pragma unroll
            for (int q = 0; q < 4; ++q)
#pragma unroll
                for (int e = 0; e < 4; ++e) nw[4 * q + e] = (f2key(r[q][e]) & ~127) | (16 * c + 4 * q + e);
            sort16_i<false>(nw);
#pragma unroll
            for (int i = 0; i < 16; ++i) top[i] = imax_(top[i], nw[i]);
            merge16_i<true>(top);
        }
        const bool odd = (lane & 1) != 0;
        float Av[16], Bv[16]; int Ai[16], Bi[16];
#pragma unroll
        for (int i = 0; i < 16; ++i) { const int mine = top[i]; const int other = __shfl_xor(mine, 1); const int ka = odd ? other : mine, kb = odd ? mine : other;
            Av[i] = key2f(ka & ~127); Ai[i] = ka & 127; Bv[i] = key2f(kb & ~127); Bi[i] = kb & 127; }
        float tv[16]; int tp[16];
#pragma unroll
        for (int j = 0; j < 16; ++j) { tv[j] = Av[0] + Bv[j]; tp[j] = Ai[0] * 128 + Bi[j]; }
        {
            float nv[16]; int np[16];
#pragma unroll
            for (int j = 0; j < 8; ++j) { nv[j] = Av[1] + Bv[j]; np[j] = Ai[1] * 128 + Bi[j]; }
#pragma unroll
            for (int j = 0; j < 5; ++j) { nv[8 + j] = Av[2] + Bv[j]; np[8 + j] = Ai[2] * 128 + Bi[j]; }
#pragma unroll
            for (int j = 0; j < 3; ++j) { nv[13 + j] = Av[3] + Bv[j]; np[13 + j] = Ai[3] * 128 + Bi[j]; }
            sort16_p<false>(nv, np);
#pragma unroll
            for (int i = 0; i < 16; ++i) { const bool g = nv[i] > tv[i]; tv[i] = g ? nv[i] : tv[i]; tp[i] = g ? np[i] : tp[i]; }
            merge16_p<true>(tv, tp);
        }
        {
            float nv[16]; int np[16];
            nv[0] = Av[3] + Bv[3]; np[0] = Ai[3] * 128 + Bi[3];
#pragma unroll
            for (int j = 0; j < 3; ++j) { nv[1 + j] = Av[4] + Bv[j]; np[1 + j] = Ai[4] * 128 + Bi[j]; }
#pragma unroll
            for (int i = 5; i < 8; ++i)
#pragma unroll
                for (int j = 0; j < 2; ++j) { nv[4 + 2 * (i - 5) + j] = Av[i] + Bv[j]; np[4 + 2 * (i - 5) + j] = Ai[i] * 128 + Bi[j]; }
#pragma unroll
            for (int i = 8; i < 14; ++i) { nv[10 + i - 8] = Av[i] + Bv[0]; np[10 + i - 8] = Ai[i] * 128 + Bi[0]; }
            sort16_p<false>(nv, np);
#pragma unroll
            for (int i = 0; i < 16; ++i) { const bool g = nv[i] > tv[i]; tv[i] = g ? nv[i] : tv[i]; tp[i] = g ? np[i] : tp[i]; }
            merge16_p<true>(tv, tp);
        }
        {
            const float hi = Av[14] + Bv[0], lo = Av[15] + Bv[0]; const int phi = Ai[14] * 128 + Bi[0], plo = Ai[15] * 128 + Bi[0];
            const float t14 = tv[14], t15 = tv[15]; const int q14 = tp[14], q15 = tp[15];
            const bool g14 = lo > t14, g15 = hi > t15;
            tv[14] = g14 ? lo : t14; tp[14] = g14 ? plo : q14; tv[15] = g15 ? hi : t15; tp[15] = g15 ? phi : q15;
        }
        float mx = tv[0];
#pragma unroll
        for (int i = 1; i < 16; ++i) mx = fmaxf(mx, tv[i]);
        float sum = 0.f;
#pragma unroll
        for (int i = 0; i < 16; ++i) { tv[i] = __expf(tv[i] - mx); sum += tv[i]; }
        const float rs = 1.f / sum;
        const size_t ob = (size_t)t * NPAIR + hp * 8;
        int oe[8]; float og[8], ou[8];
#pragma unroll
        for (int k = 0; k < 8; ++k) { const int pa = tp[k], pb = tp[8 + k]; const float va = tv[k], vb = tv[8 + k];
            oe[k] = odd ? pb : pa; const float g = (odd ? vb : va) * rs; og[k] = g * F.VSC[oe[k]]; ou[k] = F.USC[oe[k]]; }
        *(GAS v4u*)(F.IDX + ob) = (v4u){(unsigned)oe[0], (unsigned)oe[1], (unsigned)oe[2], (unsigned)oe[3]};
        *(GAS v4u*)(F.IDX + ob + 4) = (v4u){(unsigned)oe[4], (unsigned)oe[5], (unsigned)oe[6], (unsigned)oe[7]};
        *(GAS f32x4*)(F.GV + ob) = (f32x4){og[0], og[1], og[2], og[3]};
        *(GAS f32x4*)(F.GV + ob + 4) = (f32x4){og[4], og[5], og[6], og[7]};
        *(GAS f32x4*)(F.SU + ob) = (f32x4){ou[0], ou[1], ou[2], ou[3]};
        *(GAS f32x4*)(F.SU + ob + 4) = (f32x4){ou[4], ou[5], ou[6], ou[7]};
    }
}

constexpr int NSL = 10;
constexpr int RING_W = NSL * ROWB;
constexpr int TAB_V_OFS = (int)(WS_V8 - WS_U8);
static_assert(NWAVES * RING_W <= RING_BYTES, "rings fit the phase scratch region");
typedef unsigned u32x6 __attribute__((ext_vector_type(6)));
typedef float f32x32 __attribute__((ext_vector_type(32)));
typedef __bf16 bf16x32 __attribute__((ext_vector_type(32)));
typedef __bf16 bf16x2 __attribute__((ext_vector_type(2)));
__device__ __forceinline__ float gelu_erf(float z) { return 0.5f * z * (1.0f + erff(z * 0.70710678118654752f)); }
__device__ __forceinline__ void p7_sort512(int (&key)[8], int lane) {
#pragma unroll
    for (int k = 2; k <= 512; k <<= 1) {
#pragma unroll
        for (int j = k >> 1; j > 0; j >>= 1) {
            if (j >= 64) {
                const int jr = j >> 6;
#pragma unroll
                for (int r = 0; r < 8; ++r) if ((r & jr) == 0) { const int rp = r | jr; const bool asc = ((64 * r) & k) == 0;
                    const int a = key[r], b = key[rp], mn = imin_(a, b), mx = imax_(a, b); key[r] = asc ? mn : mx; key[rp] = asc ? mx : mn; }
            } else {
#pragma unroll
                for (int r = 0; r < 8; ++r) { const int mine = key[r], o = __builtin_amdgcn_ds_bpermute((lane ^ j) << 2, mine); const bool low = (lane & j) == 0, asc = ((64 * r + lane) & k) == 0;
                    key[r] = (low == asc) ? imin_(mine, o) : imax_(mine, o); }
            }
        }
    }
}
__device__ __forceinline__ int mbcnt64(unsigned long long m) { return (int)__builtin_amdgcn_mbcnt_hi((unsigned)(m >> 32), __builtin_amdgcn_mbcnt_lo((unsigned)m, 0u)); }
__device__ __forceinline__ int p7_group_by_slot(int kv) {
    const int s = (kv >> 7) & 3;
    const unsigned long long m0 = __ballot(s == 0), m1 = __ballot(s == 1), m2 = __ballot(s == 2), m3 = __ballot(s == 3);
    const int c0 = __popcll(m0), c1 = __popcll(m1), c2 = __popcll(m2);
    const int p0 = mbcnt64(m0), p1 = c0 + mbcnt64(m1), p2 = c0 + c1 + mbcnt64(m2), p3 = c0 + c1 + c2 + mbcnt64(m3);
    const int pos = s == 0 ? p0 : s == 1 ? p1 : s == 2 ? p2 : p3;
    return __builtin_amdgcn_ds_permute(pos << 2, kv);
}
__device__ __forceinline__ int sel8i(const int (&a)[8], int r) {
    const int a0 = a[0], a1 = a[1], a2 = a[2], a3 = a[3], a4 = a[4], a5 = a[5], a6 = a[6], a7 = a[7];
    int v = a0; v = r == 1 ? a1 : v; v = r == 2 ? a2 : v; v = r == 3 ? a3 : v; v = r == 4 ? a4 : v; v = r == 5 ? a5 : v; v = r == 6 ? a6 : v; v = r == 7 ? a7 : v; return v;
}
__device__ __forceinline__ float sel8f(const float (&a)[8], int r) {
    const float a0 = a[0], a1 = a[1], a2 = a[2], a3 = a[3], a4 = a[4], a5 = a[5], a6 = a[6], a7 = a[7];
    float v = a0; v = r == 1 ? a1 : v; v = r == 2 ? a2 : v; v = r == 3 ? a3 : v; v = r == 4 ? a4 : v; v = r == 5 ? a5 : v; v = r == 6 ? a6 : v; v = r == 7 ? a7 : v; return v;
}
__device__ __forceinline__ void p7_dma_row(__amdgpu_buffer_rsrc_t rs, LAS unsigned char* slotp, int soff, int v16) {
    __builtin_amdgcn_raw_ptr_buffer_load_lds(rs, (LAS void*)slotp, 16, v16, soff, 0, 0);
    if (v16 < 512) __builtin_amdgcn_raw_ptr_buffer_load_lds(rs, (LAS void*)(slotp + 1024), 16, v16, soff + 1024, 0, 0);
}
__device__ __forceinline__ u32x6 p7_read_row(const LAS unsigned char* slotp, int lane) {
    const LAS v2u* q = (const LAS v2u*)(slotp + 24 * lane); const v2u a = q[0], b = q[1], c = q[2];
    u32x6 r; r[0] = a.x; r[1] = a.y; r[2] = b.x; r[3] = b.y; r[4] = c.x; r[5] = c.y; return r;
}
__device__ __forceinline__ float p7_dot(const unsigned (&xp)[16], const bf16x32& uf) {
    float s0 = 0.f, s1 = 0.f;
#pragma unroll
    for (int m = 0; m < 16; m += 2) {
        bf16x2 a; a[0] = uf[2 * m]; a[1] = uf[2 * m + 1]; bf16x2 b; b[0] = uf[2 * m + 2]; b[1] = uf[2 * m + 3];
        const unsigned xa = xp[m], xb = xp[m + 1];
        s0 = __builtin_amdgcn_fdot2_f32_bf16(__builtin_bit_cast(bf16x2, xa), a, s0, false);
        s1 = __builtin_amdgcn_fdot2_f32_bf16(__builtin_bit_cast(bf16x2, xb), b, s1, false); }
    return s0 + s1;
}
__device__ __forceinline__ void p7_axpy(float (&acc)[32], float ck, const f32x32& vf) {
#pragma unroll
    for (int r = 0; r < 32; ++r) acc[r] = fmaf(ck, vf[r], acc[r]);
}
#define P7_WAIT_2ROWS() asm volatile("s_waitcnt vmcnt(16)" ::: "memory")
#define P7_WAIT_1ROW() asm volatile("s_waitcnt vmcnt(18)" ::: "memory")
#define P7_READS_DONE() asm volatile("s_waitcnt lgkmcnt(0)" ::: "memory")
static_assert(NSL == 10, "the counted waits above assume NSL = 10");
struct P7Stream { __amdgpu_buffer_rsrc_t tab; LAS unsigned char* ring; int rs; int v16; };
__device__ __forceinline__ LAS unsigned char* p7_slot(const P7Stream& St, int k) { int s = St.rs + k; s = s >= NSL ? s - NSL : s; return St.ring + s * ROWB; }
__device__ __forceinline__ void p7_advance(P7Stream& St, int k) { int s = St.rs + k; St.rs = s >= NSL ? s - NSL : s; }
__device__ __forceinline__ int p7_ahead(int koc, int kon, int tofs, int tofs_n, int j) {
    const int ln = (j + NSL) & 63; const int a = __builtin_amdgcn_readlane(koc, ln) + tofs, b = __builtin_amdgcn_readlane(kon, ln) + tofs_n;
    return j + NSL >= 64 ? b : a;
}
template <bool USWEEP>
__device__ __forceinline__ void p7_rows(P7Stream& St, const unsigned (&xp)[16], float (&acc)[32], int& zreg, int ccur, int koc, int kon, int tofs, int tofs_n, int j, int end, int lane) {
#pragma unroll 1
    for (; j + 1 < end; j += 2) {
        P7_WAIT_2ROWS();
        const u32x6 rowa = p7_read_row(p7_slot(St, 0), lane), rowb = p7_read_row(p7_slot(St, 1), lane);
        P7_READS_DONE();
        p7_dma_row(St.tab, p7_slot(St, 0), p7_ahead(koc, kon, tofs, tofs_n, j), St.v16);
        p7_dma_row(St.tab, p7_slot(St, 1), p7_ahead(koc, kon, tofs, tofs_n, j + 1), St.v16);
        p7_advance(St, 2);
        if constexpr (USWEEP) {
            const bf16x32 ua = __builtin_amdgcn_cvt_scalef32_pk32_bf16_fp6(rowa, 1.0f), ub = __builtin_amdgcn_cvt_scalef32_pk32_bf16_fp6(rowb, 1.0f);
            const float da = p7_dot(xp, ua), db = p7_dot(xp, ub);
            const v2u sw = __builtin_amdgcn_permlane32_swap(__float_as_uint(da), __float_as_uint(db), false, false);
            float t = __uint_as_float(sw.x) + __uint_as_float(sw.y);
            t = dpp_add(t, 0); t = dpp_add(t, 1); t = dpp_add(t, 2); t = dpp_add(t, 3); t = dpp_add(t, 4);
            const int za = __builtin_amdgcn_readlane(__float_as_int(t), 31), zb = __builtin_amdgcn_readlane(__float_as_int(t), 63);
            zreg = lane == j ? za : zreg; zreg = lane == j + 1 ? zb : zreg;
        } else {
            const float cka = __int_as_float(__builtin_amdgcn_readlane(ccur, j)), ckb = __int_as_float(__builtin_amdgcn_readlane(ccur, j + 1));
            { const f32x32 va = __builtin_amdgcn_cvt_scalef32_pk32_f32_fp6(rowa, 1.0f); p7_axpy(acc, cka, va); }
            { const f32x32 vb = __builtin_amdgcn_cvt_scalef32_pk32_f32_fp6(rowb, 1.0f); p7_axpy(acc, ckb, vb); }
        }
    }
    if (j < end) {
        P7_WAIT_1ROW();
        const u32x6 rowa = p7_read_row(p7_slot(St, 0), lane);
        P7_READS_DONE();
        p7_dma_row(St.tab, p7_slot(St, 0), p7_ahead(koc, kon, tofs, tofs_n, j), St.v16);
        p7_advance(St, 1);
        if constexpr (USWEEP) {
            const bf16x32 ua = __builtin_amdgcn_cvt_scalef32_pk32_bf16_fp6(rowa, 1.0f);
            const float da = wave_sum_lane63(p7_dot(xp, ua));
            const int za = __builtin_amdgcn_readlane(__float_as_int(da), 63);
            zreg = lane == j ? za : zreg;
        } else {
            const float cka = __int_as_float(__builtin_amdgcn_readlane(ccur, j));
            const f32x32 va = __builtin_amdgcn_cvt_scalef32_pk32_f32_fp6(rowa, 1.0f); p7_axpy(acc, cka, va);
        }
    }
}
__device__ __forceinline__ void p7_peer(Frame& F) {
    const int gw = F.vcu * NWAVES + F.wave, NGW = F.G * NWAVES, lane_in = F.lane;
    LAS f32x4* lg = (LAS f32x4*)(F.lds + LNP_OFF); LAS f32x4* lb = lg + 512;
    for (int i = F.tid; i < 512; i += NWAVES * 64) { lg[i] = ((const GAS f32x4*)F.ln2g)[i]; lb[i] = ((const GAS f32x4*)F.ln2b)[i]; }
    LDS_WAIT(); __syncthreads();
    P7Stream St; St.ring = F.lds + RING_OFF + F.wave * RING_W; St.rs = 0;
    St.tab = __builtin_amdgcn_make_buffer_rsrc((void*)F.U8, 0, TAB_V_OFS + NE * ROWB, 0x00020000);
#pragma unroll 1
    for (int tg = gw; tg < S / 4; tg += NGW) {
        const int tb = 4 * tg;
        int lane = lane_in; asm volatile("" : "+v"(lane));
        St.v16 = 16 * lane;
        int key[8]; float gvv[8], suv[8];
#pragma unroll
        for (int s = 0; s < 4; ++s)
#pragma unroll
            for (int h = 0; h < 2; ++h) { const size_t o = (size_t)(tb + s) * NPAIR + 64 * h + lane;
                key[2 * s + h] = (F.IDX[o] << 9) | (s << 7) | (64 * h + lane); gvv[2 * s + h] = F.GV[o]; suv[2 * s + h] = F.SU[o]; }
        unsigned xp0[16], xp1[16], xp2[16], xp3[16];
#pragma unroll
        for (int j = 0; j < 8; ++j) {
            const v2u w0 = ((const GAS v2u*)(F.X1 + (size_t)(tb + 0) * D) + lane)[64 * j], w1 = ((const GAS v2u*)(F.X1 + (size_t)(tb + 1) * D) + lane)[64 * j];
            const v2u w2 = ((const GAS v2u*)(F.X1 + (size_t)(tb + 2) * D) + lane)[64 * j], w3 = ((const GAS v2u*)(F.X1 + (size_t)(tb + 3) * D) + lane)[64 * j];
            xp0[2 * j] = w0.x; xp0[2 * j + 1] = w0.y; xp1[2 * j] = w1.x; xp1[2 * j + 1] = w1.y; xp2[2 * j] = w2.x; xp2[2 * j + 1] = w2.y; xp3[2 * j] = w3.x; xp3[2 * j + 1] = w3.y; }
        p7_sort512(key, lane);
#pragma unroll
        for (int r = 0; r < 8; ++r) key[r] = p7_group_by_slot(key[r]);
        VM_WAIT();
        { const int ko0 = (key[0] >> 9) * ROWB;
#pragma unroll
          for (int i = 0; i < NSL; ++i) p7_dma_row(St.tab, St.ring + i * ROWB, __builtin_amdgcn_readlane(ko0, i), St.v16); }
        St.rs = 0;
        float coef[8];
#pragma unroll
        for (int q = 0; q < 8; ++q) coef[q] = 0.f;
        float dummy_acc[32];
#pragma unroll
        for (int q = 0; q < 32; ++q) dummy_acc[q] = 0.f;
#pragma unroll 1
        for (int r = 0; r < 8; ++r) {
            const int kcur = sel8i(key, r), knext = sel8i(key, (r + 1) & 7);
            const int koc = (kcur >> 9) * ROWB, kon = (knext >> 9) * ROWB, tofs_n = r == 7 ? TAB_V_OFS : 0;
            const int sl = (kcur >> 7) & 3;
            const int e0 = __popcll(__ballot(sl == 0)), e1 = e0 + __popcll(__ballot(sl == 1)), e2 = e1 + __popcll(__ballot(sl == 2));
            int zreg = 0;
            p7_rows<true>(St, xp0, dummy_acc, zreg, 0, koc, kon, 0, tofs_n, 0, e0, lane);
            p7_rows<true>(St, xp1, dummy_acc, zreg, 0, koc, kon, 0, tofs_n, e0, e1, lane);
            p7_rows<true>(St, xp2, dummy_acc, zreg, 0, koc, kon, 0, tofs_n, e1, e2, lane);
            p7_rows<true>(St, xp3, dummy_acc, zreg, 0, koc, kon, 0, tofs_n, e2, 64, lane);
            const int pr = kcur & 127, sel = 2 * sl + (pr >> 6);
            float su = 0.f, gv = 0.f;
#pragma unroll
            for (int j = 0; j < 8; ++j) { const float a = __int_as_float(__builtin_amdgcn_ds_bpermute((pr & 63) << 2, __float_as_int(suv[j]))), b = __int_as_float(__builtin_amdgcn_ds_bpermute((pr & 63) << 2, __float_as_int(gvv[j]))); su = sel == j ? a : su; gv = sel == j ? b : gv; }
            const float cnew = gelu_erf(__int_as_float(zreg) * su) * gv;
#pragma unroll
            for (int q = 0; q < 8; ++q) { const float old = coef[q]; coef[q] = r == q ? cnew : old; }
        }
        float acc0[32], acc1[32], acc2[32], acc3[32];
#pragma unroll
        for (int q = 0; q < 32; ++q) { acc0[q] = 0.f; acc1[q] = 0.f; acc2[q] = 0.f; acc3[q] = 0.f; }
        int zdummy = 0;
#pragma unroll 1
        for (int r = 0; r < 8; ++r) {
            const int kcur = sel8i(key, r), knext = sel8i(key, r < 7 ? r + 1 : 7); const int ccur = __float_as_int(sel8f(coef, r));
            const int koc = (kcur >> 9) * ROWB, kon = (knext >> 9) * ROWB;
            const int sl = (kcur >> 7) & 3;
            const int e0 = __popcll(__ballot(sl == 0)), e1 = e0 + __popcll(__ballot(sl == 1)), e2 = e1 + __popcll(__ballot(sl == 2));
            p7_rows<false>(St, xp0, acc0, zdummy, ccur, koc, kon, TAB_V_OFS, TAB_V_OFS, 0, e0, lane);
            p7_rows<false>(St, xp0, acc1, zdummy, ccur, koc, kon, TAB_V_OFS, TAB_V_OFS, e0, e1, lane);
            p7_rows<false>(St, xp0, acc2, zdummy, ccur, koc, kon, TAB_V_OFS, TAB_V_OFS, e1, e2, lane);
            p7_rows<false>(St, xp0, acc3, zdummy, ccur, koc, kon, TAB_V_OFS, TAB_V_OFS, e2, 64, lane);
        }
        VM_WAIT();
#pragma unroll
        for (int s = 0; s < 4; ++s) {
            asm volatile("" ::: "memory"); __builtin_amdgcn_sched_barrier(0);
            float (&acc)[32] = s == 0 ? acc0 : s == 1 ? acc1 : s == 2 ? acc2 : acc3;
            const GAS v2u* xr = (const GAS v2u*)(F.X1 + (size_t)(tb + s) * D) + lane;
            float sum = 0.f;
#pragma unroll
            for (int j = 0; j < 8; ++j) { const v2u w = xr[64 * j];
                acc[4 * j + 0] = fmaf(ALPHA, bf_lo(w.x), acc[4 * j + 0]); acc[4 * j + 1] = fmaf(ALPHA, bf_hi(w.x), acc[4 * j + 1]);
                acc[4 * j + 2] = fmaf(ALPHA, bf_lo(w.y), acc[4 * j + 2]); acc[4 * j + 3] = fmaf(ALPHA, bf_hi(w.y), acc[4 * j + 3]); }
#pragma unroll
            for (int q = 0; q < 32; ++q) sum += acc[q];
            const float mean = __int_as_float(__builtin_amdgcn_readlane(__float_as_int(wave_sum_lane63(sum)), 63)) * (1.f / D); float s2 = 0.f;
#pragma unroll
            for (int q = 0; q < 32; ++q) { acc[q] -= mean; s2 = fmaf(acc[q], acc[q], s2); }
            const float rstd = 1.f / sqrtf(__int_as_float(__builtin_amdgcn_readlane(__float_as_int(wave_sum_lane63(s2)), 63)) * (1.f / D) + LN_EPS);
            GAS f32x4* orow = (GAS f32x4*)(F.out + (size_t)(tb + s) * D) + lane;
#pragma unroll
            for (int j = 0; j < 8; ++j) { const f32x4 g = lg[lane + 64 * j], b = lb[lane + 64 * j];
                f32x4 o; o.x = acc[4 * j + 0] * rstd * g.x + b.x; o.y = acc[4 * j + 1] * rstd * g.y + b.y; o.z = acc[4 * j + 2] * rstd * g.z + b.z; o.w = acc[4 * j + 3] * rstd * g.w + b.w;
                orow[64 * j] = o; }
        }
    }
}

struct Args { const float* in[19]; float* out; unsigned char* ws; int ph_lo, ph_hi, li, pad; };
__global__ void __launch_bounds__(NWAVES * 64, 2) peer_layer_fwd(Args args) {
    extern __shared__ __attribute__((aligned(16))) unsigned char lds[];
    Frame F;
    F.lds = (LAS unsigned char*)lds;
    F.MISC = (volatile LAS unsigned*)(F.lds + MISC_OFF);
    F.tid = threadIdx.x; F.lane = F.tid & 63; F.wave = __builtin_amdgcn_readfirstlane(F.tid >> 6);
    F.G = gridDim.x; { const int bx = blockIdx.x; F.vcu = (F.G % 8 == 0) ? (bx % 8) * (F.G / 8) + bx / 8 : bx; }
    unsigned char* ws = args.ws;
    F.ctl = (gu32*)(ws + WS_CTL);
    F.x = args.in[0]; F.w_in = args.in[1]; F.b_in = args.in[2]; F.ccw = args.in[3]; F.ccb = args.in[4]; F.clg = args.in[5]; F.clb = args.in[6];
    F.scw = args.in[7]; F.scbias = args.in[8]; F.w_out = args.in[9]; F.b_out = args.in[10]; F.ln1g = args.in[11]; F.ln1b = args.in[12];
    F.w_q = args.in[13]; F.sub_keys = args.in[14]; F.peer_u = args.in[15]; F.peer_v = args.in[16]; F.ln2g = args.in[17]; F.ln2b = args.in[18];
    F.out = args.out;
    F.XB = (bf16*)(ws + WS_XB); F.BT1 = (bf16*)(ws + WS_BT1); F.BT2 = (bf16*)(ws + WS_BT2); F.BT3 = (bf16*)(ws + WS_BT3);
    F.AGLU = (bf16*)(ws + WS_AGLU); F.CV = (bf16*)(ws + WS_CV); F.SCB = (bf16*)(ws + WS_SCB); F.MIX = (bf16*)(ws + WS_MIX); F.X1 = (bf16*)(ws + WS_X1);
    F.Y = (bf16*)(ws + WS_Y); F.SS = (float*)(ws + WS_S); F.IDX = (int*)(ws + WS_IDX); F.GV = (float*)(ws + WS_GV); F.SU = (float*)(ws + WS_SU);
    F.U8 = ws + WS_U8; F.V8 = ws + WS_V8; F.USC = (float*)(ws + WS_USC); F.VSC = (float*)(ws + WS_VSC);
    for (int u = F.tid; u < (LDS_BYTES - LDSCTL_OFF) / 4; u += NWAVES * 64) ((LAS unsigned*)(F.lds + LDSCTL_OFF))[u] = 0u;
    __syncthreads();
    XcdBarrier bar; bar.bar = (unsigned*)(F.ctl + CW_BAR); bar.x = 0; bar.st = nullptr;
    if (N_LAUNCHES == 1) bar = xcd_barrier_post((unsigned*)(F.ctl + CW_BAR), F.MISC + 8);
    const int lo = args.ph_lo, hi = args.ph_hi;
#ifndef ONLY_PHASE
#define ONLY_PHASE -1
#endif
#define IN(k) ((ONLY_PHASE < 0 || ONLY_PHASE == (k)) && lo <= (k) && (k) < hi)
#define SEAM(k) do { if (IN(k) && IN((k) + 1)) xcd_barrier(bar); } while (0)
#ifndef REPEAT_PHASE
#define REPEAT_PHASE -1
#endif
#define REPS(k) for (int rep_ = 0; rep_ < (REPEAT_PHASE == (k) ? 2 : 1); ++rep_)

    if (IN(0)) { REPS(0) p0_prologue(F); SEAM(0); }
    if (IN(1)) { REPS(1) {
        if (F.G == 256) { if (blockIdx.x >= 128) p0_peer_tables(F, ((int)blockIdx.x - 128) * NWAVES + F.wave, 128 * NWAVES); }
        else p0_peer_tables(F, F.vcu * NWAVES + F.wave, F.G * NWAVES);
        __syncthreads();
        pg8::Gemm g{F.XB, F.BT1, S, NIN, D}; pg8::StaticOrder So; So.init(S, NIN, F.G, (int)blockIdx.x);
        pg8::EpiInProj E{F.AGLU, F.CV, F.SCB, F.b_in};
        pg8::gemm_phase<pg8::EpiInProj, pg8::StaticOrder, PG8_ALIGN, PG8_SP2>(F.lds + RING_OFF, g, So, E); }
        SEAM(1);
    }
    if (IN(2)) { REPS(2) for (int u = F.vcu; u < S / 32; u += F.G) p2_unit(F, u); SEAM(2); }
    if (IN(3)) { REPS(3) {
        pg8::Gemm g{F.MIX, F.BT2, S, D, D}; pg8::StaticOrder So; So.init(S, D, F.G, (int)blockIdx.x);
        pg8::EpiOutProj E{F.Y, F.b_out, F.XB, ALPHA};
        pg8::gemm_phase<pg8::EpiOutProj, pg8::StaticOrder, PG8_ALIGN, PG8_SP2>(F.lds + RING_OFF, g, So, E); }
        SEAM(3);
    }
    if (IN(4)) { REPS(4) p4_ln1(F); SEAM(4); }
    if (IN(5)) { REPS(5) {
        pg8::Gemm g{F.X1, F.BT3, S, D, D}; pg8::StaticOrder So; So.init(S, D, F.G, (int)blockIdx.x);
        pg8::EpiF32 E{F.SS, D};
        pg8::gemm_phase<pg8::EpiF32, pg8::StaticOrder, PG8_ALIGN, PG8_SP2>(F.lds + RING_OFF, g, So, E); }
        SEAM(5);
    }
    if (IN(6)) { REPS(6) p6_topk(F); SEAM(6); }
    if (IN(7)) { REPS(7) p7_peer(F); }
#undef IN
#undef SEAM
}

extern "C" void kernel_launch(void* const* d_in, const int* in_sizes, int n_in, void* d_out, int out_size, void* d_ws, size_t ws_size, hipStream_t stream) {
    static int grid = 0;
    if (grid == 0) {
        if (n_in != 19 || in_sizes[0] != S * D || out_size != S * D || ws_size < WS_END) {
            fprintf(stderr, "kernel_launch: built for 19 inputs, x/out of %d floats, >= %zu bytes of workspace; got n_in %d, in0 %d, out %d, ws %zu; nothing launched\n", S * D, (size_t)WS_END, n_in, n_in > 0 ? in_sizes[0] : -1, out_size, ws_size);
            grid = -1; return; }
        int dev = 0, cus = 0, per_cu = 0;
        if (hipGetDevice(&dev) != hipSuccess || hipDeviceGetAttribute(&cus, hipDeviceAttributeMultiprocessorCount, dev) != hipSuccess) { fprintf(stderr, "kernel_launch: device query failed\n"); grid = -1; return; }
        if (hipFuncSetAttribute((const void*)peer_layer_fwd, hipFuncAttributeMaxDynamicSharedMemorySize, LDS_BYTES) != hipSuccess) { fprintf(stderr, "kernel_launch: hipFuncSetAttribute failed\n"); grid = -1; return; }
        if (hipOccupancyMaxActiveBlocksPerMultiprocessor(&per_cu, (const void*)peer_layer_fwd, NWAVES * 64, LDS_BYTES) != hipSuccess || per_cu < 1) {
            fprintf(stderr, "kernel_launch: occupancy query reports %d workgroups per CU; nothing launched\n", per_cu); (void)hipGetLastError(); grid = -1; return; }
        (void)hipGetLastError();
        grid = cus;
    }
    if (grid < 0) return;
    if (hipMemsetAsync((char*)d_ws + WS_CTL, 0, CTL_ZERO_BYTES, stream) != hipSuccess) { fprintf(stderr, "kernel_launch: hipMemsetAsync failed\n"); return; }
    Args a{};
    for (int i = 0; i < 19; ++i) a.in[i] = (const float*)d_in[i];
    a.out = (float*)d_out; a.ws = (unsigned char*)d_ws;
    for (int li = 0; li < N_LAUNCHES; ++li) {
        a.ph_lo = (N_LAUNCHES == 1) ? 0 : li; a.ph_hi = (N_LAUNCHES == 1) ? N_PHASES : li + 1; a.li = li;
        hipError_t le;
        if (N_LAUNCHES == 1) { void* kargs[] = {&a}; le = hipLaunchCooperativeKernel((const void*)peer_layer_fwd, dim3(grid), dim3(NWAVES * 64), kargs, LDS_BYTES, stream); }
        else { hipLaunchKernelGGL(peer_layer_fwd, dim3(grid), dim3(NWAVES * 64), LDS_BYTES, stream, a); le = hipPeekAtLastError(); }
        if (le != hipSuccess) { fprintf(stderr, "kernel_launch: launch %d failed: %s (grid %d x %d threads, %d B LDS)\n", li, hipGetErrorName(le), grid, NWAVES * 64, LDS_BYTES); break; }
    }
}
```

```cpp
#include <hip/hip_runtime.h>
#include <cstdio>
#include <cstdint>
namespace pg8 {
#define PG8_LAS __attribute__((address_space(3)))
typedef unsigned short bf16_t;
typedef short bf16x8 __attribute__((ext_vector_type(8)));
typedef float f32x4 __attribute__((ext_vector_type(4)));
typedef unsigned u32x4 __attribute__((ext_vector_type(4)));
constexpr int BM = 256, BK = 64, HALF = 128, HTB = HALF * BK * 2  , STAGE_BYTES = 8 * HTB, NXCD = 8, WGM = 8;

__host__ __device__ __forceinline__ int lds_byte(int r, int c) { const int st = (r >> 4) * 2 + (c >> 5), rr = r & 15, cc = c & 31, ob = rr * 64 + cc * 2; return st * 1024 + (ob ^ (((ob >> 9) & 1) << 5)); }
__host__ __device__ __forceinline__ void stage_rc(int b, int& R, int& C) { const int st = b / 1024, sb = b % 1024, swz = sb ^ (((sb >> 9) & 1) << 5); R = (st >> 1) * 16 + swz / 64; C = (st & 1) * 32 + (swz % 64) / 2; }
__host__ __device__ __forceinline__ int perm32(int rho) { const int n = rho >> 4, i = rho & 15; return 8 * (i >> 2) + 4 * n + (i & 3); }

struct Unit { int pm, pn; };
struct Gemm { const bf16_t* A; const bf16_t* Bt; int M, N, K; };

struct StaticOrder {
    int nM, nN, nwg, G, c;
    __host__ __device__ void init(int M, int N, int G_, int c_) { nM = M / BM; nN = N / BM; nwg = nM * nN; G = G_; c = c_; }
    __host__ __device__ bool next(int i, Unit& u) const {
        const long L = (long)i * G + c; if (L >= nwg) return false;
        int wgid = (int)L; { const int q = nwg / NXCD, r = nwg % NXCD, xcd = wgid % NXCD, off = wgid / NXCD; wgid = (xcd < r ? xcd * (q + 1) : r * (q + 1) + (xcd - r) * q) + off; }
        const int nig = WGM * nN, gid = wgid / nig, fm = gid * WGM, gsz = (nM - fm) < WGM ? (nM - fm) : WGM;
        u.pm = fm + ((wgid % nig) % gsz); u.pn = (wgid % nig) / gsz; return true;
    }
    __device__ __forceinline__ void a_ready(const Unit&) const {}
    __device__ __forceinline__ void done(const Unit&) const {}
};

__device__ __forceinline__ unsigned cvt_pk_bf16(float lo, float hi) { unsigned r; asm volatile("v_cvt_pk_bf16_f32 %0, %1, %2" : "=v"(r) : "v"(lo), "v"(hi)); return r; }
__device__ __forceinline__ float sigmoidf_fast(float g) { return __builtin_amdgcn_rcpf(1.0f + __expf(-g)); }

struct EpiInProj {
    static constexpr bool PERM = true, AFTER_DRAIN = false;
    bf16_t* aglu; bf16_t* cv; bf16_t* scb; const float* b_in;
    __device__ __forceinline__ void operator()(const f32x4 (&acc)[2][2][4][2], const Unit& u, int wr, int wc, int fr, int fq) const {
        const int row0 = u.pm * BM + wr * 64 + fr, cc = wc * 32 + 8 * fq;
        if (u.pn < 16) {
            const bool conf = u.pn < 8; const int j = conf ? u.pn : u.pn - 8;
            const float* b0 = b_in + (conf ? 0 : 3072) + 128 * j + cc;
            const float* b1 = b_in + (conf ? 1024 : 4096) + 128 * j + cc;
            bf16_t* O = (conf ? aglu : cv) + 128 * j + cc;
            f32x4 bv0[2], bv1[2];
#pragma unroll
            for (int n = 0; n < 2; ++n) { bv0[n] = *(const f32x4*)(b0 + 4 * n); bv1[n] = *(const f32x4*)(b1 + 4 * n); }
#pragma unroll
            for (int ai = 0; ai < 2; ++ai)
#pragma unroll
                for (int m = 0; m < 4; ++m) {
                    f32x4 r[2];
#pragma unroll
                    for (int n = 0; n < 2; ++n) { const f32x4 a = acc[ai][0][m][n] + bv0[n]; f32x4 g = acc[ai][1][m][n] + bv1[n];
                        if (conf) { g[0] = sigmoidf_fast(g[0]); g[1] = sigmoidf_fast(g[1]); g[2] = sigmoidf_fast(g[2]); g[3] = sigmoidf_fast(g[3]); }
                        r[n] = a * g; }
                    u32x4 w; w.x = cvt_pk_bf16(r[0][0], r[0][1]); w.y = cvt_pk_bf16(r[0][2], r[0][3]); w.z = cvt_pk_bf16(r[1][0], r[1][1]); w.w = cvt_pk_bf16(r[1][2], r[1][3]);
                    *(u32x4*)(O + (size_t)(row0 + ai * HALF + m * 16) * 1024) = w; }
        } else {
            const int j = u.pn - 16;
#pragma unroll
            for (int bj = 0; bj < 2; ++bj) {
                const float* b0 = b_in + 2048 + 256 * j + 128 * bj + cc; bf16_t* O = scb + 256 * j + 128 * bj + cc;
                const f32x4 bva = *(const f32x4*)(b0), bvb = *(const f32x4*)(b0 + 4);
#pragma unroll
                for (int ai = 0; ai < 2; ++ai)
#pragma unroll
                    for (int m = 0; m < 4; ++m) { const f32x4 v0 = acc[ai][bj][m][0] + bva, v1 = acc[ai][bj][m][1] + bvb;
                        u32x4 w; w.x = cvt_pk_bf16(v0[0], v0[1]); w.y = cvt_pk_bf16(v0[2], v0[3]); w.z = cvt_pk_bf16(v1[0], v1[1]); w.w = cvt_pk_bf16(v1[2], v1[3]);
                        *(u32x4*)(O + (size_t)(row0 + ai * HALF + m * 16) * 1024) = w; } }
        }
    }
};
struct EpiOutProj {
    static constexpr bool PERM = true, AFTER_DRAIN = false;
    bf16_t* YG; const float* bias; const bf16_t* xb; const float* g1; float* stat; float alpha;
    __device__ __forceinline__ void operator()(const f32x4 (&acc)[2][2][4][2], const Unit& u, int wr, int wc, int fr, int fq) const {
        const int row0 = u.pm * BM + wr * 64 + fr, col0 = u.pn * BM + wc * 32 + 8 * fq;
        f32x4 bv[2][2], gv[2][2];
#pragma unroll
        for (int bj = 0; bj < 2; ++bj)
#pragma unroll
            for (int n = 0; n < 2; ++n) { bv[bj][n] = *(const f32x4*)(bias + col0 + bj * HALF + 4 * n); gv[bj][n] = *(const f32x4*)(g1 + col0 + bj * HALF + 4 * n); }
#pragma unroll
        for (int ai = 0; ai < 2; ++ai)
#pragma unroll
            for (int m = 0; m < 4; ++m) { const int row = row0 + ai * HALF + m * 16; const size_t off = (size_t)row * 2048 + col0;
                float s1 = 0.f, s2 = 0.f;
#pragma unroll
                for (int bj = 0; bj < 2; ++bj) { const u32x4 xw = *(const u32x4*)(xb + off + bj * HALF);
                    f32x4 v0 = acc[ai][bj][m][0] + bv[bj][0], v1 = acc[ai][bj][m][1] + bv[bj][1];
                    v0[0] += alpha * __uint_as_float(xw.x << 16); v0[1] += alpha * __uint_as_float(xw.x & 0xffff0000u); v0[2] += alpha * __uint_as_float(xw.y << 16); v0[3] += alpha * __uint_as_float(xw.y & 0xffff0000u);
                    v1[0] += alpha * __uint_as_float(xw.z << 16); v1[1] += alpha * __uint_as_float(xw.z & 0xffff0000u); v1[2] += alpha * __uint_as_float(xw.w << 16); v1[3] += alpha * __uint_as_float(xw.w & 0xffff0000u);
                    s1 += ((v0[0] + v0[1]) + (v0[2] + v0[3])) + ((v1[0] + v1[1]) + (v1[2] + v1[3]));
                    s2 += ((v0[0] * v0[0] + v0[1] * v0[1]) + (v0[2] * v0[2] + v0[3] * v0[3])) + ((v1[0] * v1[0] + v1[1] * v1[1]) + (v1[2] * v1[2] + v1[3] * v1[3]));
                    v0 = v0 * gv[bj][0]; v1 = v1 * gv[bj][1];
                    u32x4 w; w.x = cvt_pk_bf16(v0[0], v0[1]); w.y = cvt_pk_bf16(v0[2], v0[3]); w.z = cvt_pk_bf16(v1[0], v1[1]); w.w = cvt_pk_bf16(v1[2], v1[3]);
                    *(u32x4*)(YG + off + bj * HALF) = w; }
                s1 += __shfl_xor(s1, 16); s2 += __shfl_xor(s2, 16); s1 += __shfl_xor(s1, 32); s2 += __shfl_xor(s2, 32);
                if (fq == 0) { atomicAdd(stat + 2 * row, s1); atomicAdd(stat + 2 * row + 1, s2); }
                asm volatile("" ::: "memory"); }
    }
};
struct EpiF32 {
    static constexpr bool PERM = false, AFTER_DRAIN = false;
    float* C; int ldc; const float* stat; const float* c12; float eps;
    __device__ __forceinline__ void operator()(const f32x4 (&acc)[2][2][4][2], const Unit& u, int wr, int wc, int fr, int fq) const {
        const int row0 = u.pm * BM + wr * 64 + fr, col0 = u.pn * BM + wc * 32 + 4 * fq;
        f32x4 c1v[2][2], c2v[2][2];
#pragma unroll
        for (int bj = 0; bj < 2; ++bj)
#pragma unroll
            for (int n = 0; n < 2; ++n) { c1v[bj][n] = *(const f32x4*)(c12 + col0 + bj * HALF + n * 16); c2v[bj][n] = *(const f32x4*)(c12 + 2048 + col0 + bj * HALF + n * 16); }
#pragma unroll
        for (int ai = 0; ai < 2; ++ai)
#pragma unroll
            for (int m = 0; m < 4; ++m) { const int row = row0 + ai * HALF + m * 16; float* rowp = C + (size_t)row * ldc + col0;
                const float s1 = stat[2 * row], s2 = stat[2 * row + 1];
                const float mean = s1 * (1.0f / 2048.0f), var = fmaxf(s2 * (1.0f / 2048.0f) - mean * mean, 0.f), rstd = 1.0f / sqrtf(var + eps);
#pragma unroll
                for (int bj = 0; bj < 2; ++bj)
#pragma unroll
                    for (int n = 0; n < 2; ++n) *(f32x4*)(rowp + bj * HALF + n * 16) = (acc[ai][bj][m][n] - c1v[bj][n] * mean) * rstd + c2v[bj][n]; }
    }
};

template <class Epi, class Sched, bool ALIGN_EPI = false, bool SP2 = false>
__device__ __forceinline__ void gemm_phase(PG8_LAS unsigned char* lds, const Gemm g, const Sched& S, const Epi& E) {
    const int tid = threadIdx.x, wid = __builtin_amdgcn_readfirstlane(tid >> 6), lane = tid & 63, wr = wid >> 2, wc = wid & 3, fr = lane & 15, fq = lane >> 4;
    const int K = g.K, nt = K / BK;
    unsigned voffA[2], voffB[2];
#pragma unroll
    for (int i = 0; i < 2; ++i) { int R, C; stage_rc(tid * 16 + i * 8192, R, C); const int Rb = Epi::PERM ? ((R & ~31) + perm32(R & 31)) : R;
        voffA[i] = (unsigned)(R * K + C) * 2u; voffB[i] = (unsigned)(Rb * K + C) * 2u; }
    const size_t kstep = (size_t)(BK * 2);
    const size_t hstep = (size_t)HALF * K * 2;
    const size_t tstep = 2 * hstep;
    const unsigned ldsw = (unsigned)wid * 1024u;
    const int aoff = lds_byte(wr * 64 + fr, fq * 8), boff = lds_byte(wc * 32 + fr, fq * 8);
#define PG8_SA(b, h) (((b) * 2 + (h)) * HTB)
#define PG8_SB(b, h) ((4 + (b) * 2 + (h)) * HTB)
#define PG8_STAGE(bufoff, gbase, voff) do { _Pragma("unroll") for (int _i = 0; _i < 2; ++_i) \
        __builtin_amdgcn_global_load_lds((const unsigned*)((const char*)(gbase) + (voff)[_i]), (PG8_LAS unsigned*)(lds + (bufoff) + ldsw + _i * 8192), 16, 0, 0); } while (0)
#define PG8_LDA(dst, b, h) do { _Pragma("unroll") for (int m = 0; m < 4; ++m) _Pragma("unroll") for (int k = 0; k < 2; ++k) dst[m][k] = *(const PG8_LAS bf16x8*)(lds + PG8_SA(b, h) + aoff + m * 2048 + k * 1024); } while (0)
#define PG8_LDB(dst, b, h) do { _Pragma("unroll") for (int n = 0; n < 2; ++n) _Pragma("unroll") for (int k = 0; k < 2; ++k) dst[n][k] = *(const PG8_LAS bf16x8*)(lds + PG8_SB(b, h) + boff + n * 2048 + k * 1024); } while (0)
#define PG8_MMA(ai, bj, At, Bt) do { __builtin_amdgcn_s_setprio(1); _Pragma("unroll") for (int m = 0; m < 4; ++m) _Pragma("unroll") for (int n = 0; n < 2; ++n) _Pragma("unroll") for (int k = 0; k < 2; ++k) \
        acc[ai][bj][m][n] = __builtin_amdgcn_mfma_f32_16x16x32_bf16(Bt[n][k], At[m][k], acc[ai][bj][m][n], 0, 0, 0); __builtin_amdgcn_s_setprio(0); } while (0)
#define PG8_WAIT_V(n) asm volatile("s_waitcnt vmcnt(" #n ")" ::: "memory")
#define PG8_WAIT_L(n) asm volatile("s_waitcnt lgkmcnt(" #n ")" ::: "memory")
#define PG8_BAR __builtin_amdgcn_s_barrier()
#define PG8_SCHED __builtin_amdgcn_sched_barrier(0)
    Unit cur, nxt; int ui = 0;
    if (!S.next(0, cur)) return;
    f32x4 acc[2][2][4][2];
#pragma unroll
    for (int a = 0; a < 2; ++a)
#pragma unroll
        for (int b = 0; b < 2; ++b)
#pragma unroll
            for (int m = 0; m < 4; ++m)
#pragma unroll
                for (int n = 0; n < 2; ++n) acc[a][b][m][n] = (f32x4){0.f, 0.f, 0.f, 0.f};
    bf16x8 At[4][2], B0[2][2], B1[2][2];
    const char* cA = (const char*)g.A + (size_t)cur.pm * tstep; const char* cB = (const char*)g.Bt + (size_t)cur.pn * tstep;
    S.a_ready(cur);
    if constexpr (SP2) {
        PG8_STAGE(PG8_SB(0, 0), cB, voffB); PG8_STAGE(PG8_SB(0, 1), cB + hstep, voffB); PG8_STAGE(PG8_SA(0, 0), cA, voffA); PG8_STAGE(PG8_SA(0, 1), cA + hstep, voffA);
        if (wr == 1) PG8_BAR;
        PG8_WAIT_V(2); PG8_BAR;
        PG8_STAGE(PG8_SB(1, 0), cB + kstep, voffB); PG8_STAGE(PG8_SA(1, 0), cA + kstep, voffA); PG8_STAGE(PG8_SB(1, 1), cB + hstep + kstep, voffB);
        PG8_WAIT_V(6); PG8_BAR;
    } else {
        PG8_STAGE(PG8_SB(0, 0), cB, voffB); PG8_STAGE(PG8_SA(0, 0), cA, voffA); PG8_STAGE(PG8_SB(0, 1), cB + hstep, voffB); PG8_STAGE(PG8_SA(0, 1), cA + hstep, voffA);
        if (wr == 1) PG8_BAR;
        PG8_WAIT_V(4); PG8_BAR;
        PG8_STAGE(PG8_SB(1, 0), cB + kstep, voffB); PG8_STAGE(PG8_SA(1, 0), cA + kstep, voffA); PG8_STAGE(PG8_SB(1, 1), cB + hstep + kstep, voffB);
        PG8_WAIT_V(6); PG8_BAR;
    }
    for (;;) {
        const bool has_next = S.next(ui + 1, nxt);
        const char* nA = has_next ? (const char*)g.A + (size_t)nxt.pm * tstep : cA; const char* nB = has_next ? (const char*)g.Bt + (size_t)nxt.pn * tstep : cB;
        for (int t = 0; t < nt; t += 2) {
            const bool last = (t == nt - 2);
            const char* a1 = cA + (size_t)(t + 1) * kstep;
            const char* a2 = last ? nA : cA + (size_t)(t + 2) * kstep; const char* b2 = last ? nB : cB + (size_t)(t + 2) * kstep;
            const char* a3 = a2 + kstep; const char* b3 = b2 + kstep;
            if (last && has_next) S.a_ready(nxt);
            if constexpr (SP2) {
            PG8_LDB(B0, 0, 0); PG8_LDB(B1, 0, 1); PG8_SCHED; PG8_LDA(At, 0, 0); PG8_STAGE(PG8_SA(1, 1), a1 + hstep, voffA);
            PG8_WAIT_V(8); PG8_WAIT_L(0); PG8_BAR; PG8_MMA(0, 0, At, B0); PG8_MMA(0, 1, At, B1); PG8_BAR; PG8_SCHED;
            PG8_LDA(At, 0, 1); PG8_STAGE(PG8_SB(0, 0), b2, voffB); PG8_STAGE(PG8_SB(0, 1), b2 + hstep, voffB); PG8_STAGE(PG8_SA(0, 0), a2, voffA);
            PG8_WAIT_V(8); PG8_WAIT_L(0); PG8_BAR; PG8_MMA(1, 0, At, B0); PG8_MMA(1, 1, At, B1); PG8_BAR; PG8_SCHED;
            PG8_LDB(B0, 1, 0); PG8_LDB(B1, 1, 1); PG8_SCHED; PG8_LDA(At, 1, 0); PG8_STAGE(PG8_SA(0, 1), a2 + hstep, voffA);
            PG8_WAIT_V(8); PG8_WAIT_L(0); PG8_BAR; PG8_MMA(0, 0, At, B0); PG8_MMA(0, 1, At, B1); PG8_BAR; PG8_SCHED;
            PG8_LDA(At, 1, 1); PG8_STAGE(PG8_SB(1, 0), b3, voffB); PG8_STAGE(PG8_SB(1, 1), b3 + hstep, voffB); PG8_STAGE(PG8_SA(1, 0), a3, voffA);
            PG8_WAIT_V(8); PG8_WAIT_L(0); PG8_BAR; PG8_MMA(1, 0, At, B0); PG8_MMA(1, 1, At, B1); PG8_BAR; PG8_SCHED;
            } else {
            PG8_LDB(B0, 0, 0); PG8_SCHED; PG8_LDA(At, 0, 0); PG8_STAGE(PG8_SA(1, 1), a1 + hstep, voffA);
            PG8_WAIT_L(8); PG8_BAR; PG8_WAIT_L(0); PG8_MMA(0, 0, At, B0); PG8_BAR; PG8_SCHED;
            PG8_LDB(B1, 0, 1); PG8_STAGE(PG8_SB(0, 0), b2, voffB);
            PG8_BAR; PG8_WAIT_L(0); PG8_MMA(0, 1, At, B1); PG8_BAR;
            PG8_LDA(At, 0, 1); PG8_STAGE(PG8_SA(0, 0), a2, voffA);
            PG8_BAR; PG8_WAIT_L(0); PG8_MMA(1, 0, At, B0); PG8_BAR; PG8_SCHED;
            PG8_STAGE(PG8_SB(0, 1), b2 + hstep, voffB);
            PG8_WAIT_V(6); PG8_BAR; PG8_MMA(1, 1, At, B1); PG8_BAR;
            PG8_LDB(B0, 1, 0); PG8_SCHED; PG8_LDA(At, 1, 0); PG8_STAGE(PG8_SA(0, 1), a2 + hstep, voffA);
            PG8_WAIT_L(8); PG8_BAR; PG8_WAIT_L(0); PG8_MMA(0, 0, At, B0); PG8_BAR; PG8_SCHED;
            PG8_LDB(B1, 1, 1); PG8_STAGE(PG8_SB(1, 0), b3, voffB);
            PG8_BAR; PG8_WAIT_L(0); PG8_MMA(0, 1, At, B1); PG8_BAR;
            PG8_LDA(At, 1, 1); PG8_STAGE(PG8_SA(1, 0), a3, voffA);
            PG8_BAR; PG8_WAIT_L(0); PG8_MMA(1, 0, At, B0); PG8_BAR; PG8_SCHED;
            PG8_STAGE(PG8_SB(1, 1), b3 + hstep, voffB);
            PG8_WAIT_V(6); PG8_BAR; PG8_MMA(1, 1, At, B1); PG8_BAR;
            }
        }
        if constexpr (ALIGN_EPI) { if (wr == 0) PG8_BAR; }
        if constexpr (!Epi::AFTER_DRAIN) { E(acc, cur, wr, wc, fr, fq); S.done(cur); }
        if (!has_next) break;
#pragma unroll
        for (int a = 0; a < 2; ++a)
#pragma unroll
            for (int b = 0; b < 2; ++b)
#pragma unroll
                for (int m = 0; m < 4; ++m)
#pragma unroll
                    for (int n = 0; n < 2; ++n) acc[a][b][m][n] = (f32x4){0.f, 0.f, 0.f, 0.f};
        cur = nxt; cA = nA; cB = nB; ++ui;
        if constexpr (ALIGN_EPI) { if (wr == 1) PG8_BAR; }
    }
    PG8_WAIT_V(0);
    if constexpr (!ALIGN_EPI) { if (wr == 0) PG8_BAR; }
    PG8_BAR;
    if constexpr (Epi::AFTER_DRAIN) { E.fused(acc, cur, wr, wc, fr, fq, lds, wid, lane); S.done(cur); }
#undef PG8_SA
#undef PG8_SB
#undef PG8_STAGE
#undef PG8_LDA
#undef PG8_LDB
#undef PG8_MMA
#undef PG8_WAIT_V
#undef PG8_WAIT_L
#undef PG8_BAR
#undef PG8_SCHED
}
}

#ifndef PG8_SP2
#define PG8_SP2 true
#endif
#ifndef PG8_ALIGN
#define PG8_ALIGN true
#endif
constexpr int NWAVES = 8;
#ifndef MK_N_LAUNCHES
#define MK_N_LAUNCHES 1
#endif
constexpr int N_PHASES = 8;
constexpr int N_LAUNCHES = MK_N_LAUNCHES;

constexpr int ROWB = 1536;
constexpr int S = 8192, D = 2048, NIN = 5120, DC = 1024, NE = 16384, NPAIR = 128;
constexpr float LN_EPS = 1e-5f;
constexpr float ALPHA = 1.189207115002721f;

constexpr size_t MiB = 1u << 20;
constexpr size_t WS_CTL = 0, CTL_ZERO_BYTES = 64 * 1024;
constexpr size_t WS_XB = 2 * MiB;
constexpr size_t WS_BT1 = 34 * MiB;
constexpr size_t WS_BT2 = 54 * MiB;
constexpr size_t WS_BT3 = 62 * MiB;
constexpr size_t WS_AGLU = 70 * MiB;
constexpr size_t WS_CV = 86 * MiB;
constexpr size_t WS_SCB = 102 * MiB;
constexpr size_t WS_MIX = 118 * MiB;
constexpr size_t WS_Y = 150 * MiB;
constexpr size_t WS_X1 = 214 * MiB;
constexpr size_t WS_S = 246 * MiB;
constexpr size_t WS_IDX = 310 * MiB;
constexpr size_t WS_GV = 314 * MiB;
constexpr size_t WS_SU = 318 * MiB;
constexpr size_t WS_U8 = 322 * MiB;
constexpr size_t WS_V8 = 354 * MiB;
constexpr size_t WS_USC = 386 * MiB;
constexpr size_t WS_VSC = 386 * MiB + 65536;
constexpr size_t WS_STAT = 386 * MiB + 131072;
constexpr size_t WS_C12 = 386 * MiB + 262144;
constexpr size_t WS_END = 387 * MiB;
constexpr int CW_BAR = 4096;

constexpr int RING_OFF = 0, RING_BYTES = 131072;
constexpr int LDSCTL_OFF = RING_BYTES, MISC_OFF = LDSCTL_OFF + 320;
constexpr int LNP_OFF = MISC_OFF + 128;
constexpr int LN2G_OFF = 122880;
constexpr int LDS_BYTES = 163840;

#define GAS __attribute__((address_space(1)))
#define LAS __attribute__((address_space(3)))
typedef unsigned short bf16;
typedef unsigned v4u __attribute__((ext_vector_type(4)));
typedef unsigned v2u __attribute__((ext_vector_type(2)));
typedef float f32x4 __attribute__((ext_vector_type(4)));
typedef float f32x2 __attribute__((ext_vector_type(2)));
typedef short bf16x8 __attribute__((ext_vector_type(8)));
typedef GAS unsigned gu32;
#define LDS_WAIT() asm volatile("s_waitcnt lgkmcnt(0)" ::: "memory")
#define VM_WAIT() asm volatile("s_waitcnt vmcnt(0)" ::: "memory")
__device__ __forceinline__ unsigned pk2(float lo, float hi) { return pg8::cvt_pk_bf16(lo, hi); }
__device__ __forceinline__ float bf_lo(unsigned w) { return __uint_as_float(w << 16); }
__device__ __forceinline__ float bf_hi(unsigned w) { return __uint_as_float(w & 0xffff0000u); }
__device__ __forceinline__ float wave_sum(float v) {
#pragma unroll
    for (int o = 1; o < 64; o <<= 1) v += __shfl_xor(v, o);
    return v;
}
__device__ __forceinline__ float wave_max(float v) {
#pragma unroll
    for (int o = 1; o < 64; o <<= 1) v = fmaxf(v, __shfl_xor(v, o));
    return v;
}

#define XB_TMO      128
#define XB_XCNT(j)  (256  + 64 * (j))
#define XB_XSUB(j)  (1280 + 64 * (j))
#define XB_XGEN(j)  (2304 + 64 * (j))
#define XB_TOP      3328
#define XB_TOPGEN   3392
#define XCD_BAR_WORDS 3456
#define XB_SPIN_CAP (1u << 18)

__device__ __forceinline__ unsigned xb_ld(unsigned* p)              { return __hip_atomic_load(p, __ATOMIC_RELAXED, __HIP_MEMORY_SCOPE_AGENT); }
__device__ __forceinline__ unsigned xb_add(unsigned* p, unsigned v) { return __hip_atomic_fetch_add(p, v, __ATOMIC_RELAXED, __HIP_MEMORY_SCOPE_AGENT); }
__device__ __forceinline__ unsigned xb_xcc_id() { return (unsigned)__builtin_amdgcn_s_getreg((3 << 11) | 20) & 0xFu; }
#define XB_SPIN(cond, bar) do { unsigned _sp = 0; while (cond) { __builtin_amdgcn_s_sleep(1); \
    if ((++_sp & 255u) == 0u) { if (xb_ld(&(bar)[XB_TMO])) break; if (_sp > XB_SPIN_CAP) { atomicAdd(&(bar)[XB_TMO], 1u); break; } } } } while (0)

struct XcdBarrier {
    unsigned* bar; unsigned x;
    volatile LAS unsigned* st;
};

__device__ __forceinline__ XcdBarrier xcd_barrier_post(unsigned* bar, volatile LAS unsigned* st) {
    XcdBarrier b; b.bar = bar; b.x = xb_xcc_id(); b.st = st;
    if (threadIdx.x == 0) (void)xb_add(&bar[XB_XCNT(b.x)], 1u);
    return b;
}
__device__ __forceinline__ void xcd_barrier_complete(unsigned* bar, unsigned x, unsigned& nloc, unsigned& nx) {
    const unsigned G = gridDim.x * gridDim.y * gridDim.z;
    unsigned sum, cnt, mine, sp = 0u;
    for (;;) {
        sum = 0u; cnt = 0u; mine = 0u;
#pragma unroll
        for (unsigned j = 0; j < 16; ++j) { const unsigned c = xb_ld(&bar[XB_XCNT(j)]); sum += c; cnt += (c > 0u) ? 1u : 0u; mine = (j == x) ? c : mine; }
        if (sum == G) break;
        __builtin_amdgcn_s_sleep(1);
        if ((++sp & 255u) == 0u) { if (xb_ld(&bar[XB_TMO])) break; if (sp > XB_SPIN_CAP) { atomicAdd(&bar[XB_TMO], 1u); break; } }
    }
    nloc = mine > 0u ? mine : 1u; nx = cnt > 0u ? cnt : 1u;
}

__device__ __forceinline__ void xcd_barrier(const XcdBarrier& b) {
    asm volatile("s_waitcnt vmcnt(0)" ::: "memory");
    __syncthreads();
    if (threadIdx.x == 0) {
        unsigned* bar = b.bar;
        __builtin_amdgcn_s_waitcnt(0);
        unsigned nloc = b.st[0], nx = b.st[1];
        if (nloc == 0u) { xcd_barrier_complete(bar, b.x, nloc, nx); b.st[0] = nloc; b.st[1] = nx; }
        const unsigned old = xb_add(&bar[XB_XSUB(b.x)], 1u);
        const unsigned gen = old / nloc;
        if (old + 1u == (gen + 1u) * nloc) {
            __builtin_amdgcn_fence(__ATOMIC_RELEASE, "agent");
            asm volatile("s_waitcnt vmcnt(0)" ::: "memory");
            const unsigned og = xb_add(&bar[XB_TOP], 1u);
            const unsigned tg = og / nx;
            if (og + 1u == (tg + 1u) * nx) xb_add(&bar[XB_TOPGEN], 1u);
            else XB_SPIN(xb_ld(&bar[XB_TOPGEN]) == tg, bar);
            __builtin_amdgcn_fence(__ATOMIC_ACQUIRE, "agent");
            xb_add(&bar[XB_XGEN(b.x)], 1u);
            asm volatile("s_waitcnt vmcnt(0)" ::: "memory");
        } else {
            XB_SPIN(xb_ld(&bar[XB_XGEN(b.x)]) == gen, bar);
            __builtin_amdgcn_fence(__ATOMIC_ACQUIRE, "agent");
            asm volatile("s_waitcnt vmcnt(0)" ::: "memory");
        }
    }
    __syncthreads();
}

struct Frame {
    LAS unsigned char* lds;
    volatile LAS unsigned* MISC;
    gu32* ctl;
    int tid, lane, wave, vcu, G;
    const float *x, *w_in, *b_in, *ccw, *ccb, *clg, *clb, *scw, *scbias, *w_out, *b_out, *ln1g, *ln1b, *w_q, *sub_keys, *peer_u, *peer_v, *ln2g, *ln2b;
    float* out;
    bf16 *XB, *BT1, *BT2, *BT3, *AGLU, *CV, *SCB, *MIX, *X1;
    bf16* Y; float* SS; int* IDX; float *STAT, *C12; float *GV, *SU; unsigned char *U8, *V8; float *USC, *VSC;
};

__device__ __forceinline__ int bt1_row(int n0) {
    const int grp = n0 >> 10, c = n0 & 1023, j = c >> 7, r = c & 127;
    if (grp == 0) return 256 * j + r;
    if (grp == 1) return 256 * j + 128 + r;
    if (grp == 2) return 4096 + c;
    if (grp == 3) return 2048 + 256 * j + r;
    return 2048 + 256 * j + 128 + r;
}
template <bool PERM_IN>
__device__ __forceinline__ void p0_transpose_item(const float* W, int K, int N, bf16* WT, LAS float* scr, int item, int lane) {
    const int nblk = N / 32, kb = item / nblk, nb = item % nblk, k0 = 64 * kb, n0 = 32 * nb;
    const int drow = PERM_IN ? bt1_row(n0) : n0;
#pragma unroll 8
    for (int i = 0; i < 32; ++i) { const int kk = 2 * i + (lane >> 5); scr[kk * 33 + (lane & 31)] = W[(size_t)(k0 + kk) * N + n0 + (lane & 31)]; }
    LDS_WAIT(); asm volatile("" ::: "memory");
    const int c = lane & 7;
#pragma unroll
    for (int j = 0; j < 4; ++j) { const int n = (lane >> 3) + 8 * j; const LAS float* s = scr + (8 * c) * 33 + n;
        v4u o; o.x = pk2(s[0 * 33], s[1 * 33]); o.y = pk2(s[2 * 33], s[3 * 33]); o.z = pk2(s[4 * 33], s[5 * 33]); o.w = pk2(s[6 * 33], s[7 * 33]);
        *(GAS v4u*)(WT + (size_t)(drow + n) * K + k0 + 8 * c) = o; }
    LDS_WAIT(); asm volatile("" ::: "memory");
}
__device__ __forceinline__ bf16x8 ld8_bf16(const float* p) {
    const f32x4 a = *(const f32x4*)p, b = *(const f32x4*)(p + 4);
    v4u w; w.x = pk2(a.x, a.y); w.y = pk2(a.z, a.w); w.z = pk2(b.x, b.y); w.w = pk2(b.z, b.w);
    return __builtin_bit_cast(bf16x8, w);
}
__device__ __forceinline__ unsigned fp6_encode(float y) {
    const unsigned sb = (__float_as_uint(y) >> 31) << 5;
    const float a = fabsf(y);
    const unsigned sub = (unsigned)__builtin_rintf(a * 8.0f);
    unsigned b = __float_as_uint(a); b += 0x7FFFFu + ((b >> 20) & 1u); b >>= 20;
    unsigned nrm = b - 1008u; nrm = nrm > 31u ? 31u : nrm;
    return sb | (a < 1.0f ? sub : nrm);
}
__device__ __forceinline__ void p0_prologue(Frame& F) {
    LAS float* scr = (LAS float*)(F.lds + RING_OFF + F.wave * 16384);
    const int gw = F.vcu * NWAVES + F.wave, NGW = F.G * NWAVES, lane = F.lane;
    constexpr int I_IN = (D / 64) * (NIN / 32), I_OUT = (D / 64) * (D / 32);
    for (int it = gw; it < I_IN + I_OUT; it += NGW) {
        if (it < I_IN) p0_transpose_item<true>(F.w_in, D, NIN, F.BT1, scr, it, lane);
        else p0_transpose_item<false>(F.w_out, D, D, F.BT2, scr, it - I_IN, lane);
    }
    for (int it = gw; it < 4096; it += NGW) {
        const int hp = it >> 8, nb = (it >> 5) & 7, db = it & 31, n0 = nb * 16, d0 = db * 64;
        const float* sk = F.sub_keys + ((size_t)hp * 128 + n0 + (lane & 15)) * 128 + 8 * (lane >> 4);
        const float* wq = F.w_q + (size_t)(d0 + (lane & 15)) * 2048 + hp * 128 + 8 * (lane >> 4);
        f32x4 acc[4];
#pragma unroll
        for (int dt = 0; dt < 4; ++dt) acc[dt] = (f32x4){0.f, 0.f, 0.f, 0.f};
#pragma unroll
        for (int ks = 0; ks < 4; ++ks) {
            const bf16x8 yf = ld8_bf16(sk + 32 * ks);
#pragma unroll
            for (int dt = 0; dt < 4; ++dt) { const bf16x8 xf = ld8_bf16(wq + (size_t)dt * 16 * 2048 + 32 * ks);
                acc[dt] = __builtin_amdgcn_mfma_f32_16x16x32_bf16(xf, yf, acc[dt], 0, 0, 0); }
        }
        bf16* orow = F.BT3 + (size_t)(hp * 128 + n0 + (lane & 15)) * 2048 + d0 + 4 * (lane >> 4);
#pragma unroll
        for (int dt = 0; dt < 4; ++dt) { v2u o; o.x = pk2(acc[dt][0], acc[dt][1]); o.y = pk2(acc[dt][2], acc[dt][3]); *(GAS v2u*)(orow + 16 * dt) = o; }
    }
    for (int i = gw * 64 + lane; i < 2 * S / 4; i += NGW * 64) ((GAS f32x4*)F.STAT)[i] = (f32x4){0.f, 0.f, 0.f, 0.f};
    for (int r = gw; r < S; r += NGW) {
        const GAS f32x4* src = (const GAS f32x4*)(F.x + (size_t)r * D) + 2 * lane;
        GAS v4u* dst = (GAS v4u*)(F.XB + (size_t)r * D) + lane;
#pragma unroll
        for (int j = 0; j < 4; ++j) { const f32x4 a = src[128 * j], b = src[128 * j + 1];
            v4u o; o.x = pk2(a.x, a.y); o.y = pk2(a.z, a.w); o.z = pk2(b.x, b.y); o.w = pk2(b.z, b.w); dst[64 * j] = o; }
    }
}
__device__ __forceinline__ void p0_encode_row(Frame& F, const f32x4 (&v)[8], int r, int lane) {
    const bool isv = r >= NE; const int e = isv ? r - NE : r;
    float am = 0.f;
#pragma unroll
    for (int j = 0; j < 8; ++j) am = fmaxf(am, fmaxf(fmaxf(fabsf(v[j].x), fabsf(v[j].y)), fmaxf(fabsf(v[j].z), fabsf(v[j].w))));
    am = wave_max(am);
    const float sc = am > 0.f ? 7.5f / am : 1.f, inv = am > 0.f ? am / 7.5f : 1.f;
    typedef float f32x16 __attribute__((ext_vector_type(16))); typedef unsigned u32x6v __attribute__((ext_vector_type(6)));
    f32x16 lo16, hi16;
#pragma unroll
    for (int i = 0; i < 16; ++i) {
        lo16[i] = v[(2 * i) >> 2][(2 * i) & 3] * sc; hi16[i] = v[(2 * i + 1) >> 2][(2 * i + 1) & 3] * sc;
    }
    const u32x6v pk = __builtin_amdgcn_cvt_scalef32_2xpk16_fp6_f32(lo16, hi16, 1.0f);
    unsigned w[6];
#pragma unroll
    for (int i = 0; i < 6; ++i) w[i] = pk[i];
    unsigned char* dst = (isv ? F.V8 : F.U8) + (size_t)e * ROWB + 24 * lane;
    *(GAS v2u*)(dst) = (v2u){w[0], w[1]}; *(GAS v2u*)(dst + 8) = (v2u){w[2], w[3]}; *(GAS v2u*)(dst + 16) = (v2u){w[4], w[5]};
    if (lane == 0) (isv ? F.VSC : F.USC)[e] = inv;
}
__device__ __forceinline__ void p0_load_row(Frame& F, f32x4 (&v)[8], int r, int lane) {
    const int rc = r < 2 * NE ? r : 2 * NE - 1;
    const GAS f32x4* src = (const GAS f32x4*)((rc >= NE ? F.peer_v : F.peer_u) + (size_t)(rc >= NE ? rc - NE : rc) * D) + lane;
#pragma unroll
    for (int j = 0; j < 8; ++j) v[j] = src[64 * j];
}
__device__ __forceinline__ void p0_peer_tables(Frame& F, int wid, int nw) {
    const int lane = F.lane;
    f32x4 a[8], b[8], na[8], nb[8];
    p0_load_row(F, na, wid, lane); p0_load_row(F, nb, wid + nw, lane);
#pragma unroll 1
    for (int r = wid; r < 2 * NE; r += 2 * nw) {
#pragma unroll
        for (int j = 0; j < 8; ++j) { a[j] = na[j]; b[j] = nb[j]; }
        p0_load_row(F, na, r + 2 * nw, lane); p0_load_row(F, nb, r + 3 * nw, lane);
        p0_encode_row(F, a, r, lane);
        if (r + nw < 2 * NE) p0_encode_row(F, b, r + nw, lane);
    }
}

__device__ __forceinline__ float dpp_add(float v, int ctrl_sel) {
    int m;
    if (ctrl_sel == 0) m = __builtin_amdgcn_update_dpp(0, __float_as_int(v), 0x111, 0xf, 0xf, false);
    else if (ctrl_sel == 1) m = __builtin_amdgcn_update_dpp(0, __float_as_int(v), 0x112, 0xf, 0xf, false);
    else if (ctrl_sel == 2) m = __builtin_amdgcn_update_dpp(0, __float_as_int(v), 0x114, 0xf, 0xf, false);
    else if (ctrl_sel == 3) m = __builtin_amdgcn_update_dpp(0, __float_as_int(v), 0x118, 0xf, 0xf, false);
    else if (ctrl_sel == 4) m = __builtin_amdgcn_update_dpp(0, __float_as_int(v), 0x142, 0xa, 0xf, false);
    else m = __builtin_amdgcn_update_dpp(0, __float_as_int(v), 0x143, 0xc, 0xf, false);
    return v + __int_as_float(m);
}
__device__ __forceinline__ float wave_sum_lane63(float v) {
    v = dpp_add(v, 0); v = dpp_add(v, 1); v = dpp_add(v, 2); v = dpp_add(v, 3); v = dpp_add(v, 4); v = dpp_add(v, 5); return v;
}
__device__ __forceinline__ void p2_unit(Frame& F, int unit) {
    const int t0 = unit * 32, tid_in = F.tid, lane = F.lane;
    LAS unsigned char* abuf = F.lds + RING_OFF;
    LAS float* stat = (LAS float*)(F.lds + LNP_OFF);
    {
        int tid = tid_in; asm volatile("" : "+v"(tid));
#pragma unroll
        for (int h = 0; h < 2; ++h) {
            v4u st[8];
#pragma unroll
            for (int k = 8 * h; k < 8 * h + 8; ++k) { const int c = tid + 512 * k; int cc = c < 62 * 128 ? c : 62 * 128 - 1; cc = (t0 - 30) * 128 + cc < 0 ? (30 - t0) * 128 : cc;
                st[k - 8 * h] = ((const GAS v4u*)F.AGLU)[(size_t)((t0 - 30) * 128 + cc)]; }
#pragma unroll
            for (int k = 8 * h; k < 8 * h + 8; ++k) { const int c = tid + 512 * k; const bool ok = (t0 - 30) * 128 + c >= 0;
                const v4u v = ok ? st[k - 8 * h] : (v4u){0u, 0u, 0u, 0u};
                if (k < 15 || tid < 62 * 128 - 512 * 15) *(LAS v4u*)(abuf + 16 * c) = v; }
            asm volatile("" ::: "memory");
        }
    }
    asm volatile("" ::: "memory"); __builtin_amdgcn_sched_barrier(0);
    {
        int tid = tid_in; asm volatile("" : "+v"(tid));
        const int cg = tid & 127, tg = tid >> 7, tb = t0 + 8 * tg;
        float w0[8], w1[8], w2[8], bs[8];
#pragma unroll
        for (int h = 0; h < 2; ++h) { const f32x4 a = *(const GAS f32x4*)(F.scw + 8 * cg + 4 * h), b = *(const GAS f32x4*)(F.scw + 1024 + 8 * cg + 4 * h), c = *(const GAS f32x4*)(F.scw + 2048 + 8 * cg + 4 * h), d = *(const GAS f32x4*)(F.scbias + 8 * cg + 4 * h);
#pragma unroll
            for (int q = 0; q < 4; ++q) { w0[4 * h + q] = a[q]; w1[4 * h + q] = b[q]; w2[4 * h + q] = c[q]; bs[4 * h + q] = d[q]; } }
        v4u cvr[10], gtr[8];
#pragma unroll
        for (int i = 0; i < 10; ++i) { const int t = tb - 2 + i, tc = t < 0 ? 0 : t; const v4u v = *(const GAS v4u*)(F.CV + (size_t)tc * 1024 + 8 * cg); cvr[i] = t < 0 ? (v4u){0u, 0u, 0u, 0u} : v; }
#pragma unroll
        for (int i = 0; i < 4; ++i) gtr[i] = *(const GAS v4u*)(F.SCB + (size_t)(tb + i) * 1024 + 8 * cg);
#pragma unroll
        for (int tt = 0; tt < 8; ++tt) {
            if (tt == 3) {
#pragma unroll
                for (int i = 4; i < 8; ++i) gtr[i] = *(const GAS v4u*)(F.SCB + (size_t)(tb + i) * 1024 + 8 * cg); }
            v4u o;
#pragma unroll
            for (int q = 0; q < 4; ++q) {
                const unsigned a2 = cvr[tt][q], a1 = cvr[tt + 1][q], a0 = cvr[tt + 2][q], g = gtr[tt][q];
                const float lo = bf_lo(g) * (bs[2 * q] + w0[2 * q] * bf_lo(a2) + w1[2 * q] * bf_lo(a1) + w2[2 * q] * bf_lo(a0));
                const float hi = bf_hi(g) * (bs[2 * q + 1] + w0[2 * q + 1] * bf_hi(a2) + w1[2 * q + 1] * bf_hi(a1) + w2[2 * q + 1] * bf_hi(a0));
                o[q] = pk2(lo, hi);
            }
            *(GAS v4u*)(F.MIX + (size_t)(tb + tt) * 2048 + 1024 + 8 * cg) = o;
        }
    }
    asm volatile("" ::: "memory"); __builtin_amdgcn_sched_barrier(0);
    LDS_WAIT(); __syncthreads();
    {
        int tid = tid_in; asm volatile("" : "+v"(tid)); const int c0 = 2 * tid;
        f32x2 w[31];
#pragma unroll
        for (int k = 0; k < 31; ++k) w[k] = *(const GAS f32x2*)(F.ccw + k * 1024 + c0);
        const f32x2 bias = *(const GAS f32x2*)(F.ccb + c0), lng = *(const GAS f32x2*)(F.clg + c0), lnb = *(const GAS f32x2*)(F.clb + c0);
#pragma unroll 1
        for (int g = 0; g < 4; ++g) {
            f32x2 o[8];
#pragma unroll
            for (int tt = 0; tt < 8; ++tt) o[tt] = bias;
#pragma unroll
            for (int half = 0; half < 2; ++half) {
                constexpr int NR = 23; const int r0 = half ? 16 : 0, k0 = half ? 16 : 0, nk = half ? 15 : 16;
                f32x2 in[NR];
#pragma unroll
                for (int i = 0; i < NR; ++i) { const int row = r0 + i < 38 ? r0 + i : 37; const unsigned raw = *(const LAS unsigned*)(abuf + (8 * g + row) * 2048 + 4 * tid); in[i] = (f32x2){bf_lo(raw), bf_hi(raw)}; }
#pragma unroll
                for (int tt = 0; tt < 8; ++tt)
#pragma unroll
                    for (int k = 0; k < 16; ++k) if (k < nk) o[tt] += w[k0 + k] * in[tt + k + k0 - r0];
                asm volatile("" ::: "memory");
            }
#pragma unroll
            for (int tt = 0; tt < 8; ++tt) { const float s1 = wave_sum_lane63(o[tt].x + o[tt].y), s2 = wave_sum_lane63(o[tt].x * o[tt].x + o[tt].y * o[tt].y);
                if (lane == 63) { stat[(tt * 2 + 0) * 8 + F.wave] = s1; stat[(tt * 2 + 1) * 8 + F.wave] = s2; } }
            LDS_WAIT(); __syncthreads();
            float tot;
            { const f32x4 a0 = *(const LAS f32x4*)(stat + (lane & 15) * 8), a1 = *(const LAS f32x4*)(stat + (lane & 15) * 8 + 4); tot = ((a0.x + a0.y) + (a0.z + a0.w)) + ((a1.x + a1.y) + (a1.z + a1.w)); }
#pragma unroll
            for (int tt = 0; tt < 8; ++tt) {
                const float mean = __int_as_float(__builtin_amdgcn_readlane(__float_as_int(tot), 2 * tt)) * (1.f / 1024.f);
                const float ex2 = __int_as_float(__builtin_amdgcn_readlane(__float_as_int(tot), 2 * tt + 1)) * (1.f / 1024.f);
                const float rstd = 1.f / sqrtf(fmaxf(ex2 - mean * mean, 0.f) + LN_EPS);
                f32x2 y = (o[tt] - mean) * rstd * lng + lnb;
                y.x *= pg8::sigmoidf_fast(y.x); y.y *= pg8::sigmoidf_fast(y.y);
                *(GAS unsigned*)(F.MIX + (size_t)(t0 + 8 * g + tt) * 2048 + c0) = pk2(y.x, y.y);
            }
            __syncthreads();
        }
    }
}

__device__ __forceinline__ void p1_c12(Frame& F) {
    const int gw = F.vcu * NWAVES + F.wave, NGW = F.G * NWAVES, lane = F.lane;
    for (int n = gw; n < 2048; n += NGW) {
        const GAS v4u* wr = (const GAS v4u*)(F.BT3 + (size_t)n * D) + lane;
        float a = 0.f, b = 0.f;
#pragma unroll
        for (int j = 0; j < 4; ++j) { const v4u w = wr[64 * j]; const int d0 = 8 * lane + 512 * j;
            const f32x4 g0 = *(const GAS f32x4*)(F.ln1g + d0), g1 = *(const GAS f32x4*)(F.ln1g + d0 + 4), b0 = *(const GAS f32x4*)(F.ln1b + d0), b1 = *(const GAS f32x4*)(F.ln1b + d0 + 4);
            a += g0.x * bf_lo(w.x) + g0.y * bf_hi(w.x) + g0.z * bf_lo(w.y) + g0.w * bf_hi(w.y) + g1.x * bf_lo(w.z) + g1.y * bf_hi(w.z) + g1.z * bf_lo(w.w) + g1.w * bf_hi(w.w);
            b += b0.x * bf_lo(w.x) + b0.y * bf_hi(w.x) + b0.z * bf_lo(w.y) + b0.w * bf_hi(w.y) + b1.x * bf_lo(w.z) + b1.y * bf_hi(w.z) + b1.z * bf_lo(w.w) + b1.w * bf_hi(w.w); }
        a = wave_sum(a); b = wave_sum(b);
        if (lane == 0) { F.C12[n] = a; F.C12[2048 + n] = b; }
    }
}

__device__ __forceinline__ int imax_(int a, int b) { return a > b ? a : b; }
__device__ __forceinline__ int imin_(int a, int b) { return a < b ? a : b; }
template <bool DESC> __device__ __forceinline__ void ce_i(int& a, int& b) { const int mx = imax_(a, b), mn = imin_(a, b); a = DESC ? mx : mn; b = DESC ? mn : mx; }
template <bool DESC> __device__ __forceinline__ void sort16_i(int (&v)[16]) {
#pragma unroll
    for (int k = 2; k <= 16; k <<= 1)
#pragma unroll
        for (int j = k >> 1; j > 0; j >>= 1)
#pragma unroll
            for (int i = 0; i < 16; ++i) { const int l = i ^ j; if (l > i) { const bool up = ((i & k) == 0); if (up != DESC) ce_i<false>(v[i], v[l]); else ce_i<true>(v[i], v[l]); } }
}
template <bool DESC> __device__ __forceinline__ void merge16_i(int (&v)[16]) {
#pragma unroll
    for (int j = 8; j > 0; j >>= 1)
#pragma unroll
        for (int i = 0; i < 16; ++i) { const int l = i ^ j; if (l > i) ce_i<DESC>(v[i], v[l]); }
}
template <bool DESC> __device__ __forceinline__ void ce_p(float& a, int& pa, float& b, int& pb) {
    const bool sw = DESC ? (a < b) : (a > b); const float ta = sw ? b : a, tb = sw ? a : b; const int qa = sw ? pb : pa, qb = sw ? pa : pb; a = ta; b = tb; pa = qa; pb = qb; }
template <bool DESC> __device__ __forceinline__ void sort16_p(float (&v)[16], int (&p)[16]) {
#pragma unroll
    for (int k = 2; k <= 16; k <<= 1)
#pragma unroll
        for (int j = k >> 1; j > 0; j >>= 1)
#pragma unroll
            for (int i = 0; i < 16; ++i) { const int l = i ^ j; if (l > i) { const bool up = ((i & k) == 0); if (up != DESC) ce_p<false>(v[i], p[i], v[l], p[l]); else ce_p<true>(v[i], p[i], v[l], p[l]); } }
}
template <bool DESC> __device__ __forceinline__ void merge16_p(float (&v)[16], int (&p)[16]) {
#pragma unroll
    for (int j = 8; j > 0; j >>= 1)
#pragma unroll
        for (int i = 0; i < 16; ++i) { const int l = i ^ j; if (l > i) ce_p<DESC>(v[i], p[i], v[l], p[l]); }
}
__device__ __forceinline__ int f2key(float f) { const int b = __float_as_int(f); return b ^ ((b >> 31) & 0x7fffffff); }
__device__ __forceinline__ float key2f(int k) { return __int_as_float(k ^ ((k >> 31) & 0x7fffffff)); }

__device__ __forceinline__ void p6_topk(Frame& F) {
    const int gw = F.vcu * NWAVES + F.wave, NGW = F.G * NWAVES, lane = F.lane;
    for (int it = gw; it < (S * 16) / 64; it += NGW) {
        const int prob = it * 64 + lane, t = prob >> 4, hp = prob & 15;
        const float* sp = F.SS + (size_t)t * 2048 + hp * 128;
        int top[16];
        {
            f32x4 r[4];
#pragma unroll
            for (int q = 0; q < 4; ++q) r[q] = *(const GAS f32x4*)(sp + 4 * q);
#pragma unroll
            for (int q = 0; q < 4; ++q)
#pragma unroll
                for (int e = 0; e < 4; ++e) top[4 * q + e] = (f2key(r[q][e]) & ~127) | (4 * q + e);
            sort16_i<true>(top);
        }
#pragma unroll 1
        for (int c = 1; c < 8; ++c) {
            f32x4 r[4]; int nw[16];
#pragma unroll
            for (int q = 0; q < 4; ++q) r[q] = *(const GAS f32x4*)(sp + 16 * c + 4 * q);
#pragma unroll
            for (int q = 0; q < 4; ++q)
#pragma unroll
                for (int e = 0; e < 4; ++e) nw[4 * q + e] = (f2key(r[q][e]) & ~127) | (16 * c + 4 * q + e);
            sort16_i<false>(nw);
#pragma unroll
            for (int i = 0; i < 16; ++i) top[i] = imax_(top[i], nw[i]);
            merge16_i<true>(top);
        }
        const bool odd = (lane & 1) != 0;
        float Av[16], Bv[16]; int Ai[16], Bi[16];
#pragma unroll
        for (int i = 0; i < 16; ++i) { const int mine = top[i]; const int other = __shfl_xor(mine, 1); const int ka = odd ? other : mine, kb = odd ? mine : other;
            Av[i] = key2f(ka & ~127); Ai[i] = ka & 127; Bv[i] = key2f(kb & ~127); Bi[i] = kb & 127; }
        float tv[16]; int tp[16];
#pragma unroll
        for (int j = 0; j < 16; ++j) { tv[j] = Av[0] + Bv[j]; tp[j] = Ai[0] * 128 + Bi[j]; }
        {
            float nv[16]; int np[16];
#pragma unroll
            for (int j = 0; j < 8; ++j) { nv[j] = Av[1] + Bv[j]; np[j] = Ai[1] * 128 + Bi[j]; }
#pragma unroll
            for (int j = 0; j < 5; ++j) { nv[8 + j] = Av[2] + Bv[j]; np[8 + j] = Ai[2] * 128 + Bi[j]; }
#pragma unroll
            for (int j = 0; j < 3; ++j) { nv[13 + j] = Av[3] + Bv[j]; np[13 + j] = Ai[3] * 128 + Bi[j]; }
            sort16_p<false>(nv, np);
#pragma unroll
            for (int i = 0; i < 16; ++i) { const bool g = nv[i] > tv[i]; tv[i] = g ? nv[i] : tv[i]; tp[i] = g ? np[i] : tp[i]; }
            merge16_p<true>(tv, tp);
        }
        {
            float nv[16]; int np[16];
            nv[0] = Av[3] + Bv[3]; np[0] = Ai[3] * 128 + Bi[3];
#pragma unroll
            for (int j = 0; j < 3; ++j) { nv[1 + j] = Av[4] + Bv[j]; np[1 + j] = Ai[4] * 128 + Bi[j]; }
#pragma unroll
            for (int i = 5; i < 8; ++i)
#pragma unroll
                for (int j = 0; j < 2; ++j) { nv[4 + 2 * (i - 5) + j] = Av[i] + Bv[j]; np[4 + 2 * (i - 5) + j] = Ai[i] * 128 + Bi[j]; }
#pragma unroll
            for (int i = 8; i < 14; ++i) { nv[10 + i - 8] = Av[i] + Bv[0]; np[10 + i - 8] = Ai[i] * 128 + Bi[0]; }
            sort16_p<false>(nv, np);
#pragma unroll
            for (int i = 0; i < 16; ++i) { const bool g = nv[i] > tv[i]; tv[i] = g ? nv[i] : tv[i]; tp[i] = g ? np[i] : tp[i]; }
            merge16_p<true>(tv, tp);
        }
        {
            const float hi = Av[14] + Bv[0], lo = Av[15] + Bv[0]; const int phi = Ai[14] * 128 + Bi[0], plo = Ai[15] * 128 + Bi[0];
            const float t14 = tv[14], t15 = tv[15]; const int q14 = tp[14], q15 = tp[15];
            const bool g14 = lo > t14, g15 = hi > t15;
            tv[14] = g14 ? lo : t14; tp[14] = g14 ? plo : q14; tv[15] = g15 ? hi : t15; tp[15] = g15 ? phi : q15;
        }
        float mx = tv[0];
#pragma unroll
        for (int i = 1; i < 16; ++i) mx = fmaxf(mx, tv[i]);
        float sum = 0.f;
#pragma unroll
        for (int i = 0; i < 16; ++i) { tv[i] = __expf(tv[i] - mx); sum += tv[i]; }
        const float rs = 1.f / sum;
        const size_t ob = (size_t)t * NPAIR + hp * 8;
        int oe[8]; float og[8], ou[8];
#pragma unroll
        for (int k = 0; k < 8; ++k) { const int pa = tp[k], pb = tp[8 + k]; const float va = tv[k], vb = tv[8 + k];
            oe[k] = odd ? pb : pa; const float g = (odd ? vb : va) * rs; og[k] = g * F.VSC[oe[k]]; ou[k] = F.USC[oe[k]]; }
        *(GAS v4u*)(F.IDX + ob) = (v4u){(unsigned)oe[0], (unsigned)oe[1], (unsigned)oe[2], (unsigned)oe[3]};
        *(GAS v4u*)(F.IDX + ob + 4) = (v4u){(unsigned)oe[4], (unsigned)oe[5], (unsigned)oe[6], (unsigned)oe[7]};
        *(GAS f32x4*)(F.GV + ob) = (f32x4){og[0], og[1], og[2], og[3]};
        *(GAS f32x4*)(F.GV + ob + 4) = (f32x4){og[4], og[5], og[6], og[7]};
        *(GAS f32x4*)(F.SU + ob) = (f32x4){ou[0], ou[1], ou[2], ou[3]};
        *(GAS f32x4*)(F.SU + ob + 4) = (f32x4){ou[4], ou[5], ou[6], ou[7]};
    }
}

constexpr int NSL = 10;
constexpr int RING_W = NSL * ROWB;
constexpr int TAB_V_OFS = (int)(WS_V8 - WS_U8);
static_assert(NWAVES * RING_W <= RING_BYTES, "rings fit the phase scratch region");
typedef unsigned u32x6 __attribute__((ext_vector_type(6)));
typedef float f32x32 __attribute__((ext_vector_type(32)));
typedef __bf16 bf16x32 __attribute__((ext_vector_type(32)));
typedef __bf16 bf16x2 __attribute__((ext_vector_type(2)));
__device__ __forceinline__ float gelu_erf(float z) { return 0.5f * z * (1.0f + erff(z * 0.70710678118654752f)); }
__device__ __forceinline__ void p7_sort512(int (&key)[8], int lane) {
#pragma unroll
    for (int k = 2; k <= 512; k <<= 1) {
#pragma unroll
        for (int j = k >> 1; j > 0; j >>= 1) {
            if (j >= 64) {
                const int jr = j >> 6;
#pragma unroll
                for (int r = 0; r < 8; ++r) if ((r & jr) == 0) { const int rp = r | jr; const bool asc = ((64 * r) & k) == 0;
                    const int a = key[r], b = key[rp], mn = imin_(a, b), mx = imax_(a, b); key[r] = asc ? mn : mx; key[rp] = asc ? mx : mn; }
            } else {
#pragma unroll
                for (int r = 0; r < 8; ++r) { const int mine = key[r], o = __builtin_amdgcn_ds_bpermute((lane ^ j) << 2, mine); const bool low = (lane & j) == 0, asc = ((64 * r + lane) & k) == 0;
                    key[r] = (low == asc) ? imin_(mine, o) : imax_(mine, o); }
            }
        }
    }
}
__device__ __forceinline__ int mbcnt64(unsigned long long m) { return (int)__builtin_amdgcn_mbcnt_hi((unsigned)(m >> 32), __builtin_amdgcn_mbcnt_lo((unsigned)m, 0u)); }
__device__ __forceinline__ int p7_group_by_slot(int kv) {
    const int s = (kv >> 7) & 3;
    const unsigned long long m0 = __ballot(s == 0), m1 = __ballot(s == 1), m2 = __ballot(s == 2), m3 = __ballot(s == 3);
    const int c0 = __popcll(m0), c1 = __popcll(m1), c2 = __popcll(m2);
    const int p0 = mbcnt64(m0), p1 = c0 + mbcnt64(m1), p2 = c0 + c1 + mbcnt64(m2), p3 = c0 + c1 + c2 + mbcnt64(m3);
    const int pos = s == 0 ? p0 : s == 1 ? p1 : s == 2 ? p2 : p3;
    return __builtin_amdgcn_ds_permute(pos << 2, kv);
}
__device__ __forceinline__ int sel8i(const int (&a)[8], int r) {
    const int a0 = a[0], a1 = a[1], a2 = a[2], a3 = a[3], a4 = a[4], a5 = a[5], a6 = a[6], a7 = a[7];
    int v = a0; v = r == 1 ? a1 : v; v = r == 2 ? a2 : v; v = r == 3 ? a3 : v; v = r == 4 ? a4 : v; v = r == 5 ? a5 : v; v = r == 6 ? a6 : v; v = r == 7 ? a7 : v; return v;
}
__device__ __forceinline__ float sel8f(const float (&a)[8], int r) {
    const float a0 = a[0], a1 = a[1], a2 = a[2], a3 = a[3], a4 = a[4], a5 = a[5], a6 = a[6], a7 = a[7];
    float v = a0; v = r == 1 ? a1 : v; v = r == 2 ? a2 : v; v = r == 3 ? a3 : v; v = r == 4 ? a4 : v; v = r == 5 ? a5 : v; v = r == 6 ? a6 : v; v = r == 7 ? a7 : v; return v;
}
__device__ __forceinline__ void p7_dma_row(__amdgpu_buffer_rsrc_t rs, LAS unsigned char* slotp, int soff, int v16) {
    __builtin_amdgcn_raw_ptr_buffer_load_lds(rs, (LAS void*)slotp, 16, v16, soff, 0, 0);
    if (v16 < 512) __builtin_amdgcn_raw_ptr_buffer_load_lds(rs, (LAS void*)(slotp + 1024), 16, v16, soff + 1024, 0, 0);
}
__device__ __forceinline__ u32x6 p7_read_row(const LAS unsigned char* slotp, int lane) {
    const LAS v2u* q = (const LAS v2u*)(slotp + 24 * lane); const v2u a = q[0], b = q[1], c = q[2];
    u32x6 r; r[0] = a.x; r[1] = a.y; r[2] = b.x; r[3] = b.y; r[4] = c.x; r[5] = c.y; return r;
}
__device__ __forceinline__ float p7_dot(const unsigned (&xp)[16], const bf16x32& uf) {
    float s0 = 0.f, s1 = 0.f;
#pragma unroll
    for (int m = 0; m < 16; m += 2) {
        bf16x2 a; a[0] = uf[2 * m]; a[1] = uf[2 * m + 1]; bf16x2 b; b[0] = uf[2 * m + 2]; b[1] = uf[2 * m + 3];
        const unsigned xa = xp[m], xb = xp[m + 1];
        s0 = __builtin_amdgcn_fdot2_f32_bf16(__builtin_bit_cast(bf16x2, xa), a, s0, false);
        s1 = __builtin_amdgcn_fdot2_f32_bf16(__builtin_bit_cast(bf16x2, xb), b, s1, false); }
    return s0 + s1;
}
__device__ __forceinline__ void p7_axpy(float (&acc)[32], float ck, const f32x32& vf) {
#pragma unroll
    for (int r = 0; r < 32; ++r) acc[r] = fmaf(ck, vf[r], acc[r]);
}
#define P7_WAIT_2ROWS() asm volatile("s_waitcnt vmcnt(16)" ::: "memory")
#define P7_WAIT_1ROW() asm volatile("s_waitcnt vmcnt(18)" ::: "memory")
#define P7_READS_DONE() asm volatile("s_waitcnt lgkmcnt(0)" ::: "memory")
static_assert(NSL == 10, "the counted waits above assume NSL = 10");
struct P7Stream { __amdgpu_buffer_rsrc_t tab; LAS unsigned char* ring; int rs; int v16; };
__device__ __forceinline__ LAS unsigned char* p7_slot(const P7Stream& St, int k) { int s = St.rs + k; s = s >= NSL ? s - NSL : s; return St.ring + s * ROWB; }
__device__ __forceinline__ void p7_advance(P7Stream& St, int k) { int s = St.rs + k; St.rs = s >= NSL ? s - NSL : s; }
__device__ __forceinline__ int p7_ahead(int koc, int kon, int tofs, int tofs_n, int j) {
    const int ln = (j + NSL) & 63; const int a = __builtin_amdgcn_readlane(koc, ln) + tofs, b = __builtin_amdgcn_readlane(kon, ln) + tofs_n;
    return j + NSL >= 64 ? b : a;
}
template <bool USWEEP>
__device__ __forceinline__ void p7_rows(P7Stream& St, const unsigned (&xp)[16], float (&acc)[32], int& zreg, int ccur, int koc, int kon, int tofs, int tofs_n, int j, int end, int lane) {
#pragma unroll 1
    for (; j + 1 < end; j += 2) {
        P7_WAIT_2ROWS();
        const u32x6 rowa = p7_read_row(p7_slot(St, 0), lane), rowb = p7_read_row(p7_slot(St, 1), lane);
        P7_READS_DONE();
        p7_dma_row(St.tab, p7_slot(St, 0), p7_ahead(koc, kon, tofs, tofs_n, j), St.v16);
        p7_dma_row(St.tab, p7_slot(St, 1), p7_ahead(koc, kon, tofs, tofs_n, j + 1), St.v16);
        p7_advance(St, 2);
        if constexpr (USWEEP) {
            const bf16x32 ua = __builtin_amdgcn_cvt_scalef32_pk32_bf16_fp6(rowa, 1.0f), ub = __builtin_amdgcn_cvt_scalef32_pk32_bf16_fp6(rowb, 1.0f);
            const float da = p7_dot(xp, ua), db = p7_dot(xp, ub);
            const v2u sw = __builtin_amdgcn_permlane32_swap(__float_as_uint(da), __float_as_uint(db), false, false);
            float t = __uint_as_float(sw.x) + __uint_as_float(sw.y);
            t = dpp_add(t, 0); t = dpp_add(t, 1); t = dpp_add(t, 2); t = dpp_add(t, 3); t = dpp_add(t, 4);
            const int za = __builtin_amdgcn_readlane(__float_as_int(t), 31), zb = __builtin_amdgcn_readlane(__float_as_int(t), 63);
            zreg = lane == j ? za : zreg; zreg = lane == j + 1 ? zb : zreg;
        } else {
            const float cka = __int_as_float(__builtin_amdgcn_readlane(ccur, j)), ckb = __int_as_float(__builtin_amdgcn_readlane(ccur, j + 1));
            { const f32x32 va = __builtin_amdgcn_cvt_scalef32_pk32_f32_fp6(rowa, 1.0f); p7_axpy(acc, cka, va); }
            { const f32x32 vb = __builtin_amdgcn_cvt_scalef32_pk32_f32_fp6(rowb, 1.0f); p7_axpy(acc, ckb, vb); }
        }
    }
    if (j < end) {
        P7_WAIT_1ROW();
        const u32x6 rowa = p7_read_row(p7_slot(St, 0), lane);
        P7_READS_DONE();
        p7_dma_row(St.tab, p7_slot(St, 0), p7_ahead(koc, kon, tofs, tofs_n, j), St.v16);
        p7_advance(St, 1);
        if constexpr (USWEEP) {
            const bf16x32 ua = __builtin_amdgcn_cvt_scalef32_pk32_bf16_fp6(rowa, 1.0f);
            const float da = wave_sum_lane63(p7_dot(xp, ua));
            const int za = __builtin_amdgcn_readlane(__float_as_int(da), 63);
            zreg = lane == j ? za : zreg;
        } else {
            const float cka = __int_as_float(__builtin_amdgcn_readlane(ccur, j));
            const f32x32 va = __builtin_amdgcn_cvt_scalef32_pk32_f32_fp6(rowa, 1.0f); p7_axpy(acc, cka, va);
        }
    }
}
__device__ __forceinline__ void p7_peer(Frame& F) {
    const int gw = F.vcu * NWAVES + F.wave, NGW = F.G * NWAVES, lane_in = F.lane;
    LAS f32x4* lg = (LAS f32x4*)(F.lds + LN2G_OFF); LAS f32x4* lb = (LAS f32x4*)(F.lds + LNP_OFF);
    LAS f32x4* l1g = lb + 512; LAS f32x4* l1b = l1g + 512;
    static_assert(LNP_OFF + 3 * 8192 <= LDS_BYTES && LN2G_OFF + 8192 <= LDSCTL_OFF, "LDS map of the PEER phase");
    for (int i = F.tid; i < 512; i += NWAVES * 64) { lg[i] = ((const GAS f32x4*)F.ln2g)[i]; lb[i] = ((const GAS f32x4*)F.ln2b)[i]; l1g[i] = ((const GAS f32x4*)F.ln1g)[i]; l1b[i] = ((const GAS f32x4*)F.ln1b)[i]; }
    LDS_WAIT(); __syncthreads();
    P7Stream St; St.ring = F.lds + RING_OFF + F.wave * RING_W; St.rs = 0;
    St.tab = __builtin_amdgcn_make_buffer_rsrc((void*)F.U8, 0, TAB_V_OFS + NE * ROWB, 0x00020000);
#pragma unroll 1
    for (int tg = gw; tg < S / 4; tg += NGW) {
        const int tb = 4 * tg;
        int lane = lane_in; asm volatile("" : "+v"(lane));
        St.v16 = 16 * lane;
        int key[8]; float gvv[8], suv[8];
#pragma unroll
        for (int s = 0; s < 4; ++s)
#pragma unroll
            for (int h = 0; h < 2; ++h) { const size_t o = (size_t)(tb + s) * NPAIR + 64 * h + lane;
                key[2 * s + h] = (F.IDX[o] << 9) | (s << 7) | (64 * h + lane); gvv[2 * s + h] = F.GV[o]; suv[2 * s + h] = F.SU[o]; }
        unsigned xp0[16], xp1[16], xp2[16], xp3[16];
        float mu[4], rs_[4];
#pragma unroll
        for (int s = 0; s < 4; ++s) { const float s1 = F.STAT[2 * (tb + s)], s2 = F.STAT[2 * (tb + s) + 1];
            mu[s] = s1 * (1.f / D); rs_[s] = 1.f / sqrtf(fmaxf(s2 * (1.f / D) - mu[s] * mu[s], 0.f) + LN_EPS); }
#pragma unroll
        for (int j = 0; j < 8; ++j) {
            const f32x4 g = l1g[lane + 64 * j], b = l1b[lane + 64 * j];
            const v2u w0 = ((const GAS v2u*)(F.Y + (size_t)(tb + 0) * D) + lane)[64 * j], w1 = ((const GAS v2u*)(F.Y + (size_t)(tb + 1) * D) + lane)[64 * j];
            const v2u w2 = ((const GAS v2u*)(F.Y + (size_t)(tb + 2) * D) + lane)[64 * j], w3 = ((const GAS v2u*)(F.Y + (size_t)(tb + 3) * D) + lane)[64 * j];
#define P7_X1PK(W_, S_, LO_) pk2(rs_[S_] * (bf_lo(LO_ ? W_.x : W_.y) - mu[S_] * (LO_ ? g.x : g.z)) + (LO_ ? b.x : b.z), rs_[S_] * (bf_hi(LO_ ? W_.x : W_.y) - mu[S_] * (LO_ ? g.y : g.w)) + (LO_ ? b.y : b.w))
            xp0[2 * j] = P7_X1PK(w0, 0, true); xp0[2 * j + 1] = P7_X1PK(w0, 0, false); xp1[2 * j] = P7_X1PK(w1, 1, true); xp1[2 * j + 1] = P7_X1PK(w1, 1, false);
            xp2[2 * j] = P7_X1PK(w2, 2, true); xp2[2 * j + 1] = P7_X1PK(w2, 2, false); xp3[2 * j] = P7_X1PK(w3, 3, true); xp3[2 * j + 1] = P7_X1PK(w3, 3, false); }
        p7_sort512(key, lane);
#pragma unroll
        for (int r = 0; r < 8; ++r) key[r] = p7_group_by_slot(key[r]);
        VM_WAIT();
        { const int ko0 = (key[0] >> 9) * ROWB;
#pragma unroll
          for (int i = 0; i < NSL; ++i) p7_dma_row(St.tab, St.ring + i * ROWB, __builtin_amdgcn_readlane(ko0, i), St.v16); }
        St.rs = 0;
        float coef[8];
#pragma unroll
        for (int q = 0; q < 8; ++q) coef[q] = 0.f;
        float dummy_acc[32];
#pragma unroll
        for (int q = 0; q < 32; ++q) dummy_acc[q] = 0.f;
#pragma unroll 1
        for (int r = 0; r < 8; ++r) {
            const int kcur = sel8i(key, r), knext = sel8i(key, (r + 1) & 7);
            const int koc = (kcur >> 9) * ROWB, kon = (knext >> 9) * ROWB, tofs_n = r == 7 ? TAB_V_OFS : 0;
            const int sl = (kcur >> 7) & 3;
            const int e0 = __popcll(__ballot(sl == 0)), e1 = e0 + __popcll(__ballot(sl == 1)), e2 = e1 + __popcll(__ballot(sl == 2));
            int zreg = 0;
            p7_rows<true>(St, xp0, dummy_acc, zreg, 0, koc, kon, 0, tofs_n, 0, e0, lane);
            p7_rows<true>(St, xp1, dummy_acc, zreg, 0, koc, kon, 0, tofs_n, e0, e1, lane);
            p7_rows<true>(St, xp2, dummy_acc, zreg, 0, koc, kon, 0, tofs_n, e1, e2, lane);
            p7_rows<true>(St, xp3, dummy_acc, zreg, 0, koc, kon, 0, tofs_n, e2, 64, lane);
            const int pr = kcur & 127, sel = 2 * sl + (pr >> 6);
            float su = 0.f, gv = 0.f;
#pragma unroll
            for (int j = 0; j < 8; ++j) { const float a = __int_as_float(__builtin_amdgcn_ds_bpermute((pr & 63) << 2, __float_as_int(suv[j]))), b = __int_as_float(__builtin_amdgcn_ds_bpermute((pr & 63) << 2, __float_as_int(gvv[j]))); su = sel == j ? a : su; gv = sel == j ? b : gv; }
            const float cnew = gelu_erf(__int_as_float(zreg) * su) * gv;
#pragma unroll
            for (int q = 0; q < 8; ++q) { const float old = coef[q]; coef[q] = r == q ? cnew : old; }
        }
        float acc0[32], acc1[32], acc2[32], acc3[32];
#pragma unroll
        for (int q = 0; q < 32; ++q) { acc0[q] = 0.f; acc1[q] = 0.f; acc2[q] = 0.f; acc3[q] = 0.f; }
        int zdummy = 0;
#pragma unroll 1
        for (int r = 0; r < 8; ++r) {
            const int kcur = sel8i(key, r), knext = sel8i(key, r < 7 ? r + 1 : 7); const int ccur = __float_as_int(sel8f(coef, r));
            const int koc = (kcur >> 9) * ROWB, kon = (knext >> 9) * ROWB;
            const int sl = (kcur >> 7) & 3;
            const int e0 = __popcll(__ballot(sl == 0)), e1 = e0 + __popcll(__ballot(sl == 1)), e2 = e1 + __popcll(__ballot(sl == 2));
            p7_rows<false>(St, xp0, acc0, zdummy, ccur, koc, kon, TAB_V_OFS, TAB_V_OFS, 0, e0, lane);
            p7_rows<false>(St, xp0, acc1, zdummy, ccur, koc, kon, TAB_V_OFS, TAB_V_OFS, e0, e1, lane);
            p7_rows<false>(St, xp0, acc2, zdummy, ccur, koc, kon, TAB_V_OFS, TAB_V_OFS, e1, e2, lane);
            p7_rows<false>(St, xp0, acc3, zdummy, ccur, koc, kon, TAB_V_OFS, TAB_V_OFS, e2, 64, lane);
        }
        VM_WAIT();
        v2u yr_[4][8];
#pragma unroll
        for (int s = 0; s < 4; ++s) {
            if ((s & 1) == 0) {
#pragma unroll
                for (int s2 = s; s2 < s + 2; ++s2)
#pragma unroll
                    for (int j = 0; j < 8; ++j) yr_[s2][j] = ((const GAS v2u*)(F.Y + (size_t)(tb + s2) * D) + lane)[64 * j];
            }
            asm volatile("" ::: "memory"); __builtin_amdgcn_sched_barrier(0);
            float (&acc)[32] = s == 0 ? acc0 : s == 1 ? acc1 : s == 2 ? acc2 : acc3;
            float sum = 0.f;
#pragma unroll
            for (int j = 0; j < 8; ++j) { const v2u w = yr_[s][j];
                const f32x4 g = l1g[lane + 64 * j], b = l1b[lane + 64 * j];
                const unsigned xa = P7_X1PK(w, s, true), xb = P7_X1PK(w, s, false);
                acc[4 * j + 0] = fmaf(ALPHA, bf_lo(xa), acc[4 * j + 0]); acc[4 * j + 1] = fmaf(ALPHA, bf_hi(xa), acc[4 * j + 1]);
                acc[4 * j + 2] = fmaf(ALPHA, bf_lo(xb), acc[4 * j + 2]); acc[4 * j + 3] = fmaf(ALPHA, bf_hi(xb), acc[4 * j + 3]); }
#pragma unroll
            for (int q = 0; q < 32; ++q) sum += acc[q];
            const float mean = __int_as_float(__builtin_amdgcn_readlane(__float_as_int(wave_sum_lane63(sum)), 63)) * (1.f / D); float s2 = 0.f;
#pragma unroll
            for (int q = 0; q < 32; ++q) { acc[q] -= mean; s2 = fmaf(acc[q], acc[q], s2); }
            const float rstd = 1.f / sqrtf(__int_as_float(__builtin_amdgcn_readlane(__float_as_int(wave_sum_lane63(s2)), 63)) * (1.f / D) + LN_EPS);
            GAS f32x4* orow = (GAS f32x4*)(F.out + (size_t)(tb + s) * D) + lane;
#pragma unroll
            for (int j = 0; j < 8; ++j) { const f32x4 g = lg[lane + 64 * j], b = lb[lane + 64 * j];
                f32x4 o; o.x = acc[4 * j + 0] * rstd * g.x + b.x; o.y = acc[4 * j + 1] * rstd * g.y + b.y; o.z = acc[4 * j + 2] * rstd * g.z + b.z; o.w = acc[4 * j + 3] * rstd * g.w + b.w;
                orow[64 * j] = o; }
        }
    }
}

struct Args { const float* in[19]; float* out; unsigned char* ws; int ph_lo, ph_hi, li, pad; };
__global__ void __launch_bounds__(NWAVES * 64, 2) peer_layer_fwd(Args args) {
    extern __shared__ __attribute__((aligned(16))) unsigned char lds[];
    Frame F;
    F.lds = (LAS unsigned char*)lds;
    F.MISC = (volatile LAS unsigned*)(F.lds + MISC_OFF);
    F.tid = threadIdx.x; F.lane = F.tid & 63; F.wave = __builtin_amdgcn_readfirstlane(F.tid >> 6);
    F.G = gridDim.x; { const int bx = blockIdx.x; F.vcu = (F.G % 8 == 0) ? (bx % 8) * (F.G / 8) + bx / 8 : bx; }
    unsigned char* ws = args.ws;
    F.ctl = (gu32*)(ws + WS_CTL);
    F.x = args.in[0]; F.w_in = args.in[1]; F.b_in = args.in[2]; F.ccw = args.in[3]; F.ccb = args.in[4]; F.clg = args.in[5]; F.clb = args.in[6];
    F.scw = args.in[7]; F.scbias = args.in[8]; F.w_out = args.in[9]; F.b_out = args.in[10]; F.ln1g = args.in[11]; F.ln1b = args.in[12];
    F.w_q = args.in[13]; F.sub_keys = args.in[14]; F.peer_u = args.in[15]; F.peer_v = args.in[16]; F.ln2g = args.in[17]; F.ln2b = args.in[18];
    F.out = args.out;
    F.XB = (bf16*)(ws + WS_XB); F.BT1 = (bf16*)(ws + WS_BT1); F.BT2 = (bf16*)(ws + WS_BT2); F.BT3 = (bf16*)(ws + WS_BT3);
    F.AGLU = (bf16*)(ws + WS_AGLU); F.CV = (bf16*)(ws + WS_CV); F.SCB = (bf16*)(ws + WS_SCB); F.MIX = (bf16*)(ws + WS_MIX); F.X1 = (bf16*)(ws + WS_X1);
    F.Y = (bf16*)(ws + WS_Y); F.SS = (float*)(ws + WS_S); F.IDX = (int*)(ws + WS_IDX); F.GV = (float*)(ws + WS_GV); F.SU = (float*)(ws + WS_SU);
    F.STAT = (float*)(ws + WS_STAT); F.C12 = (float*)(ws + WS_C12);
    F.U8 = ws + WS_U8; F.V8 = ws + WS_V8; F.USC = (float*)(ws + WS_USC); F.VSC = (float*)(ws + WS_VSC);
    for (int u = F.tid; u < (LDS_BYTES - LDSCTL_OFF) / 4; u += NWAVES * 64) ((LAS unsigned*)(F.lds + LDSCTL_OFF))[u] = 0u;
    __syncthreads();
    XcdBarrier bar; bar.bar = (unsigned*)(F.ctl + CW_BAR); bar.x = 0; bar.st = nullptr;
    if (N_LAUNCHES == 1) bar = xcd_barrier_post((unsigned*)(F.ctl + CW_BAR), F.MISC + 8);
    const int lo = args.ph_lo, hi = args.ph_hi;
#ifndef ONLY_PHASE
#define ONLY_PHASE -1
#endif
#define IN(k) ((k) != 4 && (ONLY_PHASE < 0 || ONLY_PHASE == (k)) && lo <= (k) && (k) < hi)
#define SEAM(k) do { if (IN(k) && IN((k) + 1)) xcd_barrier(bar); } while (0)
#ifndef REPEAT_PHASE
#define REPEAT_PHASE -1
#endif
#define REPS(k) for (int rep_ = 0; rep_ < (REPEAT_PHASE == (k) ? 2 : 1); ++rep_)

    if (IN(0)) { REPS(0) p0_prologue(F); SEAM(0); }
    if (IN(1)) { REPS(1) {
        if (F.G == 256) { if (blockIdx.x >= 128) p0_peer_tables(F, ((int)blockIdx.x - 128) * NWAVES + F.wave, 128 * NWAVES); }
        else p0_peer_tables(F, F.vcu * NWAVES + F.wave, F.G * NWAVES);
        p1_c12(F);
        __syncthreads();
        pg8::Gemm g{F.XB, F.BT1, S, NIN, D}; pg8::StaticOrder So; So.init(S, NIN, F.G, (int)blockIdx.x);
        pg8::EpiInProj E{F.AGLU, F.CV, F.SCB, F.b_in};
        pg8::gemm_phase<pg8::EpiInProj, pg8::StaticOrder, PG8_ALIGN, PG8_SP2>(F.lds + RING_OFF, g, So, E); }
        SEAM(1);
    }
    if (IN(2)) { REPS(2) for (int u = F.vcu; u < S / 32; u += F.G) p2_unit(F, u); SEAM(2); }
    if (IN(3)) { REPS(3) {
        pg8::Gemm g{F.MIX, F.BT2, S, D, D}; pg8::StaticOrder So; So.init(S, D, F.G, (int)blockIdx.x);
        pg8::EpiOutProj E{F.Y, F.b_out, F.XB, F.ln1g, F.STAT, ALPHA};
        pg8::gemm_phase<pg8::EpiOutProj, pg8::StaticOrder, PG8_ALIGN, PG8_SP2>(F.lds + RING_OFF, g, So, E); }
        if (IN(3) && IN(5)) xcd_barrier(bar);
    }
    if (IN(5)) { REPS(5) {
        pg8::Gemm g{F.Y, F.BT3, S, D, D}; pg8::StaticOrder So; So.init(S, D, F.G, (int)blockIdx.x);
        pg8::EpiF32 E{F.SS, D, F.STAT, F.C12, LN_EPS};
        pg8::gemm_phase<pg8::EpiF32, pg8::StaticOrder, PG8_ALIGN, PG8_SP2>(F.lds + RING_OFF, g, So, E); }
        SEAM(5);
    }
    if (IN(6)) { REPS(6) p6_topk(F); SEAM(6); }
    if (IN(7)) { REPS(7) p7_peer(F); }
#undef IN
#undef SEAM
}

extern "C" void kernel_launch(void* const* d_in, const int* in_sizes, int n_in, void* d_out, int out_size, void* d_ws, size_t ws_size, hipStream_t stream) {
    static int grid = 0;
    if (grid == 0) {
        if (n_in != 19 || in_sizes[0] != S * D || out_size != S * D || ws_size < WS_END) {
            fprintf(stderr, "kernel_launch: built for 19 inputs, x/out of %d floats, >= %zu bytes of workspace; got n_in %d, in0 %d, out %d, ws %zu; nothing launched\n", S * D, (size_t)WS_END, n_in, n_in > 0 ? in_sizes[0] : -1, out_size, ws_size);
            grid = -1; return; }
        int dev = 0, cus = 0, per_cu = 0;
        if (hipGetDevice(&dev) != hipSuccess || hipDeviceGetAttribute(&cus, hipDeviceAttributeMultiprocessorCount, dev) != hipSuccess) { fprintf(stderr, "kernel_launch: device query failed\n"); grid = -1; return; }
        if (hipFuncSetAttribute((const void*)peer_layer_fwd, hipFuncAttributeMaxDynamicSharedMemorySize, LDS_BYTES) != hipSuccess) { fprintf(stderr, "kernel_launch: hipFuncSetAttribute failed\n"); grid = -1; return; }
        if (hipOccupancyMaxActiveBlocksPerMultiprocessor(&per_cu, (const void*)peer_layer_fwd, NWAVES * 64, LDS_BYTES) != hipSuccess || per_cu < 1) {
            fprintf(stderr, "kernel_launch: occupancy query reports %d workgroups per CU; nothing launched\n", per_cu); (void)hipGetLastError(); grid = -1; return; }
        (void)hipGetLastError();
        grid = cus;
    }
    if (grid < 0) return;
    if (hipMemsetAsync((char*)d_ws + WS_CTL, 0, CTL_ZERO_BYTES, stream) != hipSuccess) { fprintf(stderr, "kernel_launch: hipMemsetAsync failed\n"); return; }
    Args a{};
    for (int i = 0; i < 19; ++i) a.in[i] = (const float*)d_in[i];
    a.out = (float*)d_out; a.ws = (unsigned char*)d_ws;
    for (int li = 0; li < N_LAUNCHES; ++li) {
        a.ph_lo = (N_LAUNCHES == 1) ? 0 : li; a.ph_hi = (N_LAUNCHES == 1) ? N_PHASES : li + 1; a.li = li;
        hipError_t le;
        if (N_LAUNCHES == 1) { void* kargs[] = {&a}; le = hipLaunchCooperativeKernel((const void*)peer_layer_fwd, dim3(grid), dim3(NWAVES * 64), kargs, LDS_BYTES, stream); }
        else { hipLaunchKernelGGL(peer_layer_fwd, dim3(grid), dim3(NWAVES * 64), LDS_BYTES, stream, a); le = hipPeekAtLastError(); }
        if (le != hipSuccess) { fprintf(stderr, "kernel_launch: launch %d failed: %s (grid %d x %d threads, %d B LDS)\n", li, hipGetErrorName(le), grid, NWAVES * 64, LDS_BYTES); break; }
    }
}
```

```cpp
#include <hip/hip_runtime.h>
#include <cstdio>
#include <cstdint>
namespace pg8 {
#define PG8_LAS __attribute__((address_space(3)))
typedef unsigned short bf16_t;
typedef short bf16x8 __attribute__((ext_vector_type(8)));
typedef float f32x4 __attribute__((ext_vector_type(4)));
typedef unsigned u32x4 __attribute__((ext_vector_type(4)));
constexpr int BM = 256, BK = 64, HALF = 128, HTB = HALF * BK * 2  , STAGE_BYTES = 8 * HTB, NXCD = 8, WGM = 8;

__host__ __device__ __forceinline__ int lds_byte(int r, int c) { const int st = (r >> 4) * 2 + (c >> 5), rr = r & 15, cc = c & 31, ob = rr * 64 + cc * 2; return st * 1024 + (ob ^ (((ob >> 9) & 1) << 5)); }
__host__ __device__ __forceinline__ void stage_rc(int b, int& R, int& C) { const int st = b / 1024, sb = b % 1024, swz = sb ^ (((sb >> 9) & 1) << 5); R = (st >> 1) * 16 + swz / 64; C = (st & 1) * 32 + (swz % 64) / 2; }
__host__ __device__ __forceinline__ int perm32(int rho) { const int n = rho >> 4, i = rho & 15; return 8 * (i >> 2) + 4 * n + (i & 3); }

struct Unit { int pm, pn; };
struct Gemm { const bf16_t* A; const bf16_t* Bt; int M, N, K; };

struct StaticOrder {
    int nM, nN, nwg, G, c;
    __host__ __device__ void init(int M, int N, int G_, int c_) { nM = M / BM; nN = N / BM; nwg = nM * nN; G = G_; c = c_; }
    __host__ __device__ bool next(int i, Unit& u) const {
        const long L = (long)i * G + c; if (L >= nwg) return false;
        int wgid = (int)L; { const int q = nwg / NXCD, r = nwg % NXCD, xcd = wgid % NXCD, off = wgid / NXCD; wgid = (xcd < r ? xcd * (q + 1) : r * (q + 1) + (xcd - r) * q) + off; }
        const int nig = WGM * nN, gid = wgid / nig, fm = gid * WGM, gsz = (nM - fm) < WGM ? (nM - fm) : WGM;
        u.pm = fm + ((wgid % nig) % gsz); u.pn = (wgid % nig) / gsz; return true;
    }
    __device__ __forceinline__ void a_ready(const Unit&) const {}
    __device__ __forceinline__ void done(const Unit&) const {}
};

__device__ __forceinline__ unsigned cvt_pk_bf16(float lo, float hi) { unsigned r; asm volatile("v_cvt_pk_bf16_f32 %0, %1, %2" : "=v"(r) : "v"(lo), "v"(hi)); return r; }
__device__ __forceinline__ float sigmoidf_fast(float g) { return __builtin_amdgcn_rcpf(1.0f + __expf(-g)); }

struct EpiInProj {
    static constexpr bool PERM = true, AFTER_DRAIN = false;
    bf16_t* aglu; bf16_t* cv; bf16_t* scb; const float* b_in;
    __device__ __forceinline__ void operator()(const f32x4 (&acc)[2][2][4][2], const Unit& u, int wr, int wc, int fr, int fq) const {
        const int row0 = u.pm * BM + wr * 64 + fr, cc = wc * 32 + 8 * fq;
        if (u.pn < 16) {
            const bool conf = u.pn < 8; const int j = conf ? u.pn : u.pn - 8;
            const float* b0 = b_in + (conf ? 0 : 3072) + 128 * j + cc;
            const float* b1 = b_in + (conf ? 1024 : 4096) + 128 * j + cc;
            bf16_t* O = (conf ? aglu : cv) + 128 * j + cc;
            f32x4 bv0[2], bv1[2];
#pragma unroll
            for (int n = 0; n < 2; ++n) { bv0[n] = *(const f32x4*)(b0 + 4 * n); bv1[n] = *(const f32x4*)(b1 + 4 * n); }
#pragma unroll
            for (int ai = 0; ai < 2; ++ai)
#pragma unroll
                for (int m = 0; m < 4; ++m) {
                    f32x4 r[2];
#pragma unroll
                    for (int n = 0; n < 2; ++n) { const f32x4 a = acc[ai][0][m][n] + bv0[n]; f32x4 g = acc[ai][1][m][n] + bv1[n];
                        if (conf) { g[0] = sigmoidf_fast(g[0]); g[1] = sigmoidf_fast(g[1]); g[2] = sigmoidf_fast(g[2]); g[3] = sigmoidf_fast(g[3]); }
                        r[n] = a * g; }
                    u32x4 w; w.x = cvt_pk_bf16(r[0][0], r[0][1]); w.y = cvt_pk_bf16(r[0][2], r[0][3]); w.z = cvt_pk_bf16(r[1][0], r[1][1]); w.w = cvt_pk_bf16(r[1][2], r[1][3]);
                    *(u32x4*)(O + (size_t)(row0 + ai * HALF + m * 16) * 1024) = w; }
        } else {
            const int j = u.pn - 16;
#pragma unroll
            for (int bj = 0; bj < 2; ++bj) {
                const float* b0 = b_in + 2048 + 256 * j + 128 * bj + cc; bf16_t* O = scb + 256 * j + 128 * bj + cc;
                const f32x4 bva = *(const f32x4*)(b0), bvb = *(const f32x4*)(b0 + 4);
#pragma unroll
                for (int ai = 0; ai < 2; ++ai)
#pragma unroll
                    for (int m = 0; m < 4; ++m) { const f32x4 v0 = acc[ai][bj][m][0] + bva, v1 = acc[ai][bj][m][1] + bvb;
                        u32x4 w; w.x = cvt_pk_bf16(v0[0], v0[1]); w.y = cvt_pk_bf16(v0[2], v0[3]); w.z = cvt_pk_bf16(v1[0], v1[1]); w.w = cvt_pk_bf16(v1[2], v1[3]);
                        *(u32x4*)(O + (size_t)(row0 + ai * HALF + m * 16) * 1024) = w; } }
        }
    }
};
struct EpiOutProj {
    static constexpr bool PERM = true, AFTER_DRAIN = false;
    bf16_t* YG; const float* bias; const bf16_t* xb; const float* g1; float* stat; float alpha;
    __device__ __forceinline__ void operator()(const f32x4 (&acc)[2][2][4][2], const Unit& u, int wr, int wc, int fr, int fq) const {
        const int row0 = u.pm * BM + wr * 64 + fr, col0 = u.pn * BM + wc * 32 + 8 * fq;
        f32x4 bv[2][2], gv[2][2];
#pragma unroll
        for (int bj = 0; bj < 2; ++bj)
#pragma unroll
            for (int n = 0; n < 2; ++n) { bv[bj][n] = *(const f32x4*)(bias + col0 + bj * HALF + 4 * n); gv[bj][n] = *(const f32x4*)(g1 + col0 + bj * HALF + 4 * n); }
#pragma unroll
        for (int ai = 0; ai < 2; ++ai)
#pragma unroll
            for (int m = 0; m < 4; ++m) { const int row = row0 + ai * HALF + m * 16; const size_t off = (size_t)row * 2048 + col0;
                float s1 = 0.f, s2 = 0.f;
#pragma unroll
                for (int bj = 0; bj < 2; ++bj) { const u32x4 xw = __builtin_nontemporal_load((const u32x4*)(xb + off + bj * HALF));
                    f32x4 v0 = acc[ai][bj][m][0] + bv[bj][0], v1 = acc[ai][bj][m][1] + bv[bj][1];
                    v0[0] += alpha * __uint_as_float(xw.x << 16); v0[1] += alpha * __uint_as_float(xw.x & 0xffff0000u); v0[2] += alpha * __uint_as_float(xw.y << 16); v0[3] += alpha * __uint_as_float(xw.y & 0xffff0000u);
                    v1[0] += alpha * __uint_as_float(xw.z << 16); v1[1] += alpha * __uint_as_float(xw.z & 0xffff0000u); v1[2] += alpha * __uint_as_float(xw.w << 16); v1[3] += alpha * __uint_as_float(xw.w & 0xffff0000u);
                    s1 += ((v0[0] + v0[1]) + (v0[2] + v0[3])) + ((v1[0] + v1[1]) + (v1[2] + v1[3]));
                    s2 += ((v0[0] * v0[0] + v0[1] * v0[1]) + (v0[2] * v0[2] + v0[3] * v0[3])) + ((v1[0] * v1[0] + v1[1] * v1[1]) + (v1[2] * v1[2] + v1[3] * v1[3]));
                    v0 = v0 * gv[bj][0]; v1 = v1 * gv[bj][1];
                    u32x4 w; w.x = cvt_pk_bf16(v0[0], v0[1]); w.y = cvt_pk_bf16(v0[2], v0[3]); w.z = cvt_pk_bf16(v1[0], v1[1]); w.w = cvt_pk_bf16(v1[2], v1[3]);
                    *(u32x4*)(YG + off + bj * HALF) = w; }
                s1 += __shfl_xor(s1, 16); s2 += __shfl_xor(s2, 16); s1 += __shfl_xor(s1, 32); s2 += __shfl_xor(s2, 32);
                if (fq == 0) { atomicAdd(stat + 2 * row, s1); atomicAdd(stat + 2 * row + 1, s2); }
                asm volatile("" ::: "memory"); }
    }
};
struct EpiF32 {
    static constexpr bool PERM = false, AFTER_DRAIN = false;
    float* C; int ldc; const float* stat; const float* c12; float eps;
    __device__ __forceinline__ void operator()(const f32x4 (&acc)[2][2][4][2], const Unit& u, int wr, int wc, int fr, int fq) const {
        const int row0 = u.pm * BM + wr * 64 + fr, col0 = u.pn * BM + wc * 32 + 4 * fq;
        f32x4 c1v[2][2], c2v[2][2];
#pragma unroll
        for (int bj = 0; bj < 2; ++bj)
#pragma unroll
            for (int n = 0; n < 2; ++n) { c1v[bj][n] = *(const f32x4*)(c12 + col0 + bj * HALF + n * 16); c2v[bj][n] = *(const f32x4*)(c12 + 2048 + col0 + bj * HALF + n * 16); }
#pragma unroll
        for (int ai = 0; ai < 2; ++ai)
#pragma unroll
            for (int m = 0; m < 4; ++m) { const int row = row0 + ai * HALF + m * 16; float* rowp = C + (size_t)row * ldc + col0;
                const float s1 = stat[2 * row], s2 = stat[2 * row + 1];
                const float mean = s1 * (1.0f / 2048.0f), var = fmaxf(s2 * (1.0f / 2048.0f) - mean * mean, 0.f), rstd = 1.0f / sqrtf(var + eps);
#pragma unroll
                for (int bj = 0; bj < 2; ++bj)
#pragma unroll
                    for (int n = 0; n < 2; ++n) *(f32x4*)(rowp + bj * HALF + n * 16) = (acc[ai][bj][m][n] - c1v[bj][n] * mean) * rstd + c2v[bj][n]; }
    }
};

template <class Epi, class Sched, bool ALIGN_EPI = false, bool SP2 = false>
__device__ __forceinline__ void gemm_phase(PG8_LAS unsigned char* lds, const Gemm g, const Sched& S, const Epi& E) {
    const int tid = threadIdx.x, wid = __builtin_amdgcn_readfirstlane(tid >> 6), lane = tid & 63, wr = wid >> 2, wc = wid & 3, fr = lane & 15, fq = lane >> 4;
    const int K = g.K, nt = K / BK;
    unsigned voffA[2], voffB[2];
#pragma unroll
    for (int i = 0; i < 2; ++i) { int R, C; stage_rc(tid * 16 + i * 8192, R, C); const int Rb = Epi::PERM ? ((R & ~31) + perm32(R & 31)) : R;
        voffA[i] = (unsigned)(R * K + C) * 2u; voffB[i] = (unsigned)(Rb * K + C) * 2u; }
    const size_t kstep = (size_t)(BK * 2);
    const size_t hstep = (size_t)HALF * K * 2;
    const size_t tstep = 2 * hstep;
    const unsigned ldsw = (unsigned)wid * 1024u;
    const int aoff = lds_byte(wr * 64 + fr, fq * 8), boff = lds_byte(wc * 32 + fr, fq * 8);
#define PG8_SA(b, h) (((b) * 2 + (h)) * HTB)
#define PG8_SB(b, h) ((4 + (b) * 2 + (h)) * HTB)
#define PG8_STAGE(bufoff, gbase, voff) do { _Pragma("unroll") for (int _i = 0; _i < 2; ++_i) \
        __builtin_amdgcn_global_load_lds((const unsigned*)((const char*)(gbase) + (voff)[_i]), (PG8_LAS unsigned*)(lds + (bufoff) + ldsw + _i * 8192), 16, 0, 0); } while (0)
#define PG8_LDA(dst, b, h) do { _Pragma("unroll") for (int m = 0; m < 4; ++m) _Pragma("unroll") for (int k = 0; k < 2; ++k) dst[m][k] = *(const PG8_LAS bf16x8*)(lds + PG8_SA(b, h) + aoff + m * 2048 + k * 1024); } while (0)
#define PG8_LDB(dst, b, h) do { _Pragma("unroll") for (int n = 0; n < 2; ++n) _Pragma("unroll") for (int k = 0; k < 2; ++k) dst[n][k] = *(const PG8_LAS bf16x8*)(lds + PG8_SB(b, h) + boff + n * 2048 + k * 1024); } while (0)
#define PG8_MMA(ai, bj, At, Bt) do { __builtin_amdgcn_s_setprio(1); _Pragma("unroll") for (int m = 0; m < 4; ++m) _Pragma("unroll") for (int n = 0; n < 2; ++n) _Pragma("unroll") for (int k = 0; k < 2; ++k) \
        acc[ai][bj][m][n] = __builtin_amdgcn_mfma_f32_16x16x32_bf16(Bt[n][k], At[m][k], acc[ai][bj][m][n], 0, 0, 0); __builtin_amdgcn_s_setprio(0); } while (0)
#define PG8_WAIT_V(n) asm volatile("s_waitcnt vmcnt(" #n ")" ::: "memory")
#define PG8_WAIT_L(n) asm volatile("s_waitcnt lgkmcnt(" #n ")" ::: "memory")
#define PG8_BAR __builtin_amdgcn_s_barrier()
#define PG8_SCHED __builtin_amdgcn_sched_barrier(0)
    Unit cur, nxt; int ui = 0;
    if (!S.next(0, cur)) return;
    f32x4 acc[2][2][4][2];
#pragma unroll
    for (int a = 0; a < 2; ++a)
#pragma unroll
        for (int b = 0; b < 2; ++b)
#pragma unroll
            for (int m = 0; m < 4; ++m)
#pragma unroll
                for (int n = 0; n < 2; ++n) acc[a][b][m][n] = (f32x4){0.f, 0.f, 0.f, 0.f};
    bf16x8 At[4][2], B0[2][2], B1[2][2];
    const char* cA = (const char*)g.A + (size_t)cur.pm * tstep; const char* cB = (const char*)g.Bt + (size_t)cur.pn * tstep;
    S.a_ready(cur);
    if constexpr (SP2) {
        PG8_STAGE(PG8_SB(0, 0), cB, voffB); PG8_STAGE(PG8_SB(0, 1), cB + hstep, voffB); PG8_STAGE(PG8_SA(0, 0), cA, voffA); PG8_STAGE(PG8_SA(0, 1), cA + hstep, voffA);
        if (wr == 1) PG8_BAR;
        PG8_WAIT_V(2); PG8_BAR;
        PG8_STAGE(PG8_SB(1, 0), cB + kstep, voffB); PG8_STAGE(PG8_SA(1, 0), cA + kstep, voffA); PG8_STAGE(PG8_SB(1, 1), cB + hstep + kstep, voffB);
        PG8_WAIT_V(6); PG8_BAR;
    } else {
        PG8_STAGE(PG8_SB(0, 0), cB, voffB); PG8_STAGE(PG8_SA(0, 0), cA, voffA); PG8_STAGE(PG8_SB(0, 1), cB + hstep, voffB); PG8_STAGE(PG8_SA(0, 1), cA + hstep, voffA);
        if (wr == 1) PG8_BAR;
        PG8_WAIT_V(4); PG8_BAR;
        PG8_STAGE(PG8_SB(1, 0), cB + kstep, voffB); PG8_STAGE(PG8_SA(1, 0), cA + kstep, voffA); PG8_STAGE(PG8_SB(1, 1), cB + hstep + kstep, voffB);
        PG8_WAIT_V(6); PG8_BAR;
    }
    for (;;) {
        const bool has_next = S.next(ui + 1, nxt);
        const char* nA = has_next ? (const char*)g.A + (size_t)nxt.pm * tstep : cA; const char* nB = has_next ? (const char*)g.Bt + (size_t)nxt.pn * tstep : cB;
        for (int t = 0; t < nt; t += 2) {
            const bool last = (t == nt - 2);
            const char* a1 = cA + (size_t)(t + 1) * kstep;
            const char* a2 = last ? nA : cA + (size_t)(t + 2) * kstep; const char* b2 = last ? nB : cB + (size_t)(t + 2) * kstep;
            const char* a3 = a2 + kstep; const char* b3 = b2 + kstep;
            if (last && has_next) S.a_ready(nxt);
            if constexpr (SP2) {
            PG8_LDB(B0, 0, 0); PG8_LDB(B1, 0, 1); PG8_SCHED; PG8_LDA(At, 0, 0); PG8_STAGE(PG8_SA(1, 1), a1 + hstep, voffA);
            PG8_WAIT_V(8); PG8_WAIT_L(0); PG8_BAR; PG8_MMA(0, 0, At, B0); PG8_MMA(0, 1, At, B1); PG8_BAR; PG8_SCHED;
            PG8_LDA(At, 0, 1); PG8_STAGE(PG8_SB(0, 0), b2, voffB); PG8_STAGE(PG8_SB(0, 1), b2 + hstep, voffB); PG8_STAGE(PG8_SA(0, 0), a2, voffA);
            PG8_WAIT_V(8); PG8_WAIT_L(0); PG8_BAR; PG8_MMA(1, 0, At, B0); PG8_MMA(1, 1, At, B1); PG8_BAR; PG8_SCHED;
            PG8_LDB(B0, 1, 0); PG8_LDB(B1, 1, 1); PG8_SCHED; PG8_LDA(At, 1, 0); PG8_STAGE(PG8_SA(0, 1), a2 + hstep, voffA);
            PG8_WAIT_V(8); PG8_WAIT_L(0); PG8_BAR; PG8_MMA(0, 0, At, B0); PG8_MMA(0, 1, At, B1); PG8_BAR; PG8_SCHED;
            PG8_LDA(At, 1, 1); PG8_STAGE(PG8_SB(1, 0), b3, voffB); PG8_STAGE(PG8_SB(1, 1), b3 + hstep, voffB); PG8_STAGE(PG8_SA(1, 0), a3, voffA);
            PG8_WAIT_V(8); PG8_WAIT_L(0); PG8_BAR; PG8_MMA(1, 0, At, B0); PG8_MMA(1, 1, At, B1); PG8_BAR; PG8_SCHED;
            } else {
            PG8_LDB(B0, 0, 0); PG8_SCHED; PG8_LDA(At, 0, 0); PG8_STAGE(PG8_SA(1, 1), a1 + hstep, voffA);
            PG8_WAIT_L(8); PG8_BAR; PG8_WAIT_L(0); PG8_MMA(0, 0, At, B0); PG8_BAR; PG8_SCHED;
            PG8_LDB(B1, 0, 1); PG8_STAGE(PG8_SB(0, 0), b2, voffB);
            PG8_BAR; PG8_WAIT_L(0); PG8_MMA(0, 1, At, B1); PG8_BAR;
            PG8_LDA(At, 0, 1); PG8_STAGE(PG8_SA(0, 0), a2, voffA);
            PG8_BAR; PG8_WAIT_L(0); PG8_MMA(1, 0, At, B0); PG8_BAR; PG8_SCHED;
            PG8_STAGE(PG8_SB(0, 1), b2 + hstep, voffB);
            PG8_WAIT_V(6); PG8_BAR; PG8_MMA(1, 1, At, B1); PG8_BAR;
            PG8_LDB(B0, 1, 0); PG8_SCHED; PG8_LDA(At, 1, 0); PG8_STAGE(PG8_SA(0, 1), a2 + hstep, voffA);
            PG8_WAIT_L(8); PG8_BAR; PG8_WAIT_L(0); PG8_MMA(0, 0, At, B0); PG8_BAR; PG8_SCHED;
            PG8_LDB(B1, 1, 1); PG8_STAGE(PG8_SB(1, 0), b3, voffB);
            PG8_BAR; PG8_WAIT_L(0); PG8_MMA(0, 1, At, B1); PG8_BAR;
            PG8_LDA(At, 1, 1); PG8_STAGE(PG8_SA(1, 0), a3, voffA);
            PG8_BAR; PG8_WAIT_L(0); PG8_MMA(1, 0, At, B0); PG8_BAR; PG8_SCHED;
            PG8_STAGE(PG8_SB(1, 1), b3 + hstep, voffB);
            PG8_WAIT_V(6); PG8_BAR; PG8_MMA(1, 1, At, B1); PG8_BAR;
            }
        }
        if constexpr (ALIGN_EPI) { if (wr == 0) PG8_BAR; }
        if constexpr (!Epi::AFTER_DRAIN) { E(acc, cur, wr, wc, fr, fq); S.done(cur); }
        if (!has_next) break;
#pragma unroll
        for (int a = 0; a < 2; ++a)
#pragma unroll
            for (int b = 0; b < 2; ++b)
#pragma unroll
                for (int m = 0; m < 4; ++m)
#pragma unroll
                    for (int n = 0; n < 2; ++n) acc[a][b][m][n] = (f32x4){0.f, 0.f, 0.f, 0.f};
        cur = nxt; cA = nA; cB = nB; ++ui;
        if constexpr (ALIGN_EPI) { if (wr == 1) PG8_BAR; }
    }
    PG8_WAIT_V(0);
    if constexpr (!ALIGN_EPI) { if (wr == 0) PG8_BAR; }
    PG8_BAR;
    if constexpr (Epi::AFTER_DRAIN) { E.fused(acc, cur, wr, wc, fr, fq, lds, wid, lane); S.done(cur); }
#undef PG8_SA
#undef PG8_SB
#undef PG8_STAGE
#undef PG8_LDA
#undef PG8_LDB
#undef PG8_MMA
#undef PG8_WAIT_V
#undef PG8_WAIT_L
#undef PG8_BAR
#undef PG8_SCHED
}
}

#ifndef PG8_SP2
#define PG8_SP2 true
#endif
#ifndef PG8_ALIGN
#define PG8_ALIGN true
#endif
constexpr int NWAVES = 8;
#ifndef MK_N_LAUNCHES
#define MK_N_LAUNCHES 1
#endif
constexpr int N_PHASES = 8;
constexpr int N_LAUNCHES = MK_N_LAUNCHES;

constexpr int ROWB = 1536;
constexpr int S = 8192, D = 2048, NIN = 5120, DC = 1024, NE = 16384, NPAIR = 128;
constexpr float LN_EPS = 1e-5f;
constexpr float ALPHA = 1.189207115002721f;

constexpr size_t MiB = 1u << 20;
constexpr size_t WS_CTL = 0, CTL_ZERO_BYTES = 64 * 1024;
constexpr size_t WS_XB = 2 * MiB;
constexpr size_t WS_BT1 = 34 * MiB;
constexpr size_t WS_BT2 = 54 * MiB;
constexpr size_t WS_BT3 = 62 * MiB;
constexpr size_t WS_AGLU = 70 * MiB;
constexpr size_t WS_CV = 86 * MiB;
constexpr size_t WS_SCB = 102 * MiB;
constexpr size_t WS_MIX = 118 * MiB;
constexpr size_t WS_Y = 150 * MiB;
constexpr size_t WS_X1 = 214 * MiB;
constexpr size_t WS_S = 246 * MiB;
constexpr size_t WS_IDX = 310 * MiB;
constexpr size_t WS_GV = 314 * MiB;
constexpr size_t WS_SU = 318 * MiB;
constexpr size_t WS_U8 = 322 * MiB;
constexpr size_t WS_V8 = 354 * MiB;
constexpr size_t WS_USC = 386 * MiB;
constexpr size_t WS_VSC = 386 * MiB + 65536;
constexpr size_t WS_STAT = 386 * MiB + 131072;
constexpr size_t WS_C12 = 386 * MiB + 262144;
constexpr size_t WS_END = 387 * MiB;
constexpr int CW_BAR = 4096;

constexpr int RING_OFF = 0, RING_BYTES = 131072;
constexpr int LDSCTL_OFF = RING_BYTES, MISC_OFF = LDSCTL_OFF + 320;
constexpr int LNP_OFF = MISC_OFF + 128;
constexpr int LN2G_OFF = 122880;
constexpr int LDS_BYTES = 163840;

#define GAS __attribute__((address_space(1)))
#define LAS __attribute__((address_space(3)))
typedef unsigned short bf16;
typedef unsigned v4u __attribute__((ext_vector_type(4)));
typedef unsigned v2u __attribute__((ext_vector_type(2)));
typedef float f32x4 __attribute__((ext_vector_type(4)));
typedef float f32x2 __attribute__((ext_vector_type(2)));
typedef short bf16x8 __attribute__((ext_vector_type(8)));
typedef GAS unsigned gu32;
#define LDS_WAIT() asm volatile("s_waitcnt lgkmcnt(0)" ::: "memory")
#define VM_WAIT() asm volatile("s_waitcnt vmcnt(0)" ::: "memory")
__device__ __forceinline__ unsigned pk2(float lo, float hi) {
    typedef __bf16 bf16x2_t __attribute__((ext_vector_type(2)));
    const f32x2 v = (f32x2){lo, hi};
    const bf16x2_t h = __builtin_convertvector(v, bf16x2_t);
    return __builtin_bit_cast(unsigned, h);
}
__device__ __forceinline__ float bf_lo(unsigned w) { return __uint_as_float(w << 16); }
__device__ __forceinline__ float bf_hi(unsigned w) { return __uint_as_float(w & 0xffff0000u); }
__device__ __forceinline__ float wave_sum(float v) {
#pragma unroll
    for (int o = 1; o < 64; o <<= 1) v += __shfl_xor(v, o);
    return v;
}
__device__ __forceinline__ float wave_max(float v) {
#pragma unroll
    for (int o = 1; o < 64; o <<= 1) v = fmaxf(v, __shfl_xor(v, o));
    return v;
}

#define XB_TMO      128
#define XB_XCNT(j)  (256  + 64 * (j))
#define XB_XSUB(j)  (1280 + 64 * (j))
#define XB_XGEN(j)  (2304 + 64 * (j))
#define XB_TOP      3328
#define XB_TOPGEN   3392
#define XCD_BAR_WORDS 3456
#define XB_SPIN_CAP (1u << 18)

__device__ __forceinline__ unsigned xb_ld(unsigned* p)              { return __hip_atomic_load(p, __ATOMIC_RELAXED, __HIP_MEMORY_SCOPE_AGENT); }
__device__ __forceinline__ unsigned xb_add(unsigned* p, unsigned v) { return __hip_atomic_fetch_add(p, v, __ATOMIC_RELAXED, __HIP_MEMORY_SCOPE_AGENT); }
__device__ __forceinline__ unsigned xb_xcc_id() { return (unsigned)__builtin_amdgcn_s_getreg((3 << 11) | 20) & 0xFu; }
#define XB_SPIN(cond, bar) do { unsigned _sp = 0; while (cond) { __builtin_amdgcn_s_sleep(1); \
    if ((++_sp & 255u) == 0u) { if (xb_ld(&(bar)[XB_TMO])) break; if (_sp > XB_SPIN_CAP) { atomicAdd(&(bar)[XB_TMO], 1u); break; } } } } while (0)

struct XcdBarrier {
    unsigned* bar; unsigned x;
    volatile LAS unsigned* st;
};

__device__ __forceinline__ XcdBarrier xcd_barrier_post(unsigned* bar, volatile LAS unsigned* st) {
    XcdBarrier b; b.bar = bar; b.x = xb_xcc_id(); b.st = st;
    if (threadIdx.x == 0) (void)xb_add(&bar[XB_XCNT(b.x)], 1u);
    return b;
}
__device__ __forceinline__ void xcd_barrier_complete(unsigned* bar, unsigned x, unsigned& nloc, unsigned& nx) {
    const unsigned G = gridDim.x * gridDim.y * gridDim.z;
    unsigned sum, cnt, mine, sp = 0u;
    for (;;) {
        sum = 0u; cnt = 0u; mine = 0u;
#pragma unroll
        for (unsigned j = 0; j < 16; ++j) { const unsigned c = xb_ld(&bar[XB_XCNT(j)]); sum += c; cnt += (c > 0u) ? 1u : 0u; mine = (j == x) ? c : mine; }
        if (sum == G) break;
        __builtin_amdgcn_s_sleep(1);
        if ((++sp & 255u) == 0u) { if (xb_ld(&bar[XB_TMO])) break; if (sp > XB_SPIN_CAP) { atomicAdd(&bar[XB_TMO], 1u); break; } }
    }
    nloc = mine > 0u ? mine : 1u; nx = cnt > 0u ? cnt : 1u;
}

__device__ __forceinline__ void xcd_barrier(const XcdBarrier& b) {
    asm volatile("s_waitcnt vmcnt(0)" ::: "memory");
    __syncthreads();
    if (threadIdx.x == 0) {
        unsigned* bar = b.bar;
        __builtin_amdgcn_s_waitcnt(0);
        unsigned nloc = b.st[0], nx = b.st[1];
        if (nloc == 0u) { xcd_barrier_complete(bar, b.x, nloc, nx); b.st[0] = nloc; b.st[1] = nx; }
        const unsigned old = xb_add(&bar[XB_XSUB(b.x)], 1u);
        const unsigned gen = old / nloc;
        if (old + 1u == (gen + 1u) * nloc) {
            __builtin_amdgcn_fence(__ATOMIC_RELEASE, "agent");
            asm volatile("s_waitcnt vmcnt(0)" ::: "memory");
            const unsigned og = xb_add(&bar[XB_TOP], 1u);
            const unsigned tg = og / nx;
            if (og + 1u == (tg + 1u) * nx) xb_add(&bar[XB_TOPGEN], 1u);
            else XB_SPIN(xb_ld(&bar[XB_TOPGEN]) == tg, bar);
            __builtin_amdgcn_fence(__ATOMIC_ACQUIRE, "agent");
            xb_add(&bar[XB_XGEN(b.x)], 1u);
            asm volatile("s_waitcnt vmcnt(0)" ::: "memory");
        } else {
            XB_SPIN(xb_ld(&bar[XB_XGEN(b.x)]) == gen, bar);
            __builtin_amdgcn_fence(__ATOMIC_ACQUIRE, "agent");
            asm volatile("s_waitcnt vmcnt(0)" ::: "memory");
        }
    }
    __syncthreads();
}

struct Frame {
    LAS unsigned char* lds;
    volatile LAS unsigned* MISC;
    gu32* ctl;
    int tid, lane, wave, vcu, G;
    const float *x, *w_in, *b_in, *ccw, *ccb, *clg, *clb, *scw, *scbias, *w_out, *b_out, *ln1g, *ln1b, *w_q, *sub_keys, *peer_u, *peer_v, *ln2g, *ln2b;
    float* out;
    bf16 *XB, *BT1, *BT2, *BT3, *AGLU, *CV, *SCB, *MIX, *X1;
    bf16* Y; float* SS; int* IDX; float *STAT, *C12; float *GV, *SU; unsigned char *U8, *V8; float *USC, *VSC;
};

__device__ __forceinline__ int bt1_row(int n0) {
    const int grp = n0 >> 10, c = n0 & 1023, j = c >> 7, r = c & 127;
    if (grp == 0) return 256 * j + r;
    if (grp == 1) return 256 * j + 128 + r;
    if (grp == 2) return 4096 + c;
    if (grp == 3) return 2048 + 256 * j + r;
    return 2048 + 256 * j + 128 + r;
}
template <bool PERM_IN>
__device__ __forceinline__ void p0_transpose_item(const float* W, int K, int N, bf16* WT, LAS float* scr, int item, int lane) {
    const int nblk = N / 32, kb = item / nblk, nb = item % nblk, k0 = 64 * kb, n0 = 32 * nb;
    const int drow = PERM_IN ? bt1_row(n0) : n0;
    float tv[32];
#pragma unroll
    for (int i = 0; i < 32; ++i) { const int kk = 2 * i + (lane >> 5); tv[i] = __builtin_nontemporal_load(W + (size_t)(k0 + kk) * N + n0 + (lane & 31)); }
#pragma unroll
    for (int i = 0; i < 32; ++i) { const int kk = 2 * i + (lane >> 5); scr[kk * 33 + (lane & 31)] = tv[i]; }
    LDS_WAIT(); asm volatile("" ::: "memory");
    const int c = lane & 7;
#pragma unroll
    for (int j = 0; j < 4; ++j) { const int n = (lane >> 3) + 8 * j; const LAS float* s = scr + (8 * c) * 33 + n;
        v4u o; o.x = pk2(s[0 * 33], s[1 * 33]); o.y = pk2(s[2 * 33], s[3 * 33]); o.z = pk2(s[4 * 33], s[5 * 33]); o.w = pk2(s[6 * 33], s[7 * 33]);
        *(GAS v4u*)(WT + (size_t)(drow + n) * K + k0 + 8 * c) = o; }
    LDS_WAIT(); asm volatile("" ::: "memory");
}
__device__ __forceinline__ bf16x8 ld8_bf16(const float* p) {
    typedef float f32x8_t __attribute__((ext_vector_type(8))); typedef __bf16 bf16x8_t __attribute__((ext_vector_type(8)));
    const f32x4 a = *(const f32x4*)p, b = *(const f32x4*)(p + 4);
    f32x8_t v; v[0] = a.x; v[1] = a.y; v[2] = a.z; v[3] = a.w; v[4] = b.x; v[5] = b.y; v[6] = b.z; v[7] = b.w;
    const bf16x8_t h = __builtin_convertvector(v, bf16x8_t);
    return __builtin_bit_cast(bf16x8, h);
}
__device__ __forceinline__ unsigned fp6_encode(float y) {
    const unsigned sb = (__float_as_uint(y) >> 31) << 5;
    const float a = fabsf(y);
    const unsigned sub = (unsigned)__builtin_rintf(a * 8.0f);
    unsigned b = __float_as_uint(a); b += 0x7FFFFu + ((b >> 20) & 1u); b >>= 20;
    unsigned nrm = b - 1008u; nrm = nrm > 31u ? 31u : nrm;
    return sb | (a < 1.0f ? sub : nrm);
}
__device__ __forceinline__ void p0_prologue(Frame& F) {
    LAS float* scr = (LAS float*)(F.lds + RING_OFF + F.wave * 16384);
    const int gw = F.vcu * NWAVES + F.wave, NGW = F.G * NWAVES, lane = F.lane;
#ifndef PROBE_P0SEC
#define PROBE_P0SEC 0
#endif
#define P0T0(k) const unsigned long long t0_##k = (PROBE_P0SEC == (k)) ? __builtin_amdgcn_s_memrealtime() : 0ull
#define P0T1(k) do { if (PROBE_P0SEC == (k)) { const unsigned long long te_ = __builtin_amdgcn_s_memrealtime(); while (__builtin_amdgcn_s_memrealtime() - te_ < te_ - t0_##k) __builtin_amdgcn_s_sleep(8); } } while (0)
    P0T0(1);
    constexpr int I_IN = (D / 64) * (NIN / 32), I_OUT = (D / 64) * (D / 32);
    for (int it = gw; it < I_IN + I_OUT; it += NGW) {
        if (it < I_IN) p0_transpose_item<true>(F.w_in, D, NIN, F.BT1, scr, it, lane);
        else p0_transpose_item<false>(F.w_out, D, D, F.BT2, scr, it - I_IN, lane);
    }
    P0T1(1); P0T0(2);
    for (int it = gw; it < 2048; it += NGW) {
        const int hp = it >> 7, db = (it >> 2) & 31, nq = it & 3, d0 = db * 64;
        const float* wq = F.w_q + (size_t)(d0 + (lane & 15)) * 2048 + hp * 128 + 8 * (lane >> 4);
        bf16x8 xf[4][4];
#pragma unroll
        for (int dt = 0; dt < 4; ++dt)
#pragma unroll
            for (int ks = 0; ks < 4; ++ks) xf[dt][ks] = ld8_bf16(wq + (size_t)dt * 16 * 2048 + 32 * ks);
#pragma unroll
        for (int nb = 2 * nq; nb < 2 * nq + 2; ++nb) {
            const int n0 = nb * 16;
            const float* sk = F.sub_keys + ((size_t)hp * 128 + n0 + (lane & 15)) * 128 + 8 * (lane >> 4);
            bf16x8 yf[4];
#pragma unroll
            for (int ks = 0; ks < 4; ++ks) yf[ks] = ld8_bf16(sk + 32 * ks);
            f32x4 acc[4];
#pragma unroll
            for (int dt = 0; dt < 4; ++dt) { acc[dt] = (f32x4){0.f, 0.f, 0.f, 0.f};
#pragma unroll
                for (int ks = 0; ks < 4; ++ks) acc[dt] = __builtin_amdgcn_mfma_f32_16x16x32_bf16(xf[dt][ks], yf[ks], acc[dt], 0, 0, 0); }
            bf16* orow = F.BT3 + (size_t)(hp * 128 + n0 + (lane & 15)) * 2048 + d0 + 4 * (lane >> 4);
#pragma unroll
            for (int dt = 0; dt < 4; ++dt) { v2u o; o.x = pk2(acc[dt][0], acc[dt][1]); o.y = pk2(acc[dt][2], acc[dt][3]); *(GAS v2u*)(orow + 16 * dt) = o; }
        }
    }
    P0T1(2); P0T0(3);
    for (int i = gw * 64 + lane; i < 2 * S / 4; i += NGW * 64) ((GAS f32x4*)F.STAT)[i] = (f32x4){0.f, 0.f, 0.f, 0.f};
    for (int r = gw; r < S; r += 2 * NGW) {
        const int r2 = r + NGW < S ? r + NGW : r;
        const GAS f32x4* s0 = (const GAS f32x4*)(F.x + (size_t)r * D) + 2 * lane; const GAS f32x4* s1 = (const GAS f32x4*)(F.x + (size_t)r2 * D) + 2 * lane;
        f32x4 v0[8], v1[8];
#pragma unroll
        for (int j = 0; j < 4; ++j) { v0[2 * j] = __builtin_nontemporal_load(s0 + 128 * j); v0[2 * j + 1] = __builtin_nontemporal_load(s0 + 128 * j + 1); v1[2 * j] = __builtin_nontemporal_load(s1 + 128 * j); v1[2 * j + 1] = __builtin_nontemporal_load(s1 + 128 * j + 1); }
        GAS v4u* d0 = (GAS v4u*)(F.XB + (size_t)r * D) + lane; GAS v4u* d1 = (GAS v4u*)(F.XB + (size_t)r2 * D) + lane;
#pragma unroll
        for (int j = 0; j < 4; ++j) { const f32x4 p0 = v0[2 * j], p1 = v0[2 * j + 1], q0 = v1[2 * j], q1 = v1[2 * j + 1];
            v4u o; o.x = pk2(p0.x, p0.y); o.y = pk2(p0.z, p0.w); o.z = pk2(p1.x, p1.y); o.w = pk2(p1.z, p1.w); d0[64 * j] = o;
            v4u o2; o2.x = pk2(q0.x, q0.y); o2.y = pk2(q0.z, q0.w); o2.z = pk2(q1.x, q1.y); o2.w = pk2(q1.z, q1.w); d1[64 * j] = o2; }
    }
    P0T1(3);
}
__device__ __forceinline__ void p0_encode_row(Frame& F, const f32x4 (&v)[8], int r, int lane) {
    const bool isv = r >= NE; const int e = isv ? r - NE : r;
    float am = 0.f;
#pragma unroll
    for (int j = 0; j < 8; ++j) am = fmaxf(am, fmaxf(fmaxf(fabsf(v[j].x), fabsf(v[j].y)), fmaxf(fabsf(v[j].z), fabsf(v[j].w))));
    am = wave_max(am);
    const float sc = am > 0.f ? 7.5f / am : 1.f, inv = am > 0.f ? am / 7.5f : 1.f;
    typedef float f32x16 __attribute__((ext_vector_type(16))); typedef unsigned u32x6v __attribute__((ext_vector_type(6)));
    f32x16 lo16, hi16;
#pragma unroll
    for (int i = 0; i < 16; ++i) {
        lo16[i] = v[(2 * i) >> 2][(2 * i) & 3] * sc; hi16[i] = v[(2 * i + 1) >> 2][(2 * i + 1) & 3] * sc;
    }
    const u32x6v pk = __builtin_amdgcn_cvt_scalef32_2xpk16_fp6_f32(lo16, hi16, 1.0f);
    unsigned w[6];
#pragma unroll
    for (int i = 0; i < 6; ++i) w[i] = pk[i];
    unsigned char* dst = (isv ? F.V8 : F.U8) + (size_t)e * ROWB;
    __builtin_nontemporal_store((v4u){w[0], w[1], w[2], w[3]}, (GAS v4u*)(dst + 16 * lane)); __builtin_nontemporal_store((v2u){w[4], w[5]}, (GAS v2u*)(dst + 1024 + 8 * lane));
    if (lane == 0) (isv ? F.VSC : F.USC)[e] = inv;
}
__device__ __forceinline__ void p0_load_row(Frame& F, f32x4 (&v)[8], int r, int lane) {
    const int rc = r < 2 * NE ? r : 2 * NE - 1;
    const GAS f32x4* src = (const GAS f32x4*)((rc >= NE ? F.peer_v : F.peer_u) + (size_t)(rc >= NE ? rc - NE : rc) * D) + lane;
#pragma unroll
    for (int j = 0; j < 8; ++j) v[j] = __builtin_nontemporal_load(src + 64 * j);
}
__device__ __forceinline__ void p0_peer_tables(Frame& F, int wid, int nw) {
    const int lane = F.lane;
    f32x4 na[8], nb[8], ma[8], mb[8];
    p0_load_row(F, na, wid, lane); p0_load_row(F, nb, wid + nw, lane); p0_load_row(F, ma, wid + 2 * nw, lane); p0_load_row(F, mb, wid + 3 * nw, lane);
#pragma unroll 1
    for (int r = wid; r < 2 * NE; r += 4 * nw) {
        p0_encode_row(F, na, r, lane); p0_load_row(F, na, r + 4 * nw, lane);
        if (r + nw < 2 * NE) p0_encode_row(F, nb, r + nw, lane);
        p0_load_row(F, nb, r + 5 * nw, lane);
        if (r + 2 * nw < 2 * NE) p0_encode_row(F, ma, r + 2 * nw, lane);
        p0_load_row(F, ma, r + 6 * nw, lane);
        if (r + 3 * nw < 2 * NE) p0_encode_row(F, mb, r + 3 * nw, lane);
        p0_load_row(F, mb, r + 7 * nw, lane);
    }
}

__device__ __forceinline__ float dpp_add(float v, int ctrl_sel) {
    int m;
    if (ctrl_sel == 0) m = __builtin_amdgcn_update_dpp(0, __float_as_int(v), 0x111, 0xf, 0xf, false);
    else if (ctrl_sel == 1) m = __builtin_amdgcn_update_dpp(0, __float_as_int(v), 0x112, 0xf, 0xf, false);
    else if (ctrl_sel == 2) m = __builtin_amdgcn_update_dpp(0, __float_as_int(v), 0x114, 0xf, 0xf, false);
    else if (ctrl_sel == 3) m = __builtin_amdgcn_update_dpp(0, __float_as_int(v), 0x118, 0xf, 0xf, false);
    else if (ctrl_sel == 4) m = __builtin_amdgcn_update_dpp(0, __float_as_int(v), 0x142, 0xa, 0xf, false);
    else m = __builtin_amdgcn_update_dpp(0, __float_as_int(v), 0x143, 0xc, 0xf, false);
    return v + __int_as_float(m);
}
__device__ __forceinline__ float wave_sum_lane63(float v) {
    v = dpp_add(v, 0); v = dpp_add(v, 1); v = dpp_add(v, 2); v = dpp_add(v, 3); v = dpp_add(v, 4); v = dpp_add(v, 5); return v;
}
__device__ __forceinline__ void p2_unit(Frame& F, int unit) {
    const int t0 = unit * 32, tid_in = F.tid, lane = F.lane;
    LAS unsigned char* abuf = F.lds + RING_OFF;
    LAS float* stat = (LAS float*)(F.lds + LNP_OFF);
    {
        int tid = tid_in; asm volatile("" : "+v"(tid));
#pragma unroll
        for (int h = 0; h < 2; ++h) {
            v4u st[8];
#pragma unroll
            for (int k = 8 * h; k < 8 * h + 8; ++k) { const int c = tid + 512 * k; int cc = c < 62 * 128 ? c : 62 * 128 - 1; cc = (t0 - 30) * 128 + cc < 0 ? (30 - t0) * 128 : cc;
                st[k - 8 * h] = __builtin_nontemporal_load((const GAS v4u*)F.AGLU + (size_t)((t0 - 30) * 128 + cc)); }
#pragma unroll
            for (int k = 8 * h; k < 8 * h + 8; ++k) { const int c = tid + 512 * k; const bool ok = (t0 - 30) * 128 + c >= 0;
                const v4u v = ok ? st[k - 8 * h] : (v4u){0u, 0u, 0u, 0u};
                if (k < 15 || tid < 62 * 128 - 512 * 15) *(LAS v4u*)(abuf + 16 * c) = v; }
            asm volatile("" ::: "memory");
        }
    }
    asm volatile("" ::: "memory"); __builtin_amdgcn_sched_barrier(0);
    {
        int tid = tid_in; asm volatile("" : "+v"(tid));
        const int cg = tid & 127, tg = tid >> 7, tb = t0 + 8 * tg;
        float w0[8], w1[8], w2[8], bs[8];
#pragma unroll
        for (int h = 0; h < 2; ++h) { const f32x4 a = *(const GAS f32x4*)(F.scw + 8 * cg + 4 * h), b = *(const GAS f32x4*)(F.scw + 1024 + 8 * cg + 4 * h), c = *(const GAS f32x4*)(F.scw + 2048 + 8 * cg + 4 * h), d = *(const GAS f32x4*)(F.scbias + 8 * cg + 4 * h);
#pragma unroll
            for (int q = 0; q < 4; ++q) { w0[4 * h + q] = a[q]; w1[4 * h + q] = b[q]; w2[4 * h + q] = c[q]; bs[4 * h + q] = d[q]; } }
        v4u cvr[10], gtr[8];
#pragma unroll
        for (int i = 0; i < 10; ++i) { const int t = tb - 2 + i, tc = t < 0 ? 0 : t; const v4u v = __builtin_nontemporal_load((const GAS v4u*)(F.CV + (size_t)tc * 1024 + 8 * cg)); cvr[i] = t < 0 ? (v4u){0u, 0u, 0u, 0u} : v; }
#pragma unroll
        for (int i = 0; i < 4; ++i) gtr[i] = __builtin_nontemporal_load((const GAS v4u*)(F.SCB + (size_t)(tb + i) * 1024 + 8 * cg));
#pragma unroll
        for (int tt = 0; tt < 8; ++tt) {
            if (tt == 3) {
#pragma unroll
                for (int i = 4; i < 8; ++i) gtr[i] = __builtin_nontemporal_load((const GAS v4u*)(F.SCB + (size_t)(tb + i) * 1024 + 8 * cg)); }
            v4u o;
#pragma unroll
            for (int q = 0; q < 4; ++q) {
                const unsigned a2 = cvr[tt][q], a1 = cvr[tt + 1][q], a0 = cvr[tt + 2][q], g = gtr[tt][q];
                const float lo = bf_lo(g) * (bs[2 * q] + w0[2 * q] * bf_lo(a2) + w1[2 * q] * bf_lo(a1) + w2[2 * q] * bf_lo(a0));
                const float hi = bf_hi(g) * (bs[2 * q + 1] + w0[2 * q + 1] * bf_hi(a2) + w1[2 * q + 1] * bf_hi(a1) + w2[2 * q + 1] * bf_hi(a0));
                o[q] = pk2(lo, hi);
            }
            *(GAS v4u*)(F.MIX + (size_t)(tb + tt) * 2048 + 1024 + 8 * cg) = o;
        }
    }
    asm volatile("" ::: "memory"); __builtin_amdgcn_sched_barrier(0);
    LDS_WAIT(); __syncthreads();
    {
        int tid = tid_in; asm volatile("" : "+v"(tid)); const int c0 = 2 * tid;
        f32x2 w[31];
#pragma unroll
        for (int k = 0; k < 31; ++k) w[k] = *(const GAS f32x2*)(F.ccw + k * 1024 + c0);
        const f32x2 bias = *(const GAS f32x2*)(F.ccb + c0), lng = *(const GAS f32x2*)(F.clg + c0), lnb = *(const GAS f32x2*)(F.clb + c0);
#pragma unroll 1
        for (int g = 0; g < 4; ++g) {
            f32x2 o[8];
#pragma unroll
            for (int tt = 0; tt < 8; ++tt) o[tt] = bias;
#pragma unroll
            for (int half = 0; half < 2; ++half) {
                constexpr int NR = 23; const int r0 = half ? 16 : 0, k0 = half ? 16 : 0, nk = half ? 15 : 16;
                f32x2 in[NR];
#pragma unroll
                for (int i = 0; i < NR; ++i) { const int row = r0 + i < 38 ? r0 + i : 37; const unsigned raw = *(const LAS unsigned*)(abuf + (8 * g + row) * 2048 + 4 * tid); in[i] = (f32x2){bf_lo(raw), bf_hi(raw)}; }
#pragma unroll
                for (int tt = 0; tt < 8; ++tt)
#pragma unroll
                    for (int k = 0; k < 16; ++k) if (k < nk) o[tt] += w[k0 + k] * in[tt + k + k0 - r0];
                asm volatile("" ::: "memory");
            }
            {
                float a[16];
#pragma unroll
                for (int tt = 0; tt < 8; ++tt) { a[2 * tt] = o[tt].x + o[tt].y; a[2 * tt + 1] = o[tt].x * o[tt].x + o[tt].y * o[tt].y; }
                float b[8];
#pragma unroll
                for (int i = 0; i < 8; ++i) { const v2u sw = __builtin_amdgcn_permlane32_swap(__float_as_uint(a[2 * i]), __float_as_uint(a[2 * i + 1]), false, false); b[i] = __uint_as_float(sw.x) + __uint_as_float(sw.y); }
                float t[4];
#pragma unroll
                for (int i = 0; i < 4; ++i) { const v2u sw = __builtin_amdgcn_permlane16_swap(__float_as_uint(b[2 * i]), __float_as_uint(b[2 * i + 1]), false, false); t[i] = __uint_as_float(sw.x) + __uint_as_float(sw.y); }
#pragma unroll
                for (int i = 0; i < 4; ++i) { t[i] = dpp_add(t[i], 0); t[i] = dpp_add(t[i], 1); t[i] = dpp_add(t[i], 2); t[i] = dpp_add(t[i], 3); }
                if ((lane & 15) == 15) { const int hi = lane >> 5, od = (lane >> 4) & 1;
#pragma unroll
                    for (int i = 0; i < 4; ++i) stat[(2 * (2 * i + od) + hi) * 8 + F.wave] = t[i]; }
            }
            LDS_WAIT(); __syncthreads();
            float tot;
            { const f32x4 a0 = *(const LAS f32x4*)(stat + (lane & 15) * 8), a1 = *(const LAS f32x4*)(stat + (lane & 15) * 8 + 4); tot = ((a0.x + a0.y) + (a0.z + a0.w)) + ((a1.x + a1.y) + (a1.z + a1.w)); }
#pragma unroll
            for (int tt = 0; tt < 8; ++tt) {
                const float mean = __int_as_float(__builtin_amdgcn_readlane(__float_as_int(tot), 2 * tt)) * (1.f / 1024.f);
                const float ex2 = __int_as_float(__builtin_amdgcn_readlane(__float_as_int(tot), 2 * tt + 1)) * (1.f / 1024.f);
                const float rstd = 1.f / sqrtf(fmaxf(ex2 - mean * mean, 0.f) + LN_EPS);
                f32x2 y = (o[tt] - mean) * rstd * lng + lnb;
                y.x *= pg8::sigmoidf_fast(y.x); y.y *= pg8::sigmoidf_fast(y.y);
                *(GAS unsigned*)(F.MIX + (size_t)(t0 + 8 * g + tt) * 2048 + c0) = pk2(y.x, y.y);
            }
            __syncthreads();
        }
    }
}

__device__ __forceinline__ void p1_c12(Frame& F) {
    const int gw = F.vcu * NWAVES + F.wave, NGW = F.G * NWAVES, lane = F.lane;
    for (int n = gw; n < 2048; n += NGW) {
        const GAS v4u* wr = (const GAS v4u*)(F.BT3 + (size_t)n * D) + lane;
        float a = 0.f, b = 0.f;
#pragma unroll
        for (int j = 0; j < 4; ++j) { const v4u w = wr[64 * j]; const int d0 = 8 * lane + 512 * j;
            const f32x4 g0 = *(const GAS f32x4*)(F.ln1g + d0), g1 = *(const GAS f32x4*)(F.ln1g + d0 + 4), b0 = *(const GAS f32x4*)(F.ln1b + d0), b1 = *(const GAS f32x4*)(F.ln1b + d0 + 4);
            a += g0.x * bf_lo(w.x) + g0.y * bf_hi(w.x) + g0.z * bf_lo(w.y) + g0.w * bf_hi(w.y) + g1.x * bf_lo(w.z) + g1.y * bf_hi(w.z) + g1.z * bf_lo(w.w) + g1.w * bf_hi(w.w);
            b += b0.x * bf_lo(w.x) + b0.y * bf_hi(w.x) + b0.z * bf_lo(w.y) + b0.w * bf_hi(w.y) + b1.x * bf_lo(w.z) + b1.y * bf_hi(w.z) + b1.z * bf_lo(w.w) + b1.w * bf_hi(w.w); }
        a = wave_sum(a); b = wave_sum(b);
        if (lane == 0) { F.C12[n] = a; F.C12[2048 + n] = b; }
    }
}

__device__ __forceinline__ int imax_(int a, int b) { return a > b ? a : b; }
__device__ __forceinline__ int imin_(int a, int b) { return a < b ? a : b; }
template <bool DESC> __device__ __forceinline__ void ce_i(int& a, int& b) { const int mx = imax_(a, b), mn = imin_(a, b); a = DESC ? mx : mn; b = DESC ? mn : mx; }
template <bool DESC> __device__ __forceinline__ void sort16_i(int (&v)[16]) {
#pragma unroll
    for (int k = 2; k <= 16; k <<= 1)
#pragma unroll
        for (int j = k >> 1; j > 0; j >>= 1)
#pragma unroll
            for (int i = 0; i < 16; ++i) { const int l = i ^ j; if (l > i) { const bool up = ((i & k) == 0); if (up != DESC) ce_i<false>(v[i], v[l]); else ce_i<true>(v[i], v[l]); } }
}
template <bool DESC> __device__ __forceinline__ void merge16_i(int (&v)[16]) {
#pragma unroll
    for (int j = 8; j > 0; j >>= 1)
#pragma unroll
        for (int i = 0; i < 16; ++i) { const int l = i ^ j; if (l > i) ce_i<DESC>(v[i], v[l]); }
}
template <bool DESC> __device__ __forceinline__ void ce_p(float& a, int& pa, float& b, int& pb) {
    const bool sw = DESC ? (a < b) : (a > b); const float ta = sw ? b : a, tb = sw ? a : b; const int qa = sw ? pb : pa, qb = sw ? pa : pb; a = ta; b = tb; pa = qa; pb = qb; }
template <bool DESC> __device__ __forceinline__ void sort16_p(float (&v)[16], int (&p)[16]) {
#pragma unroll
    for (int k = 2; k <= 16; k <<= 1)
#pragma unroll
        for (int j = k >> 1; j > 0; j >>= 1)
#pragma unroll
            for (int i = 0; i < 16; ++i) { const int l = i ^ j; if (l > i) { const bool up = ((i & k) == 0); if (up != DESC) ce_p<false>(v[i], p[i], v[l], p[l]); else ce_p<true>(v[i], p[i], v[l], p[l]); } }
}
template <bool DESC> __device__ __forceinline__ void merge16_p(float (&v)[16], int (&p)[16]) {
#pragma unroll
    for (int j = 8; j > 0; j >>= 1)
#pragma unroll
        for (int i = 0; i < 16; ++i) { const int l = i ^ j; if (l > i) ce_p<DESC>(v[i], p[i], v[l], p[l]); }
}
__device__ __forceinline__ int f2key(float f) { const int b = __float_as_int(f); return b ^ ((b >> 31) & 0x7fffffff); }
__device__ __forceinline__ float key2f(int k) { return __int_as_float(k ^ ((k >> 31) & 0x7fffffff)); }

__device__ __forceinline__ void topk_chunk(int (&top)[16], const f32x4 (&r)[4], int c, bool first) {
    int nw[16];
#pragma unroll
    for (int q = 0; q < 4; ++q)
#pragma unroll
        for (int e = 0; e < 4; ++e) nw[4 * q + e] = (f2key(r[q][e]) & ~127) | (16 * c + 4 * q + e);
    if (first) { sort16_i<true>(nw);
#pragma unroll
        for (int i = 0; i < 16; ++i) top[i] = nw[i];
    } else { sort16_i<false>(nw);
#pragma unroll
        for (int i = 0; i < 16; ++i) top[i] = imax_(top[i], nw[i]);
        merge16_i<true>(top); }
}
__device__ __forceinline__ void topk_stage2(const int (&ka)[16], const int (&kb)[16], bool odd, int (&oe)[8], float (&og)[8]) {
    float Av[16], Bv[16]; int Ai[16], Bi[16];
#pragma unroll
    for (int i = 0; i < 16; ++i) { Av[i] = key2f(ka[i] & ~127); Ai[i] = ka[i] & 127; Bv[i] = key2f(kb[i] & ~127); Bi[i] = kb[i] & 127; }
    float tv[16]; int tp[16];
#pragma unroll
    for (int j = 0; j < 16; ++j) { tv[j] = Av[0] + Bv[j]; tp[j] = Ai[0] * 128 + Bi[j]; }
    {
        float nv[16]; int np[16];
#pragma unroll
        for (int j = 0; j < 8; ++j) { nv[j] = Av[1] + Bv[j]; np[j] = Ai[1] * 128 + Bi[j]; }
#pragma unroll
        for (int j = 0; j < 5; ++j) { nv[8 + j] = Av[2] + Bv[j]; np[8 + j] = Ai[2] * 128 + Bi[j]; }
#pragma unroll
        for (int j = 0; j < 3; ++j) { nv[13 + j] = Av[3] + Bv[j]; np[13 + j] = Ai[3] * 128 + Bi[j]; }
        sort16_p<false>(nv, np);
#pragma unroll
        for (int i = 0; i < 16; ++i) { const bool g = nv[i] > tv[i]; tv[i] = g ? nv[i] : tv[i]; tp[i] = g ? np[i] : tp[i]; }
        merge16_p<true>(tv, tp);
    }
    {
        float nv[16]; int np[16];
        nv[0] = Av[3] + Bv[3]; np[0] = Ai[3] * 128 + Bi[3];
#pragma unroll
        for (int j = 0; j < 3; ++j) { nv[1 + j] = Av[4] + Bv[j]; np[1 + j] = Ai[4] * 128 + Bi[j]; }
#pragma unroll
        for (int i = 5; i < 8; ++i)
#pragma unroll
            for (int j = 0; j < 2; ++j) { nv[4 + 2 * (i - 5) + j] = Av[i] + Bv[j]; np[4 + 2 * (i - 5) + j] = Ai[i] * 128 + Bi[j]; }
#pragma unroll
        for (int i = 8; i < 14; ++i) { nv[10 + i - 8] = Av[i] + Bv[0]; np[10 + i - 8] = Ai[i] * 128 + Bi[0]; }
        sort16_p<false>(nv, np);
#pragma unroll
        for (int i = 0; i < 16; ++i) { const bool g = nv[i] > tv[i]; tv[i] = g ? nv[i] : tv[i]; tp[i] = g ? np[i] : tp[i]; }
        merge16_p<true>(tv, tp);
    }
    {
        const float hi = Av[14] + Bv[0], lo = Av[15] + Bv[0]; const int phi = Ai[14] * 128 + Bi[0], plo = Ai[15] * 128 + Bi[0];
        const float t14 = tv[14], t15 = tv[15]; const int q14 = tp[14], q15 = tp[15];
        const bool g14 = lo > t14, g15 = hi > t15;
        tv[14] = g14 ? lo : t14; tp[14] = g14 ? plo : q14; tv[15] = g15 ? hi : t15; tp[15] = g15 ? phi : q15;
    }
    float mx = tv[0];
#pragma unroll
    for (int i = 1; i < 16; ++i) mx = fmaxf(mx, tv[i]);
    float sum = 0.f;
#pragma unroll
    for (int i = 0; i < 16; ++i) { tv[i] = __expf(tv[i] - mx); sum += tv[i]; }
    const float rs = 1.f / sum;
#pragma unroll
    for (int k = 0; k < 8; ++k) { const int pa = tp[k], pb = tp[8 + k]; const float va = tv[k], vb = tv[8 + k]; oe[k] = odd ? pb : pa; og[k] = (odd ? vb : va) * rs; }
}
struct EpiScoreTopk {
    static constexpr bool PERM = false, AFTER_DRAIN = true;
    const float* stat; const float* c12; float eps; int* IDX; float* GV; float* SU; const float* USC; const float* VSC;
    __device__ __forceinline__ void fused(f32x4 (&acc)[2][2][4][2], const pg8::Unit& u, int wr, int wc, int fr, int fq, LAS unsigned char* lds, int wid, int lane) const {
        {
            const int row0 = u.pm * 256 + wr * 64 + fr, col0 = u.pn * 256 + wc * 32 + 4 * fq;
            f32x4 c1v[2][2], c2v[2][2];
#pragma unroll
            for (int bj = 0; bj < 2; ++bj)
#pragma unroll
                for (int n = 0; n < 2; ++n) { c1v[bj][n] = *(const f32x4*)(c12 + col0 + bj * 128 + n * 16); c2v[bj][n] = *(const f32x4*)(c12 + 2048 + col0 + bj * 128 + n * 16); }
#pragma unroll
            for (int ai = 0; ai < 2; ++ai)
#pragma unroll
                for (int m = 0; m < 4; ++m) { const int row = row0 + ai * 128 + m * 16;
                    const float s1 = stat[2 * row], s2 = stat[2 * row + 1];
                    const float mean = s1 * (1.0f / 2048.0f), var = fmaxf(s2 * (1.0f / 2048.0f) - mean * mean, 0.f), rstd = 1.0f / sqrtf(var + eps);
#pragma unroll
                    for (int bj = 0; bj < 2; ++bj)
#pragma unroll
                        for (int n = 0; n < 2; ++n) acc[ai][bj][m][n] = (acc[ai][bj][m][n] - c1v[bj][n] * mean) * rstd + c2v[bj][n]; }
        }
        const int tid = wid * 64 + lane, prow = tid & 255, phalf = tid >> 8;
        int tA[16], tB[16];
#pragma unroll
        for (int bj = 0; bj < 2; ++bj) {
#pragma unroll
            for (int ai = 0; ai < 2; ++ai)
#pragma unroll
                for (int m = 0; m < 4; ++m)
#pragma unroll
                    for (int n = 0; n < 2; ++n) { const int r = ai * 128 + wr * 64 + m * 16 + fr, c = wc * 32 + n * 16 + 4 * fq;
                        *(LAS f32x4*)(lds + (r * 128 + (c ^ ((r & 31) << 2))) * 4) = acc[ai][bj][m][n]; }
            LDS_WAIT(); __syncthreads();
#pragma unroll
            for (int c = 0; c < 4; ++c) { f32x4 rr[4];
#pragma unroll
                for (int q = 0; q < 4; ++q) rr[q] = *(const LAS f32x4*)(lds + (prow * 128 + ((64 * phalf + 16 * c + 4 * q) ^ ((prow & 31) << 2))) * 4);
                if (bj == 0) topk_chunk(tA, rr, 4 * phalf + c, c == 0); else topk_chunk(tB, rr, 4 * phalf + c, c == 0); }
            __syncthreads();
        }
        LAS int* xk = (LAS int*)lds;
        int top[16], oth[16];
#pragma unroll
        for (int i = 0; i < 16; ++i) { const int a = tA[i], b = tB[i]; top[i] = phalf ? b : a; oth[i] = phalf ? a : b; }
#pragma unroll
        for (int i = 0; i < 16; i += 4) *(LAS v4u*)(xk + tid * 16 + i) = (v4u){(unsigned)oth[i], (unsigned)oth[i + 1], (unsigned)oth[i + 2], (unsigned)oth[i + 3]};
        LDS_WAIT(); __syncthreads();
#pragma unroll
        for (int i = 0; i < 16; i += 4) { const v4u w = *(const LAS v4u*)(xk + (tid ^ 256) * 16 + i); oth[i] = (int)w.x; oth[i + 1] = (int)w.y; oth[i + 2] = (int)w.z; oth[i + 3] = (int)w.w; }
#pragma unroll
        for (int i = 0; i < 16; ++i) top[i] = imax_(top[i], oth[15 - i]);
        merge16_i<true>(top);
        __syncthreads();
#pragma unroll
        for (int i = 0; i < 16; i += 4) *(LAS v4u*)(xk + tid * 16 + i) = (v4u){(unsigned)top[i], (unsigned)top[i + 1], (unsigned)top[i + 2], (unsigned)top[i + 3]};
        LDS_WAIT(); __syncthreads();
#pragma unroll
        for (int i = 0; i < 16; i += 4) { const v4u w = *(const LAS v4u*)(xk + (tid ^ 256) * 16 + i); oth[i] = (int)w.x; oth[i + 1] = (int)w.y; oth[i + 2] = (int)w.z; oth[i + 3] = (int)w.w; }
        const bool odd = phalf != 0;
        int ka[16], kb[16];
#pragma unroll
        for (int i = 0; i < 16; ++i) { const int mine = top[i], other = oth[i]; ka[i] = odd ? other : mine; kb[i] = odd ? mine : other; }
        int oe[8]; float og[8];
        topk_stage2(ka, kb, odd, oe, og);
        float ov[8], ou[8];
#pragma unroll
        for (int k = 0; k < 8; ++k) { ov[k] = og[k] * VSC[oe[k]]; ou[k] = USC[oe[k]]; }
        const size_t ob = (size_t)(u.pm * 256 + prow) * NPAIR + (2 * u.pn + phalf) * 8;
        *(GAS v4u*)(IDX + ob) = (v4u){(unsigned)oe[0], (unsigned)oe[1], (unsigned)oe[2], (unsigned)oe[3]};
        *(GAS v4u*)(IDX + ob + 4) = (v4u){(unsigned)oe[4], (unsigned)oe[5], (unsigned)oe[6], (unsigned)oe[7]};
        *(GAS f32x4*)(GV + ob) = (f32x4){ov[0], ov[1], ov[2], ov[3]};
        *(GAS f32x4*)(GV + ob + 4) = (f32x4){ov[4], ov[5], ov[6], ov[7]};
        *(GAS f32x4*)(SU + ob) = (f32x4){ou[0], ou[1], ou[2], ou[3]};
        *(GAS f32x4*)(SU + ob + 4) = (f32x4){ou[4], ou[5], ou[6], ou[7]};
    }
};

constexpr int NPF = 8;
constexpr int TAB_V_OFS = (int)(WS_V8 - WS_U8);
typedef unsigned u32x6 __attribute__((ext_vector_type(6)));
typedef float f32x32 __attribute__((ext_vector_type(32)));
typedef __bf16 bf16x32 __attribute__((ext_vector_type(32)));
typedef __bf16 bf16x2 __attribute__((ext_vector_type(2)));
__device__ __forceinline__ float gelu_erf(float z) { return 0.5f * z * (1.0f + erff(z * 0.70710678118654752f)); }
__device__ __forceinline__ void p7_sort512(int (&key)[8], int lane) {
#pragma unroll
    for (int k = 2; k <= 512; k <<= 1) {
#pragma unroll
        for (int j = k >> 1; j > 0; j >>= 1) {
            if (j >= 64) {
                const int jr = j >> 6;
#pragma unroll
                for (int r = 0; r < 8; ++r) if ((r & jr) == 0) { const int rp = r | jr; const bool asc = ((64 * r) & k) == 0;
                    const int a = key[r], b = key[rp], mn = imin_(a, b), mx = imax_(a, b); key[r] = asc ? mn : mx; key[rp] = asc ? mx : mn; }
            } else {
#pragma unroll
                for (int r = 0; r < 8; ++r) { const int mine = key[r], o = __builtin_amdgcn_ds_bpermute((lane ^ j) << 2, mine); const bool low = (lane & j) == 0, asc = ((64 * r + lane) & k) == 0;
                    key[r] = (low == asc) ? imin_(mine, o) : imax_(mine, o); }
            }
        }
    }
}
__device__ __forceinline__ int mbcnt64(unsigned long long m) { return (int)__builtin_amdgcn_mbcnt_hi((unsigned)(m >> 32), __builtin_amdgcn_mbcnt_lo((unsigned)m, 0u)); }
__device__ __forceinline__ int p7_group_by_slot(int kv) {
    const int s = (kv >> 7) & 3;
    const unsigned long long m0 = __ballot(s == 0), m1 = __ballot(s == 1), m2 = __ballot(s == 2), m3 = __ballot(s == 3);
    const int c0 = __popcll(m0), c1 = __popcll(m1), c2 = __popcll(m2);
    const int p0 = mbcnt64(m0), p1 = c0 + mbcnt64(m1), p2 = c0 + c1 + mbcnt64(m2), p3 = c0 + c1 + c2 + mbcnt64(m3);
    const int pos = s == 0 ? p0 : s == 1 ? p1 : s == 2 ? p2 : p3;
    return __builtin_amdgcn_ds_permute(pos << 2, kv);
}
__device__ __forceinline__ int sel8i(const int (&a)[8], int r) {
    const int a0 = a[0], a1 = a[1], a2 = a[2], a3 = a[3], a4 = a[4], a5 = a[5], a6 = a[6], a7 = a[7];
    int v = a0; v = r == 1 ? a1 : v; v = r == 2 ? a2 : v; v = r == 3 ? a3 : v; v = r == 4 ? a4 : v; v = r == 5 ? a5 : v; v = r == 6 ? a6 : v; v = r == 7 ? a7 : v; return v;
}
__device__ __forceinline__ float sel8f(const float (&a)[8], int r) {
    const float a0 = a[0], a1 = a[1], a2 = a[2], a3 = a[3], a4 = a[4], a5 = a[5], a6 = a[6], a7 = a[7];
    float v = a0; v = r == 1 ? a1 : v; v = r == 2 ? a2 : v; v = r == 3 ? a3 : v; v = r == 4 ? a4 : v; v = r == 5 ? a5 : v; v = r == 6 ? a6 : v; v = r == 7 ? a7 : v; return v;
}
typedef u32x6 P7Row;
__device__ __forceinline__ void p7_ld(P7Row& R, __amdgpu_buffer_rsrc_t rs, int soff, int v16, int v8) {
    const v4u a = __builtin_bit_cast(v4u, __builtin_amdgcn_raw_buffer_load_b128(rs, v16, soff, 0));
    const v2u b = __builtin_bit_cast(v2u, __builtin_amdgcn_raw_buffer_load_b64(rs, v8, soff, 0));
    u32x6 r; r[0] = a.x; r[1] = a.y; r[2] = a.z; r[3] = a.w; r[4] = b.x; r[5] = b.y; R = r;
}
__device__ __forceinline__ u32x6 p7_row6(const P7Row& R) { return R; }
__device__ __forceinline__ float p7_dot(const unsigned (&xp)[16], const bf16x32& uf) {
    float s0 = 0.f, s1 = 0.f;
#pragma unroll
    for (int m = 0; m < 16; m += 2) {
        bf16x2 a; a[0] = uf[2 * m]; a[1] = uf[2 * m + 1]; bf16x2 b; b[0] = uf[2 * m + 2]; b[1] = uf[2 * m + 3];
        const unsigned xa = xp[m], xb = xp[m + 1];
        s0 = __builtin_amdgcn_fdot2_f32_bf16(__builtin_bit_cast(bf16x2, xa), a, s0, false);
        s1 = __builtin_amdgcn_fdot2_f32_bf16(__builtin_bit_cast(bf16x2, xb), b, s1, false); }
    return s0 + s1;
}
__device__ __forceinline__ void p7_axpy(float (&acc)[32], float ck, const f32x32& vf) {
#pragma unroll
    for (int r = 0; r < 32; ++r) acc[r] = fmaf(ck, vf[r], acc[r]);
}
#define P7_LAUNDER4(S_) int t0_ = S_, t1_ = S_, t2_ = S_, t3_ = S_; asm volatile("" : "+s"(t0_)); asm volatile("" : "+s"(t1_)); asm volatile("" : "+s"(t2_)); asm volatile("" : "+s"(t3_))
__device__ __forceinline__ float p7_dot_sel(const unsigned (&xp0)[16], const unsigned (&xp1)[16], const unsigned (&xp2)[16], const unsigned (&xp3)[16], const bf16x32& uf, int s) {
    P7_LAUNDER4(s);
    float d = 0.f;
    if (t0_ == 0) d = p7_dot(xp0, uf);
    if (t1_ == 1) d = p7_dot(xp1, uf);
    if (t2_ == 2) d = p7_dot(xp2, uf);
    if (t3_ == 3) d = p7_dot(xp3, uf);
    return d;
}
#define P7_USTEP(RA_, RB_, K_, K1_) { \
    float da, db; \
    { const bf16x32 ua = __builtin_amdgcn_cvt_scalef32_pk32_bf16_fp6(p7_row6(RA_), 1.0f); \
      __builtin_amdgcn_sched_barrier(0); \
      p7_ld(RA_, tab, so##K_, v16, v8); \
      da = p7_dot_sel(xp0, xp1, xp2, xp3, ua, __builtin_amdgcn_readlane(slv, j + K_)); } \
    __builtin_amdgcn_sched_barrier(0); \
    { const bf16x32 ub = __builtin_amdgcn_cvt_scalef32_pk32_bf16_fp6(p7_row6(RB_), 1.0f); \
      __builtin_amdgcn_sched_barrier(0); \
      p7_ld(RB_, tab, so##K1_, v16, v8); \
      db = p7_dot_sel(xp0, xp1, xp2, xp3, ub, __builtin_amdgcn_readlane(slv, j + K_ + 1)); } \
    const v2u sw = __builtin_amdgcn_permlane32_swap(__float_as_uint(da), __float_as_uint(db), false, false); \
    float t = __uint_as_float(sw.x) + __uint_as_float(sw.y);         \
    t = dpp_add(t, 0); t = dpp_add(t, 1); t = dpp_add(t, 2); t = dpp_add(t, 3); t = dpp_add(t, 4);     \
    const int za = __builtin_amdgcn_readlane(__float_as_int(t), 31), zb = __builtin_amdgcn_readlane(__float_as_int(t), 63); \
    zreg = lane == j + K_ ? za : zreg; zreg = lane == j + K_ + 1 ? zb : zreg; \
    __builtin_amdgcn_sched_barrier(0); }
#define P7_VSTEP(RA_, K_) { \
    const f32x32 va = __builtin_amdgcn_cvt_scalef32_pk32_f32_fp6(p7_row6(RA_), 1.0f); \
    __builtin_amdgcn_sched_barrier(0); \
    p7_ld(RA_, tab, so##K_, v16, v8); \
    const float ck = __int_as_float(__builtin_amdgcn_readlane(ccur, j + K_)); const int sv_ = __builtin_amdgcn_readlane(slv, j + K_); \
    { P7_LAUNDER4(sv_); \
      if (t0_ == 0) p7_axpy(acc0, ck, va); \
      if (t1_ == 1) p7_axpy(acc1, ck, va); \
      if (t2_ == 2) p7_axpy(acc2, ck, va); \
      if (t3_ == 3) p7_axpy(acc3, ck, va); } \
    __builtin_amdgcn_sched_barrier(0); }
template <class BarT>
__device__ __forceinline__ void p7_peer(Frame& F, const BarT& gbar) {
    const int gw = F.vcu * NWAVES + F.wave, NGW = F.G * NWAVES, lane_in = F.lane;
    LAS f32x4* lg = (LAS f32x4*)(F.lds + LN2G_OFF); LAS f32x4* lb = (LAS f32x4*)(F.lds + LNP_OFF);
    LAS f32x4* l1g = lb + 512; LAS f32x4* l1b = l1g + 512;
    static_assert(LNP_OFF + 3 * 8192 <= LDS_BYTES && LN2G_OFF + 8192 <= LDSCTL_OFF, "LDS map of the PEER phase");
    for (int i = F.tid; i < 512; i += NWAVES * 64) { lg[i] = ((const GAS f32x4*)F.ln2g)[i]; lb[i] = ((const GAS f32x4*)F.ln2b)[i]; l1g[i] = ((const GAS f32x4*)F.ln1g)[i]; l1b[i] = ((const GAS f32x4*)F.ln1b)[i]; }
    LDS_WAIT(); __syncthreads();
    const __amdgpu_buffer_rsrc_t tab = __builtin_amdgcn_make_buffer_rsrc((void*)F.U8, 0, TAB_V_OFS + NE * ROWB, 0x00020000);
#pragma unroll 1
    for (int tg = gw; tg < S / 4; tg += NGW) {
        const int tb = 4 * tg;
        int lane = lane_in; asm volatile("" : "+v"(lane));
        const int v16 = 16 * lane, v8 = 1024 + 8 * lane;
        v2u yraw[4][8]; float st1[4], st2[4];
#pragma unroll
        for (int s = 0; s < 4; ++s) { st1[s] = F.STAT[2 * (tb + s)]; st2[s] = F.STAT[2 * (tb + s) + 1];
#pragma unroll
            for (int j = 0; j < 8; ++j) yraw[s][j] = ((const GAS v2u*)(F.Y + (size_t)(tb + s) * D) + lane)[64 * j]; }
        int key[8]; float gvv[8], suv[8];
#pragma unroll
        for (int s = 0; s < 4; ++s)
#pragma unroll
            for (int h = 0; h < 2; ++h) { const size_t o = (size_t)(tb + s) * NPAIR + 64 * h + lane;
                key[2 * s + h] = (F.IDX[o] << 9) | (s << 7) | (64 * h + lane); gvv[2 * s + h] = F.GV[o]; suv[2 * s + h] = F.SU[o]; }
        unsigned xp0[16], xp1[16], xp2[16], xp3[16];
        float mu[4], rs_[4];
#pragma unroll
        for (int s = 0; s < 4; ++s) { mu[s] = st1[s] * (1.f / D); rs_[s] = 1.f / sqrtf(fmaxf(st2[s] * (1.f / D) - mu[s] * mu[s], 0.f) + LN_EPS); }
#pragma unroll
        for (int j = 0; j < 8; ++j) {
            const f32x4 g = l1g[lane + 64 * j], b = l1b[lane + 64 * j];
            const v2u w0 = yraw[0][j], w1 = yraw[1][j], w2 = yraw[2][j], w3 = yraw[3][j];
#define P7_X1PK(W_, S_, LO_) pk2(rs_[S_] * (bf_lo(LO_ ? W_.x : W_.y) - mu[S_] * (LO_ ? g.x : g.z)) + (LO_ ? b.x : b.z), rs_[S_] * (bf_hi(LO_ ? W_.x : W_.y) - mu[S_] * (LO_ ? g.y : g.w)) + (LO_ ? b.y : b.w))
            xp0[2 * j] = P7_X1PK(w0, 0, true); xp0[2 * j + 1] = P7_X1PK(w0, 0, false); xp1[2 * j] = P7_X1PK(w1, 1, true); xp1[2 * j + 1] = P7_X1PK(w1, 1, false);
            xp2[2 * j] = P7_X1PK(w2, 2, true); xp2[2 * j + 1] = P7_X1PK(w2, 2, false); xp3[2 * j] = P7_X1PK(w3, 3, true); xp3[2 * j + 1] = P7_X1PK(w3, 3, false); }
        p7_sort512(key, lane);
        P7Row R0, R1, R2, R3, R4, R5, R6, R7;
        { const int ko0 = (key[0] >> 9) * ROWB;
          p7_ld(R0, tab, __builtin_amdgcn_readlane(ko0, 0), v16, v8); p7_ld(R1, tab, __builtin_amdgcn_readlane(ko0, 1), v16, v8);
          p7_ld(R2, tab, __builtin_amdgcn_readlane(ko0, 2), v16, v8); p7_ld(R3, tab, __builtin_amdgcn_readlane(ko0, 3), v16, v8);
          p7_ld(R4, tab, __builtin_amdgcn_readlane(ko0, 4), v16, v8); p7_ld(R5, tab, __builtin_amdgcn_readlane(ko0, 5), v16, v8);
          p7_ld(R6, tab, __builtin_amdgcn_readlane(ko0, 6), v16, v8); p7_ld(R7, tab, __builtin_amdgcn_readlane(ko0, 7), v16, v8); }
        float coef[8];
#pragma unroll
        for (int q = 0; q < 8; ++q) coef[q] = 0.f;
#pragma unroll 1
        for (int r = 0; r < 8; ++r) {
            const int kcur = sel8i(key, r), knext = sel8i(key, (r + 1) & 7);
            const int koc = (kcur >> 9) * ROWB, kon = (knext >> 9) * ROWB + (r == 7 ? TAB_V_OFS : 0);
            const int slv = (kcur >> 7) & 3;
            int zreg = 0;
#pragma unroll 1
            for (int jj = 0; jj < 8; ++jj) {
                const int j = 8 * jj; const int kah = jj == 7 ? kon : koc;
                const int so0 = __builtin_amdgcn_readlane(kah, (j + NPF) & 63), so1 = __builtin_amdgcn_readlane(kah, (j + 1 + NPF) & 63), so2 = __builtin_amdgcn_readlane(kah, (j + 2 + NPF) & 63), so3 = __builtin_amdgcn_readlane(kah, (j + 3 + NPF) & 63), so4 = __builtin_amdgcn_readlane(kah, (j + 4 + NPF) & 63), so5 = __builtin_amdgcn_readlane(kah, (j + 5 + NPF) & 63), so6 = __builtin_amdgcn_readlane(kah, (j + 6 + NPF) & 63), so7 = __builtin_amdgcn_readlane(kah, (j + 7 + NPF) & 63);
                P7_USTEP(R0, R1, 0, 1) P7_USTEP(R2, R3, 2, 3) P7_USTEP(R4, R5, 4, 5) P7_USTEP(R6, R7, 6, 7)
            }
            const int pr = kcur & 127, sel = 2 * slv + (pr >> 6);
            float su = 0.f, gv = 0.f;
#pragma unroll
            for (int jq = 0; jq < 8; ++jq) { const float a = __int_as_float(__builtin_amdgcn_ds_bpermute((pr & 63) << 2, __float_as_int(suv[jq]))), b = __int_as_float(__builtin_amdgcn_ds_bpermute((pr & 63) << 2, __float_as_int(gvv[jq]))); su = sel == jq ? a : su; gv = sel == jq ? b : gv; }
            const float cnew = gelu_erf(__int_as_float(zreg) * su) * gv;
#pragma unroll
            for (int q = 0; q < 8; ++q) { const float old = coef[q]; coef[q] = r == q ? cnew : old; }
        }
        float acc0[32], acc1[32], acc2[32], acc3[32];
#pragma unroll
        for (int q = 0; q < 32; ++q) { acc0[q] = 0.f; acc1[q] = 0.f; acc2[q] = 0.f; acc3[q] = 0.f; }
#pragma unroll 1
        for (int r = 0; r < 8; ++r) {
            const int kcur = sel8i(key, r), knext = sel8i(key, r < 7 ? r + 1 : 7); const int ccur = __float_as_int(sel8f(coef, r));
            const int koc = (kcur >> 9) * ROWB + TAB_V_OFS, kon = (knext >> 9) * ROWB + TAB_V_OFS;
            const int slv = (kcur >> 7) & 3;
#pragma unroll 1
            for (int jj = 0; jj < 8; ++jj) {
                const int j = 8 * jj; const int kah = jj == 7 ? kon : koc;
                const int so0 = __builtin_amdgcn_readlane(kah, (j + NPF) & 63), so1 = __builtin_amdgcn_readlane(kah, (j + 1 + NPF) & 63), so2 = __builtin_amdgcn_readlane(kah, (j + 2 + NPF) & 63), so3 = __builtin_amdgcn_readlane(kah, (j + 3 + NPF) & 63), so4 = __builtin_amdgcn_readlane(kah, (j + 4 + NPF) & 63), so5 = __builtin_amdgcn_readlane(kah, (j + 5 + NPF) & 63), so6 = __builtin_amdgcn_readlane(kah, (j + 6 + NPF) & 63), so7 = __builtin_amdgcn_readlane(kah, (j + 7 + NPF) & 63);
                P7_VSTEP(R0, 0) P7_VSTEP(R1, 1) P7_VSTEP(R2, 2) P7_VSTEP(R3, 3) P7_VSTEP(R4, 4) P7_VSTEP(R5, 5) P7_VSTEP(R6, 6) P7_VSTEP(R7, 7)
            }
        }
        int tbe = 4 * tg; asm volatile("" : "+s"(tbe));
        { int l2 = lane_in; asm volatile("" : "+v"(l2)); lane = l2; }
#pragma unroll
        for (int s = 0; s < 4; ++s) { const float a1 = F.STAT[2 * (tbe + s)], a2 = F.STAT[2 * (tbe + s) + 1];
            mu[s] = a1 * (1.f / D); rs_[s] = 1.f / sqrtf(fmaxf(a2 * (1.f / D) - mu[s] * mu[s], 0.f) + LN_EPS); }
        v2u yr_[4][8];
#pragma unroll
        for (int s = 0; s < 4; ++s) {
            if ((s & 1) == 0) {
#pragma unroll
                for (int s2 = s; s2 < s + 2; ++s2)
#pragma unroll
                    for (int j = 0; j < 8; ++j) yr_[s2][j] = ((const GAS v2u*)(F.Y + (size_t)(tbe + s2) * D) + lane)[64 * j];
            }
            asm volatile("" ::: "memory"); __builtin_amdgcn_sched_barrier(0);
            float (&acc)[32] = s == 0 ? acc0 : s == 1 ? acc1 : s == 2 ? acc2 : acc3;
            float sum = 0.f;
#pragma unroll
            for (int j = 0; j < 8; ++j) { const v2u w = yr_[s][j];
                const f32x4 g = l1g[lane + 64 * j], b = l1b[lane + 64 * j];
                const unsigned xa = P7_X1PK(w, s, true), xb = P7_X1PK(w, s, false);
                acc[4 * j + 0] = fmaf(ALPHA, bf_lo(xa), acc[4 * j + 0]); acc[4 * j + 1] = fmaf(ALPHA, bf_hi(xa), acc[4 * j + 1]);
                acc[4 * j + 2] = fmaf(ALPHA, bf_lo(xb), acc[4 * j + 2]); acc[4 * j + 3] = fmaf(ALPHA, bf_hi(xb), acc[4 * j + 3]); }
#pragma unroll
            for (int q = 0; q < 32; ++q) sum += acc[q];
            const float mean = __int_as_float(__builtin_amdgcn_readlane(__float_as_int(wave_sum_lane63(sum)), 63)) * (1.f / D); float s2 = 0.f;
#pragma unroll
            for (int q = 0; q < 32; ++q) { acc[q] -= mean; s2 = fmaf(acc[q], acc[q], s2); }
            const float rstd = 1.f / sqrtf(__int_as_float(__builtin_amdgcn_readlane(__float_as_int(wave_sum_lane63(s2)), 63)) * (1.f / D) + LN_EPS);
            GAS f32x4* orow = (GAS f32x4*)(F.out + (size_t)(tbe + s) * D) + lane;
#pragma unroll
            for (int j = 0; j < 8; ++j) { const f32x4 g = lg[lane + 64 * j], b = lb[lane + 64 * j];
                f32x4 o; o.x = acc[4 * j + 0] * rstd * g.x + b.x; o.y = acc[4 * j + 1] * rstd * g.y + b.y; o.z = acc[4 * j + 2] * rstd * g.z + b.z; o.w = acc[4 * j + 3] * rstd * g.w + b.w;
                __builtin_nontemporal_store(o, orow + 64 * j); }
        }
    }
}

struct Args { const float* in[19]; float* out; unsigned char* ws; int ph_lo, ph_hi, li, pad; };
__global__ void __launch_bounds__(NWAVES * 64, 2) peer_layer_fwd(Args args) {
    extern __shared__ __attribute__((aligned(16))) unsigned char lds[];
    Frame F;
    F.lds = (LAS unsigned char*)lds;
    F.MISC = (volatile LAS unsigned*)(F.lds + MISC_OFF);
    F.tid = threadIdx.x; F.lane = F.tid & 63; F.wave = __builtin_amdgcn_readfirstlane(F.tid >> 6);
    F.G = gridDim.x; { const int bx = blockIdx.x; F.vcu = (F.G % 8 == 0) ? (bx % 8) * (F.G / 8) + bx / 8 : bx; }
    unsigned char* ws = args.ws;
    F.ctl = (gu32*)(ws + WS_CTL);
    F.x = args.in[0]; F.w_in = args.in[1]; F.b_in = args.in[2]; F.ccw = args.in[3]; F.ccb = args.in[4]; F.clg = args.in[5]; F.clb = args.in[6];
    F.scw = args.in[7]; F.scbias = args.in[8]; F.w_out = args.in[9]; F.b_out = args.in[10]; F.ln1g = args.in[11]; F.ln1b = args.in[12];
    F.w_q = args.in[13]; F.sub_keys = args.in[14]; F.peer_u = args.in[15]; F.peer_v = args.in[16]; F.ln2g = args.in[17]; F.ln2b = args.in[18];
    F.out = args.out;
    F.XB = (bf16*)(ws + WS_XB); F.BT1 = (bf16*)(ws + WS_BT1); F.BT2 = (bf16*)(ws + WS_BT2); F.BT3 = (bf16*)(ws + WS_BT3);
    F.AGLU = (bf16*)(ws + WS_AGLU); F.CV = (bf16*)(ws + WS_CV); F.SCB = (bf16*)(ws + WS_SCB); F.MIX = (bf16*)(ws + WS_MIX); F.X1 = (bf16*)(ws + WS_X1);
    F.Y = (bf16*)(ws + WS_Y); F.SS = (float*)(ws + WS_S); F.IDX = (int*)(ws + WS_IDX); F.GV = (float*)(ws + WS_GV); F.SU = (float*)(ws + WS_SU);
    F.STAT = (float*)(ws + WS_STAT); F.C12 = (float*)(ws + WS_C12);
    F.U8 = ws + WS_U8; F.V8 = ws + WS_V8; F.USC = (float*)(ws + WS_USC); F.VSC = (float*)(ws + WS_VSC);
    for (int u = F.tid; u < (LDS_BYTES - LDSCTL_OFF) / 4; u += NWAVES * 64) ((LAS unsigned*)(F.lds + LDSCTL_OFF))[u] = 0u;
    __syncthreads();
    XcdBarrier bar; bar.bar = (unsigned*)(F.ctl + CW_BAR); bar.x = 0; bar.st = nullptr;
    if (N_LAUNCHES == 1) bar = xcd_barrier_post((unsigned*)(F.ctl + CW_BAR), F.MISC + 8);
    const int lo = args.ph_lo, hi = args.ph_hi;
#ifndef ONLY_PHASE
#define ONLY_PHASE -1
#endif
#define IN(k) ((k) != 4 && (k) != 6 && (ONLY_PHASE < 0 || ONLY_PHASE == (k)) && lo <= (k) && (k) < hi)
#define SEAM(k) do { if (IN(k) && IN((k) + 1)) xcd_barrier(bar); } while (0)
#ifndef REPEAT_PHASE
#define REPEAT_PHASE -1
#endif
#define REPS(k) for (int rep_ = 0; rep_ < (REPEAT_PHASE == (k) ? 2 : 1); ++rep_)
#ifndef PROBE_STRETCH
#define PROBE_STRETCH -1
#endif
#define T_BEGIN(k) const unsigned long long tb_##k = (PROBE_STRETCH == (k)) ? __builtin_amdgcn_s_memrealtime() : 0ull
#define T_END(k) do { if (PROBE_STRETCH == (k)) { const unsigned long long te_ = __builtin_amdgcn_s_memrealtime(); while (__builtin_amdgcn_s_memrealtime() - te_ < te_ - tb_##k) __builtin_amdgcn_s_sleep(8); } } while (0)

    if (IN(0)) { T_BEGIN(0); REPS(0) p0_prologue(F); T_END(0); SEAM(0); }
    if (IN(1)) { T_BEGIN(1); REPS(1) {
        if (F.G == 256) { if (blockIdx.x >= 128) p0_peer_tables(F, ((int)blockIdx.x - 128) * NWAVES + F.wave, 128 * NWAVES); }
        else p0_peer_tables(F, F.vcu * NWAVES + F.wave, F.G * NWAVES);
        p1_c12(F);
        __syncthreads();
        pg8::Gemm g{F.XB, F.BT1, S, NIN, D}; pg8::StaticOrder So; So.init(S, NIN, F.G, (int)blockIdx.x);
        pg8::EpiInProj E{F.AGLU, F.CV, F.SCB, F.b_in};
        pg8::gemm_phase<pg8::EpiInProj, pg8::StaticOrder, PG8_ALIGN, PG8_SP2>(F.lds + RING_OFF, g, So, E); }
        T_END(1); SEAM(1);
    }
    if (IN(2)) { T_BEGIN(2); REPS(2) for (int u = F.vcu; u < S / 32; u += F.G) p2_unit(F, u); T_END(2); SEAM(2); }
    if (IN(3)) { T_BEGIN(3); REPS(3) {
        pg8::Gemm g{F.MIX, F.BT2, S, D, D}; pg8::StaticOrder So; So.init(S, D, F.G, (int)blockIdx.x);
        pg8::EpiOutProj E{F.Y, F.b_out, F.XB, F.ln1g, F.STAT, ALPHA};
        pg8::gemm_phase<pg8::EpiOutProj, pg8::StaticOrder, PG8_ALIGN, PG8_SP2>(F.lds + RING_OFF, g, So, E); }
        T_END(3); if (IN(3) && IN(5)) xcd_barrier(bar);
    }
    if (IN(5)) { T_BEGIN(5); REPS(5) {
        pg8::Gemm g{F.Y, F.BT3, S, D, D}; pg8::StaticOrder So; So.init(S, D, F.G, (int)blockIdx.x);
        EpiScoreTopk E{F.STAT, F.C12, LN_EPS, F.IDX, F.GV, F.SU, F.USC, F.VSC};
        pg8::gemm_phase<EpiScoreTopk, pg8::StaticOrder, false, PG8_SP2>(F.lds + RING_OFF, g, So, E); }
        T_END(5); if (IN(5) && IN(7)) xcd_barrier(bar);
    }
    if (IN(7)) { T_BEGIN(7); REPS(7) p7_peer(F, bar); T_END(7); }
#undef IN
#undef SEAM
}

extern "C" void kernel_launch(void* const* d_in, const int* in_sizes, int n_in, void* d_out, int out_size, void* d_ws, size_t ws_size, hipStream_t stream) {
    static int grid = 0;
    if (grid == 0) {
        if (n_in != 19 || in_sizes[0] != S * D || out_size != S * D || ws_size < WS_END) {
            fprintf(stderr, "kernel_launch: built for 19 inputs, x/out of %d floats, >= %zu bytes of workspace; got n_in %d, in0 %d, out %d, ws %zu; nothing launched\n", S * D, (size_t)WS_END, n_in, n_in > 0 ? in_sizes[0] : -1, out_size, ws_size);
            grid = -1; return; }
        int dev = 0, cus = 0, per_cu = 0;
        if (hipGetDevice(&dev) != hipSuccess || hipDeviceGetAttribute(&cus, hipDeviceAttributeMultiprocessorCount, dev) != hipSuccess) { fprintf(stderr, "kernel_launch: device query failed\n"); grid = -1; return; }
        if (hipFuncSetAttribute((const void*)peer_layer_fwd, hipFuncAttributeMaxDynamicSharedMemorySize, LDS_BYTES) != hipSuccess) { fprintf(stderr, "kernel_launch: hipFuncSetAttribute failed\n"); grid = -1; return; }
        if (hipOccupancyMaxActiveBlocksPerMultiprocessor(&per_cu, (const void*)peer_layer_fwd, NWAVES * 64, LDS_BYTES) != hipSuccess || per_cu < 1) {
            fprintf(stderr, "kernel_launch: occupancy query reports %d workgroups per CU; nothing launched\n", per_cu); (void)hipGetLastError(); grid = -1; return; }
        (void)hipGetLastError();
        grid = cus;
    }
    if (grid < 0) return;
    if (hipMemsetAsync((char*)d_ws + WS_CTL, 0, CTL_ZERO_BYTES, stream) != hipSuccess) { fprintf(stderr, "kernel_launch: hipMemsetAsync failed\n"); return; }
    Args a{};
    for (int i = 0; i < 19; ++i) a.in[i] = (const float*)d_in[i];
    a.out = (float*)d_out; a.ws = (unsigned char*)d_ws;
    for (int li = 0; li < N_LAUNCHES; ++li) {
        a.ph_lo = (N_LAUNCHES == 1) ? 0 : li; a.ph_hi = (N_LAUNCHES == 1) ? N_PHASES : li + 1; a.li = li;
        hipError_t le;
        if (N_LAUNCHES == 1) { void* kargs[] = {&a}; le = hipLaunchCooperativeKernel((const void*)peer_layer_fwd, dim3(grid), dim3(NWAVES * 64), kargs, LDS_BYTES, stream); }
        else { hipLaunchKernelGGL(peer_layer_fwd, dim3(grid), dim3(NWAVES * 64), LDS_BYTES, stream, a); le = hipPeekAtLastError(); }
        if (le != hipSuccess) { fprintf(stderr, "kernel_launch: launch %d failed: %s (grid %d x %d threads, %d B LDS)\n", li, hipGetErrorName(le), grid, NWAVES * 64, LDS_BYTES); break; }
    }
}
```

```cpp
#include <hip/hip_runtime.h>
#include <cstdio>
#include <cstdint>
namespace pg8 {
#define PG8_LAS __attribute__((address_space(3)))
typedef unsigned short bf16_t;
typedef short bf16x8 __attribute__((ext_vector_type(8)));
typedef float f32x4 __attribute__((ext_vector_type(4)));
typedef unsigned u32x4 __attribute__((ext_vector_type(4)));
constexpr int BM = 256, BK = 64, HALF = 128, HTB = HALF * BK * 2  , STAGE_BYTES = 8 * HTB, NXCD = 8, WGM = 8;

__host__ __device__ __forceinline__ int lds_byte(int r, int c) { const int st = (r >> 4) * 2 + (c >> 5), rr = r & 15, cc = c & 31, ob = rr * 64 + cc * 2; return st * 1024 + (ob ^ (((ob >> 9) & 1) << 5)); }
__host__ __device__ __forceinline__ void stage_rc(int b, int& R, int& C) { const int st = b / 1024, sb = b % 1024, swz = sb ^ (((sb >> 9) & 1) << 5); R = (st >> 1) * 16 + swz / 64; C = (st & 1) * 32 + (swz % 64) / 2; }
__host__ __device__ __forceinline__ int perm32(int rho) { const int n = rho >> 4, i = rho & 15; return 8 * (i >> 2) + 4 * n + (i & 3); }

struct Unit { int pm, pn; };
struct Gemm { const bf16_t* A; const bf16_t* Bt; int M, N, K; };

struct StaticOrder {
    int nM, nN, nwg, G, c;
    __host__ __device__ void init(int M, int N, int G_, int c_) { nM = M / BM; nN = N / BM; nwg = nM * nN; G = G_; c = c_; }
    __host__ __device__ bool next(int i, Unit& u) const {
        const long L = (long)i * G + c; if (L >= nwg) return false;
        int wgid = (int)L; { const int q = nwg / NXCD, r = nwg % NXCD, xcd = wgid % NXCD, off = wgid / NXCD; wgid = (xcd < r ? xcd * (q + 1) : r * (q + 1) + (xcd - r) * q) + off; }
        const int nig = WGM * nN, gid = wgid / nig, fm = gid * WGM, gsz = (nM - fm) < WGM ? (nM - fm) : WGM;
        u.pm = fm + ((wgid % nig) % gsz); u.pn = (wgid % nig) / gsz; return true;
    }
    __device__ __forceinline__ void a_ready(const Unit&) const {}
    __device__ __forceinline__ void done(const Unit&) const {}
};

__device__ __forceinline__ unsigned cvt_pk_bf16(float lo, float hi) { unsigned r; asm volatile("v_cvt_pk_bf16_f32 %0, %1, %2" : "=v"(r) : "v"(lo), "v"(hi)); return r; }
__device__ __forceinline__ float sigmoidf_fast(float g) { return __builtin_amdgcn_rcpf(1.0f + __expf(-g)); }

struct EpiInProj {
    static constexpr bool PERM = true, AFTER_DRAIN = false;
    bf16_t* aglu; bf16_t* cv; bf16_t* scb; const float* b_in;
    __device__ __forceinline__ void operator()(const f32x4 (&acc)[2][2][4][2], const Unit& u, int wr, int wc, int fr, int fq) const {
        const int row0 = u.pm * BM + wr * 64 + fr, cc = wc * 32 + 8 * fq;
        if (u.pn < 16) {
            const bool conf = u.pn < 8; const int j = conf ? u.pn : u.pn - 8;
            const float* b0 = b_in + (conf ? 0 : 3072) + 128 * j + cc;
            const float* b1 = b_in + (conf ? 1024 : 4096) + 128 * j + cc;
            bf16_t* O = (conf ? aglu : cv) + 128 * j + cc;
            f32x4 bv0[2], bv1[2];
#pragma unroll
            for (int n = 0; n < 2; ++n) { bv0[n] = *(const f32x4*)(b0 + 4 * n); bv1[n] = *(const f32x4*)(b1 + 4 * n); }
#pragma unroll
            for (int ai = 0; ai < 2; ++ai)
#pragma unroll
                for (int m = 0; m < 4; ++m) {
                    f32x4 r[2];
#pragma unroll
                    for (int n = 0; n < 2; ++n) { const f32x4 a = acc[ai][0][m][n] + bv0[n]; f32x4 g = acc[ai][1][m][n] + bv1[n];
                        if (conf) { g[0] = sigmoidf_fast(g[0]); g[1] = sigmoidf_fast(g[1]); g[2] = sigmoidf_fast(g[2]); g[3] = sigmoidf_fast(g[3]); }
                        r[n] = a * g; }
                    u32x4 w; w.x = cvt_pk_bf16(r[0][0], r[0][1]); w.y = cvt_pk_bf16(r[0][2], r[0][3]); w.z = cvt_pk_bf16(r[1][0], r[1][1]); w.w = cvt_pk_bf16(r[1][2], r[1][3]);
                    *(u32x4*)(O + (size_t)(row0 + ai * HALF + m * 16) * 1024) = w; }
        } else {
            const int j = u.pn - 16;
#pragma unroll
            for (int bj = 0; bj < 2; ++bj) {
                const float* b0 = b_in + 2048 + 256 * j + 128 * bj + cc; bf16_t* O = scb + 256 * j + 128 * bj + cc;
                const f32x4 bva = *(const f32x4*)(b0), bvb = *(const f32x4*)(b0 + 4);
#pragma unroll
                for (int ai = 0; ai < 2; ++ai)
#pragma unroll
                    for (int m = 0; m < 4; ++m) { const f32x4 v0 = acc[ai][bj][m][0] + bva, v1 = acc[ai][bj][m][1] + bvb;
                        u32x4 w; w.x = cvt_pk_bf16(v0[0], v0[1]); w.y = cvt_pk_bf16(v0[2], v0[3]); w.z = cvt_pk_bf16(v1[0], v1[1]); w.w = cvt_pk_bf16(v1[2], v1[3]);
                        *(u32x4*)(O + (size_t)(row0 + ai * HALF + m * 16) * 1024) = w; } }
        }
    }
};
struct EpiOutProj {
    static constexpr bool PERM = true, AFTER_DRAIN = false;
    bf16_t* YG; const float* bias; const bf16_t* xb; const float* g1; float* stat; float alpha;
    __device__ __forceinline__ void operator()(const f32x4 (&acc)[2][2][4][2], const Unit& u, int wr, int wc, int fr, int fq) const {
        const int row0 = u.pm * BM + wr * 64 + fr, col0 = u.pn * BM + wc * 32 + 8 * fq;
        f32x4 bv[2][2], gv[2][2];
#pragma unroll
        for (int bj = 0; bj < 2; ++bj)
#pragma unroll
            for (int n = 0; n < 2; ++n) { bv[bj][n] = *(const f32x4*)(bias + col0 + bj * HALF + 4 * n); gv[bj][n] = *(const f32x4*)(g1 + col0 + bj * HALF + 4 * n); }
#pragma unroll
        for (int ai = 0; ai < 2; ++ai)
#pragma unroll
            for (int m = 0; m < 4; ++m) { const int row = row0 + ai * HALF + m * 16; const size_t off = (size_t)row * 2048 + col0;
                float s1 = 0.f, s2 = 0.f;
#pragma unroll
                for (int bj = 0; bj < 2; ++bj) { const u32x4 xw = __builtin_nontemporal_load((const u32x4*)(xb + off + bj * HALF));
                    f32x4 v0 = acc[ai][bj][m][0] + bv[bj][0], v1 = acc[ai][bj][m][1] + bv[bj][1];
                    v0[0] += alpha * __uint_as_float(xw.x << 16); v0[1] += alpha * __uint_as_float(xw.x & 0xffff0000u); v0[2] += alpha * __uint_as_float(xw.y << 16); v0[3] += alpha * __uint_as_float(xw.y & 0xffff0000u);
                    v1[0] += alpha * __uint_as_float(xw.z << 16); v1[1] += alpha * __uint_as_float(xw.z & 0xffff0000u); v1[2] += alpha * __uint_as_float(xw.w << 16); v1[3] += alpha * __uint_as_float(xw.w & 0xffff0000u);
                    s1 += ((v0[0] + v0[1]) + (v0[2] + v0[3])) + ((v1[0] + v1[1]) + (v1[2] + v1[3]));
                    s2 += ((v0[0] * v0[0] + v0[1] * v0[1]) + (v0[2] * v0[2] + v0[3] * v0[3])) + ((v1[0] * v1[0] + v1[1] * v1[1]) + (v1[2] * v1[2] + v1[3] * v1[3]));
                    v0 = v0 * gv[bj][0]; v1 = v1 * gv[bj][1];
                    u32x4 w; w.x = cvt_pk_bf16(v0[0], v0[1]); w.y = cvt_pk_bf16(v0[2], v0[3]); w.z = cvt_pk_bf16(v1[0], v1[1]); w.w = cvt_pk_bf16(v1[2], v1[3]);
                    *(u32x4*)(YG + off + bj * HALF) = w; }
                s1 += __shfl_xor(s1, 16); s2 += __shfl_xor(s2, 16); s1 += __shfl_xor(s1, 32); s2 += __shfl_xor(s2, 32);
                if (fq == 0) { atomicAdd(stat + 2 * row, s1); atomicAdd(stat + 2 * row + 1, s2); }
                asm volatile("" ::: "memory"); }
    }
};
struct EpiF32 {
    static constexpr bool PERM = false, AFTER_DRAIN = false;
    float* C; int ldc; const float* stat; const float* c12; float eps;
    __device__ __forceinline__ void operator()(const f32x4 (&acc)[2][2][4][2], const Unit& u, int wr, int wc, int fr, int fq) const {
        const int row0 = u.pm * BM + wr * 64 + fr, col0 = u.pn * BM + wc * 32 + 4 * fq;
        f32x4 c1v[2][2], c2v[2][2];
#pragma unroll
        for (int bj = 0; bj < 2; ++bj)
#pragma unroll
            for (int n = 0; n < 2; ++n) { c1v[bj][n] = *(const f32x4*)(c12 + col0 + bj * HALF + n * 16); c2v[bj][n] = *(const f32x4*)(c12 + 2048 + col0 + bj * HALF + n * 16); }
#pragma unroll
        for (int ai = 0; ai < 2; ++ai)
#pragma unroll
            for (int m = 0; m < 4; ++m) { const int row = row0 + ai * HALF + m * 16; float* rowp = C + (size_t)row * ldc + col0;
                const float s1 = stat[2 * row], s2 = stat[2 * row + 1];
                const float mean = s1 * (1.0f / 2048.0f), var = fmaxf(s2 * (1.0f / 2048.0f) - mean * mean, 0.f), rstd = 1.0f / sqrtf(var + eps);
#pragma unroll
                for (int bj = 0; bj < 2; ++bj)
#pragma unroll
                    for (int n = 0; n < 2; ++n) *(f32x4*)(rowp + bj * HALF + n * 16) = (acc[ai][bj][m][n] - c1v[bj][n] * mean) * rstd + c2v[bj][n]; }
    }
};

template <class Epi, class Sched, bool ALIGN_EPI = false, bool SP2 = false>
__device__ __forceinline__ void gemm_phase(PG8_LAS unsigned char* lds, const Gemm g, const Sched& S, const Epi& E) {
    const int tid = threadIdx.x, wid = __builtin_amdgcn_readfirstlane(tid >> 6), lane = tid & 63, wr = wid >> 2, wc = wid & 3, fr = lane & 15, fq = lane >> 4;
    const int K = g.K, nt = K / BK;
    unsigned voffA[2], voffB[2];
#pragma unroll
    for (int i = 0; i < 2; ++i) { int R, C; stage_rc(tid * 16 + i * 8192, R, C); const int Rb = Epi::PERM ? ((R & ~31) + perm32(R & 31)) : R;
        voffA[i] = (unsigned)(R * K + C) * 2u; voffB[i] = (unsigned)(Rb * K + C) * 2u; }
    const size_t kstep = (size_t)(BK * 2);
    const size_t hstep = (size_t)HALF * K * 2;
    const size_t tstep = 2 * hstep;
    const unsigned ldsw = (unsigned)wid * 1024u;
    const int aoff = lds_byte(wr * 64 + fr, fq * 8), boff = lds_byte(wc * 32 + fr, fq * 8);
#define PG8_SA(b, h) (((b) * 2 + (h)) * HTB)
#define PG8_SB(b, h) ((4 + (b) * 2 + (h)) * HTB)
#define PG8_STAGE(bufoff, gbase, voff) do { _Pragma("unroll") for (int _i = 0; _i < 2; ++_i) \
        __builtin_amdgcn_global_load_lds((const unsigned*)((const char*)(gbase) + (voff)[_i]), (PG8_LAS unsigned*)(lds + (bufoff) + ldsw + _i * 8192), 16, 0, 0); } while (0)
#define PG8_LDA(dst, b, h) do { _Pragma("unroll") for (int m = 0; m < 4; ++m) _Pragma("unroll") for (int k = 0; k < 2; ++k) dst[m][k] = *(const PG8_LAS bf16x8*)(lds + PG8_SA(b, h) + aoff + m * 2048 + k * 1024); } while (0)
#define PG8_LDB(dst, b, h) do { _Pragma("unroll") for (int n = 0; n < 2; ++n) _Pragma("unroll") for (int k = 0; k < 2; ++k) dst[n][k] = *(const PG8_LAS bf16x8*)(lds + PG8_SB(b, h) + boff + n * 2048 + k * 1024); } while (0)
#define PG8_MMA(ai, bj, At, Bt) do { __builtin_amdgcn_s_setprio(1); _Pragma("unroll") for (int m = 0; m < 4; ++m) _Pragma("unroll") for (int n = 0; n < 2; ++n) _Pragma("unroll") for (int k = 0; k < 2; ++k) \
        acc[ai][bj][m][n] = __builtin_amdgcn_mfma_f32_16x16x32_bf16(Bt[n][k], At[m][k], acc[ai][bj][m][n], 0, 0, 0); __builtin_amdgcn_s_setprio(0); } while (0)
#define PG8_WAIT_V(n) asm volatile("s_waitcnt vmcnt(" #n ")" ::: "memory")
#define PG8_WAIT_L(n) asm volatile("s_waitcnt lgkmcnt(" #n ")" ::: "memory")
#define PG8_BAR __builtin_amdgcn_s_barrier()
#define PG8_SCHED __builtin_amdgcn_sched_barrier(0)
    Unit cur, nxt; int ui = 0;
    if (!S.next(0, cur)) return;
    f32x4 acc[2][2][4][2];
#pragma unroll
    for (int a = 0; a < 2; ++a)
#pragma unroll
        for (int b = 0; b < 2; ++b)
#pragma unroll
            for (int m = 0; m < 4; ++m)
#pragma unroll
                for (int n = 0; n < 2; ++n) acc[a][b][m][n] = (f32x4){0.f, 0.f, 0.f, 0.f};
    bf16x8 At[4][2], B0[2][2], B1[2][2];
    const char* cA = (const char*)g.A + (size_t)cur.pm * tstep; const char* cB = (const char*)g.Bt + (size_t)cur.pn * tstep;
    S.a_ready(cur);
    if constexpr (SP2) {
        PG8_STAGE(PG8_SB(0, 0), cB, voffB); PG8_STAGE(PG8_SB(0, 1), cB + hstep, voffB); PG8_STAGE(PG8_SA(0, 0), cA, voffA); PG8_STAGE(PG8_SA(0, 1), cA + hstep, voffA);
        if (wr == 1) PG8_BAR;
        PG8_WAIT_V(2); PG8_BAR;
        PG8_STAGE(PG8_SB(1, 0), cB + kstep, voffB); PG8_STAGE(PG8_SA(1, 0), cA + kstep, voffA); PG8_STAGE(PG8_SB(1, 1), cB + hstep + kstep, voffB);
        PG8_WAIT_V(6); PG8_BAR;
    } else {
        PG8_STAGE(PG8_SB(0, 0), cB, voffB); PG8_STAGE(PG8_SA(0, 0), cA, voffA); PG8_STAGE(PG8_SB(0, 1), cB + hstep, voffB); PG8_STAGE(PG8_SA(0, 1), cA + hstep, voffA);
        if (wr == 1) PG8_BAR;
        PG8_WAIT_V(4); PG8_BAR;
        PG8_STAGE(PG8_SB(1, 0), cB + kstep, voffB); PG8_STAGE(PG8_SA(1, 0), cA + kstep, voffA); PG8_STAGE(PG8_SB(1, 1), cB + hstep + kstep, voffB);
        PG8_WAIT_V(6); PG8_BAR;
    }
    for (;;) {
        const bool has_next = S.next(ui + 1, nxt);
        const char* nA = has_next ? (const char*)g.A + (size_t)nxt.pm * tstep : cA; const char* nB = has_next ? (const char*)g.Bt + (size_t)nxt.pn * tstep : cB;
        for (int t = 0; t < nt; t += 2) {
            const bool last = (t == nt - 2);
            const char* a1 = cA + (size_t)(t + 1) * kstep;
            const char* a2 = last ? nA : cA + (size_t)(t + 2) * kstep; const char* b2 = last ? nB : cB + (size_t)(t + 2) * kstep;
            const char* a3 = a2 + kstep; const char* b3 = b2 + kstep;
            if (last && has_next) S.a_ready(nxt);
            if constexpr (SP2) {
            PG8_LDB(B0, 0, 0); PG8_LDB(B1, 0, 1); PG8_SCHED; PG8_LDA(At, 0, 0); PG8_STAGE(PG8_SA(1, 1), a1 + hstep, voffA);
            PG8_WAIT_V(8); PG8_WAIT_L(0); PG8_BAR; PG8_MMA(0, 0, At, B0); PG8_MMA(0, 1, At, B1); PG8_BAR; PG8_SCHED;
            PG8_LDA(At, 0, 1); PG8_STAGE(PG8_SB(0, 0), b2, voffB); PG8_STAGE(PG8_SB(0, 1), b2 + hstep, voffB); PG8_STAGE(PG8_SA(0, 0), a2, voffA);
            PG8_WAIT_V(8); PG8_WAIT_L(0); PG8_BAR; PG8_MMA(1, 0, At, B0); PG8_MMA(1, 1, At, B1); PG8_BAR; PG8_SCHED;
            PG8_LDB(B0, 1, 0); PG8_LDB(B1, 1, 1); PG8_SCHED; PG8_LDA(At, 1, 0); PG8_STAGE(PG8_SA(0, 1), a2 + hstep, voffA);
            PG8_WAIT_V(8); PG8_WAIT_L(0); PG8_BAR; PG8_MMA(0, 0, At, B0); PG8_MMA(0, 1, At, B1); PG8_BAR; PG8_SCHED;
            PG8_LDA(At, 1, 1); PG8_STAGE(PG8_SB(1, 0), b3, voffB); PG8_STAGE(PG8_SB(1, 1), b3 + hstep, voffB); PG8_STAGE(PG8_SA(1, 0), a3, voffA);
            PG8_WAIT_V(8); PG8_WAIT_L(0); PG8_BAR; PG8_MMA(1, 0, At, B0); PG8_MMA(1, 1, At, B1); PG8_BAR; PG8_SCHED;
            } else {
            PG8_LDB(B0, 0, 0); PG8_SCHED; PG8_LDA(At, 0, 0); PG8_STAGE(PG8_SA(1, 1), a1 + hstep, voffA);
            PG8_WAIT_L(8); PG8_BAR; PG8_WAIT_L(0); PG8_MMA(0, 0, At, B0); PG8_BAR; PG8_SCHED;
            PG8_LDB(B1, 0, 1); PG8_STAGE(PG8_SB(0, 0), b2, voffB);
            PG8_BAR; PG8_WAIT_L(0); PG8_MMA(0, 1, At, B1); PG8_BAR;
            PG8_LDA(At, 0, 1); PG8_STAGE(PG8_SA(0, 0), a2, voffA);
            PG8_BAR; PG8_WAIT_L(0); PG8_MMA(1, 0, At, B0); PG8_BAR; PG8_SCHED;
            PG8_STAGE(PG8_SB(0, 1), b2 + hstep, voffB);
            PG8_WAIT_V(6); PG8_BAR; PG8_MMA(1, 1, At, B1); PG8_BAR;
            PG8_LDB(B0, 1, 0); PG8_SCHED; PG8_LDA(At, 1, 0); PG8_STAGE(PG8_SA(0, 1), a2 + hstep, voffA);
            PG8_WAIT_L(8); PG8_BAR; PG8_WAIT_L(0); PG8_MMA(0, 0, At, B0); PG8_BAR; PG8_SCHED;
            PG8_LDB(B1, 1, 1); PG8_STAGE(PG8_SB(1, 0), b3, voffB);
            PG8_BAR; PG8_WAIT_L(0); PG8_MMA(0, 1, At, B1); PG8_BAR;
            PG8_LDA(At, 1, 1); PG8_STAGE(PG8_SA(1, 0), a3, voffA);
            PG8_BAR; PG8_WAIT_L(0); PG8_MMA(1, 0, At, B0); PG8_BAR; PG8_SCHED;
            PG8_STAGE(PG8_SB(1, 1), b3 + hstep, voffB);
            PG8_WAIT_V(6); PG8_BAR; PG8_MMA(1, 1, At, B1); PG8_BAR;
            }
        }
        if constexpr (ALIGN_EPI) { if (wr == 0) PG8_BAR; }
        if constexpr (!Epi::AFTER_DRAIN) { E(acc, cur, wr, wc, fr, fq); S.done(cur); }
        if (!has_next) break;
#pragma unroll
        for (int a = 0; a < 2; ++a)
#pragma unroll
            for (int b = 0; b < 2; ++b)
#pragma unroll
                for (int m = 0; m < 4; ++m)
#pragma unroll
                    for (int n = 0; n < 2; ++n) acc[a][b][m][n] = (f32x4){0.f, 0.f, 0.f, 0.f};
        cur = nxt; cA = nA; cB = nB; ++ui;
        if constexpr (ALIGN_EPI) { if (wr == 1) PG8_BAR; }
    }
    PG8_WAIT_V(0);
    if constexpr (!ALIGN_EPI) { if (wr == 0) PG8_BAR; }
    PG8_BAR;
    if constexpr (Epi::AFTER_DRAIN) { E.fused(acc, cur, wr, wc, fr, fq, lds, wid, lane); S.done(cur); }
#undef PG8_SA
#undef PG8_SB
#undef PG8_STAGE
#undef PG8_LDA
#undef PG8_LDB
#undef PG8_MMA
#undef PG8_WAIT_V
#undef PG8_WAIT_L
#undef PG8_BAR
#undef PG8_SCHED
}
}

#ifndef PG8_SP2
#define PG8_SP2 true
#endif
#ifndef PG8_ALIGN
#define PG8_ALIGN true
#endif
constexpr int NWAVES = 8;
#ifndef MK_N_LAUNCHES
#define MK_N_LAUNCHES 1
#endif
constexpr int N_PHASES = 8;
constexpr int N_LAUNCHES = MK_N_LAUNCHES;

constexpr int ROWB = 1536;
constexpr int S = 8192, D = 2048, NIN = 5120, DC = 1024, NE = 16384, NPAIR = 128;
constexpr int HROWB = ROWB / 2;
constexpr int HALF_TAB = NE * HROWB;
constexpr float LN_EPS = 1e-5f;
constexpr float ALPHA = 1.189207115002721f;

constexpr size_t MiB = 1u << 20;
constexpr size_t WS_CTL = 0, CTL_ZERO_BYTES = 64 * 1024;
constexpr size_t WS_XB = 2 * MiB;
constexpr size_t WS_BT1 = 34 * MiB;
constexpr size_t WS_BT2 = 54 * MiB;
constexpr size_t WS_BT3 = 62 * MiB;
constexpr size_t WS_AGLU = 70 * MiB;
constexpr size_t WS_CV = 86 * MiB;
constexpr size_t WS_SCB = 102 * MiB;
constexpr size_t WS_MIX = 118 * MiB;
constexpr size_t WS_Y = 150 * MiB;
constexpr size_t WS_X1 = 214 * MiB;
constexpr size_t WS_S = 246 * MiB;
constexpr size_t WS_IDX = 310 * MiB;
constexpr size_t WS_GV = 314 * MiB;
constexpr size_t WS_SU = 318 * MiB;
constexpr size_t WS_U8 = 322 * MiB;
constexpr size_t WS_V8 = 354 * MiB;
constexpr size_t WS_USC = 386 * MiB;
constexpr size_t WS_VSC = 386 * MiB + 65536;
constexpr size_t WS_STAT = 386 * MiB + 131072;
constexpr size_t WS_C12 = 386 * MiB + 262144;
constexpr size_t WS_END = 387 * MiB;
constexpr int CW_BAR = 4096;

constexpr int RING_OFF = 0, RING_BYTES = 131072;
constexpr int LDSCTL_OFF = RING_BYTES, MISC_OFF = LDSCTL_OFF + 320;
constexpr int LNP_OFF = MISC_OFF + 128;
constexpr int LN2G_OFF = 122880;
constexpr int LDS_BYTES = 163840;

#define GAS __attribute__((address_space(1)))
#define LAS __attribute__((address_space(3)))
typedef unsigned short bf16;
typedef unsigned v4u __attribute__((ext_vector_type(4)));
typedef unsigned v2u __attribute__((ext_vector_type(2)));
typedef float f32x4 __attribute__((ext_vector_type(4)));
typedef float f32x2 __attribute__((ext_vector_type(2)));
typedef short bf16x8 __attribute__((ext_vector_type(8)));
typedef GAS unsigned gu32;
#define LDS_WAIT() asm volatile("s_waitcnt lgkmcnt(0)" ::: "memory")
#define VM_WAIT() asm volatile("s_waitcnt vmcnt(0)" ::: "memory")
__device__ __forceinline__ unsigned pk2(float lo, float hi) {
    typedef __bf16 bf16x2_t __attribute__((ext_vector_type(2)));
    const f32x2 v = (f32x2){lo, hi};
    const bf16x2_t h = __builtin_convertvector(v, bf16x2_t);
    return __builtin_bit_cast(unsigned, h);
}
__device__ __forceinline__ float bf_lo(unsigned w) { return __uint_as_float(w << 16); }
__device__ __forceinline__ float bf_hi(unsigned w) { return __uint_as_float(w & 0xffff0000u); }
__device__ __forceinline__ float wave_sum(float v) {
#pragma unroll
    for (int o = 1; o < 64; o <<= 1) v += __shfl_xor(v, o);
    return v;
}
__device__ __forceinline__ float wave_max(float v) {
#pragma unroll
    for (int o = 1; o < 64; o <<= 1) v = fmaxf(v, __shfl_xor(v, o));
    return v;
}

#define XB_TMO      128
#define XB_XCNT(j)  (256  + 64 * (j))
#define XB_XSUB(j)  (1280 + 64 * (j))
#define XB_XGEN(j)  (2304 + 64 * (j))
#define XB_TOP      3328
#define XB_TOPGEN   3392
#define XCD_BAR_WORDS 3456
#define XB_SPIN_CAP (1u << 18)

__device__ __forceinline__ unsigned xb_ld(unsigned* p)              { return __hip_atomic_load(p, __ATOMIC_RELAXED, __HIP_MEMORY_SCOPE_AGENT); }
__device__ __forceinline__ unsigned xb_add(unsigned* p, unsigned v) { return __hip_atomic_fetch_add(p, v, __ATOMIC_RELAXED, __HIP_MEMORY_SCOPE_AGENT); }
__device__ __forceinline__ unsigned xb_xcc_id() { return (unsigned)__builtin_amdgcn_s_getreg((3 << 11) | 20) & 0xFu; }
#define XB_SPIN(cond, bar) do { unsigned _sp = 0; while (cond) { __builtin_amdgcn_s_sleep(1); \
    if ((++_sp & 255u) == 0u) { if (xb_ld(&(bar)[XB_TMO])) break; if (_sp > XB_SPIN_CAP) { atomicAdd(&(bar)[XB_TMO], 1u); break; } } } } while (0)

struct XcdBarrier {
    unsigned* bar; unsigned x;
    volatile LAS unsigned* st;
};

__device__ __forceinline__ XcdBarrier xcd_barrier_post(unsigned* bar, volatile LAS unsigned* st) {
    XcdBarrier b; b.bar = bar; b.x = xb_xcc_id(); b.st = st;
    if (threadIdx.x == 0) (void)xb_add(&bar[XB_XCNT(b.x)], 1u);
    return b;
}
__device__ __forceinline__ void xcd_barrier_complete(unsigned* bar, unsigned x, unsigned& nloc, unsigned& nx) {
    const unsigned G = gridDim.x * gridDim.y * gridDim.z;
    unsigned sum, cnt, mine, sp = 0u;
    for (;;) {
        sum = 0u; cnt = 0u; mine = 0u;
#pragma unroll
        for (unsigned j = 0; j < 16; ++j) { const unsigned c = xb_ld(&bar[XB_XCNT(j)]); sum += c; cnt += (c > 0u) ? 1u : 0u; mine = (j == x) ? c : mine; }
        if (sum == G) break;
        __builtin_amdgcn_s_sleep(1);
        if ((++sp & 255u) == 0u) { if (xb_ld(&bar[XB_TMO])) break; if (sp > XB_SPIN_CAP) { atomicAdd(&bar[XB_TMO], 1u); break; } }
    }
    nloc = mine > 0u ? mine : 1u; nx = cnt > 0u ? cnt : 1u;
}

__device__ __forceinline__ void xcd_barrier(const XcdBarrier& b) {
    asm volatile("s_waitcnt vmcnt(0)" ::: "memory");
    __syncthreads();
    if (threadIdx.x == 0) {
        unsigned* bar = b.bar;
        __builtin_amdgcn_s_waitcnt(0);
        unsigned nloc = b.st[0], nx = b.st[1];
        if (nloc == 0u) { xcd_barrier_complete(bar, b.x, nloc, nx); b.st[0] = nloc; b.st[1] = nx; }
        const unsigned old = xb_add(&bar[XB_XSUB(b.x)], 1u);
        const unsigned gen = old / nloc;
        if (old + 1u == (gen + 1u) * nloc) {
            __builtin_amdgcn_fence(__ATOMIC_RELEASE, "agent");
            asm volatile("s_waitcnt vmcnt(0)" ::: "memory");
            const unsigned og = xb_add(&bar[XB_TOP], 1u);
            const unsigned tg = og / nx;
            if (og + 1u == (tg + 1u) * nx) xb_add(&bar[XB_TOPGEN], 1u);
            else XB_SPIN(xb_ld(&bar[XB_TOPGEN]) == tg, bar);
            __builtin_amdgcn_fence(__ATOMIC_ACQUIRE, "agent");
            xb_add(&bar[XB_XGEN(b.x)], 1u);
            asm volatile("s_waitcnt vmcnt(0)" ::: "memory");
        } else {
            XB_SPIN(xb_ld(&bar[XB_XGEN(b.x)]) == gen, bar);
            __builtin_amdgcn_fence(__ATOMIC_ACQUIRE, "agent");
            asm volatile("s_waitcnt vmcnt(0)" ::: "memory");
        }
    }
    __syncthreads();
}

struct Frame {
    LAS unsigned char* lds;
    volatile LAS unsigned* MISC;
    gu32* ctl;
    int tid, lane, wave, vcu, G;
    const float *x, *w_in, *b_in, *ccw, *ccb, *clg, *clb, *scw, *scbias, *w_out, *b_out, *ln1g, *ln1b, *w_q, *sub_keys, *peer_u, *peer_v, *ln2g, *ln2b;
    float* out;
    bf16 *XB, *BT1, *BT2, *BT3, *AGLU, *CV, *SCB, *MIX, *X1;
    bf16* Y; float* SS; int* IDX; float *STAT, *C12; float *GV, *SU; unsigned char *U8, *V8; float *USC, *VSC;
};

__device__ __forceinline__ int bt1_row(int n0) {
    const int grp = n0 >> 10, c = n0 & 1023, j = c >> 7, r = c & 127;
    if (grp == 0) return 256 * j + r;
    if (grp == 1) return 256 * j + 128 + r;
    if (grp == 2) return 4096 + c;
    if (grp == 3) return 2048 + 256 * j + r;
    return 2048 + 256 * j + 128 + r;
}
template <bool PERM_IN>
__device__ __forceinline__ void p0_transpose_item(const float* W, int K, int N, bf16* WT, LAS float* scr, int item, int lane) {
    const int nblk = N / 32, kb = item / nblk, nb = item % nblk, k0 = 64 * kb, n0 = 32 * nb;
    const int drow = PERM_IN ? bt1_row(n0) : n0;
    float tv[32];
#pragma unroll
    for (int i = 0; i < 32; ++i) { const int kk = 2 * i + (lane >> 5); tv[i] = __builtin_nontemporal_load(W + (size_t)(k0 + kk) * N + n0 + (lane & 31)); }
#pragma unroll
    for (int i = 0; i < 32; ++i) { const int kk = 2 * i + (lane >> 5); scr[kk * 33 + (lane & 31)] = tv[i]; }
    LDS_WAIT(); asm volatile("" ::: "memory");
    const int c = lane & 7;
#pragma unroll
    for (int j = 0; j < 4; ++j) { const int n = (lane >> 3) + 8 * j; const LAS float* s = scr + (8 * c) * 33 + n;
        v4u o; o.x = pk2(s[0 * 33], s[1 * 33]); o.y = pk2(s[2 * 33], s[3 * 33]); o.z = pk2(s[4 * 33], s[5 * 33]); o.w = pk2(s[6 * 33], s[7 * 33]);
        *(GAS v4u*)(WT + (size_t)(drow + n) * K + k0 + 8 * c) = o; }
    LDS_WAIT(); asm volatile("" ::: "memory");
}
__device__ __forceinline__ bf16x8 ld8_bf16(const float* p) {
    typedef float f32x8_t __attribute__((ext_vector_type(8))); typedef __bf16 bf16x8_t __attribute__((ext_vector_type(8)));
    const f32x4 a = *(const f32x4*)p, b = *(const f32x4*)(p + 4);
    f32x8_t v; v[0] = a.x; v[1] = a.y; v[2] = a.z; v[3] = a.w; v[4] = b.x; v[5] = b.y; v[6] = b.z; v[7] = b.w;
    const bf16x8_t h = __builtin_convertvector(v, bf16x8_t);
    return __builtin_bit_cast(bf16x8, h);
}
__device__ __forceinline__ unsigned fp6_encode(float y) {
    const unsigned sb = (__float_as_uint(y) >> 31) << 5;
    const float a = fabsf(y);
    const unsigned sub = (unsigned)__builtin_rintf(a * 8.0f);
    unsigned b = __float_as_uint(a); b += 0x7FFFFu + ((b >> 20) & 1u); b >>= 20;
    unsigned nrm = b - 1008u; nrm = nrm > 31u ? 31u : nrm;
    return sb | (a < 1.0f ? sub : nrm);
}
__device__ __forceinline__ void p0_prologue(Frame& F) {
    LAS float* scr = (LAS float*)(F.lds + RING_OFF + F.wave * 16384);
    const int gw = F.vcu * NWAVES + F.wave, NGW = F.G * NWAVES, lane = F.lane;
#ifndef PROBE_P0SEC
#define PROBE_P0SEC 0
#endif
#define P0T0(k) const unsigned long long t0_##k = (PROBE_P0SEC == (k)) ? __builtin_amdgcn_s_memrealtime() : 0ull
#define P0T1(k) do { if (PROBE_P0SEC == (k)) { const unsigned long long te_ = __builtin_amdgcn_s_memrealtime(); while (__builtin_amdgcn_s_memrealtime() - te_ < te_ - t0_##k) __builtin_amdgcn_s_sleep(8); } } while (0)
    P0T0(1);
    constexpr int I_IN = (D / 64) * (NIN / 32), I_OUT = (D / 64) * (D / 32);
    for (int it = gw; it < I_IN + I_OUT; it += NGW) {
        if (it < I_IN) p0_transpose_item<true>(F.w_in, D, NIN, F.BT1, scr, it, lane);
        else p0_transpose_item<false>(F.w_out, D, D, F.BT2, scr, it - I_IN, lane);
    }
    P0T1(1); P0T0(2);
    for (int it = gw; it < 2048; it += NGW) {
        const int hp = it >> 7, db = (it >> 2) & 31, nq = it & 3, d0 = db * 64;
        const float* wq = F.w_q + (size_t)(d0 + (lane & 15)) * 2048 + hp * 128 + 8 * (lane >> 4);
        bf16x8 xf[4][4];
#pragma unroll
        for (int dt = 0; dt < 4; ++dt)
#pragma unroll
            for (int ks = 0; ks < 4; ++ks) xf[dt][ks] = ld8_bf16(wq + (size_t)dt * 16 * 2048 + 32 * ks);
#pragma unroll
        for (int nb = 2 * nq; nb < 2 * nq + 2; ++nb) {
            const int n0 = nb * 16;
            const float* sk = F.sub_keys + ((size_t)hp * 128 + n0 + (lane & 15)) * 128 + 8 * (lane >> 4);
            bf16x8 yf[4];
#pragma unroll
            for (int ks = 0; ks < 4; ++ks) yf[ks] = ld8_bf16(sk + 32 * ks);
            f32x4 acc[4];
#pragma unroll
            for (int dt = 0; dt < 4; ++dt) { acc[dt] = (f32x4){0.f, 0.f, 0.f, 0.f};
#pragma unroll
                for (int ks = 0; ks < 4; ++ks) acc[dt] = __builtin_amdgcn_mfma_f32_16x16x32_bf16(xf[dt][ks], yf[ks], acc[dt], 0, 0, 0); }
            bf16* orow = F.BT3 + (size_t)(hp * 128 + n0 + (lane & 15)) * 2048 + d0 + 4 * (lane >> 4);
#pragma unroll
            for (int dt = 0; dt < 4; ++dt) { v2u o; o.x = pk2(acc[dt][0], acc[dt][1]); o.y = pk2(acc[dt][2], acc[dt][3]); *(GAS v2u*)(orow + 16 * dt) = o; }
        }
    }
    P0T1(2); P0T0(3);
    for (int i = gw * 64 + lane; i < 2 * S / 4; i += NGW * 64) ((GAS f32x4*)F.STAT)[i] = (f32x4){0.f, 0.f, 0.f, 0.f};
    for (int r = gw; r < S; r += 2 * NGW) {
        const int r2 = r + NGW < S ? r + NGW : r;
        const GAS f32x4* s0 = (const GAS f32x4*)(F.x + (size_t)r * D) + 2 * lane; const GAS f32x4* s1 = (const GAS f32x4*)(F.x + (size_t)r2 * D) + 2 * lane;
        f32x4 v0[8], v1[8];
#pragma unroll
        for (int j = 0; j < 4; ++j) { v0[2 * j] = __builtin_nontemporal_load(s0 + 128 * j); v0[2 * j + 1] = __builtin_nontemporal_load(s0 + 128 * j + 1); v1[2 * j] = __builtin_nontemporal_load(s1 + 128 * j); v1[2 * j + 1] = __builtin_nontemporal_load(s1 + 128 * j + 1); }
        GAS v4u* d0 = (GAS v4u*)(F.XB + (size_t)r * D) + lane; GAS v4u* d1 = (GAS v4u*)(F.XB + (size_t)r2 * D) + lane;
#pragma unroll
        for (int j = 0; j < 4; ++j) { const f32x4 p0 = v0[2 * j], p1 = v0[2 * j + 1], q0 = v1[2 * j], q1 = v1[2 * j + 1];
            v4u o; o.x = pk2(p0.x, p0.y); o.y = pk2(p0.z, p0.w); o.z = pk2(p1.x, p1.y); o.w = pk2(p1.z, p1.w); d0[64 * j] = o;
            v4u o2; o2.x = pk2(q0.x, q0.y); o2.y = pk2(q0.z, q0.w); o2.z = pk2(q1.x, q1.y); o2.w = pk2(q1.z, q1.w); d1[64 * j] = o2; }
    }
    P0T1(3);
}
__device__ __forceinline__ void p0_encode_row(Frame& F, const f32x4 (&v)[8], int r, int lane) {
    const bool isv = r >= NE; const int e = isv ? r - NE : r;
    float am = 0.f;
#pragma unroll
    for (int j = 0; j < 8; ++j) am = fmaxf(am, fmaxf(fmaxf(fabsf(v[j].x), fabsf(v[j].y)), fmaxf(fabsf(v[j].z), fabsf(v[j].w))));
    am = wave_max(am);
    const float sc = am > 0.f ? 7.5f / am : 1.f, inv = am > 0.f ? am / 7.5f : 1.f;
    typedef float f32x16 __attribute__((ext_vector_type(16))); typedef unsigned u32x6v __attribute__((ext_vector_type(6)));
    f32x16 lo16, hi16;
#pragma unroll
    for (int i = 0; i < 16; ++i) {
        lo16[i] = v[(2 * i) >> 2][(2 * i) & 3] * sc; hi16[i] = v[(2 * i + 1) >> 2][(2 * i + 1) & 3] * sc;
    }
    const u32x6v pk = __builtin_amdgcn_cvt_scalef32_2xpk16_fp6_f32(lo16, hi16, 1.0f);
    unsigned w[6];
#pragma unroll
    for (int i = 0; i < 6; ++i) w[i] = pk[i];
    unsigned char* dst = (isv ? F.V8 : F.U8) + (size_t)(lane >> 5) * HALF_TAB + (size_t)e * HROWB + 384 * ((lane >> 4) & 1);
    __builtin_nontemporal_store((v4u){w[0], w[1], w[2], w[3]}, (GAS v4u*)(dst + 16 * (lane & 15))); __builtin_nontemporal_store((v2u){w[4], w[5]}, (GAS v2u*)(dst + 256 + 8 * (lane & 15)));
    if (lane == 0) (isv ? F.VSC : F.USC)[e] = inv;
}
__device__ __forceinline__ void p0_load_row(Frame& F, f32x4 (&v)[8], int r, int lane) {
    const int rc = r < 2 * NE ? r : 2 * NE - 1;
    const GAS f32x4* src = (const GAS f32x4*)((rc >= NE ? F.peer_v : F.peer_u) + (size_t)(rc >= NE ? rc - NE : rc) * D) + lane;
#pragma unroll
    for (int j = 0; j < 8; ++j) v[j] = __builtin_nontemporal_load(src + 64 * j);
}
__device__ __forceinline__ void p0_peer_tables(Frame& F, int wid, int nw) {
    const int lane = F.lane;
    f32x4 na[8], nb[8], ma[8], mb[8];
    p0_load_row(F, na, wid, lane); p0_load_row(F, nb, wid + nw, lane); p0_load_row(F, ma, wid + 2 * nw, lane); p0_load_row(F, mb, wid + 3 * nw, lane);
#pragma unroll 1
    for (int r = wid; r < 2 * NE; r += 4 * nw) {
        p0_encode_row(F, na, r, lane); p0_load_row(F, na, r + 4 * nw, lane);
        if (r + nw < 2 * NE) p0_encode_row(F, nb, r + nw, lane);
        p0_load_row(F, nb, r + 5 * nw, lane);
        if (r + 2 * nw < 2 * NE) p0_encode_row(F, ma, r + 2 * nw, lane);
        p0_load_row(F, ma, r + 6 * nw, lane);
        if (r + 3 * nw < 2 * NE) p0_encode_row(F, mb, r + 3 * nw, lane);
        p0_load_row(F, mb, r + 7 * nw, lane);
    }
}

__device__ __forceinline__ float dpp_add(float v, int ctrl_sel) {
    int m;
    if (ctrl_sel == 0) m = __builtin_amdgcn_update_dpp(0, __float_as_int(v), 0x111, 0xf, 0xf, false);
    else if (ctrl_sel == 1) m = __builtin_amdgcn_update_dpp(0, __float_as_int(v), 0x112, 0xf, 0xf, false);
    else if (ctrl_sel == 2) m = __builtin_amdgcn_update_dpp(0, __float_as_int(v), 0x114, 0xf, 0xf, false);
    else if (ctrl_sel == 3) m = __builtin_amdgcn_update_dpp(0, __float_as_int(v), 0x118, 0xf, 0xf, false);
    else if (ctrl_sel == 4) m = __builtin_amdgcn_update_dpp(0, __float_as_int(v), 0x142, 0xa, 0xf, false);
    else m = __builtin_amdgcn_update_dpp(0, __float_as_int(v), 0x143, 0xc, 0xf, false);
    return v + __int_as_float(m);
}
__device__ __forceinline__ float wave_sum_lane63(float v) {
    v = dpp_add(v, 0); v = dpp_add(v, 1); v = dpp_add(v, 2); v = dpp_add(v, 3); v = dpp_add(v, 4); v = dpp_add(v, 5); return v;
}
__device__ __forceinline__ void p2_unit(Frame& F, int unit) {
    const int t0 = unit * 32, tid_in = F.tid, lane = F.lane;
    LAS unsigned char* abuf = F.lds + RING_OFF;
    LAS float* stat = (LAS float*)(F.lds + LNP_OFF);
    {
        int tid = tid_in; asm volatile("" : "+v"(tid));
#pragma unroll
        for (int h = 0; h < 2; ++h) {
            v4u st[8];
#pragma unroll
            for (int k = 8 * h; k < 8 * h + 8; ++k) { const int c = tid + 512 * k; int cc = c < 62 * 128 ? c : 62 * 128 - 1; cc = (t0 - 30) * 128 + cc < 0 ? (30 - t0) * 128 : cc;
                st[k - 8 * h] = __builtin_nontemporal_load((const GAS v4u*)F.AGLU + (size_t)((t0 - 30) * 128 + cc)); }
#pragma unroll
            for (int k = 8 * h; k < 8 * h + 8; ++k) { const int c = tid + 512 * k; const bool ok = (t0 - 30) * 128 + c >= 0;
                const v4u v = ok ? st[k - 8 * h] : (v4u){0u, 0u, 0u, 0u};
                if (k < 15 || tid < 62 * 128 - 512 * 15) *(LAS v4u*)(abuf + 16 * c) = v; }
            asm volatile("" ::: "memory");
        }
    }
    asm volatile("" ::: "memory"); __builtin_amdgcn_sched_barrier(0);
    {
        int tid = tid_in; asm volatile("" : "+v"(tid));
        const int cg = tid & 127, tg = tid >> 7, tb = t0 + 8 * tg;
        float w0[8], w1[8], w2[8], bs[8];
#pragma unroll
        for (int h = 0; h < 2; ++h) { const f32x4 a = *(const GAS f32x4*)(F.scw + 8 * cg + 4 * h), b = *(const GAS f32x4*)(F.scw + 1024 + 8 * cg + 4 * h), c = *(const GAS f32x4*)(F.scw + 2048 + 8 * cg + 4 * h), d = *(const GAS f32x4*)(F.scbias + 8 * cg + 4 * h);
#pragma unroll
            for (int q = 0; q < 4; ++q) { w0[4 * h + q] = a[q]; w1[4 * h + q] = b[q]; w2[4 * h + q] = c[q]; bs[4 * h + q] = d[q]; } }
        v4u cvr[10], gtr[8];
#pragma unroll
        for (int i = 0; i < 10; ++i) { const int t = tb - 2 + i, tc = t < 0 ? 0 : t; const v4u v = __builtin_nontemporal_load((const GAS v4u*)(F.CV + (size_t)tc * 1024 + 8 * cg)); cvr[i] = t < 0 ? (v4u){0u, 0u, 0u, 0u} : v; }
#pragma unroll
        for (int i = 0; i < 4; ++i) gtr[i] = __builtin_nontemporal_load((const GAS v4u*)(F.SCB + (size_t)(tb + i) * 1024 + 8 * cg));
#pragma unroll
        for (int tt = 0; tt < 8; ++tt) {
            if (tt == 3) {
#pragma unroll
                for (int i = 4; i < 8; ++i) gtr[i] = __builtin_nontemporal_load((const GAS v4u*)(F.SCB + (size_t)(tb + i) * 1024 + 8 * cg)); }
            v4u o;
#pragma unroll
            for (int q = 0; q < 4; ++q) {
                const unsigned a2 = cvr[tt][q], a1 = cvr[tt + 1][q], a0 = cvr[tt + 2][q], g = gtr[tt][q];
                const float lo = bf_lo(g) * (bs[2 * q] + w0[2 * q] * bf_lo(a2) + w1[2 * q] * bf_lo(a1) + w2[2 * q] * bf_lo(a0));
                const float hi = bf_hi(g) * (bs[2 * q + 1] + w0[2 * q + 1] * bf_hi(a2) + w1[2 * q + 1] * bf_hi(a1) + w2[2 * q + 1] * bf_hi(a0));
                o[q] = pk2(lo, hi);
            }
            *(GAS v4u*)(F.MIX + (size_t)(tb + tt) * 2048 + 1024 + 8 * cg) = o;
        }
    }
    asm volatile("" ::: "memory"); __builtin_amdgcn_sched_barrier(0);
    LDS_WAIT(); __syncthreads();
    {
        int tid = tid_in; asm volatile("" : "+v"(tid)); const int c0 = 2 * tid;
        f32x2 w[31];
#pragma unroll
        for (int k = 0; k < 31; ++k) w[k] = *(const GAS f32x2*)(F.ccw + k * 1024 + c0);
        const f32x2 bias = *(const GAS f32x2*)(F.ccb + c0), lng = *(const GAS f32x2*)(F.clg + c0), lnb = *(const GAS f32x2*)(F.clb + c0);
#pragma unroll 1
        for (int g = 0; g < 4; ++g) {
            f32x2 o[8];
#pragma unroll
            for (int tt = 0; tt < 8; ++tt) o[tt] = bias;
#pragma unroll
            for (int half = 0; half < 2; ++half) {
                constexpr int NR = 23; const int r0 = half ? 16 : 0, k0 = half ? 16 : 0, nk = half ? 15 : 16;
                f32x2 in[NR];
#pragma unroll
                for (int i = 0; i < NR; ++i) { const int row = r0 + i < 38 ? r0 + i : 37; const unsigned raw = *(const LAS unsigned*)(abuf + (8 * g + row) * 2048 + 4 * tid); in[i] = (f32x2){bf_lo(raw), bf_hi(raw)}; }
#pragma unroll
                for (int tt = 0; tt < 8; ++tt)
#pragma unroll
                    for (int k = 0; k < 16; ++k) if (k < nk) o[tt] += w[k0 + k] * in[tt + k + k0 - r0];
                asm volatile("" ::: "memory");
            }
            {
                float a[16];
#pragma unroll
                for (int tt = 0; tt < 8; ++tt) { a[2 * tt] = o[tt].x + o[tt].y; a[2 * tt + 1] = o[tt].x * o[tt].x + o[tt].y * o[tt].y; }
                float b[8];
#pragma unroll
                for (int i = 0; i < 8; ++i) { const v2u sw = __builtin_amdgcn_permlane32_swap(__float_as_uint(a[2 * i]), __float_as_uint(a[2 * i + 1]), false, false); b[i] = __uint_as_float(sw.x) + __uint_as_float(sw.y); }
                float t[4];
#pragma unroll
                for (int i = 0; i < 4; ++i) { const v2u sw = __builtin_amdgcn_permlane16_swap(__float_as_uint(b[2 * i]), __float_as_uint(b[2 * i + 1]), false, false); t[i] = __uint_as_float(sw.x) + __uint_as_float(sw.y); }
#pragma unroll
                for (int i = 0; i < 4; ++i) { t[i] = dpp_add(t[i], 0); t[i] = dpp_add(t[i], 1); t[i] = dpp_add(t[i], 2); t[i] = dpp_add(t[i], 3); }
                if ((lane & 15) == 15) { const int hi = lane >> 5, od = (lane >> 4) & 1;
#pragma unroll
                    for (int i = 0; i < 4; ++i) stat[(2 * (2 * i + od) + hi) * 8 + F.wave] = t[i]; }
            }
            LDS_WAIT(); __syncthreads();
            float tot;
            { const f32x4 a0 = *(const LAS f32x4*)(stat + (lane & 15) * 8), a1 = *(const LAS f32x4*)(stat + (lane & 15) * 8 + 4); tot = ((a0.x + a0.y) + (a0.z + a0.w)) + ((a1.x + a1.y) + (a1.z + a1.w)); }
#pragma unroll
            for (int tt = 0; tt < 8; ++tt) {
                const float mean = __int_as_float(__builtin_amdgcn_readlane(__float_as_int(tot), 2 * tt)) * (1.f / 1024.f);
                const float ex2 = __int_as_float(__builtin_amdgcn_readlane(__float_as_int(tot), 2 * tt + 1)) * (1.f / 1024.f);
                const float rstd = 1.f / sqrtf(fmaxf(ex2 - mean * mean, 0.f) + LN_EPS);
                f32x2 y = (o[tt] - mean) * rstd * lng + lnb;
                y.x *= pg8::sigmoidf_fast(y.x); y.y *= pg8::sigmoidf_fast(y.y);
                *(GAS unsigned*)(F.MIX + (size_t)(t0 + 8 * g + tt) * 2048 + c0) = pk2(y.x, y.y);
            }
            __syncthreads();
        }
    }
}

__device__ __forceinline__ void p1_c12(Frame& F) {
    const int gw = F.vcu * NWAVES + F.wave, NGW = F.G * NWAVES, lane = F.lane;
    for (int n = gw; n < 2048; n += NGW) {
        const GAS v4u* wr = (const GAS v4u*)(F.BT3 + (size_t)n * D) + lane;
        float a = 0.f, b = 0.f;
#pragma unroll
        for (int j = 0; j < 4; ++j) { const v4u w = wr[64 * j]; const int d0 = 8 * lane + 512 * j;
            const f32x4 g0 = *(const GAS f32x4*)(F.ln1g + d0), g1 = *(const GAS f32x4*)(F.ln1g + d0 + 4), b0 = *(const GAS f32x4*)(F.ln1b + d0), b1 = *(const GAS f32x4*)(F.ln1b + d0 + 4);
            a += g0.x * bf_lo(w.x) + g0.y * bf_hi(w.x) + g0.z * bf_lo(w.y) + g0.w * bf_hi(w.y) + g1.x * bf_lo(w.z) + g1.y * bf_hi(w.z) + g1.z * bf_lo(w.w) + g1.w * bf_hi(w.w);
            b += b0.x * bf_lo(w.x) + b0.y * bf_hi(w.x) + b0.z * bf_lo(w.y) + b0.w * bf_hi(w.y) + b1.x * bf_lo(w.z) + b1.y * bf_hi(w.z) + b1.z * bf_lo(w.w) + b1.w * bf_hi(w.w); }
        a = wave_sum(a); b = wave_sum(b);
        if (lane == 0) { F.C12[n] = a; F.C12[2048 + n] = b; }
    }
}

__device__ __forceinline__ int imax_(int a, int b) { return a > b ? a : b; }
__device__ __forceinline__ int imin_(int a, int b) { return a < b ? a : b; }
template <bool DESC> __device__ __forceinline__ void ce_i(int& a, int& b) { const int mx = imax_(a, b), mn = imin_(a, b); a = DESC ? mx : mn; b = DESC ? mn : mx; }
template <bool DESC> __device__ __forceinline__ void sort16_i(int (&v)[16]) {
#pragma unroll
    for (int k = 2; k <= 16; k <<= 1)
#pragma unroll
        for (int j = k >> 1; j > 0; j >>= 1)
#pragma unroll
            for (int i = 0; i < 16; ++i) { const int l = i ^ j; if (l > i) { const bool up = ((i & k) == 0); if (up != DESC) ce_i<false>(v[i], v[l]); else ce_i<true>(v[i], v[l]); } }
}
template <bool DESC> __device__ __forceinline__ void merge16_i(int (&v)[16]) {
#pragma unroll
    for (int j = 8; j > 0; j >>= 1)
#pragma unroll
        for (int i = 0; i < 16; ++i) { const int l = i ^ j; if (l > i) ce_i<DESC>(v[i], v[l]); }
}
template <bool DESC> __device__ __forceinline__ void ce_p(float& a, int& pa, float& b, int& pb) {
    const bool sw = DESC ? (a < b) : (a > b); const float ta = sw ? b : a, tb = sw ? a : b; const int qa = sw ? pb : pa, qb = sw ? pa : pb; a = ta; b = tb; pa = qa; pb = qb; }
template <bool DESC> __device__ __forceinline__ void sort16_p(float (&v)[16], int (&p)[16]) {
#pragma unroll
    for (int k = 2; k <= 16; k <<= 1)
#pragma unroll
        for (int j = k >> 1; j > 0; j >>= 1)
#pragma unroll
            for (int i = 0; i < 16; ++i) { const int l = i ^ j; if (l > i) { const bool up = ((i & k) == 0); if (up != DESC) ce_p<false>(v[i], p[i], v[l], p[l]); else ce_p<true>(v[i], p[i], v[l], p[l]); } }
}
template <bool DESC> __device__ __forceinline__ void merge16_p(float (&v)[16], int (&p)[16]) {
#pragma unroll
    for (int j = 8; j > 0; j >>= 1)
#pragma unroll
        for (int i = 0; i < 16; ++i) { const int l = i ^ j; if (l > i) ce_p<DESC>(v[i], p[i], v[l], p[l]); }
}
__device__ __forceinline__ int f2key(float f) { const int b = __float_as_int(f); return b ^ ((b >> 31) & 0x7fffffff); }
__device__ __forceinline__ float key2f(int k) { return __int_as_float(k ^ ((k >> 31) & 0x7fffffff)); }

__device__ __forceinline__ void topk_chunk(int (&top)[16], const f32x4 (&r)[4], int c, bool first) {
    int nw[16];
#pragma unroll
    for (int q = 0; q < 4; ++q)
#pragma unroll
        for (int e = 0; e < 4; ++e) nw[4 * q + e] = (f2key(r[q][e]) & ~127) | (16 * c + 4 * q + e);
    if (first) { sort16_i<true>(nw);
#pragma unroll
        for (int i = 0; i < 16; ++i) top[i] = nw[i];
    } else { sort16_i<false>(nw);
#pragma unroll
        for (int i = 0; i < 16; ++i) top[i] = imax_(top[i], nw[i]);
        merge16_i<true>(top); }
}
__device__ __forceinline__ void topk_stage2(const int (&ka)[16], const int (&kb)[16], bool odd, int (&oe)[8], float (&og)[8]) {
    float Av[16], Bv[16]; int Ai[16], Bi[16];
#pragma unroll
    for (int i = 0; i < 16; ++i) { Av[i] = key2f(ka[i] & ~127); Ai[i] = ka[i] & 127; Bv[i] = key2f(kb[i] & ~127); Bi[i] = kb[i] & 127; }
    float tv[16]; int tp[16];
#pragma unroll
    for (int j = 0; j < 16; ++j) { tv[j] = Av[0] + Bv[j]; tp[j] = Ai[0] * 128 + Bi[j]; }
    {
        float nv[16]; int np[16];
#pragma unroll
        for (int j = 0; j < 8; ++j) { nv[j] = Av[1] + Bv[j]; np[j] = Ai[1] * 128 + Bi[j]; }
#pragma unroll
        for (int j = 0; j < 5; ++j) { nv[8 + j] = Av[2] + Bv[j]; np[8 + j] = Ai[2] * 128 + Bi[j]; }
#pragma unroll
        for (int j = 0; j < 3; ++j) { nv[13 + j] = Av[3] + Bv[j]; np[13 + j] = Ai[3] * 128 + Bi[j]; }
        sort16_p<false>(nv, np);
#pragma unroll
        for (int i = 0; i < 16; ++i) { const bool g = nv[i] > tv[i]; tv[i] = g ? nv[i] : tv[i]; tp[i] = g ? np[i] : tp[i]; }
        merge16_p<true>(tv, tp);
    }
    {
        float nv[16]; int np[16];
        nv[0] = Av[3] + Bv[3]; np[0] = Ai[3] * 128 + Bi[3];
#pragma unroll
        for (int j = 0; j < 3; ++j) { nv[1 + j] = Av[4] + Bv[j]; np[1 + j] = Ai[4] * 128 + Bi[j]; }
#pragma unroll
        for (int i = 5; i < 8; ++i)
#pragma unroll
            for (int j = 0; j < 2; ++j) { nv[4 + 2 * (i - 5) + j] = Av[i] + Bv[j]; np[4 + 2 * (i - 5) + j] = Ai[i] * 128 + Bi[j]; }
#pragma unroll
        for (int i = 8; i < 14; ++i) { nv[10 + i - 8] = Av[i] + Bv[0]; np[10 + i - 8] = Ai[i] * 128 + Bi[0]; }
        sort16_p<false>(nv, np);
#pragma unroll
        for (int i = 0; i < 16; ++i) { const bool g = nv[i] > tv[i]; tv[i] = g ? nv[i] : tv[i]; tp[i] = g ? np[i] : tp[i]; }
        merge16_p<true>(tv, tp);
    }
    {
        const float hi = Av[14] + Bv[0], lo = Av[15] + Bv[0]; const int phi = Ai[14] * 128 + Bi[0], plo = Ai[15] * 128 + Bi[0];
        const float t14 = tv[14], t15 = tv[15]; const int q14 = tp[14], q15 = tp[15];
        const bool g14 = lo > t14, g15 = hi > t15;
        tv[14] = g14 ? lo : t14; tp[14] = g14 ? plo : q14; tv[15] = g15 ? hi : t15; tp[15] = g15 ? phi : q15;
    }
    float mx = tv[0];
#pragma unroll
    for (int i = 1; i < 16; ++i) mx = fmaxf(mx, tv[i]);
    float sum = 0.f;
#pragma unroll
    for (int i = 0; i < 16; ++i) { tv[i] = __expf(tv[i] - mx); sum += tv[i]; }
    const float rs = 1.f / sum;
#pragma unroll
    for (int k = 0; k < 8; ++k) { const int pa = tp[k], pb = tp[8 + k]; const float va = tv[k], vb = tv[8 + k]; oe[k] = odd ? pb : pa; og[k] = (odd ? vb : va) * rs; }
}
struct EpiScoreTopk {
    static constexpr bool PERM = false, AFTER_DRAIN = true;
    const float* stat; const float* c12; float eps; int* IDX; float* GV; float* SU; const float* USC; const float* VSC;
    __device__ __forceinline__ void fused(f32x4 (&acc)[2][2][4][2], const pg8::Unit& u, int wr, int wc, int fr, int fq, LAS unsigned char* lds, int wid, int lane) const {
        {
            const int row0 = u.pm * 256 + wr * 64 + fr, col0 = u.pn * 256 + wc * 32 + 4 * fq;
            f32x4 c1v[2][2], c2v[2][2];
#pragma unroll
            for (int bj = 0; bj < 2; ++bj)
#pragma unroll
                for (int n = 0; n < 2; ++n) { c1v[bj][n] = *(const f32x4*)(c12 + col0 + bj * 128 + n * 16); c2v[bj][n] = *(const f32x4*)(c12 + 2048 + col0 + bj * 128 + n * 16); }
#pragma unroll
            for (int ai = 0; ai < 2; ++ai)
#pragma unroll
                for (int m = 0; m < 4; ++m) { const int row = row0 + ai * 128 + m * 16;
                    const float s1 = stat[2 * row], s2 = stat[2 * row + 1];
                    const float mean = s1 * (1.0f / 2048.0f), var = fmaxf(s2 * (1.0f / 2048.0f) - mean * mean, 0.f), rstd = 1.0f / sqrtf(var + eps);
#pragma unroll
                    for (int bj = 0; bj < 2; ++bj)
#pragma unroll
                        for (int n = 0; n < 2; ++n) acc[ai][bj][m][n] = (acc[ai][bj][m][n] - c1v[bj][n] * mean) * rstd + c2v[bj][n]; }
        }
        const int tid = wid * 64 + lane, prow = tid & 255, phalf = tid >> 8;
        int tA[16], tB[16];
#pragma unroll
        for (int bj = 0; bj < 2; ++bj) {
#pragma unroll
            for (int ai = 0; ai < 2; ++ai)
#pragma unroll
                for (int m = 0; m < 4; ++m)
#pragma unroll
                    for (int n = 0; n < 2; ++n) { const int r = ai * 128 + wr * 64 + m * 16 + fr, c = wc * 32 + n * 16 + 4 * fq;
                        *(LAS f32x4*)(lds + (r * 128 + (c ^ ((r & 31) << 2))) * 4) = acc[ai][bj][m][n]; }
            LDS_WAIT(); __syncthreads();
#pragma unroll
            for (int c = 0; c < 4; ++c) { f32x4 rr[4];
#pragma unroll
                for (int q = 0; q < 4; ++q) rr[q] = *(const LAS f32x4*)(lds + (prow * 128 + ((64 * phalf + 16 * c + 4 * q) ^ ((prow & 31) << 2))) * 4);
                if (bj == 0) topk_chunk(tA, rr, 4 * phalf + c, c == 0); else topk_chunk(tB, rr, 4 * phalf + c, c == 0); }
            __syncthreads();
        }
        LAS int* xk = (LAS int*)lds;
        int top[16], oth[16];
#pragma unroll
        for (int i = 0; i < 16; ++i) { const int a = tA[i], b = tB[i]; top[i] = phalf ? b : a; oth[i] = phalf ? a : b; }
#pragma unroll
        for (int i = 0; i < 16; i += 4) *(LAS v4u*)(xk + tid * 16 + i) = (v4u){(unsigned)oth[i], (unsigned)oth[i + 1], (unsigned)oth[i + 2], (unsigned)oth[i + 3]};
        LDS_WAIT(); __syncthreads();
#pragma unroll
        for (int i = 0; i < 16; i += 4) { const v4u w = *(const LAS v4u*)(xk + (tid ^ 256) * 16 + i); oth[i] = (int)w.x; oth[i + 1] = (int)w.y; oth[i + 2] = (int)w.z; oth[i + 3] = (int)w.w; }
#pragma unroll
        for (int i = 0; i < 16; ++i) top[i] = imax_(top[i], oth[15 - i]);
        merge16_i<true>(top);
        __syncthreads();
#pragma unroll
        for (int i = 0; i < 16; i += 4) *(LAS v4u*)(xk + tid * 16 + i) = (v4u){(unsigned)top[i], (unsigned)top[i + 1], (unsigned)top[i + 2], (unsigned)top[i + 3]};
        LDS_WAIT(); __syncthreads();
#pragma unroll
        for (int i = 0; i < 16; i += 4) { const v4u w = *(const LAS v4u*)(xk + (tid ^ 256) * 16 + i); oth[i] = (int)w.x; oth[i + 1] = (int)w.y; oth[i + 2] = (int)w.z; oth[i + 3] = (int)w.w; }
        const bool odd = phalf != 0;
        int ka[16], kb[16];
#pragma unroll
        for (int i = 0; i < 16; ++i) { const int mine = top[i], other = oth[i]; ka[i] = odd ? other : mine; kb[i] = odd ? mine : other; }
        int oe[8]; float og[8];
        topk_stage2(ka, kb, odd, oe, og);
        float ov[8], ou[8];
#pragma unroll
        for (int k = 0; k < 8; ++k) { ov[k] = og[k] * VSC[oe[k]]; ou[k] = USC[oe[k]]; }
        const size_t ob = (size_t)(u.pm * 256 + prow) * NPAIR + (2 * u.pn + phalf) * 8;
        *(GAS v4u*)(IDX + ob) = (v4u){(unsigned)oe[0], (unsigned)oe[1], (unsigned)oe[2], (unsigned)oe[3]};
        *(GAS v4u*)(IDX + ob + 4) = (v4u){(unsigned)oe[4], (unsigned)oe[5], (unsigned)oe[6], (unsigned)oe[7]};
        *(GAS f32x4*)(GV + ob) = (f32x4){ov[0], ov[1], ov[2], ov[3]};
        *(GAS f32x4*)(GV + ob + 4) = (f32x4){ov[4], ov[5], ov[6], ov[7]};
        *(GAS f32x4*)(SU + ob) = (f32x4){ou[0], ou[1], ou[2], ou[3]};
        *(GAS f32x4*)(SU + ob + 4) = (f32x4){ou[4], ou[5], ou[6], ou[7]};
    }
};

constexpr int NPFU = 8, NPFV = 4;
constexpr int TAB_V_OFS = (int)(WS_V8 - WS_U8);
constexpr int P7_SKEYS = 528;
constexpr int P7_WBYTES = 4 * (P7_SKEYS + 3 * 512);
static_assert(NWAVES * P7_WBYTES <= LN2G_OFF, "PEER phase LDS map");
typedef unsigned u32x6 __attribute__((ext_vector_type(6)));
typedef float f32x32 __attribute__((ext_vector_type(32)));
typedef __bf16 bf16x32 __attribute__((ext_vector_type(32)));
typedef __bf16 bf16x2 __attribute__((ext_vector_type(2)));
__device__ __forceinline__ float gelu_erf(float z) { return 0.5f * z * (1.0f + erff(z * 0.70710678118654752f)); }
__device__ __forceinline__ void p7_sort512(int (&key)[8], int lane) {
#pragma unroll
    for (int k = 2; k <= 512; k <<= 1) {
#pragma unroll
        for (int j = k >> 1; j > 0; j >>= 1) {
            if (j >= 64) {
                const int jr = j >> 6;
#pragma unroll
                for (int r = 0; r < 8; ++r) if ((r & jr) == 0) { const int rp = r | jr; const bool asc = ((64 * r) & k) == 0;
                    const int a = key[r], b = key[rp], mn = imin_(a, b), mx = imax_(a, b); key[r] = asc ? mn : mx; key[rp] = asc ? mx : mn; }
            } else {
#pragma unroll
                for (int r = 0; r < 8; ++r) { const int mine = key[r], o = __builtin_amdgcn_ds_bpermute((lane ^ j) << 2, mine); const bool low = (lane & j) == 0, asc = ((64 * r + lane) & k) == 0;
                    key[r] = (low == asc) ? imin_(mine, o) : imax_(mine, o); }
            }
        }
    }
}
typedef u32x6 P7Row;
#define P7_LD(R_, GO_, TOFS_) { \
    const v4u a_ = __builtin_bit_cast(v4u, __builtin_amdgcn_raw_buffer_load_b128(tab, voa_ + GO_, TOFS_, 0)); \
    const v2u b_ = __builtin_bit_cast(v2u, __builtin_amdgcn_raw_buffer_load_b64(tab, vob_ + GO_, TOFS_, 0)); \
    u32x6 r_; r_[0] = a_.x; r_[1] = a_.y; r_[2] = a_.z; r_[3] = a_.w; r_[4] = b_.x; r_[5] = b_.y; R_ = r_; }
#define P7_ADDR(KEY_) const int e_ = ((KEY_) >> 7) & 16383; const int voa_ = e_ * HROWB + ca, vob_ = e_ * HROWB + cb
__device__ __forceinline__ void p7_dot2(float& s0, float& s1, const unsigned (&xp)[16], const bf16x32& uf) {
#pragma unroll
    for (int m = 0; m < 16; m += 2) {
        bf16x2 a; a[0] = uf[2 * m]; a[1] = uf[2 * m + 1]; bf16x2 b; b[0] = uf[2 * m + 2]; b[1] = uf[2 * m + 3];
        const unsigned xa = xp[m], xb = xp[m + 1];
        s0 = __builtin_amdgcn_fdot2_f32_bf16(__builtin_bit_cast(bf16x2, xa), a, s0, false);
        s1 = __builtin_amdgcn_fdot2_f32_bf16(__builtin_bit_cast(bf16x2, xb), b, s1, false); }
}
__device__ __forceinline__ void p7_axpy(f32x2 (&acc)[16], float ck, const f32x32& vf) {
#pragma unroll
    for (int r = 0; r < 16; ++r) { const f32x2 v = (f32x2){vf[2 * r], vf[2 * r + 1]}, c = (f32x2){ck, ck};
        acc[r] = __builtin_elementwise_fma(c, v, acc[r]); asm volatile("" : "+v"(acc[r])); }
}
template <int N> __device__ __forceinline__ float rowror_add(float v) {
    return v + __int_as_float(__builtin_amdgcn_update_dpp(0, __float_as_int(v), 0x120 + N, 0xf, 0xf, false));
}
__device__ __forceinline__ float quarter_sum(float v) { v = rowror_add<8>(v); v = rowror_add<4>(v); v = rowror_add<2>(v); v = rowror_add<1>(v); return v; }
#define P7_UG(R_, GO_, XP_, TOFS_) { const bf16x32 uf_ = __builtin_amdgcn_cvt_scalef32_pk32_bf16_fp6(R_, 1.0f); __builtin_amdgcn_sched_barrier(0); P7_LD(R_, GO_, TOFS_) p7_dot2(s0, s1, XP_, uf_); __builtin_amdgcn_sched_barrier(0); }
#define P7_USTEP(SET_, KK_, XA_, XB_, TOFS_) { \
    const int kn_ = knext; knext = skit[KK_ + NPFU + 1]; P7_ADDR(kn_); \
    float s0 = 0.f, s1 = 0.f; \
    P7_UG(R##SET_##0, 0, XA_, TOFS_) P7_UG(R##SET_##1, 384, XB_, TOFS_) \
    const float t_ = quarter_sum(s0 + s1); zreg = li == k8 + KK_ ? t_ : zreg; \
    __builtin_amdgcn_sched_barrier(0); }
#define P7_UPROLOGUE(TOFS_) { \
    { P7_ADDR(skq[0]); P7_LD(R00, 0, TOFS_) P7_LD(R01, 384, TOFS_) } { P7_ADDR(skq[1]); P7_LD(R10, 0, TOFS_) P7_LD(R11, 384, TOFS_) } \
    { P7_ADDR(skq[2]); P7_LD(R20, 0, TOFS_) P7_LD(R21, 384, TOFS_) } { P7_ADDR(skq[3]); P7_LD(R30, 0, TOFS_) P7_LD(R31, 384, TOFS_) } \
    { P7_ADDR(skq[4]); P7_LD(R40, 0, TOFS_) P7_LD(R41, 384, TOFS_) } { P7_ADDR(skq[5]); P7_LD(R50, 0, TOFS_) P7_LD(R51, 384, TOFS_) } \
    { P7_ADDR(skq[6]); P7_LD(R60, 0, TOFS_) P7_LD(R61, 384, TOFS_) } { P7_ADDR(skq[7]); P7_LD(R70, 0, TOFS_) P7_LD(R71, 384, TOFS_) } }
#define P7_USWEEP(XA_, XB_, TOFS_, SECOND_) { \
    P7_UPROLOGUE(TOFS_) \
    int knext = skq[NPFU]; \
    _Pragma("unroll 1") for (int it = 0; it < 8; ++it) { \
        float zreg = 0.f; \
        _Pragma("unroll 1") for (int k8 = 0; k8 < 16; k8 += 8) { \
            const LAS int* skit = skq + 16 * it + k8; \
            P7_USTEP(0, 0, XA_, XB_, TOFS_) P7_USTEP(1, 1, XA_, XB_, TOFS_) P7_USTEP(2, 2, XA_, XB_, TOFS_) P7_USTEP(3, 3, XA_, XB_, TOFS_) \
            P7_USTEP(4, 4, XA_, XB_, TOFS_) P7_USTEP(5, 5, XA_, XB_, TOFS_) P7_USTEP(6, 6, XA_, XB_, TOFS_) P7_USTEP(7, 7, XA_, XB_, TOFS_) } \
          \
        if (!SECOND_) wcf[128 * lq + 16 * it + li] = zreg; \
        else { const int pr = skq[16 * it + li] & 127; const float z_ = zreg + wcf[128 * lq + 16 * it + li]; \
            wcf[128 * lq + 16 * it + li] = gelu_erf(z_ * wsu[128 * lq + pr]) * wgv[128 * lq + pr]; } } }
#define P7_VG(R_, GO_, ACC_, TOFS_) { const f32x32 vf_ = __builtin_amdgcn_cvt_scalef32_pk32_f32_fp6(R_, 1.0f); __builtin_amdgcn_sched_barrier(0); P7_LD(R_, GO_, TOFS_) p7_axpy(ACC_, ck_, vf_); __builtin_amdgcn_sched_barrier(0); }
#define P7_VSTEP(SET_, KK_, AA_, AB_, TOFS_) { \
    const int kn_ = knext; knext = skit[KK_ + NPFV + 1]; const float ck_ = cnext; cnext = cfit[KK_ + 1]; P7_ADDR(kn_); \
    P7_VG(R##SET_##0, 0, AA_, TOFS_) P7_VG(R##SET_##1, 384, AB_, TOFS_) }
#define P7_VSWEEP(AA_, AB_, TOFS_) { \
    { P7_ADDR(skq[0]); P7_LD(R00, 0, TOFS_) P7_LD(R01, 384, TOFS_) } { P7_ADDR(skq[1]); P7_LD(R10, 0, TOFS_) P7_LD(R11, 384, TOFS_) } \
    { P7_ADDR(skq[2]); P7_LD(R20, 0, TOFS_) P7_LD(R21, 384, TOFS_) } { P7_ADDR(skq[3]); P7_LD(R30, 0, TOFS_) P7_LD(R31, 384, TOFS_) } \
    const LAS float* cfq = wcf + 128 * lq; \
    int knext = skq[NPFV]; float cnext = cfq[0]; \
    _Pragma("unroll 1") for (int k4 = 0; k4 < 128; k4 += 4) { \
        const LAS int* skit = skq + k4; const LAS float* cfit = cfq + k4; \
        P7_VSTEP(0, 0, AA_, AB_, TOFS_) P7_VSTEP(1, 1, AA_, AB_, TOFS_) P7_VSTEP(2, 2, AA_, AB_, TOFS_) P7_VSTEP(3, 3, AA_, AB_, TOFS_) } }
template <class BarT>
__device__ __forceinline__ void p7_peer(Frame& F, const BarT& gbar) {
    const int gw = F.vcu * NWAVES + F.wave, NGW = F.G * NWAVES, lane_in = F.lane;
    LAS f32x4* lg = (LAS f32x4*)(F.lds + LN2G_OFF); LAS f32x4* lb = (LAS f32x4*)(F.lds + LNP_OFF);
    LAS f32x4* l1g = lb + 512; LAS f32x4* l1b = l1g + 512;
    static_assert(LNP_OFF + 3 * 8192 <= LDS_BYTES && LN2G_OFF + 8192 <= LDSCTL_OFF, "LDS map of the PEER phase");
    for (int i = F.tid; i < 512; i += NWAVES * 64) { lg[i] = ((const GAS f32x4*)F.ln2g)[i]; lb[i] = ((const GAS f32x4*)F.ln2b)[i]; l1g[i] = ((const GAS f32x4*)F.ln1g)[i]; l1b[i] = ((const GAS f32x4*)F.ln1b)[i]; }
    LDS_WAIT(); __syncthreads();
    LAS int* wkeys = (LAS int*)(F.lds + RING_OFF + F.wave * P7_WBYTES);
    LAS float* wsu = (LAS float*)(wkeys + P7_SKEYS); LAS float* wgv = wsu + 512; LAS float* wcf = wgv + 512;
    const __amdgpu_buffer_rsrc_t tab = __builtin_amdgcn_make_buffer_rsrc((void*)F.U8, 0, TAB_V_OFS + NE * ROWB, 0x00020000);
#pragma unroll 1
    for (int tg = gw; tg < S / 4; tg += NGW) {
        const int tb = 4 * tg;
        int lane = lane_in; asm volatile("" : "+v"(lane));
        const int lq = lane >> 4, li = lane & 15, tok = tb + lq;
        const int ca = 16 * li, cb = 256 + 8 * li;
        v2u yraw[4][8];
        const float st1 = F.STAT[2 * tok], st2 = F.STAT[2 * tok + 1];
#pragma unroll
        for (int g = 0; g < 4; ++g)
#pragma unroll
            for (int a = 0; a < 8; ++a) yraw[g][a] = ((const GAS v2u*)(F.Y + (size_t)tok * D) + (16 * g + li))[64 * a];
        int key[8];
#pragma unroll
        for (int s = 0; s < 4; ++s)
#pragma unroll
            for (int h = 0; h < 2; ++h) { const size_t o = (size_t)(tb + s) * NPAIR + 64 * h + lane;
                key[2 * s + h] = (s << 21) | (F.IDX[o] << 7) | (64 * h + lane); wgv[128 * s + 64 * h + lane] = F.GV[o]; wsu[128 * s + 64 * h + lane] = F.SU[o]; }
        unsigned xp0[16], xp1[16], xp2[16], xp3[16];
        const float mu = st1 * (1.f / D), rs_ = 1.f / sqrtf(fmaxf(st2 * (1.f / D) - mu * mu, 0.f) + LN_EPS);
#define P7_X1PK(W_, LO_) pk2(rs_ * (bf_lo(LO_ ? W_.x : W_.y) - mu * (LO_ ? g.x : g.z)) + (LO_ ? b.x : b.z), rs_ * (bf_hi(LO_ ? W_.x : W_.y) - mu * (LO_ ? g.y : g.w)) + (LO_ ? b.y : b.w))
#pragma unroll
        for (int a = 0; a < 8; ++a) {
            asm volatile("" ::: "memory"); __builtin_amdgcn_sched_barrier(0);
            { const f32x4 g = l1g[li + 64 * a], b = l1b[li + 64 * a]; const v2u w = yraw[0][a]; xp0[2 * a] = P7_X1PK(w, true); xp0[2 * a + 1] = P7_X1PK(w, false); asm volatile("" : "+v"(xp0[2 * a]), "+v"(xp0[2 * a + 1])); }
            { const f32x4 g = l1g[16 + li + 64 * a], b = l1b[16 + li + 64 * a]; const v2u w = yraw[1][a]; xp1[2 * a] = P7_X1PK(w, true); xp1[2 * a + 1] = P7_X1PK(w, false); asm volatile("" : "+v"(xp1[2 * a]), "+v"(xp1[2 * a + 1])); }
            { const f32x4 g = l1g[32 + li + 64 * a], b = l1b[32 + li + 64 * a]; const v2u w = yraw[2][a]; xp2[2 * a] = P7_X1PK(w, true); xp2[2 * a + 1] = P7_X1PK(w, false); asm volatile("" : "+v"(xp2[2 * a]), "+v"(xp2[2 * a + 1])); }
            { const f32x4 g = l1g[48 + li + 64 * a], b = l1b[48 + li + 64 * a]; const v2u w = yraw[3][a]; xp3[2 * a] = P7_X1PK(w, true); xp3[2 * a + 1] = P7_X1PK(w, false); asm volatile("" : "+v"(xp3[2 * a]), "+v"(xp3[2 * a + 1])); } }
        p7_sort512(key, lane);
#pragma unroll
        for (int r = 0; r < 8; ++r) wkeys[64 * r + lane] = key[r];
        if (lane < P7_SKEYS - 512) wkeys[512 + lane] = key[7];
        const LAS int* skq = wkeys + 128 * lq;
        P7Row R00, R01, R10, R11, R20, R21, R30, R31, R40, R41, R50, R51, R60, R61, R70, R71;
        P7_USWEEP(xp0, xp1, 0, false)
        P7_USWEEP(xp2, xp3, HALF_TAB, true)
        f32x2 ap0[16], ap1[16], ap2[16], ap3[16];
#pragma unroll
        for (int r = 0; r < 16; ++r) { ap0[r] = (f32x2){0.f, 0.f}; ap1[r] = (f32x2){0.f, 0.f}; ap2[r] = (f32x2){0.f, 0.f}; ap3[r] = (f32x2){0.f, 0.f}; }
        P7_VSWEEP(ap0, ap1, TAB_V_OFS)
        P7_VSWEEP(ap2, ap3, TAB_V_OFS + HALF_TAB)
        float acc0[32], acc1[32], acc2[32], acc3[32];
#pragma unroll
        for (int r = 0; r < 16; ++r) { acc0[2 * r] = ap0[r].x; acc0[2 * r + 1] = ap0[r].y; acc1[2 * r] = ap1[r].x; acc1[2 * r + 1] = ap1[r].y; acc2[2 * r] = ap2[r].x; acc2[2 * r + 1] = ap2[r].y; acc3[2 * r] = ap3[r].x; acc3[2 * r + 1] = ap3[r].y; }
        int tbe = 4 * tg; asm volatile("" : "+s"(tbe));
        int l2 = lane_in; asm volatile("" : "+v"(l2));
        const int eq = l2 >> 4, ei = l2 & 15, etok = tbe + eq;
        const float e1 = F.STAT[2 * etok], e2 = F.STAT[2 * etok + 1];
        const float emu = e1 * (1.f / D), ers = 1.f / sqrtf(fmaxf(e2 * (1.f / D) - emu * emu, 0.f) + LN_EPS);
#define P7_X1E(W_, LO_) pk2(ers * (bf_lo(LO_ ? W_.x : W_.y) - emu * (LO_ ? g.x : g.z)) + (LO_ ? b.x : b.z), ers * (bf_hi(LO_ ? W_.x : W_.y) - emu * (LO_ ? g.y : g.w)) + (LO_ ? b.y : b.w))
#define P7_EPI_ADD(ACC_, G_) { \
        v2u yr_[8]; \
        _Pragma("unroll") for (int a = 0; a < 8; ++a) yr_[a] = ((const GAS v2u*)(F.Y + (size_t)etok * D) + (16 * G_ + ei))[64 * a]; \
        _Pragma("unroll") for (int a = 0; a < 8; ++a) { const v2u w = yr_[a]; const f32x4 g = l1g[16 * G_ + ei + 64 * a], b = l1b[16 * G_ + ei + 64 * a]; \
            const unsigned xa = P7_X1E(w, true), xb = P7_X1E(w, false);        \
            ACC_[4 * a + 0] = fmaf(ALPHA, bf_lo(xa), ACC_[4 * a + 0]); ACC_[4 * a + 1] = fmaf(ALPHA, bf_hi(xa), ACC_[4 * a + 1]); \
            ACC_[4 * a + 2] = fmaf(ALPHA, bf_lo(xb), ACC_[4 * a + 2]); ACC_[4 * a + 3] = fmaf(ALPHA, bf_hi(xb), ACC_[4 * a + 3]); } \
        _Pragma("unroll") for (int r = 0; r < 32; ++r) { asm volatile("" : "+v"(ACC_[r])); sum += ACC_[r]; } asm volatile("" : "+v"(sum)); }
        float sum = 0.f;
#define P7_FENCE() asm volatile("" ::: "memory"); __builtin_amdgcn_sched_barrier(0)
        P7_FENCE(); P7_EPI_ADD(acc0, 0) P7_FENCE(); P7_EPI_ADD(acc1, 1) P7_FENCE(); P7_EPI_ADD(acc2, 2) P7_FENCE(); P7_EPI_ADD(acc3, 3) P7_FENCE();
        float mean = quarter_sum(sum) * (1.f / D); float sq = 0.f; asm volatile("" : "+v"(mean));
#define P7_EPI_VAR(ACC_) { _Pragma("unroll") for (int r = 0; r < 32; ++r) { ACC_[r] -= mean; sq = fmaf(ACC_[r], ACC_[r], sq); asm volatile("" : "+v"(ACC_[r])); } asm volatile("" : "+v"(sq)); }
        P7_FENCE(); P7_EPI_VAR(acc0) P7_FENCE(); P7_EPI_VAR(acc1) P7_FENCE(); P7_EPI_VAR(acc2) P7_FENCE(); P7_EPI_VAR(acc3) P7_FENCE();
        float rstd = 1.f / sqrtf(quarter_sum(sq) * (1.f / D) + LN_EPS); asm volatile("" : "+v"(rstd));
        GAS f32x4* orow = (GAS f32x4*)(F.out + (size_t)etok * D) + ei;
#define P7_EPI_OUT(ACC_, G_) { \
        _Pragma("unroll") for (int a = 0; a < 8; ++a) { const f32x4 g = lg[16 * G_ + ei + 64 * a], b = lb[16 * G_ + ei + 64 * a]; \
            f32x4 o; o.x = ACC_[4 * a + 0] * rstd * g.x + b.x; o.y = ACC_[4 * a + 1] * rstd * g.y + b.y; o.z = ACC_[4 * a + 2] * rstd * g.z + b.z; o.w = ACC_[4 * a + 3] * rstd * g.w + b.w; \
            __builtin_nontemporal_store(o, orow + 16 * G_ + 64 * a); } }
        P7_FENCE(); P7_EPI_OUT(acc0, 0) P7_FENCE(); P7_EPI_OUT(acc1, 1) P7_FENCE(); P7_EPI_OUT(acc2, 2) P7_FENCE(); P7_EPI_OUT(acc3, 3)
    }
}
struct Args { const float* in[19]; float* out; unsigned char* ws; int ph_lo, ph_hi, li, pad; };
__global__ void __launch_bounds__(NWAVES * 64, 2) peer_layer_fwd(Args args) {
    extern __shared__ __attribute__((aligned(16))) unsigned char lds[];
    Frame F;
    F.lds = (LAS unsigned char*)lds;
    F.MISC = (volatile LAS unsigned*)(F.lds + MISC_OFF);
    F.tid = threadIdx.x; F.lane = F.tid & 63; F.wave = __builtin_amdgcn_readfirstlane(F.tid >> 6);
    F.G = gridDim.x; { const int bx = blockIdx.x; F.vcu = (F.G % 8 == 0) ? (bx % 8) * (F.G / 8) + bx / 8 : bx; }
    unsigned char* ws = args.ws;
    F.ctl = (gu32*)(ws + WS_CTL);
    F.x = args.in[0]; F.w_in = args.in[1]; F.b_in = args.in[2]; F.ccw = args.in[3]; F.ccb = args.in[4]; F.clg = args.in[5]; F.clb = args.in[6];
    F.scw = args.in[7]; F.scbias = args.in[8]; F.w_out = args.in[9]; F.b_out = args.in[10]; F.ln1g = args.in[11]; F.ln1b = args.in[12];
    F.w_q = args.in[13]; F.sub_keys = args.in[14]; F.peer_u = args.in[15]; F.peer_v = args.in[16]; F.ln2g = args.in[17]; F.ln2b = args.in[18];
    F.out = args.out;
    F.XB = (bf16*)(ws + WS_XB); F.BT1 = (bf16*)(ws + WS_BT1); F.BT2 = (bf16*)(ws + WS_BT2); F.BT3 = (bf16*)(ws + WS_BT3);
    F.AGLU = (bf16*)(ws + WS_AGLU); F.CV = (bf16*)(ws + WS_CV); F.SCB = (bf16*)(ws + WS_SCB); F.MIX = (bf16*)(ws + WS_MIX); F.X1 = (bf16*)(ws + WS_X1);
    F.Y = (bf16*)(ws + WS_Y); F.SS = (float*)(ws + WS_S); F.IDX = (int*)(ws + WS_IDX); F.GV = (float*)(ws + WS_GV); F.SU = (float*)(ws + WS_SU);
    F.STAT = (float*)(ws + WS_STAT); F.C12 = (float*)(ws + WS_C12);
    F.U8 = ws + WS_U8; F.V8 = ws + WS_V8; F.USC = (float*)(ws + WS_USC); F.VSC = (float*)(ws + WS_VSC);
    for (int u = F.tid; u < (LDS_BYTES - LDSCTL_OFF) / 4; u += NWAVES * 64) ((LAS unsigned*)(F.lds + LDSCTL_OFF))[u] = 0u;
    __syncthreads();
    XcdBarrier bar; bar.bar = (unsigned*)(F.ctl + CW_BAR); bar.x = 0; bar.st = nullptr;
    if (N_LAUNCHES == 1) bar = xcd_barrier_post((unsigned*)(F.ctl + CW_BAR), F.MISC + 8);
    const int lo = args.ph_lo, hi = args.ph_hi;
#ifndef ONLY_PHASE
#define ONLY_PHASE -1
#endif
#define IN(k) ((k) != 4 && (k) != 6 && (ONLY_PHASE < 0 || ONLY_PHASE == (k)) && lo <= (k) && (k) < hi)
#define SEAM(k) do { if (IN(k) && IN((k) + 1)) xcd_barrier(bar); } while (0)
#ifndef REPEAT_PHASE
#define REPEAT_PHASE -1
#endif
#define REPS(k) for (int rep_ = 0; rep_ < (REPEAT_PHASE == (k) ? 2 : 1); ++rep_)
#ifndef PROBE_STRETCH
#define PROBE_STRETCH -1
#endif
#define T_BEGIN(k) const unsigned long long tb_##k = (PROBE_STRETCH == (k)) ? __builtin_amdgcn_s_memrealtime() : 0ull
#define T_END(k) do { if (PROBE_STRETCH == (k)) { const unsigned long long te_ = __builtin_amdgcn_s_memrealtime(); while (__builtin_amdgcn_s_memrealtime() - te_ < te_ - tb_##k) __builtin_amdgcn_s_sleep(8); } } while (0)

    if (IN(0)) { T_BEGIN(0); REPS(0) p0_prologue(F); T_END(0); SEAM(0); }
    if (IN(1)) { T_BEGIN(1); REPS(1) {
        if (F.G == 256) { if (blockIdx.x >= 128) p0_peer_tables(F, ((int)blockIdx.x - 128) * NWAVES + F.wave, 128 * NWAVES); }
        else p0_peer_tables(F, F.vcu * NWAVES + F.wave, F.G * NWAVES);
        p1_c12(F);
        __syncthreads();
        pg8::Gemm g{F.XB, F.BT1, S, NIN, D}; pg8::StaticOrder So; So.init(S, NIN, F.G, (int)blockIdx.x);
        pg8::EpiInProj E{F.AGLU, F.CV, F.SCB, F.b_in};
        pg8::gemm_phase<pg8::EpiInProj, pg8::StaticOrder, PG8_ALIGN, PG8_SP2>(F.lds + RING_OFF, g, So, E); }
        T_END(1); SEAM(1);
    }
    if (IN(2)) { T_BEGIN(2); REPS(2) for (int u = F.vcu; u < S / 32; u += F.G) p2_unit(F, u); T_END(2); SEAM(2); }
    if (IN(3)) { T_BEGIN(3); REPS(3) {
        pg8::Gemm g{F.MIX, F.BT2, S, D, D}; pg8::StaticOrder So; So.init(S, D, F.G, (int)blockIdx.x);
        pg8::EpiOutProj E{F.Y, F.b_out, F.XB, F.ln1g, F.STAT, ALPHA};
        pg8::gemm_phase<pg8::EpiOutProj, pg8::StaticOrder, PG8_ALIGN, PG8_SP2>(F.lds + RING_OFF, g, So, E); }
        T_END(3); if (IN(3) && IN(5)) xcd_barrier(bar);
    }
    if (IN(5)) { T_BEGIN(5); REPS(5) {
        pg8::Gemm g{F.Y, F.BT3, S, D, D}; pg8::StaticOrder So; So.init(S, D, F.G, (int)blockIdx.x);
        EpiScoreTopk E{F.STAT, F.C12, LN_EPS, F.IDX, F.GV, F.SU, F.USC, F.VSC};
        pg8::gemm_phase<EpiScoreTopk, pg8::StaticOrder, false, PG8_SP2>(F.lds + RING_OFF, g, So, E); }
        T_END(5); if (IN(5) && IN(7)) xcd_barrier(bar);
    }
    if (IN(7)) { T_BEGIN(7); REPS(7) p7_peer(F, bar); T_END(7); }
#undef IN
#undef SEAM
}

extern "C" void kernel_launch(void* const* d_in, const int* in_sizes, int n_in, void* d_out, int out_size, void* d_ws, size_t ws_size, hipStream_t stream) {
    static int grid = 0;
    if (grid == 0) {
        if (n_in != 19 || in_sizes[0] != S * D || out_size != S * D || ws_size < WS_END) {
            fprintf(stderr, "kernel_launch: built for 19 inputs, x/out of %d floats, >= %zu bytes of workspace; got n_in %d, in0 %d, out %d, ws %zu; nothing launched\n", S * D, (size_t)WS_END, n_in, n_in > 0 ? in_sizes[0] : -1, out_size, ws_size);
            grid = -1; return; }
        int dev = 0, cus = 0, per_cu = 0;
        if (hipGetDevice(&dev) != hipSuccess || hipDeviceGetAttribute(&cus, hipDeviceAttributeMultiprocessorCount, dev) != hipSuccess) { fprintf(stderr, "kernel_launch: device query failed\n"); grid = -1; return; }
        if (hipFuncSetAttribute((const void*)peer_layer_fwd, hipFuncAttributeMaxDynamicSharedMemorySize, LDS_BYTES) != hipSuccess) { fprintf(stderr, "kernel_launch: hipFuncSetAttribute failed\n"); grid = -1; return; }
        if (hipOccupancyMaxActiveBlocksPerMultiprocessor(&per_cu, (const void*)peer_layer_fwd, NWAVES * 64, LDS_BYTES) != hipSuccess || per_cu < 1) {
            fprintf(stderr, "kernel_launch: occupancy query reports %d workgroups per CU; nothing launched\n", per_cu); (void)hipGetLastError(); grid = -1; return; }
        (void)hipGetLastError();
        grid = cus;
    }
    if (grid < 0) return;
    if (hipMemsetAsync((char*)d_ws + WS_CTL, 0, CTL_ZERO_BYTES, stream) != hipSuccess) { fprintf(stderr, "kernel_launch: hipMemsetAsync failed\n"); return; }
    Args a{};
    for (int i = 0; i < 19; ++i) a.in[i] = (const float*)d_in[i];
    a.out = (float*)d_out; a.ws = (unsigned char*)d_ws;
    for (int li = 0; li < N_LAUNCHES; ++li) {
        a.ph_lo = (N_LAUNCHES == 1) ? 0 : li; a.ph_hi = (N_LAUNCHES == 1) ? N_PHASES : li + 1; a.li = li;
        hipError_t le;
        if (N_LAUNCHES == 1) { void* kargs[] = {&a}; le = hipLaunchCooperativeKernel((const void*)peer_layer_fwd, dim3(grid), dim3(NWAVES * 64), kargs, LDS_BYTES, stream); }
        else { hipLaunchKernelGGL(peer_layer_fwd, dim3(grid), dim3(NWAVES * 64), LDS_BYTES, stream, a); le = hipPeekAtLastError(); }
        if (le != hipSuccess) { fprintf(stderr, "kernel_launch: launch %d failed: %s (grid %d x %d threads, %d B LDS)\n", li, hipGetErrorName(le), grid, NWAVES * 64, LDS_BYTES); break; }
    }
}
```
